# Optimizing an MI355X kernel written in HIP

```python
import math
import jax, jax.numpy as jnp
from jax import lax
import numpy as np

D_MODEL = 1024
BATCH = 32
SEQ = 2048
DEPTH = 2
DEC_BATCH = 16
DEC_SEQ = 64
PAST_LEN = 2048

CHUNK = 64
N_META = 16
RMS_EPS = 1e-6
SSD_HEADS = 16
SSD_HEAD_DIM = 64
SSD_GROUPS = 2
SSD_HPG = SSD_HEADS // SSD_GROUPS
SSD_STATE = 64
SSD_WIDTH = SSD_HEADS * SSD_HEAD_DIM
CONV_W = 4
CONV_DIM = SSD_WIDTH + 2 * SSD_GROUPS * SSD_STATE
S5_WIDTH = D_MODEL // 2
S5_GROUP_CH = 16
S5_GROUPS = S5_WIDTH // S5_GROUP_CH
S5_STATE = 64
SB_HEADS = 8
SB_HEAD_DIM = 64
SB_WIDTH = SB_HEADS * SB_HEAD_DIM
SB_BLOCK = 128
SB_SCALE = 1.0 / math.sqrt(SB_HEAD_DIM)
N_BRANCH = 3
D_FF = 4 * D_MODEL
OFF_Z = 0
OFF_XBC = OFF_Z + SSD_WIDTH
OFF_DT = OFF_XBC + CONV_DIM
OFF_U = OFF_DT + SSD_HEADS
OFF_Q = OFF_U + S5_WIDTH
OFF_K = OFF_Q + SB_WIDTH
OFF_V = OFF_K + SB_WIDTH
OFF_GATE = OFF_V + SB_WIDTH
IN_COLS = OFF_GATE + N_BRANCH * D_MODEL

kernel_name = 'hybrid_ssd_s5_stickbreak_stream_step'


def rmsnorm(x, g):
    xf = x.astype(jnp.float32)
    return (xf * lax.rsqrt(jnp.mean(xf * xf, axis=-1, keepdims=True) + RMS_EPS)).astype(x.dtype) * g


def causal_dwconv(x, hist, w, b):
    xp = jnp.concatenate([hist.astype(x.dtype), x], axis=1)
    T = x.shape[1]
    y = b
    for k in range(CONV_W):
        y = y + xp[:, k:k + T] * w[k]
    return y, xp[:, -(CONV_W - 1):]


def ssd_scan(x, dt, a, bm, cm, s0):
    bsz, T = x.shape[:2]
    nc = T // CHUNK
    blk = lambda t: t.reshape((bsz, nc, CHUNK) + t.shape[2:])
    x, dt, bm, cm = blk(x), blk(dt), blk(bm), blk(cm)
    a_cum = jnp.cumsum(dt * a, axis=2)
    seg = a_cum[:, :, :, None] - a_cum[:, :, None]
    causal = jnp.tril(jnp.ones((CHUNK, CHUNK), bool))[:, :, None, None]
    decay = jnp.exp(jnp.where(causal, seg, -jnp.inf))
    cb = jnp.einsum('bcign,bcjgn->bcijg', cm, bm)
    y_diag = jnp.einsum('bcijgh,bcjghp->bcighp', cb[..., None] * decay * dt[:, :, None], x)
    to_end = jnp.exp(a_cum[:, :, -1:] - a_cum) * dt
    blk_states = jnp.einsum('bcjgn,bcjgh,bcjghp->bcghpn', bm, to_end, x)
    blk_decay = jnp.exp(a_cum[:, :, -1])

    def step(s, inp):
        dec, st = inp
        return dec[..., None, None] * s + st, s

    s_final, s_in = lax.scan(step, s0.astype(jnp.float32),
                             (jnp.moveaxis(blk_decay, 1, 0), jnp.moveaxis(blk_states, 1, 0)))
    s_in = jnp.moveaxis(s_in, 0, 1)
    y_off = jnp.einsum('bcign,bcghpn,bcigh->bcighp', cm, s_in, jnp.exp(a_cum))
    return (y_diag + y_off).reshape((bsz, T) + x.shape[3:]), s_final


def ssd_branch(h, w_z, w_xbc, w_dt, conv_hist, s0, conv_w, conv_b, dt_bias, a_log, d_skip, norm_w, front):
    bsz, T, _ = h.shape
    z = h @ w_z
    xbc, conv_new = causal_dwconv(h @ w_xbc, conv_hist, conv_w, conv_b)
    xbc = jax.nn.silu(xbc)
    n_bc = SSD_GROUPS * SSD_STATE
    xs = xbc[..., :SSD_WIDTH].reshape(bsz, T, SSD_GROUPS, SSD_HPG, SSD_HEAD_DIM)
    bm = xbc[..., SSD_WIDTH:SSD_WIDTH + n_bc].reshape(bsz, T, SSD_GROUPS, SSD_STATE)
    cm = xbc[..., SSD_WIDTH + n_bc:].reshape(bsz, T, SSD_GROUPS, SSD_STATE)
    dt = jax.nn.softplus((h @ w_dt + dt_bias).astype(jnp.float32)).reshape(bsz, T, SSD_GROUPS, SSD_HPG)
    a = -jnp.exp(a_log.astype(jnp.float32)).reshape(SSD_GROUPS, SSD_HPG)
    back = (-(front + T)) % CHUNK
    pad = lambda t: jnp.pad(t, [(0, 0), (front, back)] + [(0, 0)] * (t.ndim - 2))
    y, s_new = ssd_scan(pad(xs), pad(dt), a, pad(bm), pad(cm), s0)
    y = y[:, front:front + T] + d_skip.reshape(SSD_GROUPS, SSD_HPG)[:, :, None] * xs
    y = y.reshape(bsz, T, SSD_WIDTH) * jax.nn.silu(z)
    gw = SSD_WIDTH // SSD_GROUPS
    y = rmsnorm(y.reshape(bsz, T, SSD_GROUPS, gw), norm_w.reshape(SSD_GROUPS, gw)).reshape(bsz, T, SSD_WIDTH)
    return y.astype(h.dtype), conv_new, s_new


def _complex_affine_combine(e1, e2):
    ar1, ai1, br1, bi1 = e1
    ar2, ai2, br2, bi2 = e2
    return (ar1 * ar2 - ai1 * ai2, ar1 * ai2 + ai1 * ar2,
            ar2 * br1 - ai2 * bi1 + br2, ar2 * bi1 + ai2 * br1 + bi2)


def s5_branch(u, s_re0, s_im0, lam_re, lam_im, log_step, b_re, b_im, c_re, c_im, d_skip):
    f32 = jnp.float32
    bsz, T, _ = u.shape
    ug = u.reshape(bsz, T, S5_GROUPS, S5_GROUP_CH).astype(f32)
    lr, li = lam_re.astype(f32), lam_im.astype(f32)
    step = jnp.exp(log_step.astype(f32))[:, None]
    mag = jnp.exp(lr * step)
    ab_re, ab_im = mag * jnp.cos(li * step), mag * jnp.sin(li * step)
    den = lr * lr + li * li
    nr = ab_re - 1.0
    f_re = (nr * lr + ab_im * li) / den
    f_im = (ab_im * lr - nr * li) / den
    br, bi = b_re.astype(f32), b_im.astype(f32)
    bb_re = f_re[..., None] * br - f_im[..., None] * bi
    bb_im = f_re[..., None] * bi + f_im[..., None] * br
    bu_re = jnp.einsum('btgh,gph->btgp', ug, bb_re)
    bu_im = jnp.einsum('btgh,gph->btgp', ug, bb_im)
    sr, si = s_re0.astype(f32), s_im0.astype(f32)
    bu_re = bu_re.at[:, 0].add(ab_re * sr - ab_im * si)
    bu_im = bu_im.at[:, 0].add(ab_re * si + ab_im * sr)
    a_re = jnp.broadcast_to(ab_re, (1, T) + ab_re.shape)
    a_im = jnp.broadcast_to(ab_im, (1, T) + ab_im.shape)
    _, _, x_re, x_im = lax.associative_scan(_complex_affine_combine, (a_re, a_im, bu_re, bu_im), axis=1)
    y = (jnp.einsum('btgp,ghp->btgh', x_re, c_re.astype(f32))
         - jnp.einsum('btgp,ghp->btgh', x_im, c_im.astype(f32)) + d_skip * ug)
    return y.reshape(bsz, T, S5_WIDTH).astype(u.dtype), x_re[:, -1], x_im[:, -1]


def stick_breaking(q, k, v):
    tq, tk = q.shape[1], k.shape[1]
    n_hist = tk - tq
    outs = []
    for start in range(0, tq, SB_BLOCK):
        end = min(start + SB_BLOCK, tq)
        kend = n_hist + end
        z = jnp.einsum('bqhd,bkhd->bhqk', q[:, start:end], k[:, :kend]).astype(jnp.float32) * SB_SCALE
        q_pos = n_hist + jnp.arange(start, end)
        k_pos = jnp.arange(kend)
        mask = k_pos[None, :] < q_pos[:, None]
        log_keep = jnp.where(mask, jax.nn.log_sigmoid(-z), 0.0)
        later = lax.cumsum(log_keep, axis=3, reverse=True) - log_keep
        w = jnp.where(mask, jnp.exp(jax.nn.log_sigmoid(z) + later), 0.0)
        outs.append(jnp.einsum('bhqk,bkhd->bqhd', w.astype(v.dtype), v[:, :kend]))
    return jnp.concatenate(outs, axis=1)


def trunk_layer(x, k_hist, v_hist, conv_hist, ssd_s0, s5_re0, s5_im0, front, lp):
    bsz, T, _ = x.shape
    w_in = lp['w_in']
    col = lambda off, n: w_in[:, off:off + n]
    h = rmsnorm(x, lp['norm_mix'])
    y_a, conv_new, ssd_new = ssd_branch(h, col(OFF_Z, SSD_WIDTH), col(OFF_XBC, CONV_DIM), col(OFF_DT, SSD_HEADS),
                                        conv_hist, ssd_s0, lp['conv_w'], lp['conv_b'], lp['dt_bias'],
                                        lp['a_log'], lp['d_ssd'], lp['norm_ssd'], front)
    y_b, s5_re, s5_im = s5_branch(h @ col(OFF_U, S5_WIDTH), s5_re0, s5_im0, lp['lam_re'], lp['lam_im'],
                                  lp['log_step'], lp['b_re'], lp['b_im'], lp['c_re'], lp['c_im'], lp['d_s5'])
    glu = jax.nn.gelu(y_b) @ lp['w_glu']
    out_b = glu[..., :D_MODEL] * jax.nn.sigmoid(glu[..., D_MODEL:])
    heads = lambda t: t.reshape(bsz, T, SB_HEADS, SB_HEAD_DIM)
    q = rmsnorm(heads(h @ col(OFF_Q, SB_WIDTH)), lp['q_norm'])
    k = rmsnorm(heads(h @ col(OFF_K, SB_WIDTH)), lp['k_norm'])
    v = heads(h @ col(OFF_V, SB_WIDTH))
    o_c = stick_breaking(q, jnp.concatenate([k_hist.astype(k.dtype), k], axis=1),
                         jnp.concatenate([v_hist.astype(v.dtype), v], axis=1))
    gates = jax.nn.sigmoid(h @ col(OFF_GATE, N_BRANCH * D_MODEL)).reshape(bsz, T, N_BRANCH, D_MODEL)
    mix = (gates[:, :, 0] * (y_a @ lp['w_lift_a']) + gates[:, :, 1] * out_b
           + gates[:, :, 2] * (o_c.reshape(bsz, T, SB_WIDTH) @ lp['w_lift_c']))
    x = x + mix @ lp['w_out']
    h2 = rmsnorm(x, lp['norm_ffn'])
    x = x + jnp.square(jax.nn.relu(h2 @ lp['w_up'])) @ lp['w_down']
    return x, k, v, conv_new, ssd_new, s5_re, s5_im


def setup_inputs(seed: int = 0) -> dict:
    key = jax.random.key(seed)
    ks = jax.random.split(key, 40)
    f32 = jnp.float32
    L = DEPTH

    def nrm(i, shape, scale):
        return jax.random.normal(ks[i], shape, f32) * scale

    def unif(i, shape, lo, hi):
        return jax.random.uniform(ks[i], shape, f32, lo, hi)

    dt0 = jnp.exp(unif(13, (L, SSD_HEADS), math.log(1e-3), math.log(1e-1)))
    n = jnp.arange(S5_STATE, dtype=f32)
    return {
        'x_prompt': nrm(0, (BATCH, SEQ, D_MODEL), 1.0),
        'x_sample': nrm(1, (DEC_BATCH, DEC_SEQ, D_MODEL), 1.0),
        'cache_k': nrm(2, (L, DEC_BATCH, PAST_LEN, SB_HEADS, SB_HEAD_DIM), 1.0),
        'cache_v': nrm(3, (L, DEC_BATCH, PAST_LEN, SB_HEADS, SB_HEAD_DIM), 1.0),
        'state_conv': nrm(4, (L, DEC_BATCH, CONV_W - 1, CONV_DIM), 1.0),
        'state_ssd': nrm(5, (L, DEC_BATCH, SSD_GROUPS, SSD_HPG, SSD_HEAD_DIM, SSD_STATE), 0.1),
        'state_s5_re': nrm(6, (L, DEC_BATCH, S5_GROUPS, S5_STATE), 0.1),
        'state_s5_im': nrm(7, (L, DEC_BATCH, S5_GROUPS, S5_STATE), 0.1),
        'meta_tokens': nrm(8, (N_META, D_MODEL), 1.0),
        'norm_mix': 1.0 + nrm(9, (L, D_MODEL), 0.02),
        'w_in': nrm(10, (L, D_MODEL, IN_COLS), D_MODEL ** -0.5),
        'conv_w': nrm(11, (L, CONV_W, CONV_DIM), CONV_W ** -0.5),
        'conv_b': nrm(12, (L, CONV_DIM), 0.01),
        'dt_bias': dt0 + jnp.log(-jnp.expm1(-dt0)),
        'a_log': jnp.log(unif(14, (L, SSD_HEADS), 1.0, 16.0)),
        'd_ssd': 1.0 + nrm(15, (L, SSD_HEADS), 0.02),
        'norm_ssd': 1.0 + nrm(16, (L, SSD_WIDTH), 0.02),
        'lam_re': -0.5 + nrm(17, (L, S5_GROUPS, S5_STATE), 0.01),
        'lam_im': math.pi * n + nrm(18, (L, S5_GROUPS, S5_STATE), 0.01),
        'log_step': unif(19, (L, S5_GROUPS), math.log(1e-3), math.log(1e-1)),
        'b_re': nrm(20, (L, S5_GROUPS, S5_STATE, S5_GROUP_CH), (2 * S5_GROUP_CH) ** -0.5),
        'b_im': nrm(21, (L, S5_GROUPS, S5_STATE, S5_GROUP_CH), (2 * S5_GROUP_CH) ** -0.5),
        'c_re': nrm(22, (L, S5_GROUPS, S5_GROUP_CH, S5_STATE), (2 * S5_STATE) ** -0.5),
        'c_im': nrm(23, (L, S5_GROUPS, S5_GROUP_CH, S5_STATE), (2 * S5_STATE) ** -0.5),
        'd_s5': nrm(24, (L, S5_GROUPS, S5_GROUP_CH), 1.0),
        'w_glu': nrm(25, (L, S5_WIDTH, 2 * D_MODEL), S5_WIDTH ** -0.5),
        'q_norm': 1.0 + nrm(26, (L, SB_HEAD_DIM), 0.02),
        'k_norm': 1.0 + nrm(27, (L, SB_HEAD_DIM), 0.02),
        'w_lift_a': nrm(28, (L, SSD_WIDTH, D_MODEL), SSD_WIDTH ** -0.5),
        'w_lift_c': nrm(29, (L, SB_WIDTH, D_MODEL), SB_WIDTH ** -0.5),
        'w_out': nrm(30, (L, D_MODEL, D_MODEL), D_MODEL ** -0.5),
        'norm_ffn': 1.0 + nrm(31, (L, D_MODEL), 0.02),
        'w_up': nrm(32, (L, D_MODEL, D_FF), D_MODEL ** -0.5),
        'w_down': nrm(33, (L, D_FF, D_MODEL), D_FF ** -0.5),
    }


def reference(x_prompt, x_sample, cache_k, cache_v, state_conv, state_ssd, state_s5_re, state_s5_im,
              meta_tokens, norm_mix, w_in, conv_w, conv_b, dt_bias, a_log, d_ssd, norm_ssd,
              lam_re, lam_im, log_step, b_re, b_im, c_re, c_im, d_s5, w_glu, q_norm, k_norm,
              w_lift_a, w_lift_c, w_out, norm_ffn, w_up, w_down):
    bp = x_prompt.shape[0]
    dtype = x_prompt.dtype
    xp = jnp.concatenate([jnp.broadcast_to(meta_tokens.astype(dtype)[None], (bp, N_META, D_MODEL)), x_prompt], axis=1)
    xs = x_sample
    front_p = (-N_META) % CHUNK
    front_s = PAST_LEN % CHUNK
    kv_empty = jnp.zeros((bp, 0, SB_HEADS, SB_HEAD_DIM), dtype)
    conv_p0 = jnp.zeros((bp, CONV_W - 1, CONV_DIM), dtype)
    ssd_p0 = jnp.zeros((bp, SSD_GROUPS, SSD_HPG, SSD_HEAD_DIM, SSD_STATE), jnp.float32)
    s5_p0 = jnp.zeros((bp, S5_GROUPS, S5_STATE), jnp.float32)
    outs_p, outs_s = [], []
    for l in range(DEPTH):
        lp = {'norm_mix': norm_mix[l], 'w_in': w_in[l], 'conv_w': conv_w[l], 'conv_b': conv_b[l],
              'dt_bias': dt_bias[l], 'a_log': a_log[l], 'd_ssd': d_ssd[l], 'norm_ssd': norm_ssd[l],
              'lam_re': lam_re[l], 'lam_im': lam_im[l], 'log_step': log_step[l], 'b_re': b_re[l],
              'b_im': b_im[l], 'c_re': c_re[l], 'c_im': c_im[l], 'd_s5': d_s5[l], 'w_glu': w_glu[l],
              'q_norm': q_norm[l], 'k_norm': k_norm[l], 'w_lift_a': w_lift_a[l], 'w_lift_c': w_lift_c[l],
              'w_out': w_out[l], 'norm_ffn': norm_ffn[l], 'w_up': w_up[l], 'w_down': w_down[l]}
        xp, *st_p = trunk_layer(xp, kv_empty, kv_empty, conv_p0, ssd_p0, s5_p0, s5_p0, front_p, lp)
        xs, *st_s = trunk_layer(xs, cache_k[l], cache_v[l], state_conv[l], state_ssd[l],
                                state_s5_re[l], state_s5_im[l], front_s, lp)
        outs_p.append(st_p)
        outs_s.append(st_s)
    stk = lambda outs, i: jnp.stack([o[i] for o in outs], axis=0)
    return (xp[:, N_META:], xs,
            stk(outs_p, 0), stk(outs_p, 1), stk(outs_p, 2), stk(outs_p, 3), stk(outs_p, 4), stk(outs_p, 5),
            stk(outs_s, 0), stk(outs_s, 1), stk(outs_s, 2), stk(outs_s, 3), stk(outs_s, 4), stk(outs_s, 5))
```

```cpp
#include <hip/hip_runtime.h>
#include <hip/hip_cooperative_groups.h>
#include <cstdio>
#include <cstdint>
namespace cg = cooperative_groups;

#ifndef MULTI_LAUNCH
#define MULTI_LAUNCH 0
#endif

typedef unsigned short bf16_t;
typedef short bf16x8 __attribute__((ext_vector_type(8)));
typedef float f32x4 __attribute__((ext_vector_type(4)));
typedef unsigned u32x4 __attribute__((ext_vector_type(4)));
typedef unsigned u32x2 __attribute__((ext_vector_type(2)));
#define LAS __attribute__((address_space(3)))

constexpr int D = 1024, NROWS = 67072, NS0 = 65536, NM0 = 66560;
constexpr int TP = 2064, TS = 64, NB_P = 32, NB_S = 16, PAST = 2048;
constexpr int IN_COLS = 7440, N1 = 7680;
constexpr int SSQ_SLOTS = NM0 + 32 * 32;
constexpr float EPS = 1e-6f;
constexpr size_t O_YP = 0, O_YS = 67108864ull, O_KP = O_YS + 1048576ull, SZ_KP = 2ull * 32 * 2064 * 512, O_VP = O_KP + SZ_KP,
                 O_CONVP = O_VP + SZ_KP, O_SSDP = O_CONVP + 2ull * 32 * 3 * 1280, O_S5RP = O_SSDP + 2ull * 32 * 16 * 4096, O_S5IP = O_S5RP + 2ull * 32 * 2048,
                 O_KS = O_S5IP + 2ull * 32 * 2048, O_VS = O_KS + 2ull * 16 * 64 * 512, O_CONVS = O_VS + 2ull * 16 * 64 * 512, O_SSDS = O_CONVS + 2ull * 16 * 3 * 1280,
                 O_S5RS = O_SSDS + 2ull * 16 * 16 * 4096, O_S5IS = O_S5RS + 2ull * 16 * 2048, O_END = O_S5IS + 2ull * 16 * 2048;
constexpr size_t W_BT1 = 0, W_GLU = W_BT1 + (size_t)N1 * 1024 * 2, W_LA = W_GLU + 2048ull * 512 * 2, W_LC = W_LA + 1024ull * 1024 * 2, W_OUT = W_LC + 1024ull * 512 * 2,
                 W_UP = W_OUT + 1024ull * 1024 * 2, W_DOWN = W_UP + 4096ull * 1024 * 2, W_END = W_DOWN + 4096ull * 1024 * 2;
constexpr size_t WS_CTR = W_END, WS_XMETA = WS_CTR + 4096, WS_HB = WS_XMETA + 512ull * 1024 * 4, WS_Z = WS_HB + (size_t)NROWS * 1024 * 2, WS_XBC = WS_Z + (size_t)NROWS * 1024 * 2,
                 WS_U = WS_XBC + (size_t)NROWS * 1280 * 2, WS_Q = WS_U + (size_t)NROWS * 512 * 2, WS_G = WS_Q + (size_t)NROWS * 512 * 2, WS_DT = WS_G + (size_t)NROWS * 3072 * 2,
                 WS_SSQ = WS_DT + (size_t)NROWS * 16 * 4, WS_END = WS_SSQ + (size_t)SSQ_SLOTS * 16 * 4;
constexpr size_t WS_ACT = WS_Z;
static_assert(WS_ACT + (size_t)NROWS * 4096 * 2 <= WS_DT, "ACT overlay");
constexpr int LDS_BYTES = 147456;

struct Params {
    const float* in[34];
    float* out;
    unsigned char* ws;
    int ph_lo, ph_hi;
};
typedef const __attribute__((address_space(4))) Params* CPar;
__device__ __forceinline__ CPar params_ptr() { CPar q = (CPar)__builtin_amdgcn_kernarg_segment_ptr(); asm volatile("" : "+s"(q)); return q; }
#define PIN(i) (p->in[i])
enum { I_XP = 0, I_XS, I_CK, I_CV, I_SCONV, I_SSSD, I_S5R, I_S5I, I_META, I_NMIX, I_WIN, I_CONVW, I_CONVB, I_DTB, I_ALOG, I_DSSD, I_NSSD, I_LRE, I_LIM, I_LSTEP, I_BRE, I_BIM,
       I_CRE, I_CIM, I_DS5, I_WGLU, I_QN, I_KN, I_WLA, I_WLC, I_WOUT, I_NFFN, I_WUP, I_WDOWN };

__device__ __forceinline__ int ltid() { int t = threadIdx.x; asm volatile("" : "+v"(t)); return t; }
__device__ __forceinline__ int lbid() { int t = blockIdx.x; asm volatile("" : "+s"(t)); return t; }
__device__ __forceinline__ int lgdim() { int t = gridDim.x; asm volatile("" : "+s"(t)); return t; }

__device__ __forceinline__ float bf2f(bf16_t v) { return __uint_as_float((unsigned)v << 16); }
__device__ __forceinline__ unsigned pk2(float lo, float hi) { unsigned r; asm volatile("v_cvt_pk_bf16_f32 %0, %1, %2" : "=v"(r) : "v"(lo), "v"(hi)); return r; }
__device__ __forceinline__ float lo_f(unsigned w) { return __uint_as_float(w << 16); }
__device__ __forceinline__ float hi_f(unsigned w) { return __uint_as_float(w & 0xffff0000u); }
__device__ __forceinline__ u32x2 ld_l2_u32x2(const void* ptr) { const unsigned long long v = __hip_atomic_load((const unsigned long long*)ptr, __ATOMIC_RELAXED, __HIP_MEMORY_SCOPE_AGENT); u32x2 r; r[0] = (unsigned)v; r[1] = (unsigned)(v >> 32); return r; }
__device__ __forceinline__ float sigmoidf_(float v) { return __builtin_amdgcn_rcpf(1.f + __expf(-v)); }
__device__ __forceinline__ float siluf_(float v) { return v * sigmoidf_(v); }
__device__ __forceinline__ float geluf_(float y) { const float a = 0.7978845608f * (y + 0.044715f * y * y * y); const float t = __expf(2.f * a); return 0.5f * y * (2.f - 2.f * __builtin_amdgcn_rcpf(t + 1.f)); }
__device__ __forceinline__ float wave_sum(float v) {
#pragma unroll
    for (int o = 1; o < 64; o <<= 1) v += __shfl_xor(v, o);
    return v;
}
__device__ __forceinline__ void sincos_red(double x, float& sn, float& cs) {
    const double k = __builtin_rint(x * 0.63661977236758134308);
    const float r = (float)__builtin_fma(-k, 1.57079632679489661923, x), r2 = r * r;
    const float sp = r + r * r2 * (-1.6666667163e-01f + r2 * (8.3333337680e-03f + r2 * (-1.9841270114e-04f + r2 * 2.7557314297e-06f)));
    const float cp = 1.f + r2 * (-0.5f + r2 * (4.1666667908e-02f + r2 * (-1.3888889225e-03f + r2 * (2.4801587642e-05f - r2 * 2.7557314297e-07f))));
    const int q = ((int)k) & 3;
    sn = (q == 0) ? sp : (q == 1) ? cp : (q == 2) ? -sp : -cp;
    cs = (q == 0) ? cp : (q == 1) ? -sp : (q == 2) ? -cp : sp;
}
__device__ __forceinline__ int row_of(int s, int t) { return s < 32 ? (t < 16 ? NM0 + s * 16 + t : s * 2048 + t - 16) : NS0 + (s - 32) * 64 + t; }
__device__ __forceinline__ int ssq_slot(int r) { return r < NM0 ? r : NM0 + ((r - NM0) >> 4) * 32 + ((r - NM0) & 15); }
__device__ __forceinline__ float* xloc(CPar p, int r) { return r < NM0 ? p->out + (size_t)r * 1024 : (float*)(p->ws + WS_XMETA) + (size_t)(r - NM0) * 1024; }
__device__ __forceinline__ size_t k_off(int l, int r) {
    if (r < NS0) return O_KP + ((size_t)(l * 32 + (r >> 11)) * 2064 + 16 + (r & 2047)) * 512;
    if (r < NM0) { const int rs = r - NS0; return O_KS + ((size_t)(l * 16 + (rs >> 6)) * 64 + (rs & 63)) * 512; }
    const int rm = r - NM0; return O_KP + ((size_t)(l * 32 + (rm >> 4)) * 2064 + (rm & 15)) * 512;
}

namespace pg8 {
constexpr int BM = 256, BK = 64, HALF = 128, HTB = HALF * BK * 2, STAGE_BYTES = 8 * HTB, NXCD = 8, WGM = 8;
__host__ __device__ __forceinline__ int lds_byte(int r, int c) { const int st = (r >> 4) * 2 + (c >> 5), rr = r & 15, cc = c & 31, ob = rr * 64 + cc * 2; return st * 1024 + (ob ^ (((ob >> 9) & 1) << 5)); }
__host__ __device__ __forceinline__ void stage_rc(int b, int& R, int& C) { const int st = b / 1024, sb = b % 1024, swz = sb ^ (((sb >> 9) & 1) << 5); R = (st >> 1) * 16 + swz / 64; C = (st & 1) * 32 + (swz % 64) / 2; }
struct Unit { int pm, pn; };
struct Gemm { const bf16_t* A; const bf16_t* Bt; int M, N, K, lda, ldb; };
struct StaticOrder {
    int nM, nN, nwg, G, c;
    __device__ void init(int M, int N, int G_, int c_) { nM = M / BM; nN = N / BM; nwg = nM * nN; G = G_; c = c_; }
    __device__ bool next(int i, Unit& u) const {
        const long L = (long)i * G + c; if (L >= nwg) return false;
        int wgid = (int)L; { const int q = nwg / NXCD, r = nwg % NXCD, xcd = wgid % NXCD, off = wgid / NXCD; wgid = (xcd < r ? xcd * (q + 1) : r * (q + 1) + (xcd - r) * q) + off; }
        const int nig = WGM * nN, gid = wgid / nig, fm = gid * WGM, gsz = (nM - fm) < WGM ? (nM - fm) : WGM;
        u.pm = fm + ((wgid % nig) % gsz); u.pn = (wgid % nig) / gsz; return true;
    }
};
template <class Epi>
__device__ __forceinline__ void gemm_phase(LAS unsigned char* lds, const Gemm g, const StaticOrder& S, const Epi& E) {
    const int tid = ltid(), wid = __builtin_amdgcn_readfirstlane(tid >> 6), lane = tid & 63, wr = wid >> 2, wc = wid & 3, fr = lane & 15, fq = lane >> 4;
    const int K = g.K, nt = K / BK;
    unsigned voffA[2], voffB[2];
#pragma unroll
    for (int i = 0; i < 2; ++i) { int R, C; stage_rc(tid * 16 + i * 8192, R, C); voffA[i] = (unsigned)(R * g.lda + C) * 2u; voffB[i] = (unsigned)(R * g.ldb + C) * 2u; }
    const size_t kstep = (size_t)(BK * 2);
    const size_t hstepA = (size_t)HALF * g.lda * 2, hstepB = (size_t)HALF * g.ldb * 2;
    const size_t tstepA = 2 * hstepA, tstepB = 2 * hstepB;
    const unsigned ldsw = (unsigned)wid * 1024u;
    const int aoff = lds_byte(wr * 64 + fr, fq * 8), boff = lds_byte(wc * 32 + fr, fq * 8);
#define PG8_SA(b, h) (((b) * 2 + (h)) * HTB)
#define PG8_SB(b, h) ((4 + (b) * 2 + (h)) * HTB)
#define PG8_STAGE(bufoff, gbase, voff) do { _Pragma("unroll") for (int _i = 0; _i < 2; ++_i) \
        __builtin_amdgcn_global_load_lds((const unsigned*)((const char*)(gbase) + (voff)[_i]), (LAS unsigned*)(lds + (bufoff) + ldsw + _i * 8192), 16, 0, 0); } while (0)
#define PG8_LDA(dst, b, h) do { _Pragma("unroll") for (int m = 0; m < 4; ++m) _Pragma("unroll") for (int k = 0; k < 2; ++k) dst[m][k] = *(const LAS bf16x8*)(lds + PG8_SA(b, h) + aoff + m * 2048 + k * 1024); } while (0)
#define PG8_LDB(dst, b, h) do { _Pragma("unroll") for (int n = 0; n < 2; ++n) _Pragma("unroll") for (int k = 0; k < 2; ++k) dst[n][k] = *(const LAS bf16x8*)(lds + PG8_SB(b, h) + boff + n * 2048 + k * 1024); } while (0)
#define PG8_MMA(ai, bj, At, Bt) do { __builtin_amdgcn_s_setprio(1); _Pragma("unroll") for (int m = 0; m < 4; ++m) _Pragma("unroll") for (int n = 0; n < 2; ++n) _Pragma("unroll") for (int k = 0; k < 2; ++k) \
        acc[ai][bj][m][n] = __builtin_amdgcn_mfma_f32_16x16x32_bf16(Bt[n][k], At[m][k], acc[ai][bj][m][n], 0, 0, 0); __builtin_amdgcn_s_setprio(0); } while (0)
#define PG8_WAIT_V(n) asm volatile("s_waitcnt vmcnt(" #n ")" ::: "memory")
#define PG8_WAIT_L(n) asm volatile("s_waitcnt lgkmcnt(" #n ")" ::: "memory")
#define PG8_BAR __builtin_amdgcn_s_barrier()
#define PG8_SCHED __builtin_amdgcn_sched_barrier(0)
    Unit cur, nxt; int ui = 0;
    if (!S.next(0, cur)) return;
    f32x4 acc[2][2][4][2];
#pragma unroll
    for (int a = 0; a < 2; ++a)
#pragma unroll
        for (int b = 0; b < 2; ++b)
#pragma unroll
            for (int m = 0; m < 4; ++m)
#pragma unroll
                for (int n = 0; n < 2; ++n) acc[a][b][m][n] = (f32x4){0.f, 0.f, 0.f, 0.f};
    bf16x8 At[4][2], B0[2][2], B1[2][2];
    const char* cA = (const char*)g.A + (size_t)cur.pm * tstepA; const char* cB = (const char*)g.Bt + (size_t)cur.pn * tstepB;
    PG8_STAGE(PG8_SB(0, 0), cB, voffB); PG8_STAGE(PG8_SA(0, 0), cA, voffA); PG8_STAGE(PG8_SB(0, 1), cB + hstepB, voffB); PG8_STAGE(PG8_SA(0, 1), cA + hstepA, voffA);
    if (wr == 1) PG8_BAR;
    PG8_WAIT_V(4); PG8_BAR;
    PG8_STAGE(PG8_SB(1, 0), cB + kstep, voffB); PG8_STAGE(PG8_SA(1, 0), cA + kstep, voffA); PG8_STAGE(PG8_SB(1, 1), cB + hstepB + kstep, voffB);
    PG8_WAIT_V(6); PG8_BAR;
    for (;;) {
        const bool has_next = S.next(ui + 1, nxt);
        const char* nA = has_next ? (const char*)g.A + (size_t)nxt.pm * tstepA : cA; const char* nB = has_next ? (const char*)g.Bt + (size_t)nxt.pn * tstepB : cB;
        for (int t = 0; t < nt; t += 2) {
            const bool last = (t == nt - 2);
            const char* a1 = cA + (size_t)(t + 1) * kstep;
            const char* a2 = last ? nA : cA + (size_t)(t + 2) * kstep; const char* b2 = last ? nB : cB + (size_t)(t + 2) * kstep;
            const char* a3 = a2 + kstep; const char* b3 = b2 + kstep;
            PG8_LDB(B0, 0, 0); PG8_SCHED; PG8_LDA(At, 0, 0); PG8_STAGE(PG8_SA(1, 1), a1 + hstepA, voffA);
            PG8_WAIT_L(8); PG8_BAR; PG8_WAIT_L(0); PG8_MMA(0, 0, At, B0); PG8_BAR; PG8_SCHED;
            PG8_LDB(B1, 0, 1); PG8_STAGE(PG8_SB(0, 0), b2, voffB);
            PG8_BAR; PG8_WAIT_L(0); PG8_MMA(0, 1, At, B1); PG8_BAR;
            PG8_LDA(At, 0, 1); PG8_STAGE(PG8_SA(0, 0), a2, voffA);
            PG8_BAR; PG8_WAIT_L(0); PG8_MMA(1, 0, At, B0); PG8_BAR; PG8_SCHED;
            PG8_STAGE(PG8_SB(0, 1), b2 + hstepB, voffB);
            PG8_WAIT_V(6); PG8_BAR; PG8_MMA(1, 1, At, B1); PG8_BAR;
            PG8_LDB(B0, 1, 0); PG8_SCHED; PG8_LDA(At, 1, 0); PG8_STAGE(PG8_SA(0, 1), a2 + hstepA, voffA);
            PG8_WAIT_L(8); PG8_BAR; PG8_WAIT_L(0); PG8_MMA(0, 0, At, B0); PG8_BAR; PG8_SCHED;
            PG8_LDB(B1, 1, 1); PG8_STAGE(PG8_SB(1, 0), b3, voffB);
            PG8_BAR; PG8_WAIT_L(0); PG8_MMA(0, 1, At, B1); PG8_BAR;
            PG8_LDA(At, 1, 1); PG8_STAGE(PG8_SA(1, 0), a3, voffA);
            PG8_BAR; PG8_WAIT_L(0); PG8_MMA(1, 0, At, B0); PG8_BAR; PG8_SCHED;
            PG8_STAGE(PG8_SB(1, 1), b3 + hstepB, voffB);
            PG8_WAIT_V(6); PG8_BAR; PG8_MMA(1, 1, At, B1); PG8_BAR;
        }
        E(acc, cur, wr, wc, fr, fq);
        if (!has_next) break;
#pragma unroll
        for (int a = 0; a < 2; ++a)
#pragma unroll
            for (int b = 0; b < 2; ++b)
#pragma unroll
                for (int m = 0; m < 4; ++m)
#pragma unroll
                    for (int n = 0; n < 2; ++n) acc[a][b][m][n] = (f32x4){0.f, 0.f, 0.f, 0.f};
        cur = nxt; cA = nA; cB = nB; ++ui;
    }
    PG8_WAIT_V(0);
    if (wr == 0) PG8_BAR;
    PG8_BAR;
#undef PG8_SA
#undef PG8_SB
#undef PG8_STAGE
#undef PG8_LDA
#undef PG8_LDB
#undef PG8_MMA
#undef PG8_WAIT_V
#undef PG8_WAIT_L
#undef PG8_BAR
#undef PG8_SCHED
}
}
using pg8::Unit;

struct EpiIn {
    bf16_t *Z, *XBC, *U, *Q, *G; float* DT; float* out; const float *qn, *kn; int layer;
    __device__ __forceinline__ void operator()(const f32x4 (&acc)[2][2][4][2], const Unit& u, int wr, int wc, int fr, int fq) const {
        const int pn = u.pn, rowb = u.pm * 256 + wr * 64 + fr, ctb = wc * 32 + fq * 4;
        if (pn < 11 || (pn >= 17 && pn < 29)) {
            bf16_t* base; int ld, col0; bool sig = false;
            if (pn < 4) { base = Z; ld = 1024; col0 = pn * 256; } else if (pn < 9) { base = XBC; ld = 1280; col0 = (pn - 4) * 256; }
            else if (pn < 11) { base = U; ld = 512; col0 = (pn - 9) * 256; } else { base = G; ld = 3072; col0 = (pn - 17) * 256; sig = true; }
#pragma unroll
            for (int ai = 0; ai < 2; ++ai)
#pragma unroll
                for (int m = 0; m < 4; ++m) { bf16_t* rp = base + (size_t)(rowb + ai * 128 + m * 16) * ld + col0 + ctb;
#pragma unroll
                    for (int bj = 0; bj < 2; ++bj)
#pragma unroll
                        for (int n = 0; n < 2; ++n) { f32x4 v = acc[ai][bj][m][n];
                            if (sig) { v[0] = sigmoidf_(v[0]); v[1] = sigmoidf_(v[1]); v[2] = sigmoidf_(v[2]); v[3] = sigmoidf_(v[3]); }
                            u32x2 o; o[0] = pk2(v[0], v[1]); o[1] = pk2(v[2], v[3]); *(u32x2*)(rp + bj * 128 + n * 16) = o; } }
        } else if (pn < 17) {
            const int seg = (pn - 11) >> 1, head = ((pn - 11) & 1) * 4 + wc;
            const float* nw = seg == 0 ? qn : kn;
            f32x4 wv[2][2];
#pragma unroll
            for (int bj = 0; bj < 2; ++bj)
#pragma unroll
                for (int n = 0; n < 2; ++n) wv[bj][n] = (seg < 2) ? *(const f32x4*)(nw + 32 * bj + 16 * n + 4 * fq) : (f32x4){1.f, 1.f, 1.f, 1.f};
#pragma unroll
            for (int ai = 0; ai < 2; ++ai)
#pragma unroll
                for (int m = 0; m < 4; ++m) { const int row = rowb + ai * 128 + m * 16;
                    float rs = 1.f;
                    if (seg < 2) { float ss = 0.f;
#pragma unroll
                        for (int bj = 0; bj < 2; ++bj)
#pragma unroll
                            for (int n = 0; n < 2; ++n) { const f32x4 v = acc[ai][bj][m][n]; ss += v[0] * v[0] + v[1] * v[1] + v[2] * v[2] + v[3] * v[3]; }
                        ss += __shfl_xor(ss, 16); ss += __shfl_xor(ss, 32);
                        rs = rsqrtf(ss * (1.f / 64.f) + EPS); }
                    if (seg == 0) { bf16_t* rp = Q + (size_t)row * 512 + head * 64 + 4 * fq;
#pragma unroll
                        for (int bj = 0; bj < 2; ++bj)
#pragma unroll
                            for (int n = 0; n < 2; ++n) { const f32x4 v = acc[ai][bj][m][n] * rs * wv[bj][n]; u32x2 o; o[0] = pk2(v[0], v[1]); o[1] = pk2(v[2], v[3]); *(u32x2*)(rp + 32 * bj + 16 * n) = o; }
                    } else { float* rp = out + k_off(layer, row) + (seg == 2 ? (row >= NS0 && row < NM0 ? (O_VS - O_KS) : (O_VP - O_KP)) : 0) + head * 64 + 4 * fq;
#pragma unroll
                        for (int bj = 0; bj < 2; ++bj)
#pragma unroll
                            for (int n = 0; n < 2; ++n) { const f32x4 v = acc[ai][bj][m][n] * rs * wv[bj][n]; *(f32x4*)(rp + 32 * bj + 16 * n) = v; } } }
        } else {
            if (wc == 0) {
#pragma unroll
                for (int ai = 0; ai < 2; ++ai)
#pragma unroll
                    for (int m = 0; m < 4; ++m) *(f32x4*)(DT + (size_t)(rowb + ai * 128 + m * 16) * 16 + 4 * fq) = acc[ai][0][m][0];
            }
        }
    }
};
struct EpiGlu {
    bf16_t* OB;
    __device__ __forceinline__ void operator()(const f32x4 (&acc)[2][2][4][2], const Unit& u, int wr, int wc, int fr, int fq) const {
        const int rowb = u.pm * 256 + wr * 64 + fr, colb = u.pn * 128 + wc * 32 + fq * 4;
#pragma unroll
        for (int ai = 0; ai < 2; ++ai)
#pragma unroll
            for (int m = 0; m < 4; ++m) { bf16_t* rp = OB + (size_t)(rowb + ai * 128 + m * 16) * 1024 + colb;
#pragma unroll
                for (int n = 0; n < 2; ++n) { const f32x4 a = acc[ai][0][m][n], g = acc[ai][1][m][n];
                    u32x2 o; o[0] = pk2(a[0] * sigmoidf_(g[0]), a[1] * sigmoidf_(g[1])); o[1] = pk2(a[2] * sigmoidf_(g[2]), a[3] * sigmoidf_(g[3])); *(u32x2*)(rp + n * 16) = o; } }
    }
};
struct EpiMix {
    bf16_t* R; const bf16_t* G; const bf16_t* OB; int accum;
    __device__ __forceinline__ void operator()(const f32x4 (&acc)[2][2][4][2], const Unit& u, int wr, int wc, int fr, int fq) const {
        const int rowb = u.pm * 256 + wr * 64 + fr, colb = u.pn * 256 + wc * 32 + fq * 4;
#pragma unroll
        for (int ai = 0; ai < 2; ++ai)
#pragma unroll
            for (int m = 0; m < 4; ++m) { const int row = rowb + ai * 128 + m * 16;
#pragma unroll
                for (int bj = 0; bj < 2; ++bj)
#pragma unroll
                    for (int n = 0; n < 2; ++n) { const int col = colb + bj * 128 + n * 16; f32x4 v = acc[ai][bj][m][n];
                        const u32x2 gw = *(const u32x2*)(G + (size_t)row * 3072 + col);
                        v = v * (f32x4){lo_f(gw[0]), hi_f(gw[0]), lo_f(gw[1]), hi_f(gw[1])};
                        if (OB) { const u32x2 g1 = *(const u32x2*)(G + (size_t)row * 3072 + 1024 + col), ob = *(const u32x2*)(OB + (size_t)row * 1024 + col);
                            v = v + (f32x4){lo_f(g1[0]), hi_f(g1[0]), lo_f(g1[1]), hi_f(g1[1])} * (f32x4){lo_f(ob[0]), hi_f(ob[0]), lo_f(ob[1]), hi_f(ob[1])}; }
                        bf16_t* rp = R + (size_t)row * 1024 + col;
                        if (accum) { const u32x2 rw = ld_l2_u32x2(rp); v = v + (f32x4){lo_f(rw[0]), hi_f(rw[0]), lo_f(rw[1]), hi_f(rw[1])}; }
                        u32x2 o; o[0] = pk2(v[0], v[1]); o[1] = pk2(v[2], v[3]); *(u32x2*)rp = o; } }
    }
};
struct EpiRes {
    float* out; float* xmeta;
    __device__ __forceinline__ void operator()(const f32x4 (&acc)[2][2][4][2], const Unit& u, int wr, int wc, int fr, int fq) const {
        const int rowb = u.pm * 256 + wr * 64 + fr, colb = u.pn * 256 + wc * 32 + fq * 4;
        float* base = (u.pm * 256 < NM0) ? out : xmeta - (size_t)NM0 * 1024;
#pragma unroll
        for (int ai = 0; ai < 2; ++ai)
#pragma unroll
            for (int m = 0; m < 4; ++m) { float* rp = base + (size_t)(rowb + ai * 128 + m * 16) * 1024 + colb;
#pragma unroll
                for (int bj = 0; bj < 2; ++bj)
#pragma unroll
                    for (int n = 0; n < 2; ++n) { f32x4* q = (f32x4*)(rp + bj * 128 + n * 16); *q = *q + acc[ai][bj][m][n]; } }
    }
};
struct EpiUp {
    bf16_t* ACT;
    __device__ __forceinline__ void operator()(const f32x4 (&acc)[2][2][4][2], const Unit& u, int wr, int wc, int fr, int fq) const {
        const int rowb = u.pm * 256 + wr * 64 + fr, colb = u.pn * 256 + wc * 32 + fq * 4;
#pragma unroll
        for (int ai = 0; ai < 2; ++ai)
#pragma unroll
            for (int m = 0; m < 4; ++m) { bf16_t* rp = ACT + (size_t)(rowb + ai * 128 + m * 16) * 4096 + colb;
#pragma unroll
                for (int bj = 0; bj < 2; ++bj)
#pragma unroll
                    for (int n = 0; n < 2; ++n) { f32x4 v = acc[ai][bj][m][n];
#pragma unroll
                        for (int j = 0; j < 4; ++j) { const float r = fmaxf(v[j], 0.f); v[j] = r * r; }
                        u32x2 o; o[0] = pk2(v[0], v[1]); o[1] = pk2(v[2], v[3]); *(u32x2*)(rp + bj * 128 + n * 16) = o; } }
    }
};

__device__ __forceinline__ int col_in(int n) {
    if (n < 2304) return n;
    if (n < 2816) return n + 16;
    if (n < 4352) { const int w0 = n - 2816, seg = w0 >> 9, w = w0 & 511, tile = w >> 8, ct = w & 255, bj = ct >> 7, wc = (ct >> 5) & 3, ww = ct & 31;
        return 2832 + seg * 512 + (tile * 4 + wc) * 64 + 32 * bj + ww; }
    if (n < 7424) return n + 16;
    if (n < 7440) return 2304 + (n - 7424);
    return -1;
}
template <int MAP>
__device__ __forceinline__ void prep_w(bf16_t* dst, const float* src, int K, int N, int ld, const float* scale, size_t gtid, size_t gsz) {
    const size_t items = (size_t)(K / 8) * N;
    for (size_t it = gtid; it < items; it += gsz) {
        const int n = (int)(it % N), k8 = (int)(it / N);
        const int c = MAP == 1 ? col_in(n) : (MAP == 2 ? (((n >> 7) & 1) * 1024 + (n >> 8) * 128 + (n & 127)) : n);
        float v[8];
#pragma unroll
        for (int kk = 0; kk < 8; ++kk) { const int k = k8 * 8 + kk; float x = (c >= 0) ? src[(size_t)k * ld + c] : 0.f; if (scale) x *= scale[k]; v[kk] = x; }
        u32x4 o; o[0] = pk2(v[0], v[1]); o[1] = pk2(v[2], v[3]); o[2] = pk2(v[4], v[5]); o[3] = pk2(v[6], v[7]);
        *(u32x4*)(dst + (size_t)n * K + k8 * 8) = o;
    }
}
__device__ __forceinline__ void rmsnorm_rows(CPar p, const float* g, int from_inputs) {
    const int lane = ltid() & 63, gw = lbid() * 8 + (ltid() >> 6), ngw = lgdim() * 8;
    bf16_t* HB = (bf16_t*)(p->ws + WS_HB);
    f32x4 gv[4];
#pragma unroll
    for (int j = 0; j < 4; ++j) gv[j] = *(const f32x4*)(g + lane * 4 + 256 * j);
    for (int r = gw; r < NROWS; r += ngw) {
        float* xl = xloc(p, r);
        const float* src = xl;
        if (from_inputs) src = r < NS0 ? p->in[I_XP] + (size_t)r * 1024 : (r < NM0 ? p->in[I_XS] + (size_t)(r - NS0) * 1024 : p->in[I_META] + (size_t)((r - NM0) & 15) * 1024);
        f32x4 v[4]; float s = 0.f;
#pragma unroll
        for (int j = 0; j < 4; ++j) { v[j] = *(const f32x4*)(src + lane * 4 + 256 * j); s += (v[j][0] * v[j][0] + v[j][1] * v[j][1]) + (v[j][2] * v[j][2] + v[j][3] * v[j][3]); }
        const float rstd = rsqrtf(wave_sum(s) * (1.f / 1024.f) + EPS);
#pragma unroll
        for (int j = 0; j < 4; ++j) { if (from_inputs) *(f32x4*)(xl + lane * 4 + 256 * j) = v[j];
            const f32x4 h = v[j] * rstd * gv[j]; u32x2 o; o[0] = pk2(h[0], h[1]); o[1] = pk2(h[2], h[3]); *(u32x2*)(HB + (size_t)r * 1024 + lane * 4 + 256 * j) = o; }
    }
}
__device__ __forceinline__ void ssd_norm_rows(CPar p) {
    const int lane = ltid() & 63, gw = lbid() * 8 + (ltid() >> 6), ngw = lgdim() * 8;
    bf16_t* Z = (bf16_t*)(p->ws + WS_Z);
    for (int r = gw; r < NROWS; r += ngw) {
#pragma unroll
        for (int j = 0; j < 2; ++j) { u32x4* zp = (u32x4*)(Z + (size_t)r * 1024 + j * 512 + lane * 8); const u32x4 w = *zp;
            float f[8] = {lo_f(w[0]), hi_f(w[0]), lo_f(w[1]), hi_f(w[1]), lo_f(w[2]), hi_f(w[2]), lo_f(w[3]), hi_f(w[3])};
            float ss = 0.f;
#pragma unroll
            for (int i = 0; i < 8; ++i) ss += f[i] * f[i];
            const float rs = rsqrtf(wave_sum(ss) * (1.f / 512.f) + EPS);
            u32x4 o; o[0] = pk2(f[0] * rs, f[1] * rs); o[1] = pk2(f[2] * rs, f[3] * rs); o[2] = pk2(f[4] * rs, f[5] * rs); o[3] = pk2(f[6] * rs, f[7] * rs); *zp = o; }
    }
}
__device__ __forceinline__ void phase_prep(CPar p, int l) {
    const size_t gtid = (size_t)lbid() * 512 + ltid(), gsz = (size_t)lgdim() * 512;
    unsigned char* ws = p->ws;
    prep_w<1>((bf16_t*)(ws + W_BT1), p->in[I_WIN] + (size_t)l * 1024 * IN_COLS, 1024, N1, IN_COLS, nullptr, gtid, gsz);
    prep_w<2>((bf16_t*)(ws + W_GLU), p->in[I_WGLU] + (size_t)l * 512 * 2048, 512, 2048, 2048, nullptr, gtid, gsz);
    prep_w<0>((bf16_t*)(ws + W_LA), p->in[I_WLA] + (size_t)l * 1024 * 1024, 1024, 1024, 1024, p->in[I_NSSD] + l * 1024, gtid, gsz);
    prep_w<0>((bf16_t*)(ws + W_LC), p->in[I_WLC] + (size_t)l * 512 * 1024, 512, 1024, 1024, nullptr, gtid, gsz);
    prep_w<0>((bf16_t*)(ws + W_OUT), p->in[I_WOUT] + (size_t)l * 1024 * 1024, 1024, 1024, 1024, nullptr, gtid, gsz);
    prep_w<0>((bf16_t*)(ws + W_UP), p->in[I_WUP] + (size_t)l * 1024 * 4096, 1024, 4096, 4096, nullptr, gtid, gsz);
    prep_w<0>((bf16_t*)(ws + W_DOWN), p->in[I_WDOWN] + (size_t)l * 4096 * 1024, 4096, 1024, 1024, nullptr, gtid, gsz);
    if (lbid() == 0 && ltid() < 16) ((unsigned*)(ws + WS_CTR))[ltid()] = 0u;
    rmsnorm_rows(p, p->in[I_NMIX] + l * 1024, l == 0);
}

__device__ __forceinline__ void ssd_item(CPar p, int l, int item, float* sm) {
    const int tid = ltid();
    const int s = item < 512 ? (item >> 4) : 32 + ((item - 512) >> 4), h = item & 15, g = h >> 3;
    const bool prompt = s < 32; const int b = prompt ? s : s - 32, T = prompt ? TP : TS;
    constexpr int LD = 68;
    float *sX = sm, *sB = sX + 64 * LD, *sC = sB + 64 * LD, *sM = sC + 64 * LD, *sT = sM + 64 * LD, *sdt = sT + 64 * LD, *sac = sdt + 64, *sw = sac + 64;
    const bf16_t* XBC = (const bf16_t*)(p->ws + WS_XBC); bf16_t* Z = (bf16_t*)(p->ws + WS_Z);
    const float* DT = (const float*)(p->ws + WS_DT);
    const float* cw = p->in[I_CONVW] + (size_t)l * 4 * 1280; const float* cb = p->in[I_CONVB] + (size_t)l * 1280;
    const float* hist = p->in[I_SCONV] + (size_t)(l * 16 + b) * 3 * 1280;
    const float dtb = p->in[I_DTB][l * 16 + h], aneg = -__expf(p->in[I_ALOG][l * 16 + h]), dsk = p->in[I_DSSD][l * 16 + h];
    float* sout = prompt ? p->out + O_SSDP + ((size_t)(l * 32 + b) * 16 + h) * 4096 : p->out + O_SSDS + ((size_t)(l * 16 + b) * 16 + h) * 4096;
    for (int i = tid; i < 4096; i += 512) { const int pp = i >> 6, n = i & 63; sT[n * LD + pp] = prompt ? 0.f : p->in[I_SSSD][((size_t)(l * 16 + b) * 16 + h) * 4096 + i]; }
    const int nch = (T + 63) >> 6;
#pragma unroll 1
    for (int c = 0; c < nch; ++c) {
        const int t0 = c * 64;
        __syncthreads();
#pragma unroll 1
        for (int idx = tid; idx < 64 * 192; idx += 512) {
            const int tl = idx / 192, ch = idx - tl * 192, t = t0 + tl;
            const int col = ch < 64 ? h * 64 + ch : (ch < 128 ? 1024 + g * 64 + (ch - 64) : 1152 + g * 64 + (ch - 128));
            float v = 0.f;
            if (t < T) { v = cb[col];
#pragma unroll
                for (int k = 0; k < 4; ++k) { const int tt = t - 3 + k; float x;
                    if (tt >= 0) x = bf2f(XBC[(size_t)row_of(s, tt) * 1280 + col]); else x = prompt ? 0.f : hist[(3 + tt) * 1280 + col];
                    v += x * cw[k * 1280 + col]; }
                v = siluf_(v); }
            float* dst = ch < 64 ? sX : (ch < 128 ? sB : sC);
            dst[tl * LD + (ch & 63)] = v;
        }
        if (tid < 64) { const int t = t0 + tid; float dtv = 0.f;
            if (t < T) { const float x = DT[(size_t)row_of(s, t) * 16 + h] + dtb; dtv = x > 20.f ? x : log1pf(__expf(x)); }
            float cs = dtv * aneg;
#pragma unroll
            for (int o = 1; o < 64; o <<= 1) { const float nb = __shfl_up(cs, o); if (tid >= o) cs += nb; }
            sdt[tid] = dtv; sac[tid] = cs; }
        __syncthreads();
        if (tid < 64) sw[tid] = __expf(sac[63] - sac[tid]) * sdt[tid];
        { const int t = tid >> 3, jq = tid & 7; float a8[8];
#pragma unroll
            for (int i = 0; i < 8; ++i) a8[i] = 0.f;
#pragma unroll 1
            for (int n = 0; n < 64; n += 4) { const f32x4 cv = *(const f32x4*)(sC + t * LD + n);
#pragma unroll
                for (int i = 0; i < 8; ++i) { const f32x4 bv = *(const f32x4*)(sB + (jq + 8 * i) * LD + n); a8[i] += cv[0] * bv[0] + cv[1] * bv[1] + cv[2] * bv[2] + cv[3] * bv[3]; } }
            const float act = sac[t];
#pragma unroll
            for (int i = 0; i < 8; ++i) { const int j = jq + 8 * i; sM[t * LD + j] = (j <= t) ? a8[i] * __expf(act - sac[j]) * sdt[j] : 0.f; } }
        __syncthreads();
        { const int tl = tid >> 3, pb = (tid & 7) * 8, t = t0 + tl; float y8[8], o8[8];
#pragma unroll
            for (int i = 0; i < 8; ++i) { y8[i] = 0.f; o8[i] = 0.f; }
#pragma unroll 2
            for (int j = 0; j < 64; ++j) { const float mv = sM[tl * LD + j]; const f32x4 x0 = *(const f32x4*)(sX + j * LD + pb), x1 = *(const f32x4*)(sX + j * LD + pb + 4);
#pragma unroll
                for (int i = 0; i < 4; ++i) { y8[i] += mv * x0[i]; y8[4 + i] += mv * x1[i]; } }
#pragma unroll 2
            for (int n = 0; n < 64; ++n) { const float cv = sC[tl * LD + n]; const f32x4 s0 = *(const f32x4*)(sT + n * LD + pb), s1 = *(const f32x4*)(sT + n * LD + pb + 4);
#pragma unroll
                for (int i = 0; i < 4; ++i) { o8[i] += cv * s0[i]; o8[4 + i] += cv * s1[i]; } }
            const float ea = __expf(sac[tl]);
            float ss = 0.f;
            if (t < T) { const int row = row_of(s, t); bf16_t* zp = Z + (size_t)row * 1024 + h * 64 + pb;
                const u32x4 zw = *(const u32x4*)zp; float zf[8] = {lo_f(zw[0]), hi_f(zw[0]), lo_f(zw[1]), hi_f(zw[1]), lo_f(zw[2]), hi_f(zw[2]), lo_f(zw[3]), hi_f(zw[3])};
                float r8[8];
#pragma unroll
                for (int i = 0; i < 8; ++i) { const float y = (y8[i] + ea * o8[i] + dsk * sX[tl * LD + pb + i]) * siluf_(zf[i]); r8[i] = y; ss += y * y; }
                u32x4 o; o[0] = pk2(r8[0], r8[1]); o[1] = pk2(r8[2], r8[3]); o[2] = pk2(r8[4], r8[5]); o[3] = pk2(r8[6], r8[7]); *(u32x4*)zp = o; }
            (void)ss; }
        __syncthreads();
        { const int n = tid >> 3, pb = (tid & 7) * 8; float a8[8];
#pragma unroll
            for (int i = 0; i < 8; ++i) a8[i] = 0.f;
#pragma unroll 2
            for (int j = 0; j < 64; ++j) { const float bw = sB[j * LD + n] * sw[j]; const f32x4 x0 = *(const f32x4*)(sX + j * LD + pb), x1 = *(const f32x4*)(sX + j * LD + pb + 4);
#pragma unroll
                for (int i = 0; i < 4; ++i) { a8[i] += bw * x0[i]; a8[4 + i] += bw * x1[i]; } }
            const float eL = __expf(sac[63]);
#pragma unroll
            for (int i = 0; i < 8; ++i) sT[n * LD + pb + i] = eL * sT[n * LD + pb + i] + a8[i]; }
    }
    __syncthreads();
    for (int i = tid; i < 4096; i += 512) { const int pp = i >> 6, n = i & 63; sout[i] = sT[n * LD + pp]; }
    float* cout_ = prompt ? p->out + O_CONVP + (size_t)(l * 32 + b) * 3 * 1280 : p->out + O_CONVS + (size_t)(l * 16 + b) * 3 * 1280;
    for (int idx = tid; idx < 3 * 192; idx += 512) { const int k = idx / 192, ch = idx - k * 192;
        if (ch >= 64 && (h & 7) != 0) continue;
        const int col = ch < 64 ? h * 64 + ch : (ch < 128 ? 1024 + g * 64 + (ch - 64) : 1152 + g * 64 + (ch - 128));
        cout_[k * 1280 + col] = bf2f(XBC[(size_t)row_of(s, T - 3 + k) * 1280 + col]); }
    __syncthreads();
}

__device__ __forceinline__ void s5_item(CPar p, int l, int s, int g, float* wl) {
    const int lane = ltid() & 63;
    const bool prompt = s < 32; const int b = prompt ? s : s - 32, T = prompt ? TP : TS, nblk = T >> 4;
    constexpr int LD = 68;
    float *Xr = wl, *Xi = wl + 16 * LD, *Cr = wl + 32 * LD, *Ci = wl + 48 * LD;
    bf16_t* U = (bf16_t*)(p->ws + WS_U);
    const int gp = (l * 32 + g) * 64 + lane;
    const float lr = p->in[I_LRE][gp], li = p->in[I_LIM][gp], step = expf(p->in[I_LSTEP][l * 32 + g]);
    float sn, cs; sincos_red((double)li * (double)step, sn, cs);
    const float mag = expf(lr * step), ab_re = mag * cs, ab_im = mag * sn;
    const float den = lr * lr + li * li, nr = ab_re - 1.f, f_re = (nr * lr + ab_im * li) / den, f_im = (ab_im * lr - nr * li) / den;
    float bbr[16], bbi[16];
#pragma unroll
    for (int hh = 0; hh < 16; ++hh) { const float br = p->in[I_BRE][(size_t)gp * 16 + hh], bi = p->in[I_BIM][(size_t)gp * 16 + hh]; bbr[hh] = f_re * br - f_im * bi; bbi[hh] = f_re * bi + f_im * br; }
#pragma unroll
    for (int hh = 0; hh < 16; ++hh) { Cr[hh * LD + lane] = p->in[I_CRE][((size_t)(l * 32 + g) * 16 + hh) * 64 + lane]; Ci[hh * LD + lane] = p->in[I_CIM][((size_t)(l * 32 + g) * 16 + hh) * 64 + lane]; }
    float xr = prompt ? 0.f : p->in[I_S5R][(size_t)(l * 16 + b) * 2048 + g * 64 + lane], xi = prompt ? 0.f : p->in[I_S5I][(size_t)(l * 16 + b) * 2048 + g * 64 + lane];
    const int tl = lane >> 2, hq = lane & 3;
    f32x4 dv = *(const f32x4*)(p->in[I_DS5] + (size_t)(l * 32 + g) * 16 + hq * 4);
    u32x4 ua = {0, 0, 0, 0}, ub = {0, 0, 0, 0};
    { const int r0 = row_of(s, 0); if (lane < 16) { const u32x4* up = (const u32x4*)(U + (size_t)(r0 + lane) * 512 + g * 16); ua = up[0]; ub = up[1]; } }
    for (int blk = 0; blk < nblk; ++blk) {
        const int r0 = row_of(s, blk * 16);
        const u32x4 ca = ua, cbv = ub;
        if (blk + 1 < nblk && lane < 16) { const int r1 = row_of(s, blk * 16 + 16); const u32x4* up = (const u32x4*)(U + (size_t)(r1 + lane) * 512 + g * 16); ua = up[0]; ub = up[1]; }
#pragma unroll
        for (int i = 0; i < 16; ++i) {
            float bur = 0.f, bui = 0.f;
#pragma unroll
            for (int w = 0; w < 8; ++w) { const unsigned word = (unsigned)__builtin_amdgcn_readlane((int)(w < 4 ? ca[w] : cbv[w - 4]), i);
                const float u0 = lo_f(word), u1 = hi_f(word);
                bur += bbr[2 * w] * u0 + bbr[2 * w + 1] * u1; bui += bbi[2 * w] * u0 + bbi[2 * w + 1] * u1; }
            const float nxr = ab_re * xr - ab_im * xi + bur, nxi = ab_re * xi + ab_im * xr + bui; xr = nxr; xi = nxi;
            Xr[i * LD + lane] = xr; Xi[i * LD + lane] = xi;
        }
        __builtin_amdgcn_wave_barrier(); asm volatile("s_waitcnt lgkmcnt(0)" ::: "memory");
        float a4[4] = {0.f, 0.f, 0.f, 0.f};
#pragma unroll 4
        for (int p4 = 0; p4 < 64; p4 += 4) { const f32x4 xr4 = *(const f32x4*)(Xr + tl * LD + p4), xi4 = *(const f32x4*)(Xi + tl * LD + p4);
#pragma unroll
            for (int hh = 0; hh < 4; ++hh) { const f32x4 cr4 = *(const f32x4*)(Cr + (hq * 4 + hh) * LD + p4), ci4 = *(const f32x4*)(Ci + (hq * 4 + hh) * LD + p4);
                a4[hh] += (xr4[0] * cr4[0] + xr4[1] * cr4[1] + xr4[2] * cr4[2] + xr4[3] * cr4[3]) - (xi4[0] * ci4[0] + xi4[1] * ci4[1] + xi4[2] * ci4[2] + xi4[3] * ci4[3]); } }
        { bf16_t* up = U + (size_t)(r0 + tl) * 512 + g * 16 + hq * 4; const u32x2 uw = *(const u32x2*)up;
            const float y0 = a4[0] + dv[0] * lo_f(uw[0]), y1 = a4[1] + dv[1] * hi_f(uw[0]), y2 = a4[2] + dv[2] * lo_f(uw[1]), y3 = a4[3] + dv[3] * hi_f(uw[1]);
            u32x2 o; o[0] = pk2(geluf_(y0), geluf_(y1)); o[1] = pk2(geluf_(y2), geluf_(y3)); *(u32x2*)up = o; }
        __builtin_amdgcn_wave_barrier(); asm volatile("s_waitcnt lgkmcnt(0)" ::: "memory");
    }
    float* ore = prompt ? p->out + O_S5RP + (size_t)(l * 32 + b) * 2048 : p->out + O_S5RS + (size_t)(l * 16 + b) * 2048;
    float* oim = prompt ? p->out + O_S5IP + (size_t)(l * 32 + b) * 2048 : p->out + O_S5IS + (size_t)(l * 16 + b) * 2048;
    ore[g * 64 + lane] = xr; oim[g * 64 + lane] = xi;
}

__device__ __forceinline__ void attn_item(CPar p, int l, int item, float* wl) {
    const int lane = ltid() & 63;
    int s, h, qt;
    if (item < 8448) { s = item / 264; const int rem = item - s * 264; h = rem / 33; qt = rem - h * 33; } else { const int it = item - 8448; s = 32 + (it >> 3); h = it & 7; qt = 0; }
    const bool prompt = s < 32; const int b = prompt ? s : s - 32, T = prompt ? TP : TS, nh = prompt ? 0 : PAST;
    const int i = qt * 64 + lane; const bool active = i < T; const int row = row_of(s, active ? i : T - 1);
    bf16_t* Q = (bf16_t*)(p->ws + WS_Q);
    float* Kt = wl; float* Vt = wl + 32 * 64;
    float q[64], o[64];
    { const u32x4* qp = (const u32x4*)(Q + (size_t)row * 512 + h * 64);
#pragma unroll
        for (int e = 0; e < 8; ++e) { const u32x4 w = qp[e];
#pragma unroll
            for (int j = 0; j < 4; ++j) { q[e * 8 + 2 * j] = lo_f(w[j]) * 0.125f; q[e * 8 + 2 * j + 1] = hi_f(w[j]) * 0.125f; } } }
#pragma unroll
    for (int d = 0; d < 64; ++d) o[d] = 0.f;
    const float* kp_new = prompt ? p->out + O_KP + (size_t)(l * 32 + b) * 2064 * 512 + h * 64 : p->out + O_KS + (size_t)(l * 16 + b) * 64 * 512 + h * 64;
    const float* vp_new = prompt ? p->out + O_VP + (size_t)(l * 32 + b) * 2064 * 512 + h * 64 : p->out + O_VS + (size_t)(l * 16 + b) * 64 * 512 + h * 64;
    const float* kp_old = p->in[I_CK] + (size_t)(l * 16 + b) * 2048 * 512 + h * 64;
    const float* vp_old = p->in[I_CV] + (size_t)(l * 16 + b) * 2048 * 512 + h * 64;
    const int imax = (qt * 64 + 63 < T - 1) ? qt * 64 + 63 : T - 1;
    const int jtop = nh + imax - 1;
    float run = 0.f;
    for (int jt = jtop; jt >= 0; jt -= 32) {
#pragma unroll 4
        for (int e = 0; e < 8; ++e) { const int idx = e * 64 + lane, kr = idx >> 4, pc = idx & 15, j = jt - kr;
            if (j >= 0) { const float* kp = (j < nh) ? kp_old + (size_t)j * 512 : kp_new + (size_t)(j - nh) * 512; *(f32x4*)(Kt + kr * 64 + pc * 4) = *(const f32x4*)(kp + pc * 4); } }
#pragma unroll 4
        for (int e = 0; e < 8; ++e) { const int idx = e * 64 + lane, kr = idx >> 4, pc = idx & 15, j = jt - kr;
            if (j >= 0) { const float* vp = (j < nh) ? vp_old + (size_t)j * 512 : vp_new + (size_t)(j - nh) * 512; *(f32x4*)(Vt + kr * 64 + pc * 4) = *(const f32x4*)(vp + pc * 4); } }
        __builtin_amdgcn_wave_barrier(); asm volatile("s_waitcnt vmcnt(0) lgkmcnt(0)" ::: "memory");
        const int nk = jt + 1 < 32 ? jt + 1 : 32;
        for (int kk = 0; kk < nk; ++kk) { const int j = jt - kk;
            float z = 0.f;
#pragma unroll
            for (int d = 0; d < 64; d += 4) { const f32x4 kv = *(const f32x4*)(Kt + kk * 64 + d); z += q[d] * kv[0] + q[d + 1] * kv[1] + q[d + 2] * kv[2] + q[d + 3] * kv[3]; }
            const bool valid = active && (j < nh + i);
            const float e = __expf(-z), ls = -__logf(1.f + e);
            const float w = valid ? __expf(ls + run) : 0.f;
            run += valid ? (ls - z) : 0.f;
#pragma unroll
            for (int d = 0; d < 64; d += 4) { const f32x4 vv = *(const f32x4*)(Vt + kk * 64 + d); o[d] += w * vv[0]; o[d + 1] += w * vv[1]; o[d + 2] += w * vv[2]; o[d + 3] += w * vv[3]; } }
        __builtin_amdgcn_wave_barrier(); asm volatile("s_waitcnt lgkmcnt(0)" ::: "memory");
        const int fin = (!active) || (run < -100.f);
        if (__all(fin)) break;
    }
    if (active) { u32x4* op = (u32x4*)(Q + (size_t)row * 512 + h * 64);
#pragma unroll
        for (int e = 0; e < 8; ++e) { u32x4 w; w[0] = pk2(o[e * 8], o[e * 8 + 1]); w[1] = pk2(o[e * 8 + 2], o[e * 8 + 3]); w[2] = pk2(o[e * 8 + 4], o[e * 8 + 5]); w[3] = pk2(o[e * 8 + 6], o[e * 8 + 7]); op[e] = w; } }
}

__device__ __forceinline__ void phase_mixers(CPar p, int l, float* sm) {
#ifndef SKIP_SSD
    { CPar p1 = params_ptr();
#pragma unroll 1
      for (int it = lbid(); it < 768; it += lgdim()) ssd_item(p1, l, it, sm); }
#endif
    __syncthreads();
    const int wave = __builtin_amdgcn_readfirstlane(ltid() >> 6);
    float* wl = sm + wave * (68 * 64);
#ifndef SKIP_S5
    { CPar p2 = params_ptr();
    if (wave < 4) { for (int it = lbid() * 4 + wave; it < 1024; it += lgdim() * 4) s5_item(p2, l, it >> 5, it & 31, wl); }
    else if (wave < 6) { for (int it = lbid() * 2 + (wave - 4); it < 512; it += lgdim() * 2) s5_item(p2, l, 32 + (it >> 5), it & 31, wl); } }
#endif
#ifndef SKIP_ATT
    CPar p3 = params_ptr();
    unsigned* ctr = (unsigned*)(p3->ws + WS_CTR) + l;
    for (;;) {
        unsigned it = 0; if ((ltid() & 63) == 0) it = atomicAdd(ctr, 1u);
        it = (unsigned)__builtin_amdgcn_readfirstlane((int)it);
        if (it >= 8576u) break;
        attn_item(p3, l, (int)it, wl);
    }
#endif
}

__global__ __launch_bounds__(512, 2) void mega(Params pk) {
    extern __shared__ __attribute__((aligned(16))) unsigned char smem[];
    cg::grid_group grid = cg::this_grid();
    LAS unsigned char* lds = (LAS unsigned char*)smem;
    const int ph_lo = pk.ph_lo, ph_hi = pk.ph_hi;
    for (int ph = ph_lo; ph < ph_hi; ++ph) {
        if (ph > ph_lo) grid.sync();
        CPar p = params_ptr();
        unsigned char* ws = p->ws;
        bf16_t *HB = (bf16_t*)(ws + WS_HB), *Z = (bf16_t*)(ws + WS_Z), *XBC = (bf16_t*)(ws + WS_XBC), *U = (bf16_t*)(ws + WS_U), *Q = (bf16_t*)(ws + WS_Q), *G = (bf16_t*)(ws + WS_G);
        float *DT = (float*)(ws + WS_DT), *XM = (float*)(ws + WS_XMETA);
        const int l = ph / 9, sub = ph - l * 9;
        pg8::StaticOrder S;
        if (sub == 0) {
#ifndef SKIP0
            phase_prep(p, l);
#endif
        } else if (sub == 1) {
            S.init(NROWS, N1, lgdim(), lbid());
            EpiIn E{Z, XBC, U, Q, G, DT, p->out, p->in[I_QN] + l * 64, p->in[I_KN] + l * 64, l};
#ifndef SKIP1
            pg8::gemm_phase(lds, pg8::Gemm{HB, (const bf16_t*)(ws + W_BT1), NROWS, N1, 1024, 1024, 1024}, S, E);
#endif
        } else if (sub == 2) {
#ifndef SKIP2
            phase_mixers(p, l, (float*)smem);
#endif
        } else if (sub == 3) {
            ssd_norm_rows(p);
            S.init(NROWS, 2048, lgdim(), lbid());
            EpiGlu E{XBC};
            pg8::gemm_phase(lds, pg8::Gemm{U, (const bf16_t*)(ws + W_GLU), NROWS, 2048, 512, 512, 512}, S, E);
        } else if (sub == 4) {
            S.init(NROWS, 1024, lgdim(), lbid());
            for (int call = 0; call < 2; ++call) {
                EpiMix E; pg8::Gemm g;
                if (call == 0) { E = EpiMix{HB, G, XBC, 0}; g = pg8::Gemm{Z, (const bf16_t*)(ws + W_LA), NROWS, 1024, 1024, 1024, 1024}; }
                else { E = EpiMix{HB, G + 2048, nullptr, 1}; g = pg8::Gemm{Q, (const bf16_t*)(ws + W_LC), NROWS, 1024, 512, 512, 512}; }
#ifndef SKIP3
                pg8::gemm_phase(lds, g, S, E);
#endif
            }
        } else if (sub == 5) {
            S.init(NROWS, 1024, lgdim(), lbid());
            EpiRes E{p->out, XM};
#ifndef SKIP4
            pg8::gemm_phase(lds, pg8::Gemm{HB, (const bf16_t*)(ws + W_OUT), NROWS, 1024, 1024, 1024, 1024}, S, E);
#endif
        } else if (sub == 6) {
            rmsnorm_rows(p, p->in[I_NFFN] + l * 1024, 0);
        } else if (sub == 7) {
            S.init(NROWS, 4096, lgdim(), lbid());
            EpiUp E{(bf16_t*)(ws + WS_ACT)};
#ifndef SKIP6
            pg8::gemm_phase(lds, pg8::Gemm{HB, (const bf16_t*)(ws + W_UP), NROWS, 4096, 1024, 1024, 1024}, S, E);
#endif
        } else {
            S.init(NROWS, 1024, lgdim(), lbid());
            EpiRes E{p->out, XM};
#ifndef SKIP7
            pg8::gemm_phase(lds, pg8::Gemm{(const bf16_t*)(ws + WS_ACT), (const bf16_t*)(ws + W_DOWN), NROWS, 1024, 4096, 4096, 4096}, S, E);
#endif
        }
    }
}

extern "C" void kernel_launch(void* const* d_in, const int* in_sizes, int n_in, void* d_out, int out_size, void* d_ws, size_t ws_size, hipStream_t stream) {
    static int grid = 0;
    if (grid == 0) {
        if (n_in != 34 || (size_t)out_size != O_END || ws_size < WS_END) { fprintf(stderr, "kernel_launch: unexpected shapes n_in %d out %d ws %zu (need %zu)\n", n_in, out_size, ws_size, (size_t)WS_END); grid = -1; return; }
        int dev = 0, cus = 0, per_cu = 0;
        hipGetDevice(&dev); hipDeviceGetAttribute(&cus, hipDeviceAttributeMultiprocessorCount, dev);
        if (hipFuncSetAttribute((const void*)mega, hipFuncAttributeMaxDynamicSharedMemorySize, LDS_BYTES) != hipSuccess) { fprintf(stderr, "kernel_launch: hipFuncSetAttribute failed\n"); grid = -1; return; }
        if (hipOccupancyMaxActiveBlocksPerMultiprocessor(&per_cu, (const void*)mega, 512, LDS_BYTES) != hipSuccess || per_cu < 1) { fprintf(stderr, "kernel_launch: occupancy query says %d\n", per_cu); per_cu = 1; }
        (void)hipGetLastError();
        grid = cus * per_cu;
    }
    if (grid < 0) return;
    Params p{};
    for (int i = 0; i < 34; ++i) p.in[i] = (const float*)d_in[i];
    p.out = (float*)d_out; p.ws = (unsigned char*)d_ws;
#if MULTI_LAUNCH
    for (int ph = 0; ph < 18; ++ph) { p.ph_lo = ph; p.ph_hi = ph + 1; hipLaunchKernelGGL(mega, dim3(grid), dim3(512), LDS_BYTES, stream, p); }
#else
    p.ph_lo = 0; p.ph_hi = 18;
    void* args[] = {&p};
    hipError_t e = hipLaunchCooperativeKernel((const void*)mega, dim3(grid), dim3(512), args, LDS_BYTES, stream);
    if (e != hipSuccess) fprintf(stderr, "cooperative launch failed: %s (grid %d)\n", hipGetErrorString(e), grid);
#endif
}
```

```cpp
#include <hip/hip_runtime.h>
#include <hip/hip_cooperative_groups.h>
#include <cstdio>
#include <cstdint>
namespace cg = cooperative_groups;

#ifndef MULTI_LAUNCH
#define MULTI_LAUNCH 0
#endif

typedef unsigned short bf16_t;
typedef short bf16x8 __attribute__((ext_vector_type(8)));
typedef float f32x4 __attribute__((ext_vector_type(4)));
typedef unsigned u32x4 __attribute__((ext_vector_type(4)));
typedef unsigned u32x2 __attribute__((ext_vector_type(2)));
#define LAS __attribute__((address_space(3)))

constexpr int D = 1024, NROWS = 67072, NS0 = 65536, NM0 = 66560;
constexpr int TP = 2064, TS = 64, NB_P = 32, NB_S = 16, PAST = 2048;
constexpr int IN_COLS = 7440, N1 = 7680;
constexpr int SSQ_SLOTS = NM0 + 32 * 32;
constexpr float EPS = 1e-6f;
constexpr size_t O_YP = 0, O_YS = 67108864ull, O_KP = O_YS + 1048576ull, SZ_KP = 2ull * 32 * 2064 * 512, O_VP = O_KP + SZ_KP,
                 O_CONVP = O_VP + SZ_KP, O_SSDP = O_CONVP + 2ull * 32 * 3 * 1280, O_S5RP = O_SSDP + 2ull * 32 * 16 * 4096, O_S5IP = O_S5RP + 2ull * 32 * 2048,
                 O_KS = O_S5IP + 2ull * 32 * 2048, O_VS = O_KS + 2ull * 16 * 64 * 512, O_CONVS = O_VS + 2ull * 16 * 64 * 512, O_SSDS = O_CONVS + 2ull * 16 * 3 * 1280,
                 O_S5RS = O_SSDS + 2ull * 16 * 16 * 4096, O_S5IS = O_S5RS + 2ull * 16 * 2048, O_END = O_S5IS + 2ull * 16 * 2048;
constexpr size_t W_BT1 = 0, W_GLU = W_BT1 + (size_t)N1 * 1024 * 2, W_LA = W_GLU + 2048ull * 512 * 2, W_LC = W_LA + 1024ull * 1024 * 2, W_OUT = W_LC + 1024ull * 512 * 2,
                 W_UP = W_OUT + 1024ull * 1024 * 2, W_DOWN = W_UP + 4096ull * 1024 * 2, W_END = W_DOWN + 4096ull * 1024 * 2;
constexpr size_t WS_CTR = W_END, WS_XMETA = WS_CTR + 4096, WS_HB = WS_XMETA + 512ull * 1024 * 4, WS_Z = WS_HB + (size_t)NROWS * 1024 * 2, WS_XBC = WS_Z + (size_t)NROWS * 1024 * 2,
                 WS_U = WS_XBC + (size_t)NROWS * 1280 * 2, WS_Q = WS_U + (size_t)NROWS * 512 * 2, WS_G = WS_Q + (size_t)NROWS * 512 * 2, WS_DT = WS_G + (size_t)NROWS * 3072 * 2,
                 WS_SSQ = WS_DT + (size_t)NROWS * 16 * 4, WS_END = WS_SSQ + (size_t)SSQ_SLOTS * 16 * 4;
constexpr size_t WS_ACT = WS_Z;
static_assert(WS_ACT + (size_t)NROWS * 4096 * 2 <= WS_DT, "ACT overlay");
constexpr int LDS_BYTES = 147456;

struct Params {
    const float* in[34];
    float* out;
    unsigned char* ws;
    int ph_lo, ph_hi;
};
typedef const __attribute__((address_space(4))) Params* CPar;
__device__ __forceinline__ CPar params_ptr() { CPar q = (CPar)__builtin_amdgcn_kernarg_segment_ptr(); asm volatile("" : "+s"(q)); return q; }
#define PIN(i) (p->in[i])
enum { I_XP = 0, I_XS, I_CK, I_CV, I_SCONV, I_SSSD, I_S5R, I_S5I, I_META, I_NMIX, I_WIN, I_CONVW, I_CONVB, I_DTB, I_ALOG, I_DSSD, I_NSSD, I_LRE, I_LIM, I_LSTEP, I_BRE, I_BIM,
       I_CRE, I_CIM, I_DS5, I_WGLU, I_QN, I_KN, I_WLA, I_WLC, I_WOUT, I_NFFN, I_WUP, I_WDOWN };

__device__ __forceinline__ int ltid() { int t = threadIdx.x; asm volatile("" : "+v"(t)); return t; }
__device__ __forceinline__ int lbid() { int t = blockIdx.x; asm volatile("" : "+s"(t)); return t; }
__device__ __forceinline__ int lgdim() { int t = gridDim.x; asm volatile("" : "+s"(t)); return t; }

__device__ __forceinline__ float bf2f(bf16_t v) { return __uint_as_float((unsigned)v << 16); }
__device__ __forceinline__ unsigned pk2(float lo, float hi) { unsigned r; asm volatile("v_cvt_pk_bf16_f32 %0, %1, %2" : "=v"(r) : "v"(lo), "v"(hi)); return r; }
__device__ __forceinline__ float lo_f(unsigned w) { return __uint_as_float(w << 16); }
__device__ __forceinline__ float hi_f(unsigned w) { return __uint_as_float(w & 0xffff0000u); }
__device__ __forceinline__ u32x2 ld_l2_u32x2(const void* ptr) { const unsigned long long v = __hip_atomic_load((const unsigned long long*)ptr, __ATOMIC_RELAXED, __HIP_MEMORY_SCOPE_AGENT); u32x2 r; r[0] = (unsigned)v; r[1] = (unsigned)(v >> 32); return r; }
__device__ __forceinline__ float sigmoidf_(float v) { return __builtin_amdgcn_rcpf(1.f + __expf(-v)); }
__device__ __forceinline__ float siluf_(float v) { return v * sigmoidf_(v); }
__device__ __forceinline__ float geluf_(float y) { const float a = 0.7978845608f * (y + 0.044715f * y * y * y); const float t = __expf(2.f * a); return 0.5f * y * (2.f - 2.f * __builtin_amdgcn_rcpf(t + 1.f)); }
__device__ __forceinline__ float wave_sum(float v) {
#pragma unroll
    for (int o = 1; o < 64; o <<= 1) v += __shfl_xor(v, o);
    return v;
}
__device__ __forceinline__ void sincos_red(double x, float& sn, float& cs) {
    const double k = __builtin_rint(x * 0.63661977236758134308);
    const float r = (float)__builtin_fma(-k, 1.57079632679489661923, x), r2 = r * r;
    const float sp = r + r * r2 * (-1.6666667163e-01f + r2 * (8.3333337680e-03f + r2 * (-1.9841270114e-04f + r2 * 2.7557314297e-06f)));
    const float cp = 1.f + r2 * (-0.5f + r2 * (4.1666667908e-02f + r2 * (-1.3888889225e-03f + r2 * (2.4801587642e-05f - r2 * 2.7557314297e-07f))));
    const int q = ((int)k) & 3;
    sn = (q == 0) ? sp : (q == 1) ? cp : (q == 2) ? -sp : -cp;
    cs = (q == 0) ? cp : (q == 1) ? -sp : (q == 2) ? -cp : sp;
}
__device__ __forceinline__ int row_of(int s, int t) { return s < 32 ? (t < 16 ? NM0 + s * 16 + t : s * 2048 + t - 16) : NS0 + (s - 32) * 64 + t; }
__device__ __forceinline__ int ssq_slot(int r) { return r < NM0 ? r : NM0 + ((r - NM0) >> 4) * 32 + ((r - NM0) & 15); }
__device__ __forceinline__ float* xloc(CPar p, int r) { return r < NM0 ? p->out + (size_t)r * 1024 : (float*)(p->ws + WS_XMETA) + (size_t)(r - NM0) * 1024; }
__device__ __forceinline__ size_t k_off(int l, int r) {
    if (r < NS0) return O_KP + ((size_t)(l * 32 + (r >> 11)) * 2064 + 16 + (r & 2047)) * 512;
    if (r < NM0) { const int rs = r - NS0; return O_KS + ((size_t)(l * 16 + (rs >> 6)) * 64 + (rs & 63)) * 512; }
    const int rm = r - NM0; return O_KP + ((size_t)(l * 32 + (rm >> 4)) * 2064 + (rm & 15)) * 512;
}

namespace pg8 {
constexpr int BM = 256, BK = 64, HALF = 128, HTB = HALF * BK * 2, STAGE_BYTES = 8 * HTB, NXCD = 8, WGM = 8;
__host__ __device__ __forceinline__ int lds_byte(int r, int c) { const int st = (r >> 4) * 2 + (c >> 5), rr = r & 15, cc = c & 31, ob = rr * 64 + cc * 2; return st * 1024 + (ob ^ (((ob >> 9) & 1) << 5)); }
__host__ __device__ __forceinline__ void stage_rc(int b, int& R, int& C) { const int st = b / 1024, sb = b % 1024, swz = sb ^ (((sb >> 9) & 1) << 5); R = (st >> 1) * 16 + swz / 64; C = (st & 1) * 32 + (swz % 64) / 2; }
struct Unit { int pm, pn; };
struct Gemm { const bf16_t* A; const bf16_t* Bt; int M, N, K, lda, ldb; };
struct StaticOrder {
    int nM, nN, nwg, G, c;
    __device__ void init(int M, int N, int G_, int c_) { nM = M / BM; nN = N / BM; nwg = nM * nN; G = G_; c = c_; }
    __device__ bool next(int i, Unit& u) const {
        const long L = (long)i * G + c; if (L >= nwg) return false;
        int wgid = (int)L; { const int q = nwg / NXCD, r = nwg % NXCD, xcd = wgid % NXCD, off = wgid / NXCD; wgid = (xcd < r ? xcd * (q + 1) : r * (q + 1) + (xcd - r) * q) + off; }
        const int nig = WGM * nN, gid = wgid / nig, fm = gid * WGM, gsz = (nM - fm) < WGM ? (nM - fm) : WGM;
        u.pm = fm + ((wgid % nig) % gsz); u.pn = (wgid % nig) / gsz; return true;
    }
};
template <class Epi>
__device__ __forceinline__ void gemm_phase(LAS unsigned char* lds, const Gemm g, const StaticOrder& S, const Epi& E) {
    const int tid = ltid(), wid = __builtin_amdgcn_readfirstlane(tid >> 6), lane = tid & 63, wr = wid >> 2, wc = wid & 3, fr = lane & 15, fq = lane >> 4;
    const int K = g.K, nt = K / BK;
    unsigned voffA[2], voffB[2];
#pragma unroll
    for (int i = 0; i < 2; ++i) { int R, C; stage_rc(tid * 16 + i * 8192, R, C); voffA[i] = (unsigned)(R * g.lda + C) * 2u; voffB[i] = (unsigned)(R * g.ldb + C) * 2u; }
    const size_t kstep = (size_t)(BK * 2);
    const size_t hstepA = (size_t)HALF * g.lda * 2, hstepB = (size_t)HALF * g.ldb * 2;
    const size_t tstepA = 2 * hstepA, tstepB = 2 * hstepB;
    const unsigned ldsw = (unsigned)wid * 1024u;
    const int aoff = lds_byte(wr * 64 + fr, fq * 8), boff = lds_byte(wc * 32 + fr, fq * 8);
#define PG8_SA(b, h) (((b) * 2 + (h)) * HTB)
#define PG8_SB(b, h) ((4 + (b) * 2 + (h)) * HTB)
#define PG8_STAGE(bufoff, gbase, voff) do { _Pragma("unroll") for (int _i = 0; _i < 2; ++_i) \
        __builtin_amdgcn_global_load_lds((const unsigned*)((const char*)(gbase) + (voff)[_i]), (LAS unsigned*)(lds + (bufoff) + ldsw + _i * 8192), 16, 0, 0); } while (0)
#define PG8_LDA(dst, b, h) do { _Pragma("unroll") for (int m = 0; m < 4; ++m) _Pragma("unroll") for (int k = 0; k < 2; ++k) dst[m][k] = *(const LAS bf16x8*)(lds + PG8_SA(b, h) + aoff + m * 2048 + k * 1024); } while (0)
#define PG8_LDB(dst, b, h) do { _Pragma("unroll") for (int n = 0; n < 2; ++n) _Pragma("unroll") for (int k = 0; k < 2; ++k) dst[n][k] = *(const LAS bf16x8*)(lds + PG8_SB(b, h) + boff + n * 2048 + k * 1024); } while (0)
#define PG8_MMA(ai, bj, At, Bt) do { __builtin_amdgcn_s_setprio(1); _Pragma("unroll") for (int m = 0; m < 4; ++m) _Pragma("unroll") for (int n = 0; n < 2; ++n) _Pragma("unroll") for (int k = 0; k < 2; ++k) \
        acc[ai][bj][m][n] = __builtin_amdgcn_mfma_f32_16x16x32_bf16(Bt[n][k], At[m][k], acc[ai][bj][m][n], 0, 0, 0); __builtin_amdgcn_s_setprio(0); } while (0)
#define PG8_WAIT_V(n) asm volatile("s_waitcnt vmcnt(" #n ")" ::: "memory")
#define PG8_WAIT_L(n) asm volatile("s_waitcnt lgkmcnt(" #n ")" ::: "memory")
#define PG8_BAR __builtin_amdgcn_s_barrier()
#define PG8_SCHED __builtin_amdgcn_sched_barrier(0)
    Unit cur, nxt; int ui = 0;
    if (!S.next(0, cur)) return;
    f32x4 acc[2][2][4][2];
#pragma unroll
    for (int a = 0; a < 2; ++a)
#pragma unroll
        for (int b = 0; b < 2; ++b)
#pragma unroll
            for (int m = 0; m < 4; ++m)
#pragma unroll
                for (int n = 0; n < 2; ++n) acc[a][b][m][n] = (f32x4){0.f, 0.f, 0.f, 0.f};
    bf16x8 At[4][2], B0[2][2], B1[2][2];
    const char* cA = (const char*)g.A + (size_t)cur.pm * tstepA; const char* cB = (const char*)g.Bt + (size_t)cur.pn * tstepB;
    PG8_STAGE(PG8_SB(0, 0), cB, voffB); PG8_STAGE(PG8_SA(0, 0), cA, voffA); PG8_STAGE(PG8_SB(0, 1), cB + hstepB, voffB); PG8_STAGE(PG8_SA(0, 1), cA + hstepA, voffA);
    if (wr == 1) PG8_BAR;
    PG8_WAIT_V(4); PG8_BAR;
    PG8_STAGE(PG8_SB(1, 0), cB + kstep, voffB); PG8_STAGE(PG8_SA(1, 0), cA + kstep, voffA); PG8_STAGE(PG8_SB(1, 1), cB + hstepB + kstep, voffB);
    PG8_WAIT_V(6); PG8_BAR;
    for (;;) {
        const bool has_next = S.next(ui + 1, nxt);
        const char* nA = has_next ? (const char*)g.A + (size_t)nxt.pm * tstepA : cA; const char* nB = has_next ? (const char*)g.Bt + (size_t)nxt.pn * tstepB : cB;
        for (int t = 0; t < nt; t += 2) {
            const bool last = (t == nt - 2);
            const char* a1 = cA + (size_t)(t + 1) * kstep;
            const char* a2 = last ? nA : cA + (size_t)(t + 2) * kstep; const char* b2 = last ? nB : cB + (size_t)(t + 2) * kstep;
            const char* a3 = a2 + kstep; const char* b3 = b2 + kstep;
            PG8_LDB(B0, 0, 0); PG8_SCHED; PG8_LDA(At, 0, 0); PG8_STAGE(PG8_SA(1, 1), a1 + hstepA, voffA);
            PG8_WAIT_L(8); PG8_BAR; PG8_WAIT_L(0); PG8_MMA(0, 0, At, B0); PG8_BAR; PG8_SCHED;
            PG8_LDB(B1, 0, 1); PG8_STAGE(PG8_SB(0, 0), b2, voffB);
            PG8_BAR; PG8_WAIT_L(0); PG8_MMA(0, 1, At, B1); PG8_BAR;
            PG8_LDA(At, 0, 1); PG8_STAGE(PG8_SA(0, 0), a2, voffA);
            PG8_BAR; PG8_WAIT_L(0); PG8_MMA(1, 0, At, B0); PG8_BAR; PG8_SCHED;
            PG8_STAGE(PG8_SB(0, 1), b2 + hstepB, voffB);
            PG8_WAIT_V(6); PG8_BAR; PG8_MMA(1, 1, At, B1); PG8_BAR;
            PG8_LDB(B0, 1, 0); PG8_SCHED; PG8_LDA(At, 1, 0); PG8_STAGE(PG8_SA(0, 1), a2 + hstepA, voffA);
            PG8_WAIT_L(8); PG8_BAR; PG8_WAIT_L(0); PG8_MMA(0, 0, At, B0); PG8_BAR; PG8_SCHED;
            PG8_LDB(B1, 1, 1); PG8_STAGE(PG8_SB(1, 0), b3, voffB);
            PG8_BAR; PG8_WAIT_L(0); PG8_MMA(0, 1, At, B1); PG8_BAR;
            PG8_LDA(At, 1, 1); PG8_STAGE(PG8_SA(1, 0), a3, voffA);
            PG8_BAR; PG8_WAIT_L(0); PG8_MMA(1, 0, At, B0); PG8_BAR; PG8_SCHED;
            PG8_STAGE(PG8_SB(1, 1), b3 + hstepB, voffB);
            PG8_WAIT_V(6); PG8_BAR; PG8_MMA(1, 1, At, B1); PG8_BAR;
        }
        E(acc, cur, wr, wc, fr, fq);
        if (!has_next) break;
#pragma unroll
        for (int a = 0; a < 2; ++a)
#pragma unroll
            for (int b = 0; b < 2; ++b)
#pragma unroll
                for (int m = 0; m < 4; ++m)
#pragma unroll
                    for (int n = 0; n < 2; ++n) acc[a][b][m][n] = (f32x4){0.f, 0.f, 0.f, 0.f};
        cur = nxt; cA = nA; cB = nB; ++ui;
    }
    PG8_WAIT_V(0);
    if (wr == 0) PG8_BAR;
    PG8_BAR;
#undef PG8_SA
#undef PG8_SB
#undef PG8_STAGE
#undef PG8_LDA
#undef PG8_LDB
#undef PG8_MMA
#undef PG8_WAIT_V
#undef PG8_WAIT_L
#undef PG8_BAR
#undef PG8_SCHED
}
}
using pg8::Unit;

struct EpiIn {
    bf16_t *Z, *XBC, *U, *Q, *G; float* DT; float* out; const float *qn, *kn; int layer;
    __device__ __forceinline__ void operator()(const f32x4 (&acc)[2][2][4][2], const Unit& u, int wr, int wc, int fr, int fq) const {
        const int pn = u.pn, rowb = u.pm * 256 + wr * 64 + fr, ctb = wc * 32 + fq * 4;
        if (pn < 11 || (pn >= 17 && pn < 29)) {
            bf16_t* base; int ld, col0; bool sig = false;
            if (pn < 4) { base = Z; ld = 1024; col0 = pn * 256; } else if (pn < 9) { base = XBC; ld = 1280; col0 = (pn - 4) * 256; }
            else if (pn < 11) { base = U; ld = 512; col0 = (pn - 9) * 256; } else { base = G; ld = 3072; col0 = (pn - 17) * 256; sig = true; }
#pragma unroll
            for (int ai = 0; ai < 2; ++ai)
#pragma unroll
                for (int m = 0; m < 4; ++m) { bf16_t* rp = base + (size_t)(rowb + ai * 128 + m * 16) * ld + col0 + ctb;
#pragma unroll
                    for (int bj = 0; bj < 2; ++bj)
#pragma unroll
                        for (int n = 0; n < 2; ++n) { f32x4 v = acc[ai][bj][m][n];
                            if (sig) { v[0] = sigmoidf_(v[0]); v[1] = sigmoidf_(v[1]); v[2] = sigmoidf_(v[2]); v[3] = sigmoidf_(v[3]); }
                            u32x2 o; o[0] = pk2(v[0], v[1]); o[1] = pk2(v[2], v[3]); *(u32x2*)(rp + bj * 128 + n * 16) = o; } }
        } else if (pn < 17) {
            const int seg = (pn - 11) >> 1, head = ((pn - 11) & 1) * 4 + wc;
            const float* nw = seg == 0 ? qn : kn;
            f32x4 wv[2][2];
#pragma unroll
            for (int bj = 0; bj < 2; ++bj)
#pragma unroll
                for (int n = 0; n < 2; ++n) wv[bj][n] = (seg < 2) ? *(const f32x4*)(nw + 32 * bj + 16 * n + 4 * fq) : (f32x4){1.f, 1.f, 1.f, 1.f};
#pragma unroll
            for (int ai = 0; ai < 2; ++ai)
#pragma unroll
                for (int m = 0; m < 4; ++m) { const int row = rowb + ai * 128 + m * 16;
                    float rs = 1.f;
                    if (seg < 2) { float ss = 0.f;
#pragma unroll
                        for (int bj = 0; bj < 2; ++bj)
#pragma unroll
                            for (int n = 0; n < 2; ++n) { const f32x4 v = acc[ai][bj][m][n]; ss += v[0] * v[0] + v[1] * v[1] + v[2] * v[2] + v[3] * v[3]; }
                        ss += __shfl_xor(ss, 16); ss += __shfl_xor(ss, 32);
                        rs = rsqrtf(ss * (1.f / 64.f) + EPS); }
                    if (seg == 0) { bf16_t* rp = Q + (size_t)row * 512 + head * 64 + 4 * fq;
#pragma unroll
                        for (int bj = 0; bj < 2; ++bj)
#pragma unroll
                            for (int n = 0; n < 2; ++n) { const f32x4 v = acc[ai][bj][m][n] * rs * wv[bj][n]; u32x2 o; o[0] = pk2(v[0], v[1]); o[1] = pk2(v[2], v[3]); *(u32x2*)(rp + 32 * bj + 16 * n) = o; }
                    } else { float* rp = out + k_off(layer, row) + (seg == 2 ? (row >= NS0 && row < NM0 ? (O_VS - O_KS) : (O_VP - O_KP)) : 0) + head * 64 + 4 * fq;
#pragma unroll
                        for (int bj = 0; bj < 2; ++bj)
#pragma unroll
                            for (int n = 0; n < 2; ++n) { const f32x4 v = acc[ai][bj][m][n] * rs * wv[bj][n]; *(f32x4*)(rp + 32 * bj + 16 * n) = v; } } }
        } else {
            if (wc == 0) {
#pragma unroll
                for (int ai = 0; ai < 2; ++ai)
#pragma unroll
                    for (int m = 0; m < 4; ++m) *(f32x4*)(DT + (size_t)(rowb + ai * 128 + m * 16) * 16 + 4 * fq) = acc[ai][0][m][0];
            }
        }
    }
};
struct EpiGlu {
    bf16_t* OB;
    __device__ __forceinline__ void operator()(const f32x4 (&acc)[2][2][4][2], const Unit& u, int wr, int wc, int fr, int fq) const {
        const int rowb = u.pm * 256 + wr * 64 + fr, colb = u.pn * 128 + wc * 32 + fq * 4;
#pragma unroll
        for (int ai = 0; ai < 2; ++ai)
#pragma unroll
            for (int m = 0; m < 4; ++m) { bf16_t* rp = OB + (size_t)(rowb + ai * 128 + m * 16) * 1024 + colb;
#pragma unroll
                for (int n = 0; n < 2; ++n) { const f32x4 a = acc[ai][0][m][n], g = acc[ai][1][m][n];
                    u32x2 o; o[0] = pk2(a[0] * sigmoidf_(g[0]), a[1] * sigmoidf_(g[1])); o[1] = pk2(a[2] * sigmoidf_(g[2]), a[3] * sigmoidf_(g[3])); *(u32x2*)(rp + n * 16) = o; } }
    }
};
struct EpiMix {
    bf16_t* R; const bf16_t* G; const bf16_t* OB; int accum;
    __device__ __forceinline__ void operator()(const f32x4 (&acc)[2][2][4][2], const Unit& u, int wr, int wc, int fr, int fq) const {
        const int rowb = u.pm * 256 + wr * 64 + fr, colb = u.pn * 256 + wc * 32 + fq * 4;
#pragma unroll
        for (int ai = 0; ai < 2; ++ai)
#pragma unroll
            for (int m = 0; m < 4; ++m) { const int row = rowb + ai * 128 + m * 16;
#pragma unroll
                for (int bj = 0; bj < 2; ++bj)
#pragma unroll
                    for (int n = 0; n < 2; ++n) { const int col = colb + bj * 128 + n * 16; f32x4 v = acc[ai][bj][m][n];
                        const u32x2 gw = *(const u32x2*)(G + (size_t)row * 3072 + col);
                        v = v * (f32x4){lo_f(gw[0]), hi_f(gw[0]), lo_f(gw[1]), hi_f(gw[1])};
                        if (OB) { const u32x2 g1 = *(const u32x2*)(G + (size_t)row * 3072 + 1024 + col), ob = *(const u32x2*)(OB + (size_t)row * 1024 + col);
                            v = v + (f32x4){lo_f(g1[0]), hi_f(g1[0]), lo_f(g1[1]), hi_f(g1[1])} * (f32x4){lo_f(ob[0]), hi_f(ob[0]), lo_f(ob[1]), hi_f(ob[1])}; }
                        bf16_t* rp = R + (size_t)row * 1024 + col;
                        if (accum) { const u32x2 rw = ld_l2_u32x2(rp); v = v + (f32x4){lo_f(rw[0]), hi_f(rw[0]), lo_f(rw[1]), hi_f(rw[1])}; }
                        u32x2 o; o[0] = pk2(v[0], v[1]); o[1] = pk2(v[2], v[3]); *(u32x2*)rp = o; } }
    }
};
struct EpiRes {
    float* out; float* xmeta;
    __device__ __forceinline__ void operator()(const f32x4 (&acc)[2][2][4][2], const Unit& u, int wr, int wc, int fr, int fq) const {
        const int rowb = u.pm * 256 + wr * 64 + fr, colb = u.pn * 256 + wc * 32 + fq * 4;
        float* base = (u.pm * 256 < NM0) ? out : xmeta - (size_t)NM0 * 1024;
#pragma unroll
        for (int ai = 0; ai < 2; ++ai)
#pragma unroll
            for (int m = 0; m < 4; ++m) { float* rp = base + (size_t)(rowb + ai * 128 + m * 16) * 1024 + colb;
#pragma unroll
                for (int bj = 0; bj < 2; ++bj)
#pragma unroll
                    for (int n = 0; n < 2; ++n) { f32x4* q = (f32x4*)(rp + bj * 128 + n * 16); *q = *q + acc[ai][bj][m][n]; } }
    }
};
struct EpiUp {
    bf16_t* ACT;
    __device__ __forceinline__ void operator()(const f32x4 (&acc)[2][2][4][2], const Unit& u, int wr, int wc, int fr, int fq) const {
        const int rowb = u.pm * 256 + wr * 64 + fr, colb = u.pn * 256 + wc * 32 + fq * 4;
#pragma unroll
        for (int ai = 0; ai < 2; ++ai)
#pragma unroll
            for (int m = 0; m < 4; ++m) { bf16_t* rp = ACT + (size_t)(rowb + ai * 128 + m * 16) * 4096 + colb;
#pragma unroll
                for (int bj = 0; bj < 2; ++bj)
#pragma unroll
                    for (int n = 0; n < 2; ++n) { f32x4 v = acc[ai][bj][m][n];
#pragma unroll
                        for (int j = 0; j < 4; ++j) { const float r = fmaxf(v[j], 0.f); v[j] = r * r; }
                        u32x2 o; o[0] = pk2(v[0], v[1]); o[1] = pk2(v[2], v[3]); *(u32x2*)(rp + bj * 128 + n * 16) = o; } }
    }
};

__device__ __forceinline__ int col_in(int n) {
    if (n < 2304) return n;
    if (n < 2816) return n + 16;
    if (n < 4352) { const int w0 = n - 2816, seg = w0 >> 9, w = w0 & 511, tile = w >> 8, ct = w & 255, bj = ct >> 7, wc = (ct >> 5) & 3, ww = ct & 31;
        return 2832 + seg * 512 + (tile * 4 + wc) * 64 + 32 * bj + ww; }
    if (n < 7424) return n + 16;
    if (n < 7440) return 2304 + (n - 7424);
    return -1;
}
template <int MAP>
__device__ __forceinline__ void prep_w(bf16_t* dst, const float* src, int K, int N, int ld, const float* scale, size_t gtid, size_t gsz) {
    const size_t items = (size_t)(K / 8) * N;
    for (size_t it = gtid; it < items; it += gsz) {
        const int n = (int)(it % N), k8 = (int)(it / N);
        const int c = MAP == 1 ? col_in(n) : (MAP == 2 ? (((n >> 7) & 1) * 1024 + (n >> 8) * 128 + (n & 127)) : n);
        float v[8];
#pragma unroll
        for (int kk = 0; kk < 8; ++kk) { const int k = k8 * 8 + kk; float x = (c >= 0) ? src[(size_t)k * ld + c] : 0.f; if (scale) x *= scale[k]; v[kk] = x; }
        u32x4 o; o[0] = pk2(v[0], v[1]); o[1] = pk2(v[2], v[3]); o[2] = pk2(v[4], v[5]); o[3] = pk2(v[6], v[7]);
        *(u32x4*)(dst + (size_t)n * K + k8 * 8) = o;
    }
}
__device__ __forceinline__ void rmsnorm_rows(CPar p, const float* g, int from_inputs) {
    const int lane = ltid() & 63, gw = lbid() * 8 + (ltid() >> 6), ngw = lgdim() * 8;
    bf16_t* HB = (bf16_t*)(p->ws + WS_HB);
    f32x4 gv[4];
#pragma unroll
    for (int j = 0; j < 4; ++j) gv[j] = *(const f32x4*)(g + lane * 4 + 256 * j);
    for (int r = gw; r < NROWS; r += ngw) {
        float* xl = xloc(p, r);
        const float* src = xl;
        if (from_inputs) src = r < NS0 ? p->in[I_XP] + (size_t)r * 1024 : (r < NM0 ? p->in[I_XS] + (size_t)(r - NS0) * 1024 : p->in[I_META] + (size_t)((r - NM0) & 15) * 1024);
        f32x4 v[4]; float s = 0.f;
#pragma unroll
        for (int j = 0; j < 4; ++j) { v[j] = *(const f32x4*)(src + lane * 4 + 256 * j); s += (v[j][0] * v[j][0] + v[j][1] * v[j][1]) + (v[j][2] * v[j][2] + v[j][3] * v[j][3]); }
        const float rstd = rsqrtf(wave_sum(s) * (1.f / 1024.f) + EPS);
#pragma unroll
        for (int j = 0; j < 4; ++j) { if (from_inputs) *(f32x4*)(xl + lane * 4 + 256 * j) = v[j];
            const f32x4 h = v[j] * rstd * gv[j]; u32x2 o; o[0] = pk2(h[0], h[1]); o[1] = pk2(h[2], h[3]); *(u32x2*)(HB + (size_t)r * 1024 + lane * 4 + 256 * j) = o; }
    }
}
__device__ __forceinline__ void ssd_norm_rows(CPar p) {
    const int lane = ltid() & 63, gw = lbid() * 8 + (ltid() >> 6), ngw = lgdim() * 8;
    bf16_t* Z = (bf16_t*)(p->ws + WS_Z);
    for (int r = gw; r < NROWS; r += ngw) {
#pragma unroll
        for (int j = 0; j < 2; ++j) { u32x4* zp = (u32x4*)(Z + (size_t)r * 1024 + j * 512 + lane * 8); const u32x4 w = *zp;
            float f[8] = {lo_f(w[0]), hi_f(w[0]), lo_f(w[1]), hi_f(w[1]), lo_f(w[2]), hi_f(w[2]), lo_f(w[3]), hi_f(w[3])};
            float ss = 0.f;
#pragma unroll
            for (int i = 0; i < 8; ++i) ss += f[i] * f[i];
            const float rs = rsqrtf(wave_sum(ss) * (1.f / 512.f) + EPS);
            u32x4 o; o[0] = pk2(f[0] * rs, f[1] * rs); o[1] = pk2(f[2] * rs, f[3] * rs); o[2] = pk2(f[4] * rs, f[5] * rs); o[3] = pk2(f[6] * rs, f[7] * rs); *zp = o; }
    }
}
__device__ __forceinline__ void phase_prep(CPar p, int l) {
    const size_t gtid = (size_t)lbid() * 512 + ltid(), gsz = (size_t)lgdim() * 512;
    unsigned char* ws = p->ws;
    prep_w<1>((bf16_t*)(ws + W_BT1), p->in[I_WIN] + (size_t)l * 1024 * IN_COLS, 1024, N1, IN_COLS, nullptr, gtid, gsz);
    prep_w<2>((bf16_t*)(ws + W_GLU), p->in[I_WGLU] + (size_t)l * 512 * 2048, 512, 2048, 2048, nullptr, gtid, gsz);
    prep_w<0>((bf16_t*)(ws + W_LA), p->in[I_WLA] + (size_t)l * 1024 * 1024, 1024, 1024, 1024, p->in[I_NSSD] + l * 1024, gtid, gsz);
    prep_w<0>((bf16_t*)(ws + W_LC), p->in[I_WLC] + (size_t)l * 512 * 1024, 512, 1024, 1024, nullptr, gtid, gsz);
    prep_w<0>((bf16_t*)(ws + W_OUT), p->in[I_WOUT] + (size_t)l * 1024 * 1024, 1024, 1024, 1024, nullptr, gtid, gsz);
    prep_w<0>((bf16_t*)(ws + W_UP), p->in[I_WUP] + (size_t)l * 1024 * 4096, 1024, 4096, 4096, nullptr, gtid, gsz);
    prep_w<0>((bf16_t*)(ws + W_DOWN), p->in[I_WDOWN] + (size_t)l * 4096 * 1024, 4096, 1024, 1024, nullptr, gtid, gsz);
    if (lbid() == 0 && ltid() < 16) ((unsigned*)(ws + WS_CTR))[ltid()] = 0u;
    rmsnorm_rows(p, p->in[I_NMIX] + l * 1024, l == 0);
}

__device__ __forceinline__ void ssd_item(CPar p, int l, int item, float* sm) {
    const int tid = ltid();
    const int s = item < 512 ? (item >> 4) : 32 + ((item - 512) >> 4), h = item & 15, g = h >> 3;
    const bool prompt = s < 32; const int b = prompt ? s : s - 32, T = prompt ? TP : TS;
    constexpr int LD = 68;
    float *sX = sm, *sB = sX + 64 * LD, *sC = sB + 64 * LD, *sM = sC + 64 * LD, *sT = sM + 64 * LD, *sdt = sT + 64 * LD, *sac = sdt + 64, *sw = sac + 64, *sRaw = sw + 64, *sW = sRaw + 67 * 192;
    const bf16_t* XBC = (const bf16_t*)(p->ws + WS_XBC); bf16_t* Z = (bf16_t*)(p->ws + WS_Z);
    const float* DT = (const float*)(p->ws + WS_DT);
    const float* cw = p->in[I_CONVW] + (size_t)l * 4 * 1280; const float* cb = p->in[I_CONVB] + (size_t)l * 1280;
    const float* hist = p->in[I_SCONV] + (size_t)(l * 16 + b) * 3 * 1280;
    const float dtb = p->in[I_DTB][l * 16 + h], aneg = -__expf(p->in[I_ALOG][l * 16 + h]), dsk = p->in[I_DSSD][l * 16 + h];
    float* sout = prompt ? p->out + O_SSDP + ((size_t)(l * 32 + b) * 16 + h) * 4096 : p->out + O_SSDS + ((size_t)(l * 16 + b) * 16 + h) * 4096;
    for (int i = tid; i < 5 * 192; i += 512) { const int k = i / 192, ch = i - k * 192; const int col = ch < 64 ? h * 64 + ch : (ch < 128 ? 1024 + g * 64 + (ch - 64) : 1152 + g * 64 + (ch - 128));
        sW[i] = k < 4 ? cw[k * 1280 + col] : cb[col]; }
    for (int i = tid; i < 4096; i += 512) { const int pp = i >> 6, n = i & 63; sT[n * LD + pp] = prompt ? 0.f : p->in[I_SSSD][((size_t)(l * 16 + b) * 16 + h) * 4096 + i]; }
    const int nch = (T + 63) >> 6;
#pragma unroll 1
    for (int c = 0; c < nch; ++c) {
        const int t0 = c * 64;
        __syncthreads();
#pragma unroll
        for (int it4 = 0; it4 < 4; ++it4) { const int pi = tid + it4 * 512;
            if (pi < 67 * 24) { const int rl = pi / 24, pc = pi - rl * 24, seg = pc >> 3, q8 = pc & 7, tt = t0 - 3 + rl;
                const int col = (seg == 0 ? h * 64 : (seg == 1 ? 1024 + g * 64 : 1152 + g * 64)) + q8 * 8;
                f32x4 f0 = {0.f, 0.f, 0.f, 0.f}, f1 = {0.f, 0.f, 0.f, 0.f};
                if (tt >= 0 && tt < T) { const u32x4 w = *(const u32x4*)(XBC + (size_t)row_of(s, tt) * 1280 + col);
                    f0 = (f32x4){lo_f(w[0]), hi_f(w[0]), lo_f(w[1]), hi_f(w[1])}; f1 = (f32x4){lo_f(w[2]), hi_f(w[2]), lo_f(w[3]), hi_f(w[3])}; }
                else if (tt < 0 && !prompt) { const float* hp = hist + (3 + tt) * 1280 + col; f0 = *(const f32x4*)hp; f1 = *(const f32x4*)(hp + 4); }
                float* dp = sRaw + rl * 192 + seg * 64 + q8 * 8; *(f32x4*)dp = f0; *(f32x4*)(dp + 4) = f1; } }
        __syncthreads();
#pragma unroll 4
        for (int idx = tid; idx < 64 * 192; idx += 512) {
            const int tl = idx / 192, ch = idx - tl * 192, t = t0 + tl;
            float v = 0.f;
            if (t < T) { v = sW[4 * 192 + ch];
#pragma unroll
                for (int k = 0; k < 4; ++k) v += sRaw[(tl + k) * 192 + ch] * sW[k * 192 + ch];
                v = siluf_(v); }
            float* dst = ch < 64 ? sX : (ch < 128 ? sB : sC);
            dst[tl * LD + (ch & 63)] = v;
        }
        if (tid < 64) { const int t = t0 + tid; float dtv = 0.f;
            if (t < T) { const float x = DT[(size_t)row_of(s, t) * 16 + h] + dtb; dtv = x > 20.f ? x : log1pf(__expf(x)); }
            float cs = dtv * aneg;
#pragma unroll
            for (int o = 1; o < 64; o <<= 1) { const float nb = __shfl_up(cs, o); if (tid >= o) cs += nb; }
            sdt[tid] = dtv; sac[tid] = cs; }
        __syncthreads();
        if (tid < 64) sw[tid] = __expf(sac[63] - sac[tid]) * sdt[tid];
        { const int t = tid >> 3, jq = tid & 7; float a8[8];
#pragma unroll
            for (int i = 0; i < 8; ++i) a8[i] = 0.f;
#pragma unroll 1
            for (int n = 0; n < 64; n += 4) { const f32x4 cv = *(const f32x4*)(sC + t * LD + n);
#pragma unroll
                for (int i = 0; i < 8; ++i) { const f32x4 bv = *(const f32x4*)(sB + (jq + 8 * i) * LD + n); a8[i] += cv[0] * bv[0] + cv[1] * bv[1] + cv[2] * bv[2] + cv[3] * bv[3]; } }
            const float act = sac[t];
#pragma unroll
            for (int i = 0; i < 8; ++i) { const int j = jq + 8 * i; sM[t * LD + j] = (j <= t) ? a8[i] * __expf(act - sac[j]) * sdt[j] : 0.f; } }
        __syncthreads();
        { const int tl = tid >> 3, pb = (tid & 7) * 8, t = t0 + tl; float y8[8], o8[8];
#pragma unroll
            for (int i = 0; i < 8; ++i) { y8[i] = 0.f; o8[i] = 0.f; }
#pragma unroll 2
            for (int j = 0; j < 64; ++j) { const float mv = sM[tl * LD + j]; const f32x4 x0 = *(const f32x4*)(sX + j * LD + pb), x1 = *(const f32x4*)(sX + j * LD + pb + 4);
#pragma unroll
                for (int i = 0; i < 4; ++i) { y8[i] += mv * x0[i]; y8[4 + i] += mv * x1[i]; } }
#pragma unroll 2
            for (int n = 0; n < 64; ++n) { const float cv = sC[tl * LD + n]; const f32x4 s0 = *(const f32x4*)(sT + n * LD + pb), s1 = *(const f32x4*)(sT + n * LD + pb + 4);
#pragma unroll
                for (int i = 0; i < 4; ++i) { o8[i] += cv * s0[i]; o8[4 + i] += cv * s1[i]; } }
            const float ea = __expf(sac[tl]);
            float ss = 0.f;
            if (t < T) { const int row = row_of(s, t); bf16_t* zp = Z + (size_t)row * 1024 + h * 64 + pb;
                const u32x4 zw = *(const u32x4*)zp; float zf[8] = {lo_f(zw[0]), hi_f(zw[0]), lo_f(zw[1]), hi_f(zw[1]), lo_f(zw[2]), hi_f(zw[2]), lo_f(zw[3]), hi_f(zw[3])};
                float r8[8];
#pragma unroll
                for (int i = 0; i < 8; ++i) { const float y = (y8[i] + ea * o8[i] + dsk * sX[tl * LD + pb + i]) * siluf_(zf[i]); r8[i] = y; ss += y * y; }
                u32x4 o; o[0] = pk2(r8[0], r8[1]); o[1] = pk2(r8[2], r8[3]); o[2] = pk2(r8[4], r8[5]); o[3] = pk2(r8[6], r8[7]); *(u32x4*)zp = o; }
            (void)ss; }
        __syncthreads();
        { const int n = tid >> 3, pb = (tid & 7) * 8; float a8[8];
#pragma unroll
            for (int i = 0; i < 8; ++i) a8[i] = 0.f;
#pragma unroll 2
            for (int j = 0; j < 64; ++j) { const float bw = sB[j * LD + n] * sw[j]; const f32x4 x0 = *(const f32x4*)(sX + j * LD + pb), x1 = *(const f32x4*)(sX + j * LD + pb + 4);
#pragma unroll
                for (int i = 0; i < 4; ++i) { a8[i] += bw * x0[i]; a8[4 + i] += bw * x1[i]; } }
            const float eL = __expf(sac[63]);
#pragma unroll
            for (int i = 0; i < 8; ++i) sT[n * LD + pb + i] = eL * sT[n * LD + pb + i] + a8[i]; }
    }
    __syncthreads();
    for (int i = tid; i < 4096; i += 512) { const int pp = i >> 6, n = i & 63; sout[i] = sT[n * LD + pp]; }
    float* cout_ = prompt ? p->out + O_CONVP + (size_t)(l * 32 + b) * 3 * 1280 : p->out + O_CONVS + (size_t)(l * 16 + b) * 3 * 1280;
    for (int idx = tid; idx < 3 * 192; idx += 512) { const int k = idx / 192, ch = idx - k * 192;
        if (ch >= 64 && (h & 7) != 0) continue;
        const int col = ch < 64 ? h * 64 + ch : (ch < 128 ? 1024 + g * 64 + (ch - 64) : 1152 + g * 64 + (ch - 128));
        cout_[k * 1280 + col] = bf2f(XBC[(size_t)row_of(s, T - 3 + k) * 1280 + col]); }
    __syncthreads();
}

__device__ __forceinline__ void s5_item(CPar p, int l, int s, int g, float* wl) {
    const int lane = ltid() & 63;
    const bool prompt = s < 32; const int b = prompt ? s : s - 32, T = prompt ? TP : TS, nblk = T >> 4;
    constexpr int LD = 68;
    float *Xr = wl, *Xi = wl + 16 * LD, *Cr = wl + 32 * LD, *Ci = wl + 48 * LD;
    bf16_t* U = (bf16_t*)(p->ws + WS_U);
    const int gp = (l * 32 + g) * 64 + lane;
    const float lr = p->in[I_LRE][gp], li = p->in[I_LIM][gp], step = expf(p->in[I_LSTEP][l * 32 + g]);
    float sn, cs; sincos_red((double)li * (double)step, sn, cs);
    const float mag = expf(lr * step), ab_re = mag * cs, ab_im = mag * sn;
    const float den = lr * lr + li * li, nr = ab_re - 1.f, f_re = (nr * lr + ab_im * li) / den, f_im = (ab_im * lr - nr * li) / den;
    float bbr[16], bbi[16];
#pragma unroll
    for (int hh = 0; hh < 16; ++hh) { const float br = p->in[I_BRE][(size_t)gp * 16 + hh], bi = p->in[I_BIM][(size_t)gp * 16 + hh]; bbr[hh] = f_re * br - f_im * bi; bbi[hh] = f_re * bi + f_im * br; }
#pragma unroll
    for (int hh = 0; hh < 16; ++hh) { Cr[hh * LD + lane] = p->in[I_CRE][((size_t)(l * 32 + g) * 16 + hh) * 64 + lane]; Ci[hh * LD + lane] = p->in[I_CIM][((size_t)(l * 32 + g) * 16 + hh) * 64 + lane]; }
    float xr = prompt ? 0.f : p->in[I_S5R][(size_t)(l * 16 + b) * 2048 + g * 64 + lane], xi = prompt ? 0.f : p->in[I_S5I][(size_t)(l * 16 + b) * 2048 + g * 64 + lane];
    const int tl = lane >> 2, hq = lane & 3;
    f32x4 dv = *(const f32x4*)(p->in[I_DS5] + (size_t)(l * 32 + g) * 16 + hq * 4);
    u32x4 ua = {0, 0, 0, 0}, ub = {0, 0, 0, 0};
    { const int r0 = row_of(s, 0); if (lane < 16) { const u32x4* up = (const u32x4*)(U + (size_t)(r0 + lane) * 512 + g * 16); ua = up[0]; ub = up[1]; } }
    for (int blk = 0; blk < nblk; ++blk) {
        const int r0 = row_of(s, blk * 16);
        const u32x4 ca = ua, cbv = ub;
        if (blk + 1 < nblk && lane < 16) { const int r1 = row_of(s, blk * 16 + 16); const u32x4* up = (const u32x4*)(U + (size_t)(r1 + lane) * 512 + g * 16); ua = up[0]; ub = up[1]; }
#pragma unroll
        for (int i = 0; i < 16; ++i) {
            float bur = 0.f, bui = 0.f;
#pragma unroll
            for (int w = 0; w < 8; ++w) { const unsigned word = (unsigned)__builtin_amdgcn_readlane((int)(w < 4 ? ca[w] : cbv[w - 4]), i);
                const float u0 = lo_f(word), u1 = hi_f(word);
                bur += bbr[2 * w] * u0 + bbr[2 * w + 1] * u1; bui += bbi[2 * w] * u0 + bbi[2 * w + 1] * u1; }
            const float nxr = ab_re * xr - ab_im * xi + bur, nxi = ab_re * xi + ab_im * xr + bui; xr = nxr; xi = nxi;
            Xr[i * LD + lane] = xr; Xi[i * LD + lane] = xi;
        }
        __builtin_amdgcn_wave_barrier(); asm volatile("s_waitcnt lgkmcnt(0)" ::: "memory");
        float a4[4] = {0.f, 0.f, 0.f, 0.f};
#pragma unroll 4
        for (int p4 = 0; p4 < 64; p4 += 4) { const f32x4 xr4 = *(const f32x4*)(Xr + tl * LD + p4), xi4 = *(const f32x4*)(Xi + tl * LD + p4);
#pragma unroll
            for (int hh = 0; hh < 4; ++hh) { const f32x4 cr4 = *(const f32x4*)(Cr + (hq * 4 + hh) * LD + p4), ci4 = *(const f32x4*)(Ci + (hq * 4 + hh) * LD + p4);
                a4[hh] += (xr4[0] * cr4[0] + xr4[1] * cr4[1] + xr4[2] * cr4[2] + xr4[3] * cr4[3]) - (xi4[0] * ci4[0] + xi4[1] * ci4[1] + xi4[2] * ci4[2] + xi4[3] * ci4[3]); } }
        { bf16_t* up = U + (size_t)(r0 + tl) * 512 + g * 16 + hq * 4; const u32x2 uw = *(const u32x2*)up;
            const float y0 = a4[0] + dv[0] * lo_f(uw[0]), y1 = a4[1] + dv[1] * hi_f(uw[0]), y2 = a4[2] + dv[2] * lo_f(uw[1]), y3 = a4[3] + dv[3] * hi_f(uw[1]);
            u32x2 o; o[0] = pk2(geluf_(y0), geluf_(y1)); o[1] = pk2(geluf_(y2), geluf_(y3)); *(u32x2*)up = o; }
        __builtin_amdgcn_wave_barrier(); asm volatile("s_waitcnt lgkmcnt(0)" ::: "memory");
    }
    float* ore = prompt ? p->out + O_S5RP + (size_t)(l * 32 + b) * 2048 : p->out + O_S5RS + (size_t)(l * 16 + b) * 2048;
    float* oim = prompt ? p->out + O_S5IP + (size_t)(l * 32 + b) * 2048 : p->out + O_S5IS + (size_t)(l * 16 + b) * 2048;
    ore[g * 64 + lane] = xr; oim[g * 64 + lane] = xi;
}

__device__ __forceinline__ void attn_item(CPar p, int l, int item, float* wl) {
    const int lane = ltid() & 63;
    int s, h, qt;
    if (item < 8448) { s = item / 264; const int rem = item - s * 264; h = rem / 33; qt = rem - h * 33; } else { const int it = item - 8448; s = 32 + (it >> 3); h = it & 7; qt = 0; }
    const bool prompt = s < 32; const int b = prompt ? s : s - 32, T = prompt ? TP : TS, nh = prompt ? 0 : PAST;
    const int i = qt * 64 + lane; const bool active = i < T; const int row = row_of(s, active ? i : T - 1);
    bf16_t* Q = (bf16_t*)(p->ws + WS_Q);
    float* Kt = wl; float* Vt = wl + 32 * 64;
    float q[64], o[64];
    { const u32x4* qp = (const u32x4*)(Q + (size_t)row * 512 + h * 64);
#pragma unroll
        for (int e = 0; e < 8; ++e) { const u32x4 w = qp[e];
#pragma unroll
            for (int j = 0; j < 4; ++j) { q[e * 8 + 2 * j] = lo_f(w[j]) * 0.125f; q[e * 8 + 2 * j + 1] = hi_f(w[j]) * 0.125f; } } }
#pragma unroll
    for (int d = 0; d < 64; ++d) o[d] = 0.f;
    const float* kp_new = prompt ? p->out + O_KP + (size_t)(l * 32 + b) * 2064 * 512 + h * 64 : p->out + O_KS + (size_t)(l * 16 + b) * 64 * 512 + h * 64;
    const float* vp_new = prompt ? p->out + O_VP + (size_t)(l * 32 + b) * 2064 * 512 + h * 64 : p->out + O_VS + (size_t)(l * 16 + b) * 64 * 512 + h * 64;
    const float* kp_old = p->in[I_CK] + (size_t)(l * 16 + b) * 2048 * 512 + h * 64;
    const float* vp_old = p->in[I_CV] + (size_t)(l * 16 + b) * 2048 * 512 + h * 64;
    const int imax = (qt * 64 + 63 < T - 1) ? qt * 64 + 63 : T - 1;
    const int jtop = nh + imax - 1;
    float run = 0.f;
    for (int jt = jtop; jt >= 0; jt -= 32) {
#pragma unroll 4
        for (int e = 0; e < 8; ++e) { const int idx = e * 64 + lane, kr = idx >> 4, pc = idx & 15, j = jt - kr;
            if (j >= 0) { const float* kp = (j < nh) ? kp_old + (size_t)j * 512 : kp_new + (size_t)(j - nh) * 512; *(f32x4*)(Kt + kr * 64 + pc * 4) = *(const f32x4*)(kp + pc * 4); } }
#pragma unroll 4
        for (int e = 0; e < 8; ++e) { const int idx = e * 64 + lane, kr = idx >> 4, pc = idx & 15, j = jt - kr;
            if (j >= 0) { const float* vp = (j < nh) ? vp_old + (size_t)j * 512 : vp_new + (size_t)(j - nh) * 512; *(f32x4*)(Vt + kr * 64 + pc * 4) = *(const f32x4*)(vp + pc * 4); } }
        __builtin_amdgcn_wave_barrier(); asm volatile("s_waitcnt vmcnt(0) lgkmcnt(0)" ::: "memory");
        const int nk = jt + 1 < 32 ? jt + 1 : 32;
        for (int kk = 0; kk < nk; ++kk) { const int j = jt - kk;
            float z = 0.f;
#pragma unroll
            for (int d = 0; d < 64; d += 4) { const f32x4 kv = *(const f32x4*)(Kt + kk * 64 + d); z += q[d] * kv[0] + q[d + 1] * kv[1] + q[d + 2] * kv[2] + q[d + 3] * kv[3]; }
            const bool valid = active && (j < nh + i);
            const float e = __expf(-z), ls = -__logf(1.f + e);
            const float w = valid ? __expf(ls + run) : 0.f;
            run += valid ? (ls - z) : 0.f;
#pragma unroll
            for (int d = 0; d < 64; d += 4) { const f32x4 vv = *(const f32x4*)(Vt + kk * 64 + d); o[d] += w * vv[0]; o[d + 1] += w * vv[1]; o[d + 2] += w * vv[2]; o[d + 3] += w * vv[3]; } }
        __builtin_amdgcn_wave_barrier(); asm volatile("s_waitcnt lgkmcnt(0)" ::: "memory");
        const int fin = (!active) || (run < -100.f);
        if (__all(fin)) break;
    }
    if (active) { u32x4* op = (u32x4*)(Q + (size_t)row * 512 + h * 64);
#pragma unroll
        for (int e = 0; e < 8; ++e) { u32x4 w; w[0] = pk2(o[e * 8], o[e * 8 + 1]); w[1] = pk2(o[e * 8 + 2], o[e * 8 + 3]); w[2] = pk2(o[e * 8 + 4], o[e * 8 + 5]); w[3] = pk2(o[e * 8 + 6], o[e * 8 + 7]); op[e] = w; } }
}

__device__ __forceinline__ void phase_mixers(CPar p, int l, float* sm) {
#ifndef SKIP_SSD
    { CPar p1 = params_ptr();
#pragma unroll 1
      for (int it = lbid(); it < 768; it += lgdim()) ssd_item(p1, l, it, sm); }
#endif
    __syncthreads();
    const int wave = __builtin_amdgcn_readfirstlane(ltid() >> 6);
    float* wl = sm + wave * (68 * 64);
#ifndef SKIP_S5
    { CPar p2 = params_ptr();
    if (wave < 4) { for (int it = lbid() * 4 + wave; it < 1024; it += lgdim() * 4) s5_item(p2, l, it >> 5, it & 31, wl); }
    else if (wave < 6) { for (int it = lbid() * 2 + (wave - 4); it < 512; it += lgdim() * 2) s5_item(p2, l, 32 + (it >> 5), it & 31, wl); } }
#endif
#ifndef SKIP_ATT
    CPar p3 = params_ptr();
    unsigned* ctr = (unsigned*)(p3->ws + WS_CTR) + l;
    for (;;) {
        unsigned it = 0; if ((ltid() & 63) == 0) it = atomicAdd(ctr, 1u);
        it = (unsigned)__builtin_amdgcn_readfirstlane((int)it);
        if (it >= 8576u) break;
        attn_item(p3, l, (int)it, wl);
    }
#endif
}

__global__ __launch_bounds__(512, 2) void mega(Params pk) {
    extern __shared__ __attribute__((aligned(16))) unsigned char smem[];
    cg::grid_group grid = cg::this_grid();
    LAS unsigned char* lds = (LAS unsigned char*)smem;
    const int ph_lo = pk.ph_lo, ph_hi = pk.ph_hi;
    for (int ph = ph_lo; ph < ph_hi; ++ph) {
        if (ph > ph_lo) grid.sync();
        CPar p = params_ptr();
        unsigned char* ws = p->ws;
        bf16_t *HB = (bf16_t*)(ws + WS_HB), *Z = (bf16_t*)(ws + WS_Z), *XBC = (bf16_t*)(ws + WS_XBC), *U = (bf16_t*)(ws + WS_U), *Q = (bf16_t*)(ws + WS_Q), *G = (bf16_t*)(ws + WS_G);
        float *DT = (float*)(ws + WS_DT), *XM = (float*)(ws + WS_XMETA);
        const int l = ph / 9, sub = ph - l * 9;
        pg8::StaticOrder S;
        if (sub == 0) {
#ifndef SKIP0
            phase_prep(p, l);
#endif
        } else if (sub == 1) {
            S.init(NROWS, N1, lgdim(), lbid());
            EpiIn E{Z, XBC, U, Q, G, DT, p->out, p->in[I_QN] + l * 64, p->in[I_KN] + l * 64, l};
#ifndef SKIP1
            pg8::gemm_phase(lds, pg8::Gemm{HB, (const bf16_t*)(ws + W_BT1), NROWS, N1, 1024, 1024, 1024}, S, E);
#endif
        } else if (sub == 2) {
#ifndef SKIP2
            phase_mixers(p, l, (float*)smem);
#endif
        } else if (sub == 3) {
            ssd_norm_rows(p);
            S.init(NROWS, 2048, lgdim(), lbid());
            EpiGlu E{XBC};
            pg8::gemm_phase(lds, pg8::Gemm{U, (const bf16_t*)(ws + W_GLU), NROWS, 2048, 512, 512, 512}, S, E);
        } else if (sub == 4) {
            S.init(NROWS, 1024, lgdim(), lbid());
            for (int call = 0; call < 2; ++call) {
                EpiMix E; pg8::Gemm g;
                if (call == 0) { E = EpiMix{HB, G, XBC, 0}; g = pg8::Gemm{Z, (const bf16_t*)(ws + W_LA), NROWS, 1024, 1024, 1024, 1024}; }
                else { E = EpiMix{HB, G + 2048, nullptr, 1}; g = pg8::Gemm{Q, (const bf16_t*)(ws + W_LC), NROWS, 1024, 512, 512, 512}; }
#ifndef SKIP3
                pg8::gemm_phase(lds, g, S, E);
#endif
            }
        } else if (sub == 5) {
            S.init(NROWS, 1024, lgdim(), lbid());
            EpiRes E{p->out, XM};
#ifndef SKIP4
            pg8::gemm_phase(lds, pg8::Gemm{HB, (const bf16_t*)(ws + W_OUT), NROWS, 1024, 1024, 1024, 1024}, S, E);
#endif
        } else if (sub == 6) {
            rmsnorm_rows(p, p->in[I_NFFN] + l * 1024, 0);
        } else if (sub == 7) {
            S.init(NROWS, 4096, lgdim(), lbid());
            EpiUp E{(bf16_t*)(ws + WS_ACT)};
#ifndef SKIP6
            pg8::gemm_phase(lds, pg8::Gemm{HB, (const bf16_t*)(ws + W_UP), NROWS, 4096, 1024, 1024, 1024}, S, E);
#endif
        } else {
            S.init(NROWS, 1024, lgdim(), lbid());
            EpiRes E{p->out, XM};
#ifndef SKIP7
            pg8::gemm_phase(lds, pg8::Gemm{(const bf16_t*)(ws + WS_ACT), (const bf16_t*)(ws + W_DOWN), NROWS, 1024, 4096, 4096, 4096}, S, E);
#endif
        }
    }
}

extern "C" void kernel_launch(void* const* d_in, const int* in_sizes, int n_in, void* d_out, int out_size, void* d_ws, size_t ws_size, hipStream_t stream) {
    static int grid = 0;
    if (grid == 0) {
        if (n_in != 34 || (size_t)out_size != O_END || ws_size < WS_END) { fprintf(stderr, "kernel_launch: unexpected shapes n_in %d out %d ws %zu (need %zu)\n", n_in, out_size, ws_size, (size_t)WS_END); grid = -1; return; }
        int dev = 0, cus = 0, per_cu = 0;
        hipGetDevice(&dev); hipDeviceGetAttribute(&cus, hipDeviceAttributeMultiprocessorCount, dev);
        if (hipFuncSetAttribute((const void*)mega, hipFuncAttributeMaxDynamicSharedMemorySize, LDS_BYTES) != hipSuccess) { fprintf(stderr, "kernel_launch: hipFuncSetAttribute failed\n"); grid = -1; return; }
        if (hipOccupancyMaxActiveBlocksPerMultiprocessor(&per_cu, (const void*)mega, 512, LDS_BYTES) != hipSuccess || per_cu < 1) { fprintf(stderr, "kernel_launch: occupancy query says %d\n", per_cu); per_cu = 1; }
        (void)hipGetLastError();
        grid = cus * per_cu;
    }
    if (grid < 0) return;
    Params p{};
    for (int i = 0; i < 34; ++i) p.in[i] = (const float*)d_in[i];
    p.out = (float*)d_out; p.ws = (unsigned char*)d_ws;
#if MULTI_LAUNCH
    for (int ph = 0; ph < 18; ++ph) { p.ph_lo = ph; p.ph_hi = ph + 1; hipLaunchKernelGGL(mega, dim3(grid), dim3(512), LDS_BYTES, stream, p); }
#else
    p.ph_lo = 0; p.ph_hi = 18;
    void* args[] = {&p};
    hipError_t e = hipLaunchCooperativeKernel((const void*)mega, dim3(grid), dim3(512), args, LDS_BYTES, stream);
    if (e != hipSuccess) fprintf(stderr, "cooperative launch failed: %s (grid %d)\n", hipGetErrorString(e), grid);
#endif
}
```

```cpp
#include <hip/hip_runtime.h>
#include <hip/hip_cooperative_groups.h>
#include <cstdio>
#include <cstdint>
namespace cg = cooperative_groups;

#ifndef MULTI_LAUNCH
#define MULTI_LAUNCH 0
#endif

typedef unsigned short bf16_t;
typedef short bf16x8 __attribute__((ext_vector_type(8)));
typedef float f32x4 __attribute__((ext_vector_type(4)));
typedef unsigned u32x4 __attribute__((ext_vector_type(4)));
typedef unsigned u32x2 __attribute__((ext_vector_type(2)));
#define LAS __attribute__((address_space(3)))

constexpr int D = 1024, NROWS = 67072, NS0 = 65536, NM0 = 66560;
constexpr int TP = 2064, TS = 64, NB_P = 32, NB_S = 16, PAST = 2048;
constexpr int IN_COLS = 7440, N1 = 7680;
constexpr int SSQ_SLOTS = NM0 + 32 * 32;
constexpr float EPS = 1e-6f;
constexpr size_t O_YP = 0, O_YS = 67108864ull, O_KP = O_YS + 1048576ull, SZ_KP = 2ull * 32 * 2064 * 512, O_VP = O_KP + SZ_KP,
                 O_CONVP = O_VP + SZ_KP, O_SSDP = O_CONVP + 2ull * 32 * 3 * 1280, O_S5RP = O_SSDP + 2ull * 32 * 16 * 4096, O_S5IP = O_S5RP + 2ull * 32 * 2048,
                 O_KS = O_S5IP + 2ull * 32 * 2048, O_VS = O_KS + 2ull * 16 * 64 * 512, O_CONVS = O_VS + 2ull * 16 * 64 * 512, O_SSDS = O_CONVS + 2ull * 16 * 3 * 1280,
                 O_S5RS = O_SSDS + 2ull * 16 * 16 * 4096, O_S5IS = O_S5RS + 2ull * 16 * 2048, O_END = O_S5IS + 2ull * 16 * 2048;
constexpr size_t W_BT1 = 0, W_GLU = W_BT1 + (size_t)N1 * 1024 * 2, W_LA = W_GLU + 2048ull * 512 * 2, W_LC = W_LA + 1024ull * 1024 * 2, W_OUT = W_LC + 1024ull * 512 * 2,
                 W_UP = W_OUT + 1024ull * 1024 * 2, W_DOWN = W_UP + 4096ull * 1024 * 2, W_END = W_DOWN + 4096ull * 1024 * 2;
constexpr size_t WS_CTR = W_END, WS_XMETA = WS_CTR + 4096, WS_HB = WS_XMETA + 512ull * 1024 * 4, WS_Z = WS_HB + (size_t)NROWS * 1024 * 2, WS_XBC = WS_Z + (size_t)NROWS * 1024 * 2,
                 WS_U = WS_XBC + (size_t)NROWS * 1280 * 2, WS_Q = WS_U + (size_t)NROWS * 512 * 2, WS_G = WS_Q + (size_t)NROWS * 512 * 2, WS_DT = WS_G + (size_t)NROWS * 3072 * 2,
                 WS_SSQ = WS_DT + (size_t)NROWS * 16 * 4, WS_END = WS_SSQ + (size_t)SSQ_SLOTS * 16 * 4;
constexpr size_t WS_ACT = WS_Z;
static_assert(WS_ACT + (size_t)NROWS * 4096 * 2 <= WS_DT, "ACT overlay");
constexpr int LDS_BYTES = 147456;

struct Params {
    const float* in[34];
    float* out;
    unsigned char* ws;
    int ph_lo, ph_hi;
};
typedef const __attribute__((address_space(4))) Params* CPar;
__device__ __forceinline__ CPar params_ptr() { CPar q = (CPar)__builtin_amdgcn_kernarg_segment_ptr(); asm volatile("" : "+s"(q)); return q; }
#define PIN(i) (p->in[i])
enum { I_XP = 0, I_XS, I_CK, I_CV, I_SCONV, I_SSSD, I_S5R, I_S5I, I_META, I_NMIX, I_WIN, I_CONVW, I_CONVB, I_DTB, I_ALOG, I_DSSD, I_NSSD, I_LRE, I_LIM, I_LSTEP, I_BRE, I_BIM,
       I_CRE, I_CIM, I_DS5, I_WGLU, I_QN, I_KN, I_WLA, I_WLC, I_WOUT, I_NFFN, I_WUP, I_WDOWN };

__device__ __forceinline__ int ltid() { int t = threadIdx.x; asm volatile("" : "+v"(t)); return t; }
__device__ __forceinline__ int lbid() { int t = blockIdx.x; asm volatile("" : "+s"(t)); return t; }
__device__ __forceinline__ int lgdim() { int t = gridDim.x; asm volatile("" : "+s"(t)); return t; }

__device__ __forceinline__ float bf2f(bf16_t v) { return __uint_as_float((unsigned)v << 16); }
__device__ __forceinline__ unsigned pk2(float lo, float hi) { unsigned r; asm volatile("v_cvt_pk_bf16_f32 %0, %1, %2" : "=v"(r) : "v"(lo), "v"(hi)); return r; }
__device__ __forceinline__ float lo_f(unsigned w) { return __uint_as_float(w << 16); }
__device__ __forceinline__ float hi_f(unsigned w) { return __uint_as_float(w & 0xffff0000u); }
__device__ __forceinline__ u32x2 ld_l2_u32x2(const void* ptr) { const unsigned long long v = __hip_atomic_load((const unsigned long long*)ptr, __ATOMIC_RELAXED, __HIP_MEMORY_SCOPE_AGENT); u32x2 r; r[0] = (unsigned)v; r[1] = (unsigned)(v >> 32); return r; }
__device__ __forceinline__ float sigmoidf_(float v) { return __builtin_amdgcn_rcpf(1.f + __expf(-v)); }
__device__ __forceinline__ float siluf_(float v) { return v * sigmoidf_(v); }
__device__ __forceinline__ float geluf_(float y) { const float a = 0.7978845608f * (y + 0.044715f * y * y * y); const float t = __expf(2.f * a); return 0.5f * y * (2.f - 2.f * __builtin_amdgcn_rcpf(t + 1.f)); }
__device__ __forceinline__ float wave_sum(float v) {
#pragma unroll
    for (int o = 1; o < 64; o <<= 1) v += __shfl_xor(v, o);
    return v;
}
__device__ __forceinline__ void sincos_red(double x, float& sn, float& cs) {
    const double k = __builtin_rint(x * 0.63661977236758134308);
    const float r = (float)__builtin_fma(-k, 1.57079632679489661923, x), r2 = r * r;
    const float sp = r + r * r2 * (-1.6666667163e-01f + r2 * (8.3333337680e-03f + r2 * (-1.9841270114e-04f + r2 * 2.7557314297e-06f)));
    const float cp = 1.f + r2 * (-0.5f + r2 * (4.1666667908e-02f + r2 * (-1.3888889225e-03f + r2 * (2.4801587642e-05f - r2 * 2.7557314297e-07f))));
    const int q = ((int)k) & 3;
    sn = (q == 0) ? sp : (q == 1) ? cp : (q == 2) ? -sp : -cp;
    cs = (q == 0) ? cp : (q == 1) ? -sp : (q == 2) ? -cp : sp;
}
__device__ __forceinline__ int row_of(int s, int t) { return s < 32 ? (t < 16 ? NM0 + s * 16 + t : s * 2048 + t - 16) : NS0 + (s - 32) * 64 + t; }
__device__ __forceinline__ int ssq_slot(int r) { return r < NM0 ? r : NM0 + ((r - NM0) >> 4) * 32 + ((r - NM0) & 15); }
__device__ __forceinline__ float* xloc(CPar p, int r) { return r < NM0 ? p->out + (size_t)r * 1024 : (float*)(p->ws + WS_XMETA) + (size_t)(r - NM0) * 1024; }
__device__ __forceinline__ size_t k_off(int l, int r) {
    if (r < NS0) return O_KP + ((size_t)(l * 32 + (r >> 11)) * 2064 + 16 + (r & 2047)) * 512;
    if (r < NM0) { const int rs = r - NS0; return O_KS + ((size_t)(l * 16 + (rs >> 6)) * 64 + (rs & 63)) * 512; }
    const int rm = r - NM0; return O_KP + ((size_t)(l * 32 + (rm >> 4)) * 2064 + (rm & 15)) * 512;
}

namespace pg8 {
constexpr int BM = 256, BK = 64, HALF = 128, HTB = HALF * BK * 2, STAGE_BYTES = 8 * HTB, NXCD = 8, WGM = 8;
__host__ __device__ __forceinline__ int lds_byte(int r, int c) { const int st = (r >> 4) * 2 + (c >> 5), rr = r & 15, cc = c & 31, ob = rr * 64 + cc * 2; return st * 1024 + (ob ^ (((ob >> 9) & 1) << 5)); }
__host__ __device__ __forceinline__ void stage_rc(int b, int& R, int& C) { const int st = b / 1024, sb = b % 1024, swz = sb ^ (((sb >> 9) & 1) << 5); R = (st >> 1) * 16 + swz / 64; C = (st & 1) * 32 + (swz % 64) / 2; }
struct Unit { int pm, pn; };
struct Gemm { const bf16_t* A; const bf16_t* Bt; int M, N, K, lda, ldb; };
struct StaticOrder {
    int nM, nN, nwg, G, c;
    __device__ void init(int M, int N, int G_, int c_) { nM = M / BM; nN = N / BM; nwg = nM * nN; G = G_; c = c_; }
    __device__ bool next(int i, Unit& u) const {
        const long L = (long)i * G + c; if (L >= nwg) return false;
        int wgid = (int)L; { const int q = nwg / NXCD, r = nwg % NXCD, xcd = wgid % NXCD, off = wgid / NXCD; wgid = (xcd < r ? xcd * (q + 1) : r * (q + 1) + (xcd - r) * q) + off; }
        const int nig = WGM * nN, gid = wgid / nig, fm = gid * WGM, gsz = (nM - fm) < WGM ? (nM - fm) : WGM;
        u.pm = fm + ((wgid % nig) % gsz); u.pn = (wgid % nig) / gsz; return true;
    }
};
template <class Epi>
__device__ __forceinline__ void gemm_phase(LAS unsigned char* lds, const Gemm g, const StaticOrder& S, const Epi& E) {
    const int tid = ltid(), wid = __builtin_amdgcn_readfirstlane(tid >> 6), lane = tid & 63, wr = wid >> 2, wc = wid & 3, fr = lane & 15, fq = lane >> 4;
    const int K = g.K, nt = K / BK;
    unsigned voffA[2], voffB[2];
#pragma unroll
    for (int i = 0; i < 2; ++i) { int R, C; stage_rc(tid * 16 + i * 8192, R, C); voffA[i] = (unsigned)(R * g.lda + C) * 2u; voffB[i] = (unsigned)(R * g.ldb + C) * 2u; }
    const size_t kstep = (size_t)(BK * 2);
    const size_t hstepA = (size_t)HALF * g.lda * 2, hstepB = (size_t)HALF * g.ldb * 2;
    const size_t tstepA = 2 * hstepA, tstepB = 2 * hstepB;
    const unsigned ldsw = (unsigned)wid * 1024u;
    const int aoff = lds_byte(wr * 64 + fr, fq * 8), boff = lds_byte(wc * 32 + fr, fq * 8);
#define PG8_SA(b, h) (((b) * 2 + (h)) * HTB)
#define PG8_SB(b, h) ((4 + (b) * 2 + (h)) * HTB)
#define PG8_STAGE(bufoff, gbase, voff) do { _Pragma("unroll") for (int _i = 0; _i < 2; ++_i) \
        __builtin_amdgcn_global_load_lds((const unsigned*)((const char*)(gbase) + (voff)[_i]), (LAS unsigned*)(lds + (bufoff) + ldsw + _i * 8192), 16, 0, 0); } while (0)
#define PG8_LDA(dst, b, h) do { _Pragma("unroll") for (int m = 0; m < 4; ++m) _Pragma("unroll") for (int k = 0; k < 2; ++k) dst[m][k] = *(const LAS bf16x8*)(lds + PG8_SA(b, h) + aoff + m * 2048 + k * 1024); } while (0)
#define PG8_LDB(dst, b, h) do { _Pragma("unroll") for (int n = 0; n < 2; ++n) _Pragma("unroll") for (int k = 0; k < 2; ++k) dst[n][k] = *(const LAS bf16x8*)(lds + PG8_SB(b, h) + boff + n * 2048 + k * 1024); } while (0)
#define PG8_MMA(ai, bj, At, Bt) do { __builtin_amdgcn_s_setprio(1); _Pragma("unroll") for (int m = 0; m < 4; ++m) _Pragma("unroll") for (int n = 0; n < 2; ++n) _Pragma("unroll") for (int k = 0; k < 2; ++k) \
        acc[ai][bj][m][n] = __builtin_amdgcn_mfma_f32_16x16x32_bf16(Bt[n][k], At[m][k], acc[ai][bj][m][n], 0, 0, 0); __builtin_amdgcn_s_setprio(0); } while (0)
#define PG8_WAIT_V(n) asm volatile("s_waitcnt vmcnt(" #n ")" ::: "memory")
#define PG8_WAIT_L(n) asm volatile("s_waitcnt lgkmcnt(" #n ")" ::: "memory")
#define PG8_BAR __builtin_amdgcn_s_barrier()
#define PG8_SCHED __builtin_amdgcn_sched_barrier(0)
    Unit cur, nxt; int ui = 0;
    if (!S.next(0, cur)) return;
    f32x4 acc[2][2][4][2];
#pragma unroll
    for (int a = 0; a < 2; ++a)
#pragma unroll
        for (int b = 0; b < 2; ++b)
#pragma unroll
            for (int m = 0; m < 4; ++m)
#pragma unroll
                for (int n = 0; n < 2; ++n) acc[a][b][m][n] = (f32x4){0.f, 0.f, 0.f, 0.f};
    bf16x8 At[4][2], B0[2][2], B1[2][2];
    const char* cA = (const char*)g.A + (size_t)cur.pm * tstepA; const char* cB = (const char*)g.Bt + (size_t)cur.pn * tstepB;
    PG8_STAGE(PG8_SB(0, 0), cB, voffB); PG8_STAGE(PG8_SA(0, 0), cA, voffA); PG8_STAGE(PG8_SB(0, 1), cB + hstepB, voffB); PG8_STAGE(PG8_SA(0, 1), cA + hstepA, voffA);
    if (wr == 1) PG8_BAR;
    PG8_WAIT_V(4); PG8_BAR;
    PG8_STAGE(PG8_SB(1, 0), cB + kstep, voffB); PG8_STAGE(PG8_SA(1, 0), cA + kstep, voffA); PG8_STAGE(PG8_SB(1, 1), cB + hstepB + kstep, voffB);
    PG8_WAIT_V(6); PG8_BAR;
    for (;;) {
        const bool has_next = S.next(ui + 1, nxt);
        const char* nA = has_next ? (const char*)g.A + (size_t)nxt.pm * tstepA : cA; const char* nB = has_next ? (const char*)g.Bt + (size_t)nxt.pn * tstepB : cB;
        for (int t = 0; t < nt; t += 2) {
            const bool last = (t == nt - 2);
            const char* a1 = cA + (size_t)(t + 1) * kstep;
            const char* a2 = last ? nA : cA + (size_t)(t + 2) * kstep; const char* b2 = last ? nB : cB + (size_t)(t + 2) * kstep;
            const char* a3 = a2 + kstep; const char* b3 = b2 + kstep;
            PG8_LDB(B0, 0, 0); PG8_SCHED; PG8_LDA(At, 0, 0); PG8_STAGE(PG8_SA(1, 1), a1 + hstepA, voffA);
            PG8_WAIT_L(8); PG8_BAR; PG8_WAIT_L(0); PG8_MMA(0, 0, At, B0); PG8_BAR; PG8_SCHED;
            PG8_LDB(B1, 0, 1); PG8_STAGE(PG8_SB(0, 0), b2, voffB);
            PG8_BAR; PG8_WAIT_L(0); PG8_MMA(0, 1, At, B1); PG8_BAR;
            PG8_LDA(At, 0, 1); PG8_STAGE(PG8_SA(0, 0), a2, voffA);
            PG8_BAR; PG8_WAIT_L(0); PG8_MMA(1, 0, At, B0); PG8_BAR; PG8_SCHED;
            PG8_STAGE(PG8_SB(0, 1), b2 + hstepB, voffB);
            PG8_WAIT_V(6); PG8_BAR; PG8_MMA(1, 1, At, B1); PG8_BAR;
            PG8_LDB(B0, 1, 0); PG8_SCHED; PG8_LDA(At, 1, 0); PG8_STAGE(PG8_SA(0, 1), a2 + hstepA, voffA);
            PG8_WAIT_L(8); PG8_BAR; PG8_WAIT_L(0); PG8_MMA(0, 0, At, B0); PG8_BAR; PG8_SCHED;
            PG8_LDB(B1, 1, 1); PG8_STAGE(PG8_SB(1, 0), b3, voffB);
            PG8_BAR; PG8_WAIT_L(0); PG8_MMA(0, 1, At, B1); PG8_BAR;
            PG8_LDA(At, 1, 1); PG8_STAGE(PG8_SA(1, 0), a3, voffA);
            PG8_BAR; PG8_WAIT_L(0); PG8_MMA(1, 0, At, B0); PG8_BAR; PG8_SCHED;
            PG8_STAGE(PG8_SB(1, 1), b3 + hstepB, voffB);
            PG8_WAIT_V(6); PG8_BAR; PG8_MMA(1, 1, At, B1); PG8_BAR;
        }
        E(acc, cur, wr, wc, fr, fq);
        if (!has_next) break;
#pragma unroll
        for (int a = 0; a < 2; ++a)
#pragma unroll
            for (int b = 0; b < 2; ++b)
#pragma unroll
                for (int m = 0; m < 4; ++m)
#pragma unroll
                    for (int n = 0; n < 2; ++n) acc[a][b][m][n] = (f32x4){0.f, 0.f, 0.f, 0.f};
        cur = nxt; cA = nA; cB = nB; ++ui;
    }
    PG8_WAIT_V(0);
    if (wr == 0) PG8_BAR;
    PG8_BAR;
#undef PG8_SA
#undef PG8_SB
#undef PG8_STAGE
#undef PG8_LDA
#undef PG8_LDB
#undef PG8_MMA
#undef PG8_WAIT_V
#undef PG8_WAIT_L
#undef PG8_BAR
#undef PG8_SCHED
}
}
using pg8::Unit;

struct EpiIn {
    bf16_t *Z, *XBC, *U, *Q, *G; float* DT; float* out; const float *qn, *kn; int layer;
    __device__ __forceinline__ void operator()(const f32x4 (&acc)[2][2][4][2], const Unit& u, int wr, int wc, int fr, int fq) const {
        const int pn = u.pn, rowb = u.pm * 256 + wr * 64 + fr, ctb = wc * 32 + fq * 4;
        if (pn < 11 || (pn >= 17 && pn < 29)) {
            bf16_t* base; int ld, col0; bool sig = false;
            if (pn < 4) { base = Z; ld = 1024; col0 = pn * 256; } else if (pn < 9) { base = XBC; ld = 1280; col0 = (pn - 4) * 256; }
            else if (pn < 11) { base = U; ld = 512; col0 = (pn - 9) * 256; } else { base = G; ld = 3072; col0 = (pn - 17) * 256; sig = true; }
#pragma unroll
            for (int ai = 0; ai < 2; ++ai)
#pragma unroll
                for (int m = 0; m < 4; ++m) { bf16_t* rp = base + (size_t)(rowb + ai * 128 + m * 16) * ld + col0 + ctb;
#pragma unroll
                    for (int bj = 0; bj < 2; ++bj)
#pragma unroll
                        for (int n = 0; n < 2; ++n) { f32x4 v = acc[ai][bj][m][n];
                            if (sig) { v[0] = sigmoidf_(v[0]); v[1] = sigmoidf_(v[1]); v[2] = sigmoidf_(v[2]); v[3] = sigmoidf_(v[3]); }
                            u32x2 o; o[0] = pk2(v[0], v[1]); o[1] = pk2(v[2], v[3]); *(u32x2*)(rp + bj * 128 + n * 16) = o; } }
        } else if (pn < 17) {
            const int seg = (pn - 11) >> 1, head = ((pn - 11) & 1) * 4 + wc;
            const float* nw = seg == 0 ? qn : kn;
            f32x4 wv[2][2];
#pragma unroll
            for (int bj = 0; bj < 2; ++bj)
#pragma unroll
                for (int n = 0; n < 2; ++n) wv[bj][n] = (seg < 2) ? *(const f32x4*)(nw + 32 * bj + 16 * n + 4 * fq) : (f32x4){1.f, 1.f, 1.f, 1.f};
#pragma unroll
            for (int ai = 0; ai < 2; ++ai)
#pragma unroll
                for (int m = 0; m < 4; ++m) { const int row = rowb + ai * 128 + m * 16;
                    float rs = 1.f;
                    if (seg < 2) { float ss = 0.f;
#pragma unroll
                        for (int bj = 0; bj < 2; ++bj)
#pragma unroll
                            for (int n = 0; n < 2; ++n) { const f32x4 v = acc[ai][bj][m][n]; ss += v[0] * v[0] + v[1] * v[1] + v[2] * v[2] + v[3] * v[3]; }
                        ss += __shfl_xor(ss, 16); ss += __shfl_xor(ss, 32);
                        rs = rsqrtf(ss * (1.f / 64.f) + EPS); }
                    if (seg == 0) { bf16_t* rp = Q + (size_t)row * 512 + head * 64 + 4 * fq;
#pragma unroll
                        for (int bj = 0; bj < 2; ++bj)
#pragma unroll
                            for (int n = 0; n < 2; ++n) { const f32x4 v = acc[ai][bj][m][n] * rs * wv[bj][n]; u32x2 o; o[0] = pk2(v[0], v[1]); o[1] = pk2(v[2], v[3]); *(u32x2*)(rp + 32 * bj + 16 * n) = o; }
                    } else { float* rp = out + k_off(layer, row) + (seg == 2 ? (row >= NS0 && row < NM0 ? (O_VS - O_KS) : (O_VP - O_KP)) : 0) + head * 64 + 4 * fq;
#pragma unroll
                        for (int bj = 0; bj < 2; ++bj)
#pragma unroll
                            for (int n = 0; n < 2; ++n) { const f32x4 v = acc[ai][bj][m][n] * rs * wv[bj][n]; *(f32x4*)(rp + 32 * bj + 16 * n) = v; } } }
        } else {
            if (wc == 0) {
#pragma unroll
                for (int ai = 0; ai < 2; ++ai)
#pragma unroll
                    for (int m = 0; m < 4; ++m) *(f32x4*)(DT + (size_t)(rowb + ai * 128 + m * 16) * 16 + 4 * fq) = acc[ai][0][m][0];
            }
        }
    }
};
struct EpiGlu {
    bf16_t* OB;
    __device__ __forceinline__ void operator()(const f32x4 (&acc)[2][2][4][2], const Unit& u, int wr, int wc, int fr, int fq) const {
        const int rowb = u.pm * 256 + wr * 64 + fr, colb = u.pn * 128 + wc * 32 + fq * 4;
#pragma unroll
        for (int ai = 0; ai < 2; ++ai)
#pragma unroll
            for (int m = 0; m < 4; ++m) { bf16_t* rp = OB + (size_t)(rowb + ai * 128 + m * 16) * 1024 + colb;
#pragma unroll
                for (int n = 0; n < 2; ++n) { const f32x4 a = acc[ai][0][m][n], g = acc[ai][1][m][n];
                    u32x2 o; o[0] = pk2(a[0] * sigmoidf_(g[0]), a[1] * sigmoidf_(g[1])); o[1] = pk2(a[2] * sigmoidf_(g[2]), a[3] * sigmoidf_(g[3])); *(u32x2*)(rp + n * 16) = o; } }
    }
};
struct EpiMix {
    bf16_t* R; const bf16_t* G; const bf16_t* OB; int accum;
    __device__ __forceinline__ void operator()(const f32x4 (&acc)[2][2][4][2], const Unit& u, int wr, int wc, int fr, int fq) const {
        const int rowb = u.pm * 256 + wr * 64 + fr, colb = u.pn * 256 + wc * 32 + fq * 4;
#pragma unroll
        for (int ai = 0; ai < 2; ++ai)
#pragma unroll
            for (int m = 0; m < 4; ++m) { const int row = rowb + ai * 128 + m * 16;
#pragma unroll
                for (int bj = 0; bj < 2; ++bj)
#pragma unroll
                    for (int n = 0; n < 2; ++n) { const int col = colb + bj * 128 + n * 16; f32x4 v = acc[ai][bj][m][n];
                        const u32x2 gw = *(const u32x2*)(G + (size_t)row * 3072 + col);
                        v = v * (f32x4){lo_f(gw[0]), hi_f(gw[0]), lo_f(gw[1]), hi_f(gw[1])};
                        if (OB) { const u32x2 g1 = *(const u32x2*)(G + (size_t)row * 3072 + 1024 + col), ob = *(const u32x2*)(OB + (size_t)row * 1024 + col);
                            v = v + (f32x4){lo_f(g1[0]), hi_f(g1[0]), lo_f(g1[1]), hi_f(g1[1])} * (f32x4){lo_f(ob[0]), hi_f(ob[0]), lo_f(ob[1]), hi_f(ob[1])}; }
                        bf16_t* rp = R + (size_t)row * 1024 + col;
                        if (accum) { const u32x2 rw = ld_l2_u32x2(rp); v = v + (f32x4){lo_f(rw[0]), hi_f(rw[0]), lo_f(rw[1]), hi_f(rw[1])}; }
                        u32x2 o; o[0] = pk2(v[0], v[1]); o[1] = pk2(v[2], v[3]); *(u32x2*)rp = o; } }
    }
};
struct EpiRes {
    float* out; float* xmeta;
    __device__ __forceinline__ void operator()(const f32x4 (&acc)[2][2][4][2], const Unit& u, int wr, int wc, int fr, int fq) const {
        const int rowb = u.pm * 256 + wr * 64 + fr, colb = u.pn * 256 + wc * 32 + fq * 4;
        float* base = (u.pm * 256 < NM0) ? out : xmeta - (size_t)NM0 * 1024;
#pragma unroll
        for (int ai = 0; ai < 2; ++ai)
#pragma unroll
            for (int m = 0; m < 4; ++m) { float* rp = base + (size_t)(rowb + ai * 128 + m * 16) * 1024 + colb;
#pragma unroll
                for (int bj = 0; bj < 2; ++bj)
#pragma unroll
                    for (int n = 0; n < 2; ++n) { f32x4* q = (f32x4*)(rp + bj * 128 + n * 16); *q = *q + acc[ai][bj][m][n]; } }
    }
};
struct EpiUp {
    bf16_t* ACT;
    __device__ __forceinline__ void operator()(const f32x4 (&acc)[2][2][4][2], const Unit& u, int wr, int wc, int fr, int fq) const {
        const int rowb = u.pm * 256 + wr * 64 + fr, colb = u.pn * 256 + wc * 32 + fq * 4;
#pragma unroll
        for (int ai = 0; ai < 2; ++ai)
#pragma unroll
            for (int m = 0; m < 4; ++m) { bf16_t* rp = ACT + (size_t)(rowb + ai * 128 + m * 16) * 4096 + colb;
#pragma unroll
                for (int bj = 0; bj < 2; ++bj)
#pragma unroll
                    for (int n = 0; n < 2; ++n) { f32x4 v = acc[ai][bj][m][n];
#pragma unroll
                        for (int j = 0; j < 4; ++j) { const float r = fmaxf(v[j], 0.f); v[j] = r * r; }
                        u32x2 o; o[0] = pk2(v[0], v[1]); o[1] = pk2(v[2], v[3]); *(u32x2*)(rp + bj * 128 + n * 16) = o; } }
    }
};

__device__ __forceinline__ int col_in(int n) {
    if (n < 2304) return n;
    if (n < 2816) return n + 16;
    if (n < 4352) { const int w0 = n - 2816, seg = w0 >> 9, w = w0 & 511, tile = w >> 8, ct = w & 255, bj = ct >> 7, wc = (ct >> 5) & 3, ww = ct & 31;
        return 2832 + seg * 512 + (tile * 4 + wc) * 64 + 32 * bj + ww; }
    if (n < 7424) return n + 16;
    if (n < 7440) return 2304 + (n - 7424);
    return -1;
}
template <int MAP>
__device__ __forceinline__ void prep_w(bf16_t* dst, const float* src, int K, int N, int ld, const float* scale, size_t gtid, size_t gsz) {
    const size_t items = (size_t)(K / 8) * N;
    for (size_t it = gtid; it < items; it += gsz) {
        const int n = (int)(it % N), k8 = (int)(it / N);
        const int c = MAP == 1 ? col_in(n) : (MAP == 2 ? (((n >> 7) & 1) * 1024 + (n >> 8) * 128 + (n & 127)) : n);
        float v[8];
#pragma unroll
        for (int kk = 0; kk < 8; ++kk) { const int k = k8 * 8 + kk; float x = (c >= 0) ? src[(size_t)k * ld + c] : 0.f; if (scale) x *= scale[k]; v[kk] = x; }
        u32x4 o; o[0] = pk2(v[0], v[1]); o[1] = pk2(v[2], v[3]); o[2] = pk2(v[4], v[5]); o[3] = pk2(v[6], v[7]);
        *(u32x4*)(dst + (size_t)n * K + k8 * 8) = o;
    }
}
__device__ __forceinline__ void rmsnorm_rows(CPar p, const float* g, int from_inputs) {
    const int lane = ltid() & 63, gw = lbid() * 8 + (ltid() >> 6), ngw = lgdim() * 8;
    bf16_t* HB = (bf16_t*)(p->ws + WS_HB);
    f32x4 gv[4];
#pragma unroll
    for (int j = 0; j < 4; ++j) gv[j] = *(const f32x4*)(g + lane * 4 + 256 * j);
    for (int r = gw; r < NROWS; r += ngw) {
        float* xl = xloc(p, r);
        const float* src = xl;
        if (from_inputs) src = r < NS0 ? p->in[I_XP] + (size_t)r * 1024 : (r < NM0 ? p->in[I_XS] + (size_t)(r - NS0) * 1024 : p->in[I_META] + (size_t)((r - NM0) & 15) * 1024);
        f32x4 v[4]; float s = 0.f;
#pragma unroll
        for (int j = 0; j < 4; ++j) { v[j] = *(const f32x4*)(src + lane * 4 + 256 * j); s += (v[j][0] * v[j][0] + v[j][1] * v[j][1]) + (v[j][2] * v[j][2] + v[j][3] * v[j][3]); }
        const float rstd = rsqrtf(wave_sum(s) * (1.f / 1024.f) + EPS);
#pragma unroll
        for (int j = 0; j < 4; ++j) { if (from_inputs) *(f32x4*)(xl + lane * 4 + 256 * j) = v[j];
            const f32x4 h = v[j] * rstd * gv[j]; u32x2 o; o[0] = pk2(h[0], h[1]); o[1] = pk2(h[2], h[3]); *(u32x2*)(HB + (size_t)r * 1024 + lane * 4 + 256 * j) = o; }
    }
}
__device__ __forceinline__ void ssd_norm_rows(CPar p) {
    const int lane = ltid() & 63, gw = lbid() * 8 + (ltid() >> 6), ngw = lgdim() * 8;
    bf16_t* Z = (bf16_t*)(p->ws + WS_Z);
    for (int r = gw; r < NROWS; r += ngw) {
#pragma unroll
        for (int j = 0; j < 2; ++j) { u32x4* zp = (u32x4*)(Z + (size_t)r * 1024 + j * 512 + lane * 8); const u32x4 w = *zp;
            float f[8] = {lo_f(w[0]), hi_f(w[0]), lo_f(w[1]), hi_f(w[1]), lo_f(w[2]), hi_f(w[2]), lo_f(w[3]), hi_f(w[3])};
            float ss = 0.f;
#pragma unroll
            for (int i = 0; i < 8; ++i) ss += f[i] * f[i];
            const float rs = rsqrtf(wave_sum(ss) * (1.f / 512.f) + EPS);
            u32x4 o; o[0] = pk2(f[0] * rs, f[1] * rs); o[1] = pk2(f[2] * rs, f[3] * rs); o[2] = pk2(f[4] * rs, f[5] * rs); o[3] = pk2(f[6] * rs, f[7] * rs); *zp = o; }
    }
}
__device__ __forceinline__ void phase_prep(CPar p, int l) {
    const size_t gtid = (size_t)lbid() * 512 + ltid(), gsz = (size_t)lgdim() * 512;
    unsigned char* ws = p->ws;
    prep_w<1>((bf16_t*)(ws + W_BT1), p->in[I_WIN] + (size_t)l * 1024 * IN_COLS, 1024, N1, IN_COLS, nullptr, gtid, gsz);
    prep_w<2>((bf16_t*)(ws + W_GLU), p->in[I_WGLU] + (size_t)l * 512 * 2048, 512, 2048, 2048, nullptr, gtid, gsz);
    prep_w<0>((bf16_t*)(ws + W_LA), p->in[I_WLA] + (size_t)l * 1024 * 1024, 1024, 1024, 1024, p->in[I_NSSD] + l * 1024, gtid, gsz);
    prep_w<0>((bf16_t*)(ws + W_LC), p->in[I_WLC] + (size_t)l * 512 * 1024, 512, 1024, 1024, nullptr, gtid, gsz);
    prep_w<0>((bf16_t*)(ws + W_OUT), p->in[I_WOUT] + (size_t)l * 1024 * 1024, 1024, 1024, 1024, nullptr, gtid, gsz);
    prep_w<0>((bf16_t*)(ws + W_UP), p->in[I_WUP] + (size_t)l * 1024 * 4096, 1024, 4096, 4096, nullptr, gtid, gsz);
    prep_w<0>((bf16_t*)(ws + W_DOWN), p->in[I_WDOWN] + (size_t)l * 4096 * 1024, 4096, 1024, 1024, nullptr, gtid, gsz);
    if (lbid() == 0 && ltid() < 16) ((unsigned*)(ws + WS_CTR))[ltid()] = 0u;
    rmsnorm_rows(p, p->in[I_NMIX] + l * 1024, l == 0);
}

__device__ __forceinline__ bf16_t f2bf_(float v) { return (bf16_t)(pk2(v, v) & 0xffffu); }
__device__ __forceinline__ void ssd_item(CPar p, int l, int item, float* sm) {
    const int tid = ltid(), lane = tid & 63, wave = __builtin_amdgcn_readfirstlane(tid >> 6), rb = wave >> 1, chh = wave & 1, fr = lane & 15, fq = lane >> 4;
    const int s = item < 512 ? (item >> 4) : 32 + ((item - 512) >> 4), h = item & 15, g = h >> 3;
    const bool prompt = s < 32; const int b = prompt ? s : s - 32, T = prompt ? TP : TS;
    constexpr int LB = 72;
    bf16_t *Cb = (bf16_t*)sm, *Bb = Cb + 64 * LB, *XT = Bb + 64 * LB, *WB = XT + 64 * LB, *Mb = WB + 64 * LB, *Sb = Mb + 64 * LB;
    float *sRaw = (float*)(Sb + 64 * LB), *sW = sRaw + 67 * 192, *sdtA = sW + 5 * 192, *sacA = sdtA + 33 * 64, *sw = sacA + 33 * 64;
    const bf16_t* XBC = (const bf16_t*)(p->ws + WS_XBC); bf16_t* Z = (bf16_t*)(p->ws + WS_Z);
    const float* DT = (const float*)(p->ws + WS_DT);
    const float* cw = p->in[I_CONVW] + (size_t)l * 4 * 1280; const float* cb = p->in[I_CONVB] + (size_t)l * 1280;
    const float* hist = p->in[I_SCONV] + (size_t)(l * 16 + b) * 3 * 1280;
    const float dtb = p->in[I_DTB][l * 16 + h], aneg = -__expf(p->in[I_ALOG][l * 16 + h]), dsk = p->in[I_DSSD][l * 16 + h];
    float* sout = prompt ? p->out + O_SSDP + ((size_t)(l * 32 + b) * 16 + h) * 4096 : p->out + O_SSDS + ((size_t)(l * 16 + b) * 16 + h) * 4096;
    for (int i = tid; i < 5 * 192; i += 512) { const int k = i / 192, ch = i - k * 192; const int col = ch < 64 ? h * 64 + ch : (ch < 128 ? 1024 + g * 64 + (ch - 64) : 1152 + g * 64 + (ch - 128));
        sW[i] = k < 4 ? cw[k * 1280 + col] : cb[col]; }
    f32x4 accS[2];
#pragma unroll
    for (int c2 = 0; c2 < 2; ++c2)
#pragma unroll
        for (int r = 0; r < 4; ++r) { const int pp = rb * 16 + fq * 4 + r, n = chh * 32 + c2 * 16 + fr;
            const float v = prompt ? 0.f : p->in[I_SSSD][((size_t)(l * 16 + b) * 16 + h) * 4096 + pp * 64 + n]; accS[c2][r] = v; Sb[pp * LB + n] = f2bf_(v); }
    const int nch = (T + 63) >> 6;
    { const int wv = tid >> 6, ln = tid & 63; float xv[5];
#pragma unroll
        for (int r = 0; r < 5; ++r) { const int c = wv + 8 * r, t = c * 64 + ln; xv[r] = (c < nch && t < T) ? DT[(size_t)row_of(s, t) * 16 + h] + dtb : -1e30f; }
#pragma unroll
        for (int r = 0; r < 5; ++r) { const int c = wv + 8 * r;
            if (c < nch) { const float x = xv[r]; const float dtv = x < -1e29f ? 0.f : (x > 20.f ? x : log1pf(__expf(x))); float cs = dtv * aneg;
#pragma unroll
                for (int o = 1; o < 64; o <<= 1) { const float nb = __shfl_up(cs, o); if (ln >= o) cs += nb; }
                sdtA[c * 64 + ln] = dtv; sacA[c * 64 + ln] = cs; } } }
    u32x4 pf[4];
#define SSD_ISSUE(cc) do { _Pragma("unroll") for (int it4 = 0; it4 < 4; ++it4) { const int pi = tid + it4 * 512; pf[it4] = (u32x4){0u, 0u, 0u, 0u}; \
        if (pi < 67 * 24) { const int rl = pi / 24, pc = pi - rl * 24, seg = pc >> 3, q8 = pc & 7, tt = (cc) * 64 - 3 + rl; \
            const int col = (seg == 0 ? h * 64 : (seg == 1 ? 1024 + g * 64 : 1152 + g * 64)) + q8 * 8; \
            if (tt >= 0 && tt < T) pf[it4] = *(const u32x4*)(XBC + (size_t)row_of(s, tt) * 1280 + col); } } } while (0)
#define SSD_FRAG(P, r0, ks) (*(const bf16x8*)((P) + ((r0) + fr) * LB + (ks) * 32 + fq * 8))
    SSD_ISSUE(0);
#pragma unroll 1
    for (int c = 0; c < nch; ++c) {
        const int t0 = c * 64; const float* sdt = sdtA + t0; const float* sac = sacA + t0;
        __syncthreads();
#pragma unroll
        for (int it4 = 0; it4 < 4; ++it4) { const int pi = tid + it4 * 512;
            if (pi < 67 * 24) { const int rl = pi / 24, pc = pi - rl * 24, seg = pc >> 3, q8 = pc & 7, tt = t0 - 3 + rl;
                const u32x4 w = pf[it4];
                f32x4 f0 = {lo_f(w[0]), hi_f(w[0]), lo_f(w[1]), hi_f(w[1])}, f1 = {lo_f(w[2]), hi_f(w[2]), lo_f(w[3]), hi_f(w[3])};
                if (tt < 0 && !prompt) { const int col = (seg == 0 ? h * 64 : (seg == 1 ? 1024 + g * 64 : 1152 + g * 64)) + q8 * 8; const float* hp = hist + (3 + tt) * 1280 + col; f0 = *(const f32x4*)hp; f1 = *(const f32x4*)(hp + 4); }
                float* dp = sRaw + rl * 192 + seg * 64 + q8 * 8; *(f32x4*)dp = f0; *(f32x4*)(dp + 4) = f1; } }
        if (tid < 64) sw[tid] = __expf(sac[63] - sac[tid]) * sdt[tid];
        if (c + 1 < nch) SSD_ISSUE(c + 1);
        __syncthreads();
#pragma unroll 4
        for (int idx = tid; idx < 64 * 192; idx += 512) {
            const int tl = idx / 192, ch = idx - tl * 192, t = t0 + tl;
            float v = 0.f;
            if (t < T) { v = sW[4 * 192 + ch];
#pragma unroll
                for (int k = 0; k < 4; ++k) v += sRaw[(tl + k) * 192 + ch] * sW[k * 192 + ch];
                v = siluf_(v); }
            const int cc = ch & 63;
            if (ch < 64) XT[cc * LB + tl] = f2bf_(v);
            else if (ch < 128) { Bb[tl * LB + cc] = f2bf_(v); WB[cc * LB + tl] = f2bf_(v * sw[tl]); }
            else Cb[tl * LB + cc] = f2bf_(v);
        }
        __syncthreads();
        f32x4 acc2[2];
        { const bf16x8 aC0 = SSD_FRAG(Cb, rb * 16, 0), aC1 = SSD_FRAG(Cb, rb * 16, 1);
#pragma unroll
            for (int c2 = 0; c2 < 2; ++c2) { const int j0 = chh * 32 + c2 * 16;
                f32x4 m = {0.f, 0.f, 0.f, 0.f};
                if (j0 <= rb * 16 + 15) { m = __builtin_amdgcn_mfma_f32_16x16x32_bf16(aC0, SSD_FRAG(Bb, j0, 0), m, 0, 0, 0); m = __builtin_amdgcn_mfma_f32_16x16x32_bf16(aC1, SSD_FRAG(Bb, j0, 1), m, 0, 0, 0); }
                const int j = j0 + fr; const float acj = sac[j], dtj = sdt[j];
#pragma unroll
                for (int r = 0; r < 4; ++r) { const int tl = rb * 16 + fq * 4 + r; Mb[tl * LB + j] = f2bf_(j <= tl ? m[r] * __expf(sac[tl] - acj) * dtj : 0.f); }
                f32x4 y = {0.f, 0.f, 0.f, 0.f};
                y = __builtin_amdgcn_mfma_f32_16x16x32_bf16(aC0, SSD_FRAG(Sb, j0, 0), y, 0, 0, 0); y = __builtin_amdgcn_mfma_f32_16x16x32_bf16(aC1, SSD_FRAG(Sb, j0, 1), y, 0, 0, 0);
#pragma unroll
                for (int r = 0; r < 4; ++r) y[r] *= __expf(sac[rb * 16 + fq * 4 + r]);
                acc2[c2] = y; }
            const bf16x8 aX0 = SSD_FRAG(XT, rb * 16, 0), aX1 = SSD_FRAG(XT, rb * 16, 1); const float eL = __expf(sac[63]);
#pragma unroll
            for (int c2 = 0; c2 < 2; ++c2) { const int n0 = chh * 32 + c2 * 16; f32x4 sv = accS[c2] * eL;
                sv = __builtin_amdgcn_mfma_f32_16x16x32_bf16(aX0, SSD_FRAG(WB, n0, 0), sv, 0, 0, 0); sv = __builtin_amdgcn_mfma_f32_16x16x32_bf16(aX1, SSD_FRAG(WB, n0, 1), sv, 0, 0, 0); accS[c2] = sv; } }
        __syncthreads();
        { const bf16x8 aM0 = SSD_FRAG(Mb, rb * 16, 0), aM1 = SSD_FRAG(Mb, rb * 16, 1);
#pragma unroll
            for (int c2 = 0; c2 < 2; ++c2) { const int p0 = chh * 32 + c2 * 16, pp = p0 + fr; f32x4 y = acc2[c2];
                y = __builtin_amdgcn_mfma_f32_16x16x32_bf16(aM0, SSD_FRAG(XT, p0, 0), y, 0, 0, 0); y = __builtin_amdgcn_mfma_f32_16x16x32_bf16(aM1, SSD_FRAG(XT, p0, 1), y, 0, 0, 0);
#pragma unroll
                for (int r = 0; r < 4; ++r) { const int tl = rb * 16 + fq * 4 + r, t = t0 + tl;
                    if (t < T) { bf16_t* zp = Z + (size_t)row_of(s, t) * 1024 + h * 64 + pp; const float yy = (y[r] + dsk * bf2f(XT[pp * LB + tl])) * siluf_(bf2f(*zp)); *zp = f2bf_(yy); } } }
#pragma unroll
            for (int c2 = 0; c2 < 2; ++c2)
#pragma unroll
                for (int r = 0; r < 4; ++r) Sb[(rb * 16 + fq * 4 + r) * LB + chh * 32 + c2 * 16 + fr] = f2bf_(accS[c2][r]); }
    }
    __syncthreads();
#pragma unroll
    for (int c2 = 0; c2 < 2; ++c2)
#pragma unroll
        for (int r = 0; r < 4; ++r) sout[(rb * 16 + fq * 4 + r) * 64 + chh * 32 + c2 * 16 + fr] = accS[c2][r];
    float* cout_ = prompt ? p->out + O_CONVP + (size_t)(l * 32 + b) * 3 * 1280 : p->out + O_CONVS + (size_t)(l * 16 + b) * 3 * 1280;
    for (int idx = tid; idx < 3 * 192; idx += 512) { const int k = idx / 192, ch = idx - k * 192;
        if (ch >= 64 && (h & 7) != 0) continue;
        const int col = ch < 64 ? h * 64 + ch : (ch < 128 ? 1024 + g * 64 + (ch - 64) : 1152 + g * 64 + (ch - 128));
        cout_[k * 1280 + col] = bf2f(XBC[(size_t)row_of(s, T - 3 + k) * 1280 + col]); }
    __syncthreads();
#undef SSD_ISSUE
#undef SSD_FRAG
}

__device__ __forceinline__ void s5_item(CPar p, int l, int s, int g, float* wl) {
    const int lane = ltid() & 63;
    const bool prompt = s < 32; const int b = prompt ? s : s - 32, T = prompt ? TP : TS, nblk = T >> 4;
    constexpr int LD = 68;
    float *Xr = wl, *Xi = wl + 16 * LD, *Cr = wl + 32 * LD, *Ci = wl + 48 * LD;
    bf16_t* U = (bf16_t*)(p->ws + WS_U);
    const int gp = (l * 32 + g) * 64 + lane;
    const float lr = p->in[I_LRE][gp], li = p->in[I_LIM][gp], step = expf(p->in[I_LSTEP][l * 32 + g]);
    float sn, cs; sincos_red((double)li * (double)step, sn, cs);
    const float mag = expf(lr * step), ab_re = mag * cs, ab_im = mag * sn;
    const float den = lr * lr + li * li, nr = ab_re - 1.f, f_re = (nr * lr + ab_im * li) / den, f_im = (ab_im * lr - nr * li) / den;
    float bbr[16], bbi[16];
#pragma unroll
    for (int hh = 0; hh < 16; ++hh) { const float br = p->in[I_BRE][(size_t)gp * 16 + hh], bi = p->in[I_BIM][(size_t)gp * 16 + hh]; bbr[hh] = f_re * br - f_im * bi; bbi[hh] = f_re * bi + f_im * br; }
#pragma unroll
    for (int hh = 0; hh < 16; ++hh) { Cr[hh * LD + lane] = p->in[I_CRE][((size_t)(l * 32 + g) * 16 + hh) * 64 + lane]; Ci[hh * LD + lane] = p->in[I_CIM][((size_t)(l * 32 + g) * 16 + hh) * 64 + lane]; }
    float xr = prompt ? 0.f : p->in[I_S5R][(size_t)(l * 16 + b) * 2048 + g * 64 + lane], xi = prompt ? 0.f : p->in[I_S5I][(size_t)(l * 16 + b) * 2048 + g * 64 + lane];
    const int tl = lane >> 2, hq = lane & 3;
    f32x4 dv = *(const f32x4*)(p->in[I_DS5] + (size_t)(l * 32 + g) * 16 + hq * 4);
    u32x4 ua = {0, 0, 0, 0}, ub = {0, 0, 0, 0};
    { const int r0 = row_of(s, 0); if (lane < 16) { const u32x4* up = (const u32x4*)(U + (size_t)(r0 + lane) * 512 + g * 16); ua = up[0]; ub = up[1]; } }
    for (int blk = 0; blk < nblk; ++blk) {
        const int r0 = row_of(s, blk * 16);
        const u32x4 ca = ua, cbv = ub;
        if (blk + 1 < nblk && lane < 16) { const int r1 = row_of(s, blk * 16 + 16); const u32x4* up = (const u32x4*)(U + (size_t)(r1 + lane) * 512 + g * 16); ua = up[0]; ub = up[1]; }
#pragma unroll
        for (int i = 0; i < 16; ++i) {
            float bur = 0.f, bui = 0.f;
#pragma unroll
            for (int w = 0; w < 8; ++w) { const unsigned word = (unsigned)__builtin_amdgcn_readlane((int)(w < 4 ? ca[w] : cbv[w - 4]), i);
                const float u0 = lo_f(word), u1 = hi_f(word);
                bur += bbr[2 * w] * u0 + bbr[2 * w + 1] * u1; bui += bbi[2 * w] * u0 + bbi[2 * w + 1] * u1; }
            const float nxr = ab_re * xr - ab_im * xi + bur, nxi = ab_re * xi + ab_im * xr + bui; xr = nxr; xi = nxi;
            Xr[i * LD + lane] = xr; Xi[i * LD + lane] = xi;
        }
        __builtin_amdgcn_wave_barrier(); asm volatile("s_waitcnt lgkmcnt(0)" ::: "memory");
        float a4[4] = {0.f, 0.f, 0.f, 0.f};
#pragma unroll 4
        for (int p4 = 0; p4 < 64; p4 += 4) { const f32x4 xr4 = *(const f32x4*)(Xr + tl * LD + p4), xi4 = *(const f32x4*)(Xi + tl * LD + p4);
#pragma unroll
            for (int hh = 0; hh < 4; ++hh) { const f32x4 cr4 = *(const f32x4*)(Cr + (hq * 4 + hh) * LD + p4), ci4 = *(const f32x4*)(Ci + (hq * 4 + hh) * LD + p4);
                a4[hh] += (xr4[0] * cr4[0] + xr4[1] * cr4[1] + xr4[2] * cr4[2] + xr4[3] * cr4[3]) - (xi4[0] * ci4[0] + xi4[1] * ci4[1] + xi4[2] * ci4[2] + xi4[3] * ci4[3]); } }
        { bf16_t* up = U + (size_t)(r0 + tl) * 512 + g * 16 + hq * 4; const u32x2 uw = *(const u32x2*)up;
            const float y0 = a4[0] + dv[0] * lo_f(uw[0]), y1 = a4[1] + dv[1] * hi_f(uw[0]), y2 = a4[2] + dv[2] * lo_f(uw[1]), y3 = a4[3] + dv[3] * hi_f(uw[1]);
            u32x2 o; o[0] = pk2(geluf_(y0), geluf_(y1)); o[1] = pk2(geluf_(y2), geluf_(y3)); *(u32x2*)up = o; }
        __builtin_amdgcn_wave_barrier(); asm volatile("s_waitcnt lgkmcnt(0)" ::: "memory");
    }
    float* ore = prompt ? p->out + O_S5RP + (size_t)(l * 32 + b) * 2048 : p->out + O_S5RS + (size_t)(l * 16 + b) * 2048;
    float* oim = prompt ? p->out + O_S5IP + (size_t)(l * 32 + b) * 2048 : p->out + O_S5IS + (size_t)(l * 16 + b) * 2048;
    ore[g * 64 + lane] = xr; oim[g * 64 + lane] = xi;
}

__device__ __forceinline__ void attn_item(CPar p, int l, int item, float* wl) {
    const int lane = ltid() & 63;
    int s, h, qt;
    if (item < 8448) { s = item / 264; const int rem = item - s * 264; h = rem / 33; qt = rem - h * 33; } else { const int it = item - 8448; s = 32 + (it >> 3); h = it & 7; qt = 0; }
    const bool prompt = s < 32; const int b = prompt ? s : s - 32, T = prompt ? TP : TS, nh = prompt ? 0 : PAST;
    const int i = qt * 64 + lane; const bool active = i < T; const int row = row_of(s, active ? i : T - 1);
    bf16_t* Q = (bf16_t*)(p->ws + WS_Q);
    float* Kt = wl; float* Vt = wl + 32 * 64;
    float q[64], o[64];
    { const u32x4* qp = (const u32x4*)(Q + (size_t)row * 512 + h * 64);
#pragma unroll
        for (int e = 0; e < 8; ++e) { const u32x4 w = qp[e];
#pragma unroll
            for (int j = 0; j < 4; ++j) { q[e * 8 + 2 * j] = lo_f(w[j]) * 0.125f; q[e * 8 + 2 * j + 1] = hi_f(w[j]) * 0.125f; } } }
#pragma unroll
    for (int d = 0; d < 64; ++d) o[d] = 0.f;
    const float* kp_new = prompt ? p->out + O_KP + (size_t)(l * 32 + b) * 2064 * 512 + h * 64 : p->out + O_KS + (size_t)(l * 16 + b) * 64 * 512 + h * 64;
    const float* vp_new = prompt ? p->out + O_VP + (size_t)(l * 32 + b) * 2064 * 512 + h * 64 : p->out + O_VS + (size_t)(l * 16 + b) * 64 * 512 + h * 64;
    const float* kp_old = p->in[I_CK] + (size_t)(l * 16 + b) * 2048 * 512 + h * 64;
    const float* vp_old = p->in[I_CV] + (size_t)(l * 16 + b) * 2048 * 512 + h * 64;
    const int imax = (qt * 64 + 63 < T - 1) ? qt * 64 + 63 : T - 1;
    const int jtop = nh + imax - 1;
    float run = 0.f;
    for (int jt = jtop; jt >= 0; jt -= 32) {
#pragma unroll 4
        for (int e = 0; e < 8; ++e) { const int idx = e * 64 + lane, kr = idx >> 4, pc = idx & 15, j = jt - kr;
            if (j >= 0) { const float* kp = (j < nh) ? kp_old + (size_t)j * 512 : kp_new + (size_t)(j - nh) * 512; *(f32x4*)(Kt + kr * 64 + pc * 4) = *(const f32x4*)(kp + pc * 4); } }
#pragma unroll 4
        for (int e = 0; e < 8; ++e) { const int idx = e * 64 + lane, kr = idx >> 4, pc = idx & 15, j = jt - kr;
            if (j >= 0) { const float* vp = (j < nh) ? vp_old + (size_t)j * 512 : vp_new + (size_t)(j - nh) * 512; *(f32x4*)(Vt + kr * 64 + pc * 4) = *(const f32x4*)(vp + pc * 4); } }
        __builtin_amdgcn_wave_barrier(); asm volatile("s_waitcnt vmcnt(0) lgkmcnt(0)" ::: "memory");
        const int nk = jt + 1 < 32 ? jt + 1 : 32;
        for (int kk = 0; kk < nk; ++kk) { const int j = jt - kk;
            float z = 0.f;
#pragma unroll
            for (int d = 0; d < 64; d += 4) { const f32x4 kv = *(const f32x4*)(Kt + kk * 64 + d); z += q[d] * kv[0] + q[d + 1] * kv[1] + q[d + 2] * kv[2] + q[d + 3] * kv[3]; }
            const bool valid = active && (j < nh + i);
            const float e = __expf(-z), ls = -__logf(1.f + e);
            const float w = valid ? __expf(ls + run) : 0.f;
            run += valid ? (ls - z) : 0.f;
#pragma unroll
            for (int d = 0; d < 64; d += 4) { const f32x4 vv = *(const f32x4*)(Vt + kk * 64 + d); o[d] += w * vv[0]; o[d + 1] += w * vv[1]; o[d + 2] += w * vv[2]; o[d + 3] += w * vv[3]; } }
        __builtin_amdgcn_wave_barrier(); asm volatile("s_waitcnt lgkmcnt(0)" ::: "memory");
        const int fin = (!active) || (run < -100.f);
        if (__all(fin)) break;
    }
    if (active) { u32x4* op = (u32x4*)(Q + (size_t)row * 512 + h * 64);
#pragma unroll
        for (int e = 0; e < 8; ++e) { u32x4 w; w[0] = pk2(o[e * 8], o[e * 8 + 1]); w[1] = pk2(o[e * 8 + 2], o[e * 8 + 3]); w[2] = pk2(o[e * 8 + 4], o[e * 8 + 5]); w[3] = pk2(o[e * 8 + 6], o[e * 8 + 7]); op[e] = w; } }
}

__device__ __forceinline__ void phase_mixers(CPar p, int l, float* sm) {
#ifndef SKIP_SSD
    { CPar p1 = params_ptr();
#pragma unroll 1
      for (int it = lbid(); it < 768; it += lgdim()) ssd_item(p1, l, it, sm); }
#endif
    __syncthreads();
    const int wave = __builtin_amdgcn_readfirstlane(ltid() >> 6);
    float* wl = sm + wave * (68 * 64);
#ifndef SKIP_S5
    { CPar p2 = params_ptr();
    if (wave < 4) { for (int it = lbid() * 4 + wave; it < 1024; it += lgdim() * 4) s5_item(p2, l, it >> 5, it & 31, wl); }
    else if (wave < 6) { for (int it = lbid() * 2 + (wave - 4); it < 512; it += lgdim() * 2) s5_item(p2, l, 32 + (it >> 5), it & 31, wl); } }
#endif
#ifndef SKIP_ATT
    CPar p3 = params_ptr();
    unsigned* ctr = (unsigned*)(p3->ws + WS_CTR) + l;
    for (;;) {
        unsigned it = 0; if ((ltid() & 63) == 0) it = atomicAdd(ctr, 1u);
        it = (unsigned)__builtin_amdgcn_readfirstlane((int)it);
        if (it >= 8576u) break;
        attn_item(p3, l, (int)it, wl);
    }
#endif
}

__global__ __launch_bounds__(512, 2) void mega(Params pk) {
    extern __shared__ __attribute__((aligned(16))) unsigned char smem[];
    cg::grid_group grid = cg::this_grid();
    LAS unsigned char* lds = (LAS unsigned char*)smem;
    const int ph_lo = pk.ph_lo, ph_hi = pk.ph_hi;
    for (int ph = ph_lo; ph < ph_hi; ++ph) {
        if (ph > ph_lo) grid.sync();
        CPar p = params_ptr();
        unsigned char* ws = p->ws;
        bf16_t *HB = (bf16_t*)(ws + WS_HB), *Z = (bf16_t*)(ws + WS_Z), *XBC = (bf16_t*)(ws + WS_XBC), *U = (bf16_t*)(ws + WS_U), *Q = (bf16_t*)(ws + WS_Q), *G = (bf16_t*)(ws + WS_G);
        float *DT = (float*)(ws + WS_DT), *XM = (float*)(ws + WS_XMETA);
        const int l = ph / 9, sub = ph - l * 9;
        pg8::StaticOrder S;
        if (sub == 0) {
#ifndef SKIP0
            phase_prep(p, l);
#endif
        } else if (sub == 1) {
            S.init(NROWS, N1, lgdim(), lbid());
            EpiIn E{Z, XBC, U, Q, G, DT, p->out, p->in[I_QN] + l * 64, p->in[I_KN] + l * 64, l};
#ifndef SKIP1
            pg8::gemm_phase(lds, pg8::Gemm{HB, (const bf16_t*)(ws + W_BT1), NROWS, N1, 1024, 1024, 1024}, S, E);
#endif
        } else if (sub == 2) {
#ifndef SKIP2
            phase_mixers(p, l, (float*)smem);
#endif
        } else if (sub == 3) {
            ssd_norm_rows(p);
            S.init(NROWS, 2048, lgdim(), lbid());
            EpiGlu E{XBC};
            pg8::gemm_phase(lds, pg8::Gemm{U, (const bf16_t*)(ws + W_GLU), NROWS, 2048, 512, 512, 512}, S, E);
        } else if (sub == 4) {
            S.init(NROWS, 1024, lgdim(), lbid());
            for (int call = 0; call < 2; ++call) {
                EpiMix E; pg8::Gemm g;
                if (call == 0) { E = EpiMix{HB, G, XBC, 0}; g = pg8::Gemm{Z, (const bf16_t*)(ws + W_LA), NROWS, 1024, 1024, 1024, 1024}; }
                else { E = EpiMix{HB, G + 2048, nullptr, 1}; g = pg8::Gemm{Q, (const bf16_t*)(ws + W_LC), NROWS, 1024, 512, 512, 512}; }
#ifndef SKIP3
                pg8::gemm_phase(lds, g, S, E);
#endif
            }
        } else if (sub == 5) {
            S.init(NROWS, 1024, lgdim(), lbid());
            EpiRes E{p->out, XM};
#ifndef SKIP4
            pg8::gemm_phase(lds, pg8::Gemm{HB, (const bf16_t*)(ws + W_OUT), NROWS, 1024, 1024, 1024, 1024}, S, E);
#endif
        } else if (sub == 6) {
            rmsnorm_rows(p, p->in[I_NFFN] + l * 1024, 0);
        } else if (sub == 7) {
            S.init(NROWS, 4096, lgdim(), lbid());
            EpiUp E{(bf16_t*)(ws + WS_ACT)};
#ifndef SKIP6
            pg8::gemm_phase(lds, pg8::Gemm{HB, (const bf16_t*)(ws + W_UP), NROWS, 4096, 1024, 1024, 1024}, S, E);
#endif
        } else {
            S.init(NROWS, 1024, lgdim(), lbid());
            EpiRes E{p->out, XM};
#ifndef SKIP7
            pg8::gemm_phase(lds, pg8::Gemm{(const bf16_t*)(ws + WS_ACT), (const bf16_t*)(ws + W_DOWN), NROWS, 1024, 4096, 4096, 4096}, S, E);
#endif
        }
    }
}

extern "C" void kernel_launch(void* const* d_in, const int* in_sizes, int n_in, void* d_out, int out_size, void* d_ws, size_t ws_size, hipStream_t stream) {
    static int grid = 0;
    if (grid == 0) {
        if (n_in != 34 || (size_t)out_size != O_END || ws_size < WS_END) { fprintf(stderr, "kernel_launch: unexpected shapes n_in %d out %d ws %zu (need %zu)\n", n_in, out_size, ws_size, (size_t)WS_END); grid = -1; return; }
        int dev = 0, cus = 0, per_cu = 0;
        hipGetDevice(&dev); hipDeviceGetAttribute(&cus, hipDeviceAttributeMultiprocessorCount, dev);
        if (hipFuncSetAttribute((const void*)mega, hipFuncAttributeMaxDynamicSharedMemorySize, LDS_BYTES) != hipSuccess) { fprintf(stderr, "kernel_launch: hipFuncSetAttribute failed\n"); grid = -1; return; }
        if (hipOccupancyMaxActiveBlocksPerMultiprocessor(&per_cu, (const void*)mega, 512, LDS_BYTES) != hipSuccess || per_cu < 1) { fprintf(stderr, "kernel_launch: occupancy query says %d\n", per_cu); per_cu = 1; }
        (void)hipGetLastError();
        grid = cus * per_cu;
    }
    if (grid < 0) return;
    Params p{};
    for (int i = 0; i < 34; ++i) p.in[i] = (const float*)d_in[i];
    p.out = (float*)d_out; p.ws = (unsigned char*)d_ws;
#if MULTI_LAUNCH
    for (int ph = 0; ph < 18; ++ph) { p.ph_lo = ph; p.ph_hi = ph + 1; hipLaunchKernelGGL(mega, dim3(grid), dim3(512), LDS_BYTES, stream, p); }
#else
    p.ph_lo = 0; p.ph_hi = 18;
    void* args[] = {&p};
    hipError_t e = hipLaunchCooperativeKernel((const void*)mega, dim3(grid), dim3(512), args, LDS_BYTES, stream);
    if (e != hipSuccess) fprintf(stderr, "cooperative launch failed: %s (grid %d)\n", hipGetErrorString(e), grid);
#endif
}
```

```cpp
#include <hip/hip_runtime.h>
#include <hip/hip_cooperative_groups.h>
#include <cstdio>
#include <cstdint>
namespace cg = cooperative_groups;

#ifndef MULTI_LAUNCH
#define MULTI_LAUNCH 0
#endif

typedef unsigned short bf16_t;
typedef short bf16x8 __attribute__((ext_vector_type(8)));
typedef float f32x4 __attribute__((ext_vector_type(4)));
typedef unsigned u32x4 __attribute__((ext_vector_type(4)));
typedef unsigned u32x2 __attribute__((ext_vector_type(2)));
#define LAS __attribute__((address_space(3)))

constexpr int D = 1024, NROWS = 67072, NS0 = 65536, NM0 = 66560;
constexpr int TP = 2064, TS = 64, NB_P = 32, NB_S = 16, PAST = 2048;
constexpr int IN_COLS = 7440, N1 = 7680;
constexpr int SSQ_SLOTS = NM0 + 32 * 32;
constexpr float EPS = 1e-6f;
constexpr size_t O_YP = 0, O_YS = 67108864ull, O_KP = O_YS + 1048576ull, SZ_KP = 2ull * 32 * 2064 * 512, O_VP = O_KP + SZ_KP,
                 O_CONVP = O_VP + SZ_KP, O_SSDP = O_CONVP + 2ull * 32 * 3 * 1280, O_S5RP = O_SSDP + 2ull * 32 * 16 * 4096, O_S5IP = O_S5RP + 2ull * 32 * 2048,
                 O_KS = O_S5IP + 2ull * 32 * 2048, O_VS = O_KS + 2ull * 16 * 64 * 512, O_CONVS = O_VS + 2ull * 16 * 64 * 512, O_SSDS = O_CONVS + 2ull * 16 * 3 * 1280,
                 O_S5RS = O_SSDS + 2ull * 16 * 16 * 4096, O_S5IS = O_S5RS + 2ull * 16 * 2048, O_END = O_S5IS + 2ull * 16 * 2048;
constexpr size_t W_BT1 = 0, W_GLU = W_BT1 + (size_t)N1 * 1024 * 2, W_LA = W_GLU + 2048ull * 512 * 2, W_LC = W_LA + 1024ull * 1024 * 2, W_OUT = W_LC + 1024ull * 512 * 2,
                 W_UP = W_OUT + 1024ull * 1024 * 2, W_DOWN = W_UP + 4096ull * 1024 * 2, W_END = W_DOWN + 4096ull * 1024 * 2;
constexpr size_t WS_CTR = W_END, WS_XMETA = WS_CTR + 4096, WS_HB = WS_XMETA + 512ull * 1024 * 4, WS_Z = WS_HB + (size_t)NROWS * 1024 * 2, WS_XBC = WS_Z + (size_t)NROWS * 1024 * 2,
                 WS_U = WS_XBC + (size_t)NROWS * 1280 * 2, WS_Q = WS_U + (size_t)NROWS * 512 * 2, WS_G = WS_Q + (size_t)NROWS * 512 * 2, WS_DT = WS_G + (size_t)NROWS * 3072 * 2,
                 WS_SSQ = WS_DT + (size_t)NROWS * 16 * 4, WS_END = WS_SSQ + (size_t)SSQ_SLOTS * 16 * 4;
constexpr size_t WS_ACT = WS_Z;
static_assert(WS_ACT + (size_t)NROWS * 4096 * 2 <= WS_DT, "ACT overlay");
constexpr int LDS_BYTES = 147456;

struct Params {
    const float* in[34];
    float* out;
    unsigned char* ws;
    int ph_lo, ph_hi;
};
typedef const __attribute__((address_space(4))) Params* CPar;
__device__ __forceinline__ CPar params_ptr() { CPar q = (CPar)__builtin_amdgcn_kernarg_segment_ptr(); asm volatile("" : "+s"(q)); return q; }
#define PIN(i) (p->in[i])
enum { I_XP = 0, I_XS, I_CK, I_CV, I_SCONV, I_SSSD, I_S5R, I_S5I, I_META, I_NMIX, I_WIN, I_CONVW, I_CONVB, I_DTB, I_ALOG, I_DSSD, I_NSSD, I_LRE, I_LIM, I_LSTEP, I_BRE, I_BIM,
       I_CRE, I_CIM, I_DS5, I_WGLU, I_QN, I_KN, I_WLA, I_WLC, I_WOUT, I_NFFN, I_WUP, I_WDOWN };

__device__ __forceinline__ int ltid() { int t = threadIdx.x; asm volatile("" : "+v"(t)); return t; }
__device__ __forceinline__ int lbid() { int t = blockIdx.x; asm volatile("" : "+s"(t)); return t; }
__device__ __forceinline__ int lgdim() { int t = gridDim.x; asm volatile("" : "+s"(t)); return t; }

__device__ __forceinline__ float bf2f(bf16_t v) { return __uint_as_float((unsigned)v << 16); }
__device__ __forceinline__ unsigned pk2(float lo, float hi) { unsigned r; asm volatile("v_cvt_pk_bf16_f32 %0, %1, %2" : "=v"(r) : "v"(lo), "v"(hi)); return r; }
__device__ __forceinline__ float lo_f(unsigned w) { return __uint_as_float(w << 16); }
__device__ __forceinline__ float hi_f(unsigned w) { return __uint_as_float(w & 0xffff0000u); }
__device__ __forceinline__ u32x2 ld_l2_u32x2(const void* ptr) { const unsigned long long v = __hip_atomic_load((const unsigned long long*)ptr, __ATOMIC_RELAXED, __HIP_MEMORY_SCOPE_AGENT); u32x2 r; r[0] = (unsigned)v; r[1] = (unsigned)(v >> 32); return r; }
__device__ __forceinline__ float sigmoidf_(float v) { return __builtin_amdgcn_rcpf(1.f + __expf(-v)); }
__device__ __forceinline__ float siluf_(float v) { return v * sigmoidf_(v); }
__device__ __forceinline__ float geluf_(float y) { const float a = 0.7978845608f * (y + 0.044715f * y * y * y); const float t = __expf(2.f * a); return 0.5f * y * (2.f - 2.f * __builtin_amdgcn_rcpf(t + 1.f)); }
__device__ __forceinline__ float wave_sum(float v) {
#pragma unroll
    for (int o = 1; o < 64; o <<= 1) v += __shfl_xor(v, o);
    return v;
}
__device__ __forceinline__ void sincos_red(double x, float& sn, float& cs) {
    const double k = __builtin_rint(x * 0.63661977236758134308);
    const float r = (float)__builtin_fma(-k, 1.57079632679489661923, x), r2 = r * r;
    const float sp = r + r * r2 * (-1.6666667163e-01f + r2 * (8.3333337680e-03f + r2 * (-1.9841270114e-04f + r2 * 2.7557314297e-06f)));
    const float cp = 1.f + r2 * (-0.5f + r2 * (4.1666667908e-02f + r2 * (-1.3888889225e-03f + r2 * (2.4801587642e-05f - r2 * 2.7557314297e-07f))));
    const int q = ((int)k) & 3;
    sn = (q == 0) ? sp : (q == 1) ? cp : (q == 2) ? -sp : -cp;
    cs = (q == 0) ? cp : (q == 1) ? -sp : (q == 2) ? -cp : sp;
}
__device__ __forceinline__ int row_of(int s, int t) { return s < 32 ? (t < 16 ? NM0 + s * 16 + t : s * 2048 + t - 16) : NS0 + (s - 32) * 64 + t; }
__device__ __forceinline__ int ssq_slot(int r) { return r < NM0 ? r : NM0 + ((r - NM0) >> 4) * 32 + ((r - NM0) & 15); }
__device__ __forceinline__ float* xloc(CPar p, int r) { return r < NM0 ? p->out + (size_t)r * 1024 : (float*)(p->ws + WS_XMETA) + (size_t)(r - NM0) * 1024; }
__device__ __forceinline__ size_t k_off(int l, int r) {
    if (r < NS0) return O_KP + ((size_t)(l * 32 + (r >> 11)) * 2064 + 16 + (r & 2047)) * 512;
    if (r < NM0) { const int rs = r - NS0; return O_KS + ((size_t)(l * 16 + (rs >> 6)) * 64 + (rs & 63)) * 512; }
    const int rm = r - NM0; return O_KP + ((size_t)(l * 32 + (rm >> 4)) * 2064 + (rm & 15)) * 512;
}

namespace pg8 {
constexpr int BM = 256, BK = 64, HALF = 128, HTB = HALF * BK * 2, STAGE_BYTES = 8 * HTB, NXCD = 8, WGM = 8;
__host__ __device__ __forceinline__ int lds_byte(int r, int c) { const int st = (r >> 4) * 2 + (c >> 5), rr = r & 15, cc = c & 31, ob = rr * 64 + cc * 2; return st * 1024 + (ob ^ (((ob >> 9) & 1) << 5)); }
__host__ __device__ __forceinline__ void stage_rc(int b, int& R, int& C) { const int st = b / 1024, sb = b % 1024, swz = sb ^ (((sb >> 9) & 1) << 5); R = (st >> 1) * 16 + swz / 64; C = (st & 1) * 32 + (swz % 64) / 2; }
struct Unit { int pm, pn; };
struct Gemm { const bf16_t* A; const bf16_t* Bt; int M, N, K, lda, ldb; };
struct StaticOrder {
    int nM, nN, nwg, G, c;
    __device__ void init(int M, int N, int G_, int c_) { nM = M / BM; nN = N / BM; nwg = nM * nN; G = G_; c = c_; }
    __device__ bool next(int i, Unit& u) const {
        const long L = (long)i * G + c; if (L >= nwg) return false;
        int wgid = (int)L; { const int q = nwg / NXCD, r = nwg % NXCD, xcd = wgid % NXCD, off = wgid / NXCD; wgid = (xcd < r ? xcd * (q + 1) : r * (q + 1) + (xcd - r) * q) + off; }
        const int nig = WGM * nN, gid = wgid / nig, fm = gid * WGM, gsz = (nM - fm) < WGM ? (nM - fm) : WGM;
        u.pm = fm + ((wgid % nig) % gsz); u.pn = (wgid % nig) / gsz; return true;
    }
};
template <class Epi>
__device__ __forceinline__ void gemm_phase(LAS unsigned char* lds, const Gemm g, const StaticOrder& S, const Epi& E) {
    const int tid = ltid(), wid = __builtin_amdgcn_readfirstlane(tid >> 6), lane = tid & 63, wr = wid >> 2, wc = wid & 3, fr = lane & 15, fq = lane >> 4;
    const int K = g.K, nt = K / BK;
    unsigned voffA[2], voffB[2];
#pragma unroll
    for (int i = 0; i < 2; ++i) { int R, C; stage_rc(tid * 16 + i * 8192, R, C); voffA[i] = (unsigned)(R * g.lda + C) * 2u; voffB[i] = (unsigned)(R * g.ldb + C) * 2u; }
    const size_t kstep = (size_t)(BK * 2);
    const size_t hstepA = (size_t)HALF * g.lda * 2, hstepB = (size_t)HALF * g.ldb * 2;
    const size_t tstepA = 2 * hstepA, tstepB = 2 * hstepB;
    const unsigned ldsw = (unsigned)wid * 1024u;
    const int aoff = lds_byte(wr * 64 + fr, fq * 8), boff = lds_byte(wc * 32 + fr, fq * 8);
#define PG8_SA(b, h) (((b) * 2 + (h)) * HTB)
#define PG8_SB(b, h) ((4 + (b) * 2 + (h)) * HTB)
#define PG8_STAGE(bufoff, gbase, voff) do { _Pragma("unroll") for (int _i = 0; _i < 2; ++_i) \
        __builtin_amdgcn_global_load_lds((const unsigned*)((const char*)(gbase) + (voff)[_i]), (LAS unsigned*)(lds + (bufoff) + ldsw + _i * 8192), 16, 0, 0); } while (0)
#define PG8_LDA(dst, b, h) do { _Pragma("unroll") for (int m = 0; m < 4; ++m) _Pragma("unroll") for (int k = 0; k < 2; ++k) dst[m][k] = *(const LAS bf16x8*)(lds + PG8_SA(b, h) + aoff + m * 2048 + k * 1024); } while (0)
#define PG8_LDB(dst, b, h) do { _Pragma("unroll") for (int n = 0; n < 2; ++n) _Pragma("unroll") for (int k = 0; k < 2; ++k) dst[n][k] = *(const LAS bf16x8*)(lds + PG8_SB(b, h) + boff + n * 2048 + k * 1024); } while (0)
#define PG8_MMA(ai, bj, At, Bt) do { __builtin_amdgcn_s_setprio(1); _Pragma("unroll") for (int m = 0; m < 4; ++m) _Pragma("unroll") for (int n = 0; n < 2; ++n) _Pragma("unroll") for (int k = 0; k < 2; ++k) \
        acc[ai][bj][m][n] = __builtin_amdgcn_mfma_f32_16x16x32_bf16(Bt[n][k], At[m][k], acc[ai][bj][m][n], 0, 0, 0); __builtin_amdgcn_s_setprio(0); } while (0)
#define PG8_WAIT_V(n) asm volatile("s_waitcnt vmcnt(" #n ")" ::: "memory")
#define PG8_WAIT_L(n) asm volatile("s_waitcnt lgkmcnt(" #n ")" ::: "memory")
#define PG8_BAR __builtin_amdgcn_s_barrier()
#define PG8_SCHED __builtin_amdgcn_sched_barrier(0)
    Unit cur, nxt; int ui = 0;
    if (!S.next(0, cur)) return;
    f32x4 acc[2][2][4][2];
#pragma unroll
    for (int a = 0; a < 2; ++a)
#pragma unroll
        for (int b = 0; b < 2; ++b)
#pragma unroll
            for (int m = 0; m < 4; ++m)
#pragma unroll
                for (int n = 0; n < 2; ++n) acc[a][b][m][n] = (f32x4){0.f, 0.f, 0.f, 0.f};
    bf16x8 At[4][2], B0[2][2], B1[2][2];
    const char* cA = (const char*)g.A + (size_t)cur.pm * tstepA; const char* cB = (const char*)g.Bt + (size_t)cur.pn * tstepB;
    PG8_STAGE(PG8_SB(0, 0), cB, voffB); PG8_STAGE(PG8_SA(0, 0), cA, voffA); PG8_STAGE(PG8_SB(0, 1), cB + hstepB, voffB); PG8_STAGE(PG8_SA(0, 1), cA + hstepA, voffA);
    if (wr == 1) PG8_BAR;
    PG8_WAIT_V(4); PG8_BAR;
    PG8_STAGE(PG8_SB(1, 0), cB + kstep, voffB); PG8_STAGE(PG8_SA(1, 0), cA + kstep, voffA); PG8_STAGE(PG8_SB(1, 1), cB + hstepB + kstep, voffB);
    PG8_WAIT_V(6); PG8_BAR;
    for (;;) {
        const bool has_next = S.next(ui + 1, nxt);
        const char* nA = has_next ? (const char*)g.A + (size_t)nxt.pm * tstepA : cA; const char* nB = has_next ? (const char*)g.Bt + (size_t)nxt.pn * tstepB : cB;
        for (int t = 0; t < nt; t += 2) {
            const bool last = (t == nt - 2);
            const char* a1 = cA + (size_t)(t + 1) * kstep;
            const char* a2 = last ? nA : cA + (size_t)(t + 2) * kstep; const char* b2 = last ? nB : cB + (size_t)(t + 2) * kstep;
            const char* a3 = a2 + kstep; const char* b3 = b2 + kstep;
            PG8_LDB(B0, 0, 0); PG8_SCHED; PG8_LDA(At, 0, 0); PG8_STAGE(PG8_SA(1, 1), a1 + hstepA, voffA);
            PG8_WAIT_L(8); PG8_BAR; PG8_WAIT_L(0); PG8_MMA(0, 0, At, B0); PG8_BAR; PG8_SCHED;
            PG8_LDB(B1, 0, 1); PG8_STAGE(PG8_SB(0, 0), b2, voffB);
            PG8_BAR; PG8_WAIT_L(0); PG8_MMA(0, 1, At, B1); PG8_BAR;
            PG8_LDA(At, 0, 1); PG8_STAGE(PG8_SA(0, 0), a2, voffA);
            PG8_BAR; PG8_WAIT_L(0); PG8_MMA(1, 0, At, B0); PG8_BAR; PG8_SCHED;
            PG8_STAGE(PG8_SB(0, 1), b2 + hstepB, voffB);
            PG8_WAIT_V(6); PG8_BAR; PG8_MMA(1, 1, At, B1); PG8_BAR;
            PG8_LDB(B0, 1, 0); PG8_SCHED; PG8_LDA(At, 1, 0); PG8_STAGE(PG8_SA(0, 1), a2 + hstepA, voffA);
            PG8_WAIT_L(8); PG8_BAR; PG8_WAIT_L(0); PG8_MMA(0, 0, At, B0); PG8_BAR; PG8_SCHED;
            PG8_LDB(B1, 1, 1); PG8_STAGE(PG8_SB(1, 0), b3, voffB);
            PG8_BAR; PG8_WAIT_L(0); PG8_MMA(0, 1, At, B1); PG8_BAR;
            PG8_LDA(At, 1, 1); PG8_STAGE(PG8_SA(1, 0), a3, voffA);
            PG8_BAR; PG8_WAIT_L(0); PG8_MMA(1, 0, At, B0); PG8_BAR; PG8_SCHED;
            PG8_STAGE(PG8_SB(1, 1), b3 + hstepB, voffB);
            PG8_WAIT_V(6); PG8_BAR; PG8_MMA(1, 1, At, B1); PG8_BAR;
        }
        E(acc, cur, wr, wc, fr, fq);
        if (!has_next) break;
#pragma unroll
        for (int a = 0; a < 2; ++a)
#pragma unroll
            for (int b = 0; b < 2; ++b)
#pragma unroll
                for (int m = 0; m < 4; ++m)
#pragma unroll
                    for (int n = 0; n < 2; ++n) acc[a][b][m][n] = (f32x4){0.f, 0.f, 0.f, 0.f};
        cur = nxt; cA = nA; cB = nB; ++ui;
    }
    PG8_WAIT_V(0);
    if (wr == 0) PG8_BAR;
    PG8_BAR;
#undef PG8_SA
#undef PG8_SB
#undef PG8_STAGE
#undef PG8_LDA
#undef PG8_LDB
#undef PG8_MMA
#undef PG8_WAIT_V
#undef PG8_WAIT_L
#undef PG8_BAR
#undef PG8_SCHED
}
}
using pg8::Unit;

struct EpiIn {
    bf16_t *Z, *XBC, *U, *Q, *G; float* DT; float* out; const float *qn, *kn; int layer;
    __device__ __forceinline__ void operator()(const f32x4 (&acc)[2][2][4][2], const Unit& u, int wr, int wc, int fr, int fq) const {
        const int pn = u.pn, rowb = u.pm * 256 + wr * 64 + fr, ctb = wc * 32 + fq * 4;
        if (pn < 11 || (pn >= 17 && pn < 29)) {
            bf16_t* base; int ld, col0; bool sig = false;
            if (pn < 4) { base = Z; ld = 1024; col0 = pn * 256; } else if (pn < 9) { base = XBC; ld = 1280; col0 = (pn - 4) * 256; }
            else if (pn < 11) { base = U; ld = 512; col0 = (pn - 9) * 256; } else { base = G; ld = 3072; col0 = (pn - 17) * 256; sig = true; }
#pragma unroll
            for (int ai = 0; ai < 2; ++ai)
#pragma unroll
                for (int m = 0; m < 4; ++m) { bf16_t* rp = base + (size_t)(rowb + ai * 128 + m * 16) * ld + col0 + ctb;
#pragma unroll
                    for (int bj = 0; bj < 2; ++bj)
#pragma unroll
                        for (int n = 0; n < 2; ++n) { f32x4 v = acc[ai][bj][m][n];
                            if (sig) { v[0] = sigmoidf_(v[0]); v[1] = sigmoidf_(v[1]); v[2] = sigmoidf_(v[2]); v[3] = sigmoidf_(v[3]); }
                            u32x2 o; o[0] = pk2(v[0], v[1]); o[1] = pk2(v[2], v[3]); *(u32x2*)(rp + bj * 128 + n * 16) = o; } }
        } else if (pn < 17) {
            const int seg = (pn - 11) >> 1, head = ((pn - 11) & 1) * 4 + wc;
            const float* nw = seg == 0 ? qn : kn;
            f32x4 wv[2][2];
#pragma unroll
            for (int bj = 0; bj < 2; ++bj)
#pragma unroll
                for (int n = 0; n < 2; ++n) wv[bj][n] = (seg < 2) ? *(const f32x4*)(nw + 32 * bj + 16 * n + 4 * fq) : (f32x4){1.f, 1.f, 1.f, 1.f};
#pragma unroll
            for (int ai = 0; ai < 2; ++ai)
#pragma unroll
                for (int m = 0; m < 4; ++m) { const int row = rowb + ai * 128 + m * 16;
                    float rs = 1.f;
                    if (seg < 2) { float ss = 0.f;
#pragma unroll
                        for (int bj = 0; bj < 2; ++bj)
#pragma unroll
                            for (int n = 0; n < 2; ++n) { const f32x4 v = acc[ai][bj][m][n]; ss += v[0] * v[0] + v[1] * v[1] + v[2] * v[2] + v[3] * v[3]; }
                        ss += __shfl_xor(ss, 16); ss += __shfl_xor(ss, 32);
                        rs = rsqrtf(ss * (1.f / 64.f) + EPS); }
                    if (seg == 0) { bf16_t* rp = Q + (size_t)row * 512 + head * 64 + 4 * fq;
#pragma unroll
                        for (int bj = 0; bj < 2; ++bj)
#pragma unroll
                            for (int n = 0; n < 2; ++n) { const f32x4 v = acc[ai][bj][m][n] * rs * wv[bj][n]; u32x2 o; o[0] = pk2(v[0], v[1]); o[1] = pk2(v[2], v[3]); *(u32x2*)(rp + 32 * bj + 16 * n) = o; }
                    } else { float* rp = out + k_off(layer, row) + (seg == 2 ? (row >= NS0 && row < NM0 ? (O_VS - O_KS) : (O_VP - O_KP)) : 0) + head * 64 + 4 * fq;
#pragma unroll
                        for (int bj = 0; bj < 2; ++bj)
#pragma unroll
                            for (int n = 0; n < 2; ++n) { const f32x4 v = acc[ai][bj][m][n] * rs * wv[bj][n]; *(f32x4*)(rp + 32 * bj + 16 * n) = v; } } }
        } else {
            if (wc == 0) {
#pragma unroll
                for (int ai = 0; ai < 2; ++ai)
#pragma unroll
                    for (int m = 0; m < 4; ++m) *(f32x4*)(DT + (size_t)(rowb + ai * 128 + m * 16) * 16 + 4 * fq) = acc[ai][0][m][0];
            }
        }
    }
};
struct EpiGlu {
    bf16_t* OB;
    __device__ __forceinline__ void operator()(const f32x4 (&acc)[2][2][4][2], const Unit& u, int wr, int wc, int fr, int fq) const {
        const int rowb = u.pm * 256 + wr * 64 + fr, colb = u.pn * 128 + wc * 32 + fq * 4;
#pragma unroll
        for (int ai = 0; ai < 2; ++ai)
#pragma unroll
            for (int m = 0; m < 4; ++m) { bf16_t* rp = OB + (size_t)(rowb + ai * 128 + m * 16) * 1024 + colb;
#pragma unroll
                for (int n = 0; n < 2; ++n) { const f32x4 a = acc[ai][0][m][n], g = acc[ai][1][m][n];
                    u32x2 o; o[0] = pk2(a[0] * sigmoidf_(g[0]), a[1] * sigmoidf_(g[1])); o[1] = pk2(a[2] * sigmoidf_(g[2]), a[3] * sigmoidf_(g[3])); *(u32x2*)(rp + n * 16) = o; } }
    }
};
struct EpiMix {
    bf16_t* R; const bf16_t* G; const bf16_t* OB; int accum;
    __device__ __forceinline__ void operator()(const f32x4 (&acc)[2][2][4][2], const Unit& u, int wr, int wc, int fr, int fq) const {
        const int rowb = u.pm * 256 + wr * 64 + fr, colb = u.pn * 256 + wc * 32 + fq * 4;
#pragma unroll
        for (int ai = 0; ai < 2; ++ai)
#pragma unroll
            for (int m = 0; m < 4; ++m) { const int row = rowb + ai * 128 + m * 16;
#pragma unroll
                for (int bj = 0; bj < 2; ++bj)
#pragma unroll
                    for (int n = 0; n < 2; ++n) { const int col = colb + bj * 128 + n * 16; f32x4 v = acc[ai][bj][m][n];
                        const u32x2 gw = *(const u32x2*)(G + (size_t)row * 3072 + col);
                        v = v * (f32x4){lo_f(gw[0]), hi_f(gw[0]), lo_f(gw[1]), hi_f(gw[1])};
                        if (OB) { const u32x2 g1 = *(const u32x2*)(G + (size_t)row * 3072 + 1024 + col), ob = *(const u32x2*)(OB + (size_t)row * 1024 + col);
                            v = v + (f32x4){lo_f(g1[0]), hi_f(g1[0]), lo_f(g1[1]), hi_f(g1[1])} * (f32x4){lo_f(ob[0]), hi_f(ob[0]), lo_f(ob[1]), hi_f(ob[1])}; }
                        bf16_t* rp = R + (size_t)row * 1024 + col;
                        if (accum) { const u32x2 rw = ld_l2_u32x2(rp); v = v + (f32x4){lo_f(rw[0]), hi_f(rw[0]), lo_f(rw[1]), hi_f(rw[1])}; }
                        u32x2 o; o[0] = pk2(v[0], v[1]); o[1] = pk2(v[2], v[3]); *(u32x2*)rp = o; } }
    }
};
struct EpiRes {
    float* out; float* xmeta;
    __device__ __forceinline__ void operator()(const f32x4 (&acc)[2][2][4][2], const Unit& u, int wr, int wc, int fr, int fq) const {
        const int rowb = u.pm * 256 + wr * 64 + fr, colb = u.pn * 256 + wc * 32 + fq * 4;
        float* base = (u.pm * 256 < NM0) ? out : xmeta - (size_t)NM0 * 1024;
#pragma unroll
        for (int ai = 0; ai < 2; ++ai)
#pragma unroll
            for (int m = 0; m < 4; ++m) { float* rp = base + (size_t)(rowb + ai * 128 + m * 16) * 1024 + colb;
#pragma unroll
                for (int bj = 0; bj < 2; ++bj)
#pragma unroll
                    for (int n = 0; n < 2; ++n) { f32x4* q = (f32x4*)(rp + bj * 128 + n * 16); *q = *q + acc[ai][bj][m][n]; } }
    }
};
struct EpiUp {
    bf16_t* ACT;
    __device__ __forceinline__ void operator()(const f32x4 (&acc)[2][2][4][2], const Unit& u, int wr, int wc, int fr, int fq) const {
        const int rowb = u.pm * 256 + wr * 64 + fr, colb = u.pn * 256 + wc * 32 + fq * 4;
#pragma unroll
        for (int ai = 0; ai < 2; ++ai)
#pragma unroll
            for (int m = 0; m < 4; ++m) { bf16_t* rp = ACT + (size_t)(rowb + ai * 128 + m * 16) * 4096 + colb;
#pragma unroll
                for (int bj = 0; bj < 2; ++bj)
#pragma unroll
                    for (int n = 0; n < 2; ++n) { f32x4 v = acc[ai][bj][m][n];
#pragma unroll
                        for (int j = 0; j < 4; ++j) { const float r = fmaxf(v[j], 0.f); v[j] = r * r; }
                        u32x2 o; o[0] = pk2(v[0], v[1]); o[1] = pk2(v[2], v[3]); *(u32x2*)(rp + bj * 128 + n * 16) = o; } }
    }
};

__device__ __forceinline__ int col_in(int n) {
    if (n < 2304) return n;
    if (n < 2816) return n + 16;
    if (n < 4352) { const int w0 = n - 2816, seg = w0 >> 9, w = w0 & 511, tile = w >> 8, ct = w & 255, bj = ct >> 7, wc = (ct >> 5) & 3, ww = ct & 31;
        return 2832 + seg * 512 + (tile * 4 + wc) * 64 + 32 * bj + ww; }
    if (n < 7424) return n + 16;
    if (n < 7440) return 2304 + (n - 7424);
    return -1;
}
template <int MAP>
__device__ __forceinline__ void prep_w(bf16_t* dst, const float* src, int K, int N, int ld, const float* scale, size_t gtid, size_t gsz) {
    const size_t items = (size_t)(K / 8) * N;
    for (size_t it = gtid; it < items; it += gsz) {
        const int n = (int)(it % N), k8 = (int)(it / N);
        const int c = MAP == 1 ? col_in(n) : (MAP == 2 ? (((n >> 7) & 1) * 1024 + (n >> 8) * 128 + (n & 127)) : n);
        float v[8];
#pragma unroll
        for (int kk = 0; kk < 8; ++kk) { const int k = k8 * 8 + kk; float x = (c >= 0) ? src[(size_t)k * ld + c] : 0.f; if (scale) x *= scale[k]; v[kk] = x; }
        u32x4 o; o[0] = pk2(v[0], v[1]); o[1] = pk2(v[2], v[3]); o[2] = pk2(v[4], v[5]); o[3] = pk2(v[6], v[7]);
        *(u32x4*)(dst + (size_t)n * K + k8 * 8) = o;
    }
}
__device__ __forceinline__ void rmsnorm_rows(CPar p, const float* g, int from_inputs) {
    const int lane = ltid() & 63, gw = lbid() * 8 + (ltid() >> 6), ngw = lgdim() * 8;
    bf16_t* HB = (bf16_t*)(p->ws + WS_HB);
    f32x4 gv[4];
#pragma unroll
    for (int j = 0; j < 4; ++j) gv[j] = *(const f32x4*)(g + lane * 4 + 256 * j);
    for (int r = gw; r < NROWS; r += ngw) {
        float* xl = xloc(p, r);
        const float* src = xl;
        if (from_inputs) src = r < NS0 ? p->in[I_XP] + (size_t)r * 1024 : (r < NM0 ? p->in[I_XS] + (size_t)(r - NS0) * 1024 : p->in[I_META] + (size_t)((r - NM0) & 15) * 1024);
        f32x4 v[4]; float s = 0.f;
#pragma unroll
        for (int j = 0; j < 4; ++j) { v[j] = *(const f32x4*)(src + lane * 4 + 256 * j); s += (v[j][0] * v[j][0] + v[j][1] * v[j][1]) + (v[j][2] * v[j][2] + v[j][3] * v[j][3]); }
        const float rstd = rsqrtf(wave_sum(s) * (1.f / 1024.f) + EPS);
#pragma unroll
        for (int j = 0; j < 4; ++j) { if (from_inputs) *(f32x4*)(xl + lane * 4 + 256 * j) = v[j];
            const f32x4 h = v[j] * rstd * gv[j]; u32x2 o; o[0] = pk2(h[0], h[1]); o[1] = pk2(h[2], h[3]); *(u32x2*)(HB + (size_t)r * 1024 + lane * 4 + 256 * j) = o; }
    }
}
__device__ __forceinline__ void ssd_norm_rows(CPar p) {
    const int lane = ltid() & 63, gw = lbid() * 8 + (ltid() >> 6), ngw = lgdim() * 8;
    bf16_t* Z = (bf16_t*)(p->ws + WS_Z);
    for (int r = gw; r < NROWS; r += ngw) {
#pragma unroll
        for (int j = 0; j < 2; ++j) { u32x4* zp = (u32x4*)(Z + (size_t)r * 1024 + j * 512 + lane * 8); const u32x4 w = *zp;
            float f[8] = {lo_f(w[0]), hi_f(w[0]), lo_f(w[1]), hi_f(w[1]), lo_f(w[2]), hi_f(w[2]), lo_f(w[3]), hi_f(w[3])};
            float ss = 0.f;
#pragma unroll
            for (int i = 0; i < 8; ++i) ss += f[i] * f[i];
            const float rs = rsqrtf(wave_sum(ss) * (1.f / 512.f) + EPS);
            u32x4 o; o[0] = pk2(f[0] * rs, f[1] * rs); o[1] = pk2(f[2] * rs, f[3] * rs); o[2] = pk2(f[4] * rs, f[5] * rs); o[3] = pk2(f[6] * rs, f[7] * rs); *zp = o; }
    }
}
__device__ __forceinline__ void phase_prep(CPar p, int l) {
    const size_t gtid = (size_t)lbid() * 512 + ltid(), gsz = (size_t)lgdim() * 512;
    unsigned char* ws = p->ws;
    prep_w<1>((bf16_t*)(ws + W_BT1), p->in[I_WIN] + (size_t)l * 1024 * IN_COLS, 1024, N1, IN_COLS, nullptr, gtid, gsz);
    prep_w<2>((bf16_t*)(ws + W_GLU), p->in[I_WGLU] + (size_t)l * 512 * 2048, 512, 2048, 2048, nullptr, gtid, gsz);
    prep_w<0>((bf16_t*)(ws + W_LA), p->in[I_WLA] + (size_t)l * 1024 * 1024, 1024, 1024, 1024, p->in[I_NSSD] + l * 1024, gtid, gsz);
    prep_w<0>((bf16_t*)(ws + W_LC), p->in[I_WLC] + (size_t)l * 512 * 1024, 512, 1024, 1024, nullptr, gtid, gsz);
    prep_w<0>((bf16_t*)(ws + W_OUT), p->in[I_WOUT] + (size_t)l * 1024 * 1024, 1024, 1024, 1024, nullptr, gtid, gsz);
    prep_w<0>((bf16_t*)(ws + W_UP), p->in[I_WUP] + (size_t)l * 1024 * 4096, 1024, 4096, 4096, nullptr, gtid, gsz);
    prep_w<0>((bf16_t*)(ws + W_DOWN), p->in[I_WDOWN] + (size_t)l * 4096 * 1024, 4096, 1024, 1024, nullptr, gtid, gsz);
    if (lbid() == 0 && ltid() < 16) ((unsigned*)(ws + WS_CTR))[ltid()] = 0u;
    rmsnorm_rows(p, p->in[I_NMIX] + l * 1024, l == 0);
}

__device__ __forceinline__ bf16_t f2bf_(float v) { return (bf16_t)(pk2(v, v) & 0xffffu); }
__device__ __forceinline__ void ssd_item(CPar p, int l, int item, float* sm) {
    const int tid = ltid(), lane = tid & 63, wave = __builtin_amdgcn_readfirstlane(tid >> 6), rb = wave >> 1, chh = wave & 1, fr = lane & 15, fq = lane >> 4;
    const int s = item < 512 ? (item >> 4) : 32 + ((item - 512) >> 4), h = item & 15, g = h >> 3;
    const bool prompt = s < 32; const int b = prompt ? s : s - 32, T = prompt ? TP : TS;
    constexpr int LB = 72;
    bf16_t *Cb = (bf16_t*)sm, *Bb = Cb + 64 * LB, *XT = Bb + 64 * LB, *WB = XT + 64 * LB, *Mb = WB + 64 * LB, *Sb = Mb + 64 * LB;
    float *sRaw = (float*)(Sb + 64 * LB), *sW = sRaw + 67 * 192, *sdtA = sW + 5 * 192, *sacA = sdtA + 33 * 64, *sw = sacA + 33 * 64;
    const bf16_t* XBC = (const bf16_t*)(p->ws + WS_XBC); bf16_t* Z = (bf16_t*)(p->ws + WS_Z);
    const float* DT = (const float*)(p->ws + WS_DT);
    const float* cw = p->in[I_CONVW] + (size_t)l * 4 * 1280; const float* cb = p->in[I_CONVB] + (size_t)l * 1280;
    const float* hist = p->in[I_SCONV] + (size_t)(l * 16 + b) * 3 * 1280;
    const float dtb = p->in[I_DTB][l * 16 + h], aneg = -__expf(p->in[I_ALOG][l * 16 + h]), dsk = p->in[I_DSSD][l * 16 + h];
    float* sout = prompt ? p->out + O_SSDP + ((size_t)(l * 32 + b) * 16 + h) * 4096 : p->out + O_SSDS + ((size_t)(l * 16 + b) * 16 + h) * 4096;
    for (int i = tid; i < 5 * 192; i += 512) { const int k = i / 192, ch = i - k * 192; const int col = ch < 64 ? h * 64 + ch : (ch < 128 ? 1024 + g * 64 + (ch - 64) : 1152 + g * 64 + (ch - 128));
        sW[i] = k < 4 ? cw[k * 1280 + col] : cb[col]; }
    f32x4 accS[2];
#pragma unroll
    for (int c2 = 0; c2 < 2; ++c2)
#pragma unroll
        for (int r = 0; r < 4; ++r) { const int pp = rb * 16 + fq * 4 + r, n = chh * 32 + c2 * 16 + fr;
            const float v = prompt ? 0.f : p->in[I_SSSD][((size_t)(l * 16 + b) * 16 + h) * 4096 + pp * 64 + n]; accS[c2][r] = v; Sb[pp * LB + n] = f2bf_(v); }
    const int nch = (T + 63) >> 6;
    { const int wv = tid >> 6, ln = tid & 63; float xv[5];
#pragma unroll
        for (int r = 0; r < 5; ++r) { const int c = wv + 8 * r, t = c * 64 + ln; xv[r] = (c < nch && t < T) ? DT[(size_t)row_of(s, t) * 16 + h] + dtb : -1e30f; }
#pragma unroll
        for (int r = 0; r < 5; ++r) { const int c = wv + 8 * r;
            if (c < nch) { const float x = xv[r]; const float dtv = x < -1e29f ? 0.f : (x > 20.f ? x : log1pf(__expf(x))); float cs = dtv * aneg;
#pragma unroll
                for (int o = 1; o < 64; o <<= 1) { const float nb = __shfl_up(cs, o); if (ln >= o) cs += nb; }
                sdtA[c * 64 + ln] = dtv; sacA[c * 64 + ln] = cs; } } }
    u32x4 pf[4];
#define SSD_ISSUE(cc) do { _Pragma("unroll") for (int it4 = 0; it4 < 4; ++it4) { const int pi = tid + it4 * 512; pf[it4] = (u32x4){0u, 0u, 0u, 0u}; \
        if (pi < 67 * 24) { const int rl = pi / 24, pc = pi - rl * 24, seg = pc >> 3, q8 = pc & 7, tt = (cc) * 64 - 3 + rl; \
            const int col = (seg == 0 ? h * 64 : (seg == 1 ? 1024 + g * 64 : 1152 + g * 64)) + q8 * 8; \
            if (tt >= 0 && tt < T) pf[it4] = *(const u32x4*)(XBC + (size_t)row_of(s, tt) * 1280 + col); } } } while (0)
#define SSD_FRAG(P, r0, ks) (*(const bf16x8*)((P) + ((r0) + fr) * LB + (ks) * 32 + fq * 8))
    SSD_ISSUE(0);
#pragma unroll 1
    for (int c = 0; c < nch; ++c) {
        const int t0 = c * 64; const float* sdt = sdtA + t0; const float* sac = sacA + t0;
        __syncthreads();
#pragma unroll
        for (int it4 = 0; it4 < 4; ++it4) { const int pi = tid + it4 * 512;
            if (pi < 67 * 24) { const int rl = pi / 24, pc = pi - rl * 24, seg = pc >> 3, q8 = pc & 7, tt = t0 - 3 + rl;
                const u32x4 w = pf[it4];
                f32x4 f0 = {lo_f(w[0]), hi_f(w[0]), lo_f(w[1]), hi_f(w[1])}, f1 = {lo_f(w[2]), hi_f(w[2]), lo_f(w[3]), hi_f(w[3])};
                if (tt < 0 && !prompt) { const int col = (seg == 0 ? h * 64 : (seg == 1 ? 1024 + g * 64 : 1152 + g * 64)) + q8 * 8; const float* hp = hist + (3 + tt) * 1280 + col; f0 = *(const f32x4*)hp; f1 = *(const f32x4*)(hp + 4); }
                float* dp = sRaw + rl * 192 + seg * 64 + q8 * 8; *(f32x4*)dp = f0; *(f32x4*)(dp + 4) = f1; } }
        if (tid < 64) sw[tid] = __expf(sac[63] - sac[tid]) * sdt[tid];
        if (c + 1 < nch) SSD_ISSUE(c + 1);
        __syncthreads();
#pragma unroll 4
        for (int idx = tid; idx < 64 * 192; idx += 512) {
            const int tl = idx / 192, ch = idx - tl * 192, t = t0 + tl;
            float v = 0.f;
            if (t < T) { v = sW[4 * 192 + ch];
#pragma unroll
                for (int k = 0; k < 4; ++k) v += sRaw[(tl + k) * 192 + ch] * sW[k * 192 + ch];
                v = siluf_(v); }
            const int cc = ch & 63;
            if (ch < 64) XT[cc * LB + tl] = f2bf_(v);
            else if (ch < 128) { Bb[tl * LB + cc] = f2bf_(v); WB[cc * LB + tl] = f2bf_(v * sw[tl]); }
            else Cb[tl * LB + cc] = f2bf_(v);
        }
        __syncthreads();
        f32x4 acc2[2];
        { const bf16x8 aC0 = SSD_FRAG(Cb, rb * 16, 0), aC1 = SSD_FRAG(Cb, rb * 16, 1);
#pragma unroll
            for (int c2 = 0; c2 < 2; ++c2) { const int j0 = chh * 32 + c2 * 16;
                f32x4 m = {0.f, 0.f, 0.f, 0.f};
                if (j0 <= rb * 16 + 15) { m = __builtin_amdgcn_mfma_f32_16x16x32_bf16(aC0, SSD_FRAG(Bb, j0, 0), m, 0, 0, 0); m = __builtin_amdgcn_mfma_f32_16x16x32_bf16(aC1, SSD_FRAG(Bb, j0, 1), m, 0, 0, 0); }
                const int j = j0 + fr; const float acj = sac[j], dtj = sdt[j];
#pragma unroll
                for (int r = 0; r < 4; ++r) { const int tl = rb * 16 + fq * 4 + r; Mb[tl * LB + j] = f2bf_(j <= tl ? m[r] * __expf(sac[tl] - acj) * dtj : 0.f); }
                f32x4 y = {0.f, 0.f, 0.f, 0.f};
                y = __builtin_amdgcn_mfma_f32_16x16x32_bf16(aC0, SSD_FRAG(Sb, j0, 0), y, 0, 0, 0); y = __builtin_amdgcn_mfma_f32_16x16x32_bf16(aC1, SSD_FRAG(Sb, j0, 1), y, 0, 0, 0);
#pragma unroll
                for (int r = 0; r < 4; ++r) y[r] *= __expf(sac[rb * 16 + fq * 4 + r]);
                acc2[c2] = y; }
            const bf16x8 aX0 = SSD_FRAG(XT, rb * 16, 0), aX1 = SSD_FRAG(XT, rb * 16, 1); const float eL = __expf(sac[63]);
#pragma unroll
            for (int c2 = 0; c2 < 2; ++c2) { const int n0 = chh * 32 + c2 * 16; f32x4 sv = accS[c2] * eL;
                sv = __builtin_amdgcn_mfma_f32_16x16x32_bf16(aX0, SSD_FRAG(WB, n0, 0), sv, 0, 0, 0); sv = __builtin_amdgcn_mfma_f32_16x16x32_bf16(aX1, SSD_FRAG(WB, n0, 1), sv, 0, 0, 0); accS[c2] = sv; } }
        __syncthreads();
        { const bf16x8 aM0 = SSD_FRAG(Mb, rb * 16, 0), aM1 = SSD_FRAG(Mb, rb * 16, 1);
#pragma unroll
            for (int c2 = 0; c2 < 2; ++c2) { const int p0 = chh * 32 + c2 * 16, pp = p0 + fr; f32x4 y = acc2[c2];
                y = __builtin_amdgcn_mfma_f32_16x16x32_bf16(aM0, SSD_FRAG(XT, p0, 0), y, 0, 0, 0); y = __builtin_amdgcn_mfma_f32_16x16x32_bf16(aM1, SSD_FRAG(XT, p0, 1), y, 0, 0, 0);
#pragma unroll
                for (int r = 0; r < 4; ++r) { const int tl = rb * 16 + fq * 4 + r, t = t0 + tl;
                    if (t < T) { bf16_t* zp = Z + (size_t)row_of(s, t) * 1024 + h * 64 + pp; const float yy = (y[r] + dsk * bf2f(XT[pp * LB + tl])) * siluf_(bf2f(*zp)); *zp = f2bf_(yy); } } }
#pragma unroll
            for (int c2 = 0; c2 < 2; ++c2)
#pragma unroll
                for (int r = 0; r < 4; ++r) Sb[(rb * 16 + fq * 4 + r) * LB + chh * 32 + c2 * 16 + fr] = f2bf_(accS[c2][r]); }
    }
    __syncthreads();
#pragma unroll
    for (int c2 = 0; c2 < 2; ++c2)
#pragma unroll
        for (int r = 0; r < 4; ++r) sout[(rb * 16 + fq * 4 + r) * 64 + chh * 32 + c2 * 16 + fr] = accS[c2][r];
    float* cout_ = prompt ? p->out + O_CONVP + (size_t)(l * 32 + b) * 3 * 1280 : p->out + O_CONVS + (size_t)(l * 16 + b) * 3 * 1280;
    for (int idx = tid; idx < 3 * 192; idx += 512) { const int k = idx / 192, ch = idx - k * 192;
        if (ch >= 64 && (h & 7) != 0) continue;
        const int col = ch < 64 ? h * 64 + ch : (ch < 128 ? 1024 + g * 64 + (ch - 64) : 1152 + g * 64 + (ch - 128));
        cout_[k * 1280 + col] = bf2f(XBC[(size_t)row_of(s, T - 3 + k) * 1280 + col]); }
    __syncthreads();
#undef SSD_ISSUE
#undef SSD_FRAG
}

__device__ __forceinline__ void s5_item(CPar p, int l, int s, int g, float* wl) {
    const int lane = ltid() & 63, fr = lane & 15, fq = lane >> 4;
    const bool prompt = s < 32; const int b = prompt ? s : s - 32, T = prompt ? TP : TS, nblk = T >> 4;
    constexpr int LBX = 136;
    bf16_t* Xb = (bf16_t*)wl;
    bf16_t* U = (bf16_t*)(p->ws + WS_U);
    const int gp = (l * 32 + g) * 64 + lane;
    const float lr = p->in[I_LRE][gp], li = p->in[I_LIM][gp], step = expf(p->in[I_LSTEP][l * 32 + g]);
    float sn, cs; sincos_red((double)li * (double)step, sn, cs);
    const float mag = expf(lr * step), ab_re = mag * cs, ab_im = mag * sn;
    const float den = lr * lr + li * li, nr = ab_re - 1.f, f_re = (nr * lr + ab_im * li) / den, f_im = (ab_im * lr - nr * li) / den;
    float bbr[16], bbi[16];
#pragma unroll
    for (int hh = 0; hh < 16; ++hh) { const float br = p->in[I_BRE][(size_t)gp * 16 + hh], bi = p->in[I_BIM][(size_t)gp * 16 + hh]; bbr[hh] = f_re * br - f_im * bi; bbi[hh] = f_re * bi + f_im * br; }
    bf16x8 cfrag[4];
#pragma unroll
    for (int ks = 0; ks < 4; ++ks) { const int k0 = ks * 32 + fq * 8; const bool im = k0 >= 64;
        const float* cp = (im ? p->in[I_CIM] : p->in[I_CRE]) + ((size_t)(l * 32 + g) * 16 + fr) * 64 + (k0 & 63);
        const f32x4 c0 = *(const f32x4*)cp, c1 = *(const f32x4*)(cp + 4); const float sg = im ? -1.f : 1.f;
        u32x4 w; w[0] = pk2(sg * c0[0], sg * c0[1]); w[1] = pk2(sg * c0[2], sg * c0[3]); w[2] = pk2(sg * c1[0], sg * c1[1]); w[3] = pk2(sg * c1[2], sg * c1[3]);
        cfrag[ks] = __builtin_bit_cast(bf16x8, w); }
    float xr = prompt ? 0.f : p->in[I_S5R][(size_t)(l * 16 + b) * 2048 + g * 64 + lane], xi = prompt ? 0.f : p->in[I_S5I][(size_t)(l * 16 + b) * 2048 + g * 64 + lane];
    const float dsk = p->in[I_DS5][(size_t)(l * 32 + g) * 16 + fr];
    u32x4 ua = {0, 0, 0, 0}, ub = {0, 0, 0, 0};
    { const int r0 = row_of(s, 0); if (lane < 16) { const u32x4* up = (const u32x4*)(U + (size_t)(r0 + lane) * 512 + g * 16); ua = up[0]; ub = up[1]; } }
    for (int blk = 0; blk < nblk; ++blk) {
        const int r0 = row_of(s, blk * 16);
        const u32x4 ca = ua, cbv = ub;
        if (blk + 1 < nblk && lane < 16) { const int r1 = row_of(s, blk * 16 + 16); const u32x4* up = (const u32x4*)(U + (size_t)(r1 + lane) * 512 + g * 16); ua = up[0]; ub = up[1]; }
#pragma unroll
        for (int i = 0; i < 16; ++i) {
            float bur = 0.f, bui = 0.f;
#pragma unroll
            for (int w = 0; w < 8; ++w) { const unsigned word = (unsigned)__builtin_amdgcn_readlane((int)(w < 4 ? ca[w] : cbv[w - 4]), i);
                const float u0 = lo_f(word), u1 = hi_f(word);
                bur += bbr[2 * w] * u0 + bbr[2 * w + 1] * u1; bui += bbi[2 * w] * u0 + bbi[2 * w + 1] * u1; }
            const float nxr = ab_re * xr - ab_im * xi + bur, nxi = ab_re * xi + ab_im * xr + bui; xr = nxr; xi = nxi;
            Xb[i * LBX + lane] = f2bf_(xr); Xb[i * LBX + 64 + lane] = f2bf_(xi);
        }
        __builtin_amdgcn_wave_barrier(); asm volatile("s_waitcnt lgkmcnt(0)" ::: "memory");
        f32x4 y = {0.f, 0.f, 0.f, 0.f};
#pragma unroll
        for (int ks = 0; ks < 4; ++ks) y = __builtin_amdgcn_mfma_f32_16x16x32_bf16(*(const bf16x8*)(Xb + fr * LBX + ks * 32 + fq * 8), cfrag[ks], y, 0, 0, 0);
#pragma unroll
        for (int r = 0; r < 4; ++r) { bf16_t* up = U + (size_t)(r0 + fq * 4 + r) * 512 + g * 16 + fr; *up = f2bf_(geluf_(y[r] + dsk * bf2f(*up))); }
        __builtin_amdgcn_wave_barrier(); asm volatile("s_waitcnt lgkmcnt(0)" ::: "memory");
    }
    float* ore = prompt ? p->out + O_S5RP + (size_t)(l * 32 + b) * 2048 : p->out + O_S5RS + (size_t)(l * 16 + b) * 2048;
    float* oim = prompt ? p->out + O_S5IP + (size_t)(l * 32 + b) * 2048 : p->out + O_S5IS + (size_t)(l * 16 + b) * 2048;
    ore[g * 64 + lane] = xr; oim[g * 64 + lane] = xi;
}

__device__ __forceinline__ void attn_item(CPar p, int l, int item, float* wl) {
    const int lane = ltid() & 63;
    int s, h, qt;
    if (item < 8448) { s = item / 264; const int rem = item - s * 264; h = rem / 33; qt = rem - h * 33; } else { const int it = item - 8448; s = 32 + (it >> 3); h = it & 7; qt = 0; }
    const bool prompt = s < 32; const int b = prompt ? s : s - 32, T = prompt ? TP : TS, nh = prompt ? 0 : PAST;
    const int i = qt * 64 + lane; const bool active = i < T; const int row = row_of(s, active ? i : T - 1);
    bf16_t* Q = (bf16_t*)(p->ws + WS_Q);
    float* Kt = wl; float* Vt = wl + 32 * 64;
    float q[64], o[64];
    { const u32x4* qp = (const u32x4*)(Q + (size_t)row * 512 + h * 64);
#pragma unroll
        for (int e = 0; e < 8; ++e) { const u32x4 w = qp[e];
#pragma unroll
            for (int j = 0; j < 4; ++j) { q[e * 8 + 2 * j] = lo_f(w[j]) * 0.125f; q[e * 8 + 2 * j + 1] = hi_f(w[j]) * 0.125f; } } }
#pragma unroll
    for (int d = 0; d < 64; ++d) o[d] = 0.f;
    const float* kp_new = prompt ? p->out + O_KP + (size_t)(l * 32 + b) * 2064 * 512 + h * 64 : p->out + O_KS + (size_t)(l * 16 + b) * 64 * 512 + h * 64;
    const float* vp_new = prompt ? p->out + O_VP + (size_t)(l * 32 + b) * 2064 * 512 + h * 64 : p->out + O_VS + (size_t)(l * 16 + b) * 64 * 512 + h * 64;
    const float* kp_old = p->in[I_CK] + (size_t)(l * 16 + b) * 2048 * 512 + h * 64;
    const float* vp_old = p->in[I_CV] + (size_t)(l * 16 + b) * 2048 * 512 + h * 64;
    const int imax = (qt * 64 + 63 < T - 1) ? qt * 64 + 63 : T - 1;
    const int jtop = nh + imax - 1;
    float run = 0.f;
    for (int jt = jtop; jt >= 0; jt -= 32) {
#pragma unroll 4
        for (int e = 0; e < 8; ++e) { const int idx = e * 64 + lane, kr = idx >> 4, pc = idx & 15, j = jt - kr;
            if (j >= 0) { const float* kp = (j < nh) ? kp_old + (size_t)j * 512 : kp_new + (size_t)(j - nh) * 512; *(f32x4*)(Kt + kr * 64 + pc * 4) = *(const f32x4*)(kp + pc * 4); } }
#pragma unroll 4
        for (int e = 0; e < 8; ++e) { const int idx = e * 64 + lane, kr = idx >> 4, pc = idx & 15, j = jt - kr;
            if (j >= 0) { const float* vp = (j < nh) ? vp_old + (size_t)j * 512 : vp_new + (size_t)(j - nh) * 512; *(f32x4*)(Vt + kr * 64 + pc * 4) = *(const f32x4*)(vp + pc * 4); } }
        __builtin_amdgcn_wave_barrier(); asm volatile("s_waitcnt vmcnt(0) lgkmcnt(0)" ::: "memory");
        const int nk = jt + 1 < 32 ? jt + 1 : 32;
        for (int kk = 0; kk < nk; ++kk) { const int j = jt - kk;
            float z = 0.f;
#pragma unroll
            for (int d = 0; d < 64; d += 4) { const f32x4 kv = *(const f32x4*)(Kt + kk * 64 + d); z += q[d] * kv[0] + q[d + 1] * kv[1] + q[d + 2] * kv[2] + q[d + 3] * kv[3]; }
            const bool valid = active && (j < nh + i);
            const float e = __expf(-z), ls = -__logf(1.f + e);
            const float w = valid ? __expf(ls + run) : 0.f;
            run += valid ? (ls - z) : 0.f;
#pragma unroll
            for (int d = 0; d < 64; d += 4) { const f32x4 vv = *(const f32x4*)(Vt + kk * 64 + d); o[d] += w * vv[0]; o[d + 1] += w * vv[1]; o[d + 2] += w * vv[2]; o[d + 3] += w * vv[3]; } }
        __builtin_amdgcn_wave_barrier(); asm volatile("s_waitcnt lgkmcnt(0)" ::: "memory");
        const int fin = (!active) || (run < -50.f);
        if (__all(fin)) break;
    }
    if (active) { u32x4* op = (u32x4*)(Q + (size_t)row * 512 + h * 64);
#pragma unroll
        for (int e = 0; e < 8; ++e) { u32x4 w; w[0] = pk2(o[e * 8], o[e * 8 + 1]); w[1] = pk2(o[e * 8 + 2], o[e * 8 + 3]); w[2] = pk2(o[e * 8 + 4], o[e * 8 + 5]); w[3] = pk2(o[e * 8 + 6], o[e * 8 + 7]); op[e] = w; } }
}

__device__ __forceinline__ void phase_mixers(CPar p, int l, float* sm) {
#ifndef SKIP_SSD
    { CPar p1 = params_ptr();
#pragma unroll 1
      for (int it = lbid(); it < 768; it += lgdim()) ssd_item(p1, l, it, sm); }
#endif
    __syncthreads();
    const int wave = __builtin_amdgcn_readfirstlane(ltid() >> 6);
    float* wl = sm + wave * (68 * 64);
#ifndef SKIP_S5
    { CPar p2 = params_ptr();
    if (wave < 4) { for (int it = lbid() * 4 + wave; it < 1024; it += lgdim() * 4) s5_item(p2, l, it >> 5, it & 31, wl); }
    else if (wave < 6) { for (int it = lbid() * 2 + (wave - 4); it < 512; it += lgdim() * 2) s5_item(p2, l, 32 + (it >> 5), it & 31, wl); } }
#endif
#ifndef SKIP_ATT
    CPar p3 = params_ptr();
    unsigned* ctr = (unsigned*)(p3->ws + WS_CTR) + l;
    for (;;) {
        unsigned it = 0; if ((ltid() & 63) == 0) it = atomicAdd(ctr, 1u);
        it = (unsigned)__builtin_amdgcn_readfirstlane((int)it);
        if (it >= 8576u) break;
        attn_item(p3, l, (int)it, wl);
    }
#endif
}

__global__ __launch_bounds__(512, 2) void mega(Params pk) {
    extern __shared__ __attribute__((aligned(16))) unsigned char smem[];
    cg::grid_group grid = cg::this_grid();
    LAS unsigned char* lds = (LAS unsigned char*)smem;
    const int ph_lo = pk.ph_lo, ph_hi = pk.ph_hi;
    for (int ph = ph_lo; ph < ph_hi; ++ph) {
        if (ph > ph_lo) grid.sync();
        CPar p = params_ptr();
        unsigned char* ws = p->ws;
        bf16_t *HB = (bf16_t*)(ws + WS_HB), *Z = (bf16_t*)(ws + WS_Z), *XBC = (bf16_t*)(ws + WS_XBC), *U = (bf16_t*)(ws + WS_U), *Q = (bf16_t*)(ws + WS_Q), *G = (bf16_t*)(ws + WS_G);
        float *DT = (float*)(ws + WS_DT), *XM = (float*)(ws + WS_XMETA);
        const int l = ph / 9, sub = ph - l * 9;
        pg8::StaticOrder S;
        if (sub == 0) {
#ifndef SKIP0
            phase_prep(p, l);
#endif
        } else if (sub == 1) {
            S.init(NROWS, N1, lgdim(), lbid());
            EpiIn E{Z, XBC, U, Q, G, DT, p->out, p->in[I_QN] + l * 64, p->in[I_KN] + l * 64, l};
#ifndef SKIP1
            pg8::gemm_phase(lds, pg8::Gemm{HB, (const bf16_t*)(ws + W_BT1), NROWS, N1, 1024, 1024, 1024}, S, E);
#endif
        } else if (sub == 2) {
#ifndef SKIP2
            phase_mixers(p, l, (float*)smem);
#endif
        } else if (sub == 3) {
            ssd_norm_rows(p);
            S.init(NROWS, 2048, lgdim(), lbid());
            EpiGlu E{XBC};
            pg8::gemm_phase(lds, pg8::Gemm{U, (const bf16_t*)(ws + W_GLU), NROWS, 2048, 512, 512, 512}, S, E);
        } else if (sub == 4) {
            S.init(NROWS, 1024, lgdim(), lbid());
            for (int call = 0; call < 2; ++call) {
                EpiMix E; pg8::Gemm g;
                if (call == 0) { E = EpiMix{HB, G, XBC, 0}; g = pg8::Gemm{Z, (const bf16_t*)(ws + W_LA), NROWS, 1024, 1024, 1024, 1024}; }
                else { E = EpiMix{HB, G + 2048, nullptr, 1}; g = pg8::Gemm{Q, (const bf16_t*)(ws + W_LC), NROWS, 1024, 512, 512, 512}; }
#ifndef SKIP3
                pg8::gemm_phase(lds, g, S, E);
#endif
            }
        } else if (sub == 5) {
            S.init(NROWS, 1024, lgdim(), lbid());
            EpiRes E{p->out, XM};
#ifndef SKIP4
            pg8::gemm_phase(lds, pg8::Gemm{HB, (const bf16_t*)(ws + W_OUT), NROWS, 1024, 1024, 1024, 1024}, S, E);
#endif
        } else if (sub == 6) {
            rmsnorm_rows(p, p->in[I_NFFN] + l * 1024, 0);
        } else if (sub == 7) {
            S.init(NROWS, 4096, lgdim(), lbid());
            EpiUp E{(bf16_t*)(ws + WS_ACT)};
#ifndef SKIP6
            pg8::gemm_phase(lds, pg8::Gemm{HB, (const bf16_t*)(ws + W_UP), NROWS, 4096, 1024, 1024, 1024}, S, E);
#endif
        } else {
            S.init(NROWS, 1024, lgdim(), lbid());
            EpiRes E{p->out, XM};
#ifndef SKIP7
            pg8::gemm_phase(lds, pg8::Gemm{(const bf16_t*)(ws + WS_ACT), (const bf16_t*)(ws + W_DOWN), NROWS, 1024, 4096, 4096, 4096}, S, E);
#endif
        }
    }
}

extern "C" void kernel_launch(void* const* d_in, const int* in_sizes, int n_in, void* d_out, int out_size, void* d_ws, size_t ws_size, hipStream_t stream) {
    static int grid = 0;
    if (grid == 0) {
        if (n_in != 34 || (size_t)out_size != O_END || ws_size < WS_END) { fprintf(stderr, "kernel_launch: unexpected shapes n_in %d out %d ws %zu (need %zu)\n", n_in, out_size, ws_size, (size_t)WS_END); grid = -1; return; }
        int dev = 0, cus = 0, per_cu = 0;
        hipGetDevice(&dev); hipDeviceGetAttribute(&cus, hipDeviceAttributeMultiprocessorCount, dev);
        if (hipFuncSetAttribute((const void*)mega, hipFuncAttributeMaxDynamicSharedMemorySize, LDS_BYTES) != hipSuccess) { fprintf(stderr, "kernel_launch: hipFuncSetAttribute failed\n"); grid = -1; return; }
        if (hipOccupancyMaxActiveBlocksPerMultiprocessor(&per_cu, (const void*)mega, 512, LDS_BYTES) != hipSuccess || per_cu < 1) { fprintf(stderr, "kernel_launch: occupancy query says %d\n", per_cu); per_cu = 1; }
        (void)hipGetLastError();
        grid = cus * per_cu;
    }
    if (grid < 0) return;
    Params p{};
    for (int i = 0; i < 34; ++i) p.in[i] = (const float*)d_in[i];
    p.out = (float*)d_out; p.ws = (unsigned char*)d_ws;
#if MULTI_LAUNCH
    for (int ph = 0; ph < 18; ++ph) { p.ph_lo = ph; p.ph_hi = ph + 1; hipLaunchKernelGGL(mega, dim3(grid), dim3(512), LDS_BYTES, stream, p); }
#else
    p.ph_lo = 0; p.ph_hi = 18;
    void* args[] = {&p};
    hipError_t e = hipLaunchCooperativeKernel((const void*)mega, dim3(grid), dim3(512), args, LDS_BYTES, stream);
    if (e != hipSuccess) fprintf(stderr, "cooperative launch failed: %s (grid %d)\n", hipGetErrorString(e), grid);
#endif
}
```

```cpp
#include <hip/hip_runtime.h>
#include <hip/hip_cooperative_groups.h>
#include <cstdio>
#include <cstdint>
namespace cg = cooperative_groups;

#ifndef MULTI_LAUNCH
#define MULTI_LAUNCH 0
#endif

typedef unsigned short bf16_t;
typedef short bf16x8 __attribute__((ext_vector_type(8)));
typedef float f32x4 __attribute__((ext_vector_type(4)));
typedef unsigned u32x4 __attribute__((ext_vector_type(4)));
typedef unsigned u32x2 __attribute__((ext_vector_type(2)));
#define LAS __attribute__((address_space(3)))

constexpr int D = 1024, NROWS = 67072, NS0 = 65536, NM0 = 66560;
constexpr int TP = 2064, TS = 64, NB_P = 32, NB_S = 16, PAST = 2048;
constexpr int IN_COLS = 7440, N1 = 7680;
constexpr int SSQ_SLOTS = NM0 + 32 * 32;
constexpr float EPS = 1e-6f;
constexpr size_t O_YP = 0, O_YS = 67108864ull, O_KP = O_YS + 1048576ull, SZ_KP = 2ull * 32 * 2064 * 512, O_VP = O_KP + SZ_KP,
                 O_CONVP = O_VP + SZ_KP, O_SSDP = O_CONVP + 2ull * 32 * 3 * 1280, O_S5RP = O_SSDP + 2ull * 32 * 16 * 4096, O_S5IP = O_S5RP + 2ull * 32 * 2048,
                 O_KS = O_S5IP + 2ull * 32 * 2048, O_VS = O_KS + 2ull * 16 * 64 * 512, O_CONVS = O_VS + 2ull * 16 * 64 * 512, O_SSDS = O_CONVS + 2ull * 16 * 3 * 1280,
                 O_S5RS = O_SSDS + 2ull * 16 * 16 * 4096, O_S5IS = O_S5RS + 2ull * 16 * 2048, O_END = O_S5IS + 2ull * 16 * 2048;
constexpr size_t W_BT1 = 0, W_GLU = W_BT1 + (size_t)N1 * 1024 * 2, W_LA = W_GLU + 2048ull * 512 * 2, W_LC = W_LA + 1024ull * 1024 * 2, W_OUT = W_LC + 1024ull * 512 * 2,
                 W_UP = W_OUT + 1024ull * 1024 * 2, W_DOWN = W_UP + 4096ull * 1024 * 2, W_END = W_DOWN + 4096ull * 1024 * 2;
constexpr size_t WS_CTR = W_END, WS_XMETA = WS_CTR + 4096, WS_HB = WS_XMETA + 512ull * 1024 * 4, WS_Z = WS_HB + (size_t)NROWS * 1024 * 2, WS_XBC = WS_Z + (size_t)NROWS * 1024 * 2,
                 WS_U = WS_XBC + (size_t)NROWS * 1280 * 2, WS_Q = WS_U + (size_t)NROWS * 512 * 2, WS_G = WS_Q + (size_t)NROWS * 512 * 2, WS_DT = WS_G + (size_t)NROWS * 3072 * 2,
                 WS_SSQ = WS_DT + (size_t)NROWS * 16 * 4, WS_END = WS_SSQ + (size_t)SSQ_SLOTS * 16 * 4;
constexpr size_t WS_ACT = WS_Z;
static_assert(WS_ACT + (size_t)NROWS * 4096 * 2 <= WS_DT, "ACT overlay");
constexpr int LDS_BYTES = 147456;

struct Params {
    const float* in[34];
    float* out;
    unsigned char* ws;
    int ph_lo, ph_hi;
};
typedef const __attribute__((address_space(4))) Params* CPar;
__device__ __forceinline__ CPar params_ptr() { CPar q = (CPar)__builtin_amdgcn_kernarg_segment_ptr(); asm volatile("" : "+s"(q)); return q; }
#define PIN(i) (p->in[i])
enum { I_XP = 0, I_XS, I_CK, I_CV, I_SCONV, I_SSSD, I_S5R, I_S5I, I_META, I_NMIX, I_WIN, I_CONVW, I_CONVB, I_DTB, I_ALOG, I_DSSD, I_NSSD, I_LRE, I_LIM, I_LSTEP, I_BRE, I_BIM,
       I_CRE, I_CIM, I_DS5, I_WGLU, I_QN, I_KN, I_WLA, I_WLC, I_WOUT, I_NFFN, I_WUP, I_WDOWN };

__device__ __forceinline__ int ltid() { int t = threadIdx.x; asm volatile("" : "+v"(t)); return t; }
__device__ __forceinline__ int lbid() { int t = blockIdx.x; asm volatile("" : "+s"(t)); return t; }
__device__ __forceinline__ int lgdim() { int t = gridDim.x; asm volatile("" : "+s"(t)); return t; }

__device__ __forceinline__ float bf2f(bf16_t v) { return __uint_as_float((unsigned)v << 16); }
__device__ __forceinline__ unsigned pk2(float lo, float hi) { unsigned r; asm volatile("v_cvt_pk_bf16_f32 %0, %1, %2" : "=v"(r) : "v"(lo), "v"(hi)); return r; }
__device__ __forceinline__ float lo_f(unsigned w) { return __uint_as_float(w << 16); }
__device__ __forceinline__ float hi_f(unsigned w) { return __uint_as_float(w & 0xffff0000u); }
__device__ __forceinline__ u32x2 ld_l2_u32x2(const void* ptr) { const unsigned long long v = __hip_atomic_load((const unsigned long long*)ptr, __ATOMIC_RELAXED, __HIP_MEMORY_SCOPE_AGENT); u32x2 r; r[0] = (unsigned)v; r[1] = (unsigned)(v >> 32); return r; }
__device__ __forceinline__ float sigmoidf_(float v) { return __builtin_amdgcn_rcpf(1.f + __expf(-v)); }
__device__ __forceinline__ float siluf_(float v) { return v * sigmoidf_(v); }
__device__ __forceinline__ float geluf_(float y) { const float a = 0.7978845608f * (y + 0.044715f * y * y * y); const float t = __expf(2.f * a); return 0.5f * y * (2.f - 2.f * __builtin_amdgcn_rcpf(t + 1.f)); }
__device__ __forceinline__ float wave_sum(float v) {
#pragma unroll
    for (int o = 1; o < 64; o <<= 1) v += __shfl_xor(v, o);
    return v;
}
__device__ __forceinline__ void sincos_red(double x, float& sn, float& cs) {
    const double k = __builtin_rint(x * 0.63661977236758134308);
    const float r = (float)__builtin_fma(-k, 1.57079632679489661923, x), r2 = r * r;
    const float sp = r + r * r2 * (-1.6666667163e-01f + r2 * (8.3333337680e-03f + r2 * (-1.9841270114e-04f + r2 * 2.7557314297e-06f)));
    const float cp = 1.f + r2 * (-0.5f + r2 * (4.1666667908e-02f + r2 * (-1.3888889225e-03f + r2 * (2.4801587642e-05f - r2 * 2.7557314297e-07f))));
    const int q = ((int)k) & 3;
    sn = (q == 0) ? sp : (q == 1) ? cp : (q == 2) ? -sp : -cp;
    cs = (q == 0) ? cp : (q == 1) ? -sp : (q == 2) ? -cp : sp;
}
__device__ __forceinline__ int row_of(int s, int t) { return s < 32 ? (t < 16 ? NM0 + s * 16 + t : s * 2048 + t - 16) : NS0 + (s - 32) * 64 + t; }
__device__ __forceinline__ int ssq_slot(int r) { return r < NM0 ? r : NM0 + ((r - NM0) >> 4) * 32 + ((r - NM0) & 15); }
__device__ __forceinline__ float* xloc(CPar p, int r) { return r < NM0 ? p->out + (size_t)r * 1024 : (float*)(p->ws + WS_XMETA) + (size_t)(r - NM0) * 1024; }
__device__ __forceinline__ size_t k_off(int l, int r) {
    if (r < NS0) return O_KP + ((size_t)(l * 32 + (r >> 11)) * 2064 + 16 + (r & 2047)) * 512;
    if (r < NM0) { const int rs = r - NS0; return O_KS + ((size_t)(l * 16 + (rs >> 6)) * 64 + (rs & 63)) * 512; }
    const int rm = r - NM0; return O_KP + ((size_t)(l * 32 + (rm >> 4)) * 2064 + (rm & 15)) * 512;
}

namespace pg8 {
constexpr int BM = 256, BK = 64, HALF = 128, HTB = HALF * BK * 2, STAGE_BYTES = 8 * HTB, NXCD = 8, WGM = 8;
__host__ __device__ __forceinline__ int lds_byte(int r, int c) { const int st = (r >> 4) * 2 + (c >> 5), rr = r & 15, cc = c & 31, ob = rr * 64 + cc * 2; return st * 1024 + (ob ^ (((ob >> 9) & 1) << 5)); }
__host__ __device__ __forceinline__ void stage_rc(int b, int& R, int& C) { const int st = b / 1024, sb = b % 1024, swz = sb ^ (((sb >> 9) & 1) << 5); R = (st >> 1) * 16 + swz / 64; C = (st & 1) * 32 + (swz % 64) / 2; }
struct Unit { int pm, pn; };
struct Gemm { const bf16_t* A; const bf16_t* Bt; int M, N, K, lda, ldb; };
struct StaticOrder {
    int nM, nN, nwg, G, c;
    __device__ void init(int M, int N, int G_, int c_) { nM = M / BM; nN = N / BM; nwg = nM * nN; G = G_; c = c_; }
    __device__ bool next(int i, Unit& u) const {
        const long L = (long)i * G + c; if (L >= nwg) return false;
        int wgid = (int)L; { const int q = nwg / NXCD, r = nwg % NXCD, xcd = wgid % NXCD, off = wgid / NXCD; wgid = (xcd < r ? xcd * (q + 1) : r * (q + 1) + (xcd - r) * q) + off; }
        const int nig = WGM * nN, gid = wgid / nig, fm = gid * WGM, gsz = (nM - fm) < WGM ? (nM - fm) : WGM;
        u.pm = fm + ((wgid % nig) % gsz); u.pn = (wgid % nig) / gsz; return true;
    }
};
template <class Epi>
__device__ __forceinline__ void gemm_phase(LAS unsigned char* lds, const Gemm g, const StaticOrder& S, const Epi& E) {
    const int tid = ltid(), wid = __builtin_amdgcn_readfirstlane(tid >> 6), lane = tid & 63, wr = wid >> 2, wc = wid & 3, fr = lane & 15, fq = lane >> 4;
    const int K = g.K, nt = K / BK;
    unsigned voffA[2], voffB[2];
#pragma unroll
    for (int i = 0; i < 2; ++i) { int R, C; stage_rc(tid * 16 + i * 8192, R, C); voffA[i] = (unsigned)(R * g.lda + C) * 2u; voffB[i] = (unsigned)(R * g.ldb + C) * 2u; }
    const size_t kstep = (size_t)(BK * 2);
    const size_t hstepA = (size_t)HALF * g.lda * 2, hstepB = (size_t)HALF * g.ldb * 2;
    const size_t tstepA = 2 * hstepA, tstepB = 2 * hstepB;
    const unsigned ldsw = (unsigned)wid * 1024u;
    const int aoff = lds_byte(wr * 64 + fr, fq * 8), boff = lds_byte(wc * 32 + fr, fq * 8);
#define PG8_SA(b, h) (((b) * 2 + (h)) * HTB)
#define PG8_SB(b, h) ((4 + (b) * 2 + (h)) * HTB)
#define PG8_STAGE(bufoff, gbase, voff) do { _Pragma("unroll") for (int _i = 0; _i < 2; ++_i) \
        __builtin_amdgcn_global_load_lds((const unsigned*)((const char*)(gbase) + (voff)[_i]), (LAS unsigned*)(lds + (bufoff) + ldsw + _i * 8192), 16, 0, 0); } while (0)
#define PG8_LDA(dst, b, h) do { _Pragma("unroll") for (int m = 0; m < 4; ++m) _Pragma("unroll") for (int k = 0; k < 2; ++k) dst[m][k] = *(const LAS bf16x8*)(lds + PG8_SA(b, h) + aoff + m * 2048 + k * 1024); } while (0)
#define PG8_LDB(dst, b, h) do { _Pragma("unroll") for (int n = 0; n < 2; ++n) _Pragma("unroll") for (int k = 0; k < 2; ++k) dst[n][k] = *(const LAS bf16x8*)(lds + PG8_SB(b, h) + boff + n * 2048 + k * 1024); } while (0)
#define PG8_MMA(ai, bj, At, Bt) do { __builtin_amdgcn_s_setprio(1); _Pragma("unroll") for (int m = 0; m < 4; ++m) _Pragma("unroll") for (int n = 0; n < 2; ++n) _Pragma("unroll") for (int k = 0; k < 2; ++k) \
        acc[ai][bj][m][n] = __builtin_amdgcn_mfma_f32_16x16x32_bf16(Bt[n][k], At[m][k], acc[ai][bj][m][n], 0, 0, 0); __builtin_amdgcn_s_setprio(0); } while (0)
#define PG8_WAIT_V(n) asm volatile("s_waitcnt vmcnt(" #n ")" ::: "memory")
#define PG8_WAIT_L(n) asm volatile("s_waitcnt lgkmcnt(" #n ")" ::: "memory")
#define PG8_BAR __builtin_amdgcn_s_barrier()
#define PG8_SCHED __builtin_amdgcn_sched_barrier(0)
    Unit cur, nxt; int ui = 0;
    if (!S.next(0, cur)) return;
    f32x4 acc[2][2][4][2];
#pragma unroll
    for (int a = 0; a < 2; ++a)
#pragma unroll
        for (int b = 0; b < 2; ++b)
#pragma unroll
            for (int m = 0; m < 4; ++m)
#pragma unroll
                for (int n = 0; n < 2; ++n) acc[a][b][m][n] = (f32x4){0.f, 0.f, 0.f, 0.f};
    bf16x8 At[4][2], B0[2][2], B1[2][2];
    const char* cA = (const char*)g.A + (size_t)cur.pm * tstepA; const char* cB = (const char*)g.Bt + (size_t)cur.pn * tstepB;
    PG8_STAGE(PG8_SB(0, 0), cB, voffB); PG8_STAGE(PG8_SA(0, 0), cA, voffA); PG8_STAGE(PG8_SB(0, 1), cB + hstepB, voffB); PG8_STAGE(PG8_SA(0, 1), cA + hstepA, voffA);
    if (wr == 1) PG8_BAR;
    PG8_WAIT_V(4); PG8_BAR;
    PG8_STAGE(PG8_SB(1, 0), cB + kstep, voffB); PG8_STAGE(PG8_SA(1, 0), cA + kstep, voffA); PG8_STAGE(PG8_SB(1, 1), cB + hstepB + kstep, voffB);
    PG8_WAIT_V(6); PG8_BAR;
    for (;;) {
        const bool has_next = S.next(ui + 1, nxt);
        const char* nA = has_next ? (const char*)g.A + (size_t)nxt.pm * tstepA : cA; const char* nB = has_next ? (const char*)g.Bt + (size_t)nxt.pn * tstepB : cB;
        for (int t = 0; t < nt; t += 2) {
            const bool last = (t == nt - 2);
            const char* a1 = cA + (size_t)(t + 1) * kstep;
            const char* a2 = last ? nA : cA + (size_t)(t + 2) * kstep; const char* b2 = last ? nB : cB + (size_t)(t + 2) * kstep;
            const char* a3 = a2 + kstep; const char* b3 = b2 + kstep;
            PG8_LDB(B0, 0, 0); PG8_SCHED; PG8_LDA(At, 0, 0); PG8_STAGE(PG8_SA(1, 1), a1 + hstepA, voffA);
            PG8_WAIT_L(8); PG8_BAR; PG8_WAIT_L(0); PG8_MMA(0, 0, At, B0); PG8_BAR; PG8_SCHED;
            PG8_LDB(B1, 0, 1); PG8_STAGE(PG8_SB(0, 0), b2, voffB);
            PG8_BAR; PG8_WAIT_L(0); PG8_MMA(0, 1, At, B1); PG8_BAR;
            PG8_LDA(At, 0, 1); PG8_STAGE(PG8_SA(0, 0), a2, voffA);
            PG8_BAR; PG8_WAIT_L(0); PG8_MMA(1, 0, At, B0); PG8_BAR; PG8_SCHED;
            PG8_STAGE(PG8_SB(0, 1), b2 + hstepB, voffB);
            PG8_WAIT_V(6); PG8_BAR; PG8_MMA(1, 1, At, B1); PG8_BAR;
            PG8_LDB(B0, 1, 0); PG8_SCHED; PG8_LDA(At, 1, 0); PG8_STAGE(PG8_SA(0, 1), a2 + hstepA, voffA);
            PG8_WAIT_L(8); PG8_BAR; PG8_WAIT_L(0); PG8_MMA(0, 0, At, B0); PG8_BAR; PG8_SCHED;
            PG8_LDB(B1, 1, 1); PG8_STAGE(PG8_SB(1, 0), b3, voffB);
            PG8_BAR; PG8_WAIT_L(0); PG8_MMA(0, 1, At, B1); PG8_BAR;
            PG8_LDA(At, 1, 1); PG8_STAGE(PG8_SA(1, 0), a3, voffA);
            PG8_BAR; PG8_WAIT_L(0); PG8_MMA(1, 0, At, B0); PG8_BAR; PG8_SCHED;
            PG8_STAGE(PG8_SB(1, 1), b3 + hstepB, voffB);
            PG8_WAIT_V(6); PG8_BAR; PG8_MMA(1, 1, At, B1); PG8_BAR;
        }
        E(acc, cur, wr, wc, fr, fq);
        if (!has_next) break;
#pragma unroll
        for (int a = 0; a < 2; ++a)
#pragma unroll
            for (int b = 0; b < 2; ++b)
#pragma unroll
                for (int m = 0; m < 4; ++m)
#pragma unroll
                    for (int n = 0; n < 2; ++n) acc[a][b][m][n] = (f32x4){0.f, 0.f, 0.f, 0.f};
        cur = nxt; cA = nA; cB = nB; ++ui;
    }
    PG8_WAIT_V(0);
    if (wr == 0) PG8_BAR;
    PG8_BAR;
#undef PG8_SA
#undef PG8_SB
#undef PG8_STAGE
#undef PG8_LDA
#undef PG8_LDB
#undef PG8_MMA
#undef PG8_WAIT_V
#undef PG8_WAIT_L
#undef PG8_BAR
#undef PG8_SCHED
}
}
using pg8::Unit;

struct EpiIn {
    bf16_t *Z, *XBC, *U, *Q, *G; float* DT; float* out; const float *qn, *kn; int layer;
    __device__ __forceinline__ void operator()(const f32x4 (&acc)[2][2][4][2], const Unit& u, int wr, int wc, int fr, int fq) const {
        const int pn = u.pn, rowb = u.pm * 256 + wr * 64 + fr, ctb = wc * 32 + fq * 4;
        if (pn < 11 || (pn >= 17 && pn < 29)) {
            bf16_t* base; int ld, col0; bool sig = false;
            if (pn < 4) { base = Z; ld = 1024; col0 = pn * 256; } else if (pn < 9) { base = XBC; ld = 1280; col0 = (pn - 4) * 256; }
            else if (pn < 11) { base = U; ld = 512; col0 = (pn - 9) * 256; } else { base = G; ld = 3072; col0 = (pn - 17) * 256; sig = true; }
#pragma unroll
            for (int ai = 0; ai < 2; ++ai)
#pragma unroll
                for (int m = 0; m < 4; ++m) { bf16_t* rp = base + (size_t)(rowb + ai * 128 + m * 16) * ld + col0 + ctb;
#pragma unroll
                    for (int bj = 0; bj < 2; ++bj)
#pragma unroll
                        for (int n = 0; n < 2; ++n) { f32x4 v = acc[ai][bj][m][n];
                            if (sig) { v[0] = sigmoidf_(v[0]); v[1] = sigmoidf_(v[1]); v[2] = sigmoidf_(v[2]); v[3] = sigmoidf_(v[3]); }
                            u32x2 o; o[0] = pk2(v[0], v[1]); o[1] = pk2(v[2], v[3]); *(u32x2*)(rp + bj * 128 + n * 16) = o; } }
        } else if (pn < 17) {
            const int seg = (pn - 11) >> 1, head = ((pn - 11) & 1) * 4 + wc;
            const float* nw = seg == 0 ? qn : kn;
            f32x4 wv[2][2];
#pragma unroll
            for (int bj = 0; bj < 2; ++bj)
#pragma unroll
                for (int n = 0; n < 2; ++n) wv[bj][n] = (seg < 2) ? *(const f32x4*)(nw + 32 * bj + 16 * n + 4 * fq) : (f32x4){1.f, 1.f, 1.f, 1.f};
#pragma unroll
            for (int ai = 0; ai < 2; ++ai)
#pragma unroll
                for (int m = 0; m < 4; ++m) { const int row = rowb + ai * 128 + m * 16;
                    float rs = 1.f;
                    if (seg < 2) { float ss = 0.f;
#pragma unroll
                        for (int bj = 0; bj < 2; ++bj)
#pragma unroll
                            for (int n = 0; n < 2; ++n) { const f32x4 v = acc[ai][bj][m][n]; ss += v[0] * v[0] + v[1] * v[1] + v[2] * v[2] + v[3] * v[3]; }
                        ss += __shfl_xor(ss, 16); ss += __shfl_xor(ss, 32);
                        rs = rsqrtf(ss * (1.f / 64.f) + EPS); }
                    if (seg == 0) { bf16_t* rp = Q + (size_t)row * 512 + head * 64 + 4 * fq;
#pragma unroll
                        for (int bj = 0; bj < 2; ++bj)
#pragma unroll
                            for (int n = 0; n < 2; ++n) { const f32x4 v = acc[ai][bj][m][n] * rs * wv[bj][n]; u32x2 o; o[0] = pk2(v[0], v[1]); o[1] = pk2(v[2], v[3]); *(u32x2*)(rp + 32 * bj + 16 * n) = o; }
                    } else { float* rp = out + k_off(layer, row) + (seg == 2 ? (row >= NS0 && row < NM0 ? (O_VS - O_KS) : (O_VP - O_KP)) : 0) + head * 64 + 4 * fq;
#pragma unroll
                        for (int bj = 0; bj < 2; ++bj)
#pragma unroll
                            for (int n = 0; n < 2; ++n) { const f32x4 v = acc[ai][bj][m][n] * rs * wv[bj][n]; *(f32x4*)(rp + 32 * bj + 16 * n) = v; } } }
        } else {
            if (wc == 0) {
#pragma unroll
                for (int ai = 0; ai < 2; ++ai)
#pragma unroll
                    for (int m = 0; m < 4; ++m) *(f32x4*)(DT + (size_t)(rowb + ai * 128 + m * 16) * 16 + 4 * fq) = acc[ai][0][m][0];
            }
        }
    }
};
struct EpiGlu {
    bf16_t* OB;
    __device__ __forceinline__ void operator()(const f32x4 (&acc)[2][2][4][2], const Unit& u, int wr, int wc, int fr, int fq) const {
        const int rowb = u.pm * 256 + wr * 64 + fr, colb = u.pn * 128 + wc * 32 + fq * 4;
#pragma unroll
        for (int ai = 0; ai < 2; ++ai)
#pragma unroll
            for (int m = 0; m < 4; ++m) { bf16_t* rp = OB + (size_t)(rowb + ai * 128 + m * 16) * 1024 + colb;
#pragma unroll
                for (int n = 0; n < 2; ++n) { const f32x4 a = acc[ai][0][m][n], g = acc[ai][1][m][n];
                    u32x2 o; o[0] = pk2(a[0] * sigmoidf_(g[0]), a[1] * sigmoidf_(g[1])); o[1] = pk2(a[2] * sigmoidf_(g[2]), a[3] * sigmoidf_(g[3])); *(u32x2*)(rp + n * 16) = o; } }
    }
};
struct EpiMix {
    bf16_t* R; const bf16_t* G; const bf16_t* OB; int accum;
    __device__ __forceinline__ void operator()(const f32x4 (&acc)[2][2][4][2], const Unit& u, int wr, int wc, int fr, int fq) const {
        const int rowb = u.pm * 256 + wr * 64 + fr, colb = u.pn * 256 + wc * 32 + fq * 4;
#pragma unroll
        for (int ai = 0; ai < 2; ++ai)
#pragma unroll
            for (int m = 0; m < 4; ++m) { const int row = rowb + ai * 128 + m * 16;
#pragma unroll
                for (int bj = 0; bj < 2; ++bj)
#pragma unroll
                    for (int n = 0; n < 2; ++n) { const int col = colb + bj * 128 + n * 16; f32x4 v = acc[ai][bj][m][n];
                        const u32x2 gw = *(const u32x2*)(G + (size_t)row * 3072 + col);
                        v = v * (f32x4){lo_f(gw[0]), hi_f(gw[0]), lo_f(gw[1]), hi_f(gw[1])};
                        if (OB) { const u32x2 g1 = *(const u32x2*)(G + (size_t)row * 3072 + 1024 + col), ob = *(const u32x2*)(OB + (size_t)row * 1024 + col);
                            v = v + (f32x4){lo_f(g1[0]), hi_f(g1[0]), lo_f(g1[1]), hi_f(g1[1])} * (f32x4){lo_f(ob[0]), hi_f(ob[0]), lo_f(ob[1]), hi_f(ob[1])}; }
                        bf16_t* rp = R + (size_t)row * 1024 + col;
                        if (accum) { const u32x2 rw = ld_l2_u32x2(rp); v = v + (f32x4){lo_f(rw[0]), hi_f(rw[0]), lo_f(rw[1]), hi_f(rw[1])}; }
                        u32x2 o; o[0] = pk2(v[0], v[1]); o[1] = pk2(v[2], v[3]); *(u32x2*)rp = o; } }
    }
};
struct EpiRes {
    float* out; float* xmeta;
    __device__ __forceinline__ void operator()(const f32x4 (&acc)[2][2][4][2], const Unit& u, int wr, int wc, int fr, int fq) const {
        const int rowb = u.pm * 256 + wr * 64 + fr, colb = u.pn * 256 + wc * 32 + fq * 4;
        float* base = (u.pm * 256 < NM0) ? out : xmeta - (size_t)NM0 * 1024;
#pragma unroll
        for (int ai = 0; ai < 2; ++ai)
#pragma unroll
            for (int m = 0; m < 4; ++m) { float* rp = base + (size_t)(rowb + ai * 128 + m * 16) * 1024 + colb;
#pragma unroll
                for (int bj = 0; bj < 2; ++bj)
#pragma unroll
                    for (int n = 0; n < 2; ++n) { f32x4* q = (f32x4*)(rp + bj * 128 + n * 16); *q = *q + acc[ai][bj][m][n]; } }
    }
};
struct EpiUp {
    bf16_t* ACT;
    __device__ __forceinline__ void operator()(const f32x4 (&acc)[2][2][4][2], const Unit& u, int wr, int wc, int fr, int fq) const {
        const int rowb = u.pm * 256 + wr * 64 + fr, colb = u.pn * 256 + wc * 32 + fq * 4;
#pragma unroll
        for (int ai = 0; ai < 2; ++ai)
#pragma unroll
            for (int m = 0; m < 4; ++m) { bf16_t* rp = ACT + (size_t)(rowb + ai * 128 + m * 16) * 4096 + colb;
#pragma unroll
                for (int bj = 0; bj < 2; ++bj)
#pragma unroll
                    for (int n = 0; n < 2; ++n) { f32x4 v = acc[ai][bj][m][n];
#pragma unroll
                        for (int j = 0; j < 4; ++j) { const float r = fmaxf(v[j], 0.f); v[j] = r * r; }
                        u32x2 o; o[0] = pk2(v[0], v[1]); o[1] = pk2(v[2], v[3]); *(u32x2*)(rp + bj * 128 + n * 16) = o; } }
    }
};

__device__ __forceinline__ int col_in(int n) {
    if (n < 2304) return n;
    if (n < 2816) return n + 16;
    if (n < 4352) { const int w0 = n - 2816, seg = w0 >> 9, w = w0 & 511, tile = w >> 8, ct = w & 255, bj = ct >> 7, wc = (ct >> 5) & 3, ww = ct & 31;
        return 2832 + seg * 512 + (tile * 4 + wc) * 64 + 32 * bj + ww; }
    if (n < 7424) return n + 16;
    if (n < 7440) return 2304 + (n - 7424);
    return -1;
}
template <int MAP>
__device__ __forceinline__ void prep_w(bf16_t* dst, const float* src, int K, int N, int ld, const float* scale, size_t gtid, size_t gsz) {
    const size_t items = (size_t)(K / 8) * N;
    for (size_t it = gtid; it < items; it += gsz) {
        const int n = (int)(it % N), k8 = (int)(it / N);
        const int c = MAP == 1 ? col_in(n) : (MAP == 2 ? (((n >> 7) & 1) * 1024 + (n >> 8) * 128 + (n & 127)) : n);
        float v[8];
#pragma unroll
        for (int kk = 0; kk < 8; ++kk) { const int k = k8 * 8 + kk; float x = (c >= 0) ? src[(size_t)k * ld + c] : 0.f; if (scale) x *= scale[k]; v[kk] = x; }
        u32x4 o; o[0] = pk2(v[0], v[1]); o[1] = pk2(v[2], v[3]); o[2] = pk2(v[4], v[5]); o[3] = pk2(v[6], v[7]);
        *(u32x4*)(dst + (size_t)n * K + k8 * 8) = o;
    }
}
__device__ __forceinline__ void rmsnorm_rows(CPar p, const float* g, int from_inputs) {
    const int lane = ltid() & 63, gw = lbid() * 8 + (ltid() >> 6), ngw = lgdim() * 8;
    bf16_t* HB = (bf16_t*)(p->ws + WS_HB);
    f32x4 gv[4];
#pragma unroll
    for (int j = 0; j < 4; ++j) gv[j] = *(const f32x4*)(g + lane * 4 + 256 * j);
    for (int r = gw; r < NROWS; r += ngw) {
        float* xl = xloc(p, r);
        const float* src = xl;
        if (from_inputs) src = r < NS0 ? p->in[I_XP] + (size_t)r * 1024 : (r < NM0 ? p->in[I_XS] + (size_t)(r - NS0) * 1024 : p->in[I_META] + (size_t)((r - NM0) & 15) * 1024);
        f32x4 v[4]; float s = 0.f;
#pragma unroll
        for (int j = 0; j < 4; ++j) { v[j] = *(const f32x4*)(src + lane * 4 + 256 * j); s += (v[j][0] * v[j][0] + v[j][1] * v[j][1]) + (v[j][2] * v[j][2] + v[j][3] * v[j][3]); }
        const float rstd = rsqrtf(wave_sum(s) * (1.f / 1024.f) + EPS);
#pragma unroll
        for (int j = 0; j < 4; ++j) { if (from_inputs) *(f32x4*)(xl + lane * 4 + 256 * j) = v[j];
            const f32x4 h = v[j] * rstd * gv[j]; u32x2 o; o[0] = pk2(h[0], h[1]); o[1] = pk2(h[2], h[3]); *(u32x2*)(HB + (size_t)r * 1024 + lane * 4 + 256 * j) = o; }
    }
}
__device__ __forceinline__ void ssd_norm_rows(CPar p) {
    const int lane = ltid() & 63, gw = lbid() * 8 + (ltid() >> 6), ngw = lgdim() * 8;
    bf16_t* Z = (bf16_t*)(p->ws + WS_Z);
    for (int r = gw; r < NROWS; r += ngw) {
#pragma unroll
        for (int j = 0; j < 2; ++j) { u32x4* zp = (u32x4*)(Z + (size_t)r * 1024 + j * 512 + lane * 8); const u32x4 w = *zp;
            float f[8] = {lo_f(w[0]), hi_f(w[0]), lo_f(w[1]), hi_f(w[1]), lo_f(w[2]), hi_f(w[2]), lo_f(w[3]), hi_f(w[3])};
            float ss = 0.f;
#pragma unroll
            for (int i = 0; i < 8; ++i) ss += f[i] * f[i];
            const float rs = rsqrtf(wave_sum(ss) * (1.f / 512.f) + EPS);
            u32x4 o; o[0] = pk2(f[0] * rs, f[1] * rs); o[1] = pk2(f[2] * rs, f[3] * rs); o[2] = pk2(f[4] * rs, f[5] * rs); o[3] = pk2(f[6] * rs, f[7] * rs); *zp = o; }
    }
}
__device__ __forceinline__ void phase_prep(CPar p, int l) {
    const size_t gtid = (size_t)lbid() * 512 + ltid(), gsz = (size_t)lgdim() * 512;
    unsigned char* ws = p->ws;
    prep_w<1>((bf16_t*)(ws + W_BT1), p->in[I_WIN] + (size_t)l * 1024 * IN_COLS, 1024, N1, IN_COLS, nullptr, gtid, gsz);
    prep_w<2>((bf16_t*)(ws + W_GLU), p->in[I_WGLU] + (size_t)l * 512 * 2048, 512, 2048, 2048, nullptr, gtid, gsz);
    prep_w<0>((bf16_t*)(ws + W_LA), p->in[I_WLA] + (size_t)l * 1024 * 1024, 1024, 1024, 1024, p->in[I_NSSD] + l * 1024, gtid, gsz);
    prep_w<0>((bf16_t*)(ws + W_LC), p->in[I_WLC] + (size_t)l * 512 * 1024, 512, 1024, 1024, nullptr, gtid, gsz);
    prep_w<0>((bf16_t*)(ws + W_OUT), p->in[I_WOUT] + (size_t)l * 1024 * 1024, 1024, 1024, 1024, nullptr, gtid, gsz);
    prep_w<0>((bf16_t*)(ws + W_UP), p->in[I_WUP] + (size_t)l * 1024 * 4096, 1024, 4096, 4096, nullptr, gtid, gsz);
    prep_w<0>((bf16_t*)(ws + W_DOWN), p->in[I_WDOWN] + (size_t)l * 4096 * 1024, 4096, 1024, 1024, nullptr, gtid, gsz);
    if (lbid() == 0 && ltid() < 16) ((unsigned*)(ws + WS_CTR))[ltid()] = 0u;
    rmsnorm_rows(p, p->in[I_NMIX] + l * 1024, l == 0);
}

__device__ __forceinline__ bf16_t f2bf_(float v) { return (bf16_t)(pk2(v, v) & 0xffffu); }
__device__ __forceinline__ void ssd_item(CPar p, int l, int item, float* sm) {
    const int tid = ltid(), lane = tid & 63, wave = __builtin_amdgcn_readfirstlane(tid >> 6), rb = wave >> 1, chh = wave & 1, fr = lane & 15, fq = lane >> 4;
    const int s = item < 512 ? (item >> 4) : 32 + ((item - 512) >> 4), h = item & 15, g = h >> 3;
    const bool prompt = s < 32; const int b = prompt ? s : s - 32, T = prompt ? TP : TS;
    constexpr int LB = 72;
    bf16_t *Cb = (bf16_t*)sm, *Bb = Cb + 64 * LB, *XT = Bb + 64 * LB, *WB = XT + 64 * LB, *Mb = WB + 64 * LB, *Sb = Mb + 64 * LB;
    float *sRaw = (float*)(Sb + 64 * LB), *sW = sRaw + 67 * 192, *sdtA = sW + 5 * 192, *sacA = sdtA + 33 * 64, *sw = sacA + 33 * 64;
    const bf16_t* XBC = (const bf16_t*)(p->ws + WS_XBC); bf16_t* Z = (bf16_t*)(p->ws + WS_Z);
    const float* DT = (const float*)(p->ws + WS_DT);
    const float* cw = p->in[I_CONVW] + (size_t)l * 4 * 1280; const float* cb = p->in[I_CONVB] + (size_t)l * 1280;
    const float* hist = p->in[I_SCONV] + (size_t)(l * 16 + b) * 3 * 1280;
    const float dtb = p->in[I_DTB][l * 16 + h], aneg = -__expf(p->in[I_ALOG][l * 16 + h]), dsk = p->in[I_DSSD][l * 16 + h];
    float* sout = prompt ? p->out + O_SSDP + ((size_t)(l * 32 + b) * 16 + h) * 4096 : p->out + O_SSDS + ((size_t)(l * 16 + b) * 16 + h) * 4096;
    for (int i = tid; i < 5 * 192; i += 512) { const int k = i / 192, ch = i - k * 192; const int col = ch < 64 ? h * 64 + ch : (ch < 128 ? 1024 + g * 64 + (ch - 64) : 1152 + g * 64 + (ch - 128));
        sW[i] = k < 4 ? cw[k * 1280 + col] : cb[col]; }
    f32x4 accS[2];
#pragma unroll
    for (int c2 = 0; c2 < 2; ++c2)
#pragma unroll
        for (int r = 0; r < 4; ++r) { const int pp = rb * 16 + fq * 4 + r, n = chh * 32 + c2 * 16 + fr;
            const float v = prompt ? 0.f : p->in[I_SSSD][((size_t)(l * 16 + b) * 16 + h) * 4096 + pp * 64 + n]; accS[c2][r] = v; Sb[pp * LB + n] = f2bf_(v); }
    const int nch = (T + 63) >> 6;
    { const int wv = tid >> 6, ln = tid & 63; float xv[5];
#pragma unroll
        for (int r = 0; r < 5; ++r) { const int c = wv + 8 * r, t = c * 64 + ln; xv[r] = (c < nch && t < T) ? DT[(size_t)row_of(s, t) * 16 + h] + dtb : -1e30f; }
#pragma unroll
        for (int r = 0; r < 5; ++r) { const int c = wv + 8 * r;
            if (c < nch) { const float x = xv[r]; const float dtv = x < -1e29f ? 0.f : (x > 20.f ? x : log1pf(__expf(x))); float cs = dtv * aneg;
#pragma unroll
                for (int o = 1; o < 64; o <<= 1) { const float nb = __shfl_up(cs, o); if (ln >= o) cs += nb; }
                sdtA[c * 64 + ln] = dtv; sacA[c * 64 + ln] = cs; } } }
    u32x4 pf[4];
#define SSD_ISSUE(cc) do { _Pragma("unroll") for (int it4 = 0; it4 < 4; ++it4) { const int pi = tid + it4 * 512; pf[it4] = (u32x4){0u, 0u, 0u, 0u}; \
        if (pi < 67 * 24) { const int rl = pi / 24, pc = pi - rl * 24, seg = pc >> 3, q8 = pc & 7, tt = (cc) * 64 - 3 + rl; \
            const int col = (seg == 0 ? h * 64 : (seg == 1 ? 1024 + g * 64 : 1152 + g * 64)) + q8 * 8; \
            if (tt >= 0 && tt < T) pf[it4] = *(const u32x4*)(XBC + (size_t)row_of(s, tt) * 1280 + col); } } } while (0)
#define SSD_FRAG(P, r0, ks) (*(const bf16x8*)((P) + ((r0) + fr) * LB + (ks) * 32 + fq * 8))
    SSD_ISSUE(0);
#pragma unroll 1
    for (int c = 0; c < nch; ++c) {
        const int t0 = c * 64; const float* sdt = sdtA + t0; const float* sac = sacA + t0;
        __syncthreads();
#pragma unroll
        for (int it4 = 0; it4 < 4; ++it4) { const int pi = tid + it4 * 512;
            if (pi < 67 * 24) { const int rl = pi / 24, pc = pi - rl * 24, seg = pc >> 3, q8 = pc & 7, tt = t0 - 3 + rl;
                const u32x4 w = pf[it4];
                f32x4 f0 = {lo_f(w[0]), hi_f(w[0]), lo_f(w[1]), hi_f(w[1])}, f1 = {lo_f(w[2]), hi_f(w[2]), lo_f(w[3]), hi_f(w[3])};
                if (tt < 0 && !prompt) { const int col = (seg == 0 ? h * 64 : (seg == 1 ? 1024 + g * 64 : 1152 + g * 64)) + q8 * 8; const float* hp = hist + (3 + tt) * 1280 + col; f0 = *(const f32x4*)hp; f1 = *(const f32x4*)(hp + 4); }
                float* dp = sRaw + rl * 192 + seg * 64 + q8 * 8; *(f32x4*)dp = f0; *(f32x4*)(dp + 4) = f1; } }
        if (tid < 64) sw[tid] = __expf(sac[63] - sac[tid]) * sdt[tid];
        if (c + 1 < nch) SSD_ISSUE(c + 1);
        __syncthreads();
#pragma unroll 4
        for (int idx = tid; idx < 64 * 192; idx += 512) {
            const int tl = idx / 192, ch = idx - tl * 192, t = t0 + tl;
            float v = 0.f;
            if (t < T) { v = sW[4 * 192 + ch];
#pragma unroll
                for (int k = 0; k < 4; ++k) v += sRaw[(tl + k) * 192 + ch] * sW[k * 192 + ch];
                v = siluf_(v); }
            const int cc = ch & 63;
            if (ch < 64) XT[cc * LB + tl] = f2bf_(v);
            else if (ch < 128) { Bb[tl * LB + cc] = f2bf_(v); WB[cc * LB + tl] = f2bf_(v * sw[tl]); }
            else Cb[tl * LB + cc] = f2bf_(v);
        }
        __syncthreads();
        f32x4 acc2[2];
        { const bf16x8 aC0 = SSD_FRAG(Cb, rb * 16, 0), aC1 = SSD_FRAG(Cb, rb * 16, 1);
#pragma unroll
            for (int c2 = 0; c2 < 2; ++c2) { const int j0 = chh * 32 + c2 * 16;
                f32x4 m = {0.f, 0.f, 0.f, 0.f};
                if (j0 <= rb * 16 + 15) { m = __builtin_amdgcn_mfma_f32_16x16x32_bf16(aC0, SSD_FRAG(Bb, j0, 0), m, 0, 0, 0); m = __builtin_amdgcn_mfma_f32_16x16x32_bf16(aC1, SSD_FRAG(Bb, j0, 1), m, 0, 0, 0); }
                const int j = j0 + fr; const float acj = sac[j], dtj = sdt[j];
#pragma unroll
                for (int r = 0; r < 4; ++r) { const int tl = rb * 16 + fq * 4 + r; Mb[tl * LB + j] = f2bf_(j <= tl ? m[r] * __expf(sac[tl] - acj) * dtj : 0.f); }
                f32x4 y = {0.f, 0.f, 0.f, 0.f};
                y = __builtin_amdgcn_mfma_f32_16x16x32_bf16(aC0, SSD_FRAG(Sb, j0, 0), y, 0, 0, 0); y = __builtin_amdgcn_mfma_f32_16x16x32_bf16(aC1, SSD_FRAG(Sb, j0, 1), y, 0, 0, 0);
#pragma unroll
                for (int r = 0; r < 4; ++r) y[r] *= __expf(sac[rb * 16 + fq * 4 + r]);
                acc2[c2] = y; }
            const bf16x8 aX0 = SSD_FRAG(XT, rb * 16, 0), aX1 = SSD_FRAG(XT, rb * 16, 1); const float eL = __expf(sac[63]);
#pragma unroll
            for (int c2 = 0; c2 < 2; ++c2) { const int n0 = chh * 32 + c2 * 16; f32x4 sv = accS[c2] * eL;
                sv = __builtin_amdgcn_mfma_f32_16x16x32_bf16(aX0, SSD_FRAG(WB, n0, 0), sv, 0, 0, 0); sv = __builtin_amdgcn_mfma_f32_16x16x32_bf16(aX1, SSD_FRAG(WB, n0, 1), sv, 0, 0, 0); accS[c2] = sv; } }
        __syncthreads();
        { const bf16x8 aM0 = SSD_FRAG(Mb, rb * 16, 0), aM1 = SSD_FRAG(Mb, rb * 16, 1);
#pragma unroll
            for (int c2 = 0; c2 < 2; ++c2) { const int p0 = chh * 32 + c2 * 16, pp = p0 + fr; f32x4 y = acc2[c2];
                y = __builtin_amdgcn_mfma_f32_16x16x32_bf16(aM0, SSD_FRAG(XT, p0, 0), y, 0, 0, 0); y = __builtin_amdgcn_mfma_f32_16x16x32_bf16(aM1, SSD_FRAG(XT, p0, 1), y, 0, 0, 0);
#pragma unroll
                for (int r = 0; r < 4; ++r) { const int tl = rb * 16 + fq * 4 + r, t = t0 + tl;
                    if (t < T) { bf16_t* zp = Z + (size_t)row_of(s, t) * 1024 + h * 64 + pp; const float yy = (y[r] + dsk * bf2f(XT[pp * LB + tl])) * siluf_(bf2f(*zp)); *zp = f2bf_(yy); } } }
#pragma unroll
            for (int c2 = 0; c2 < 2; ++c2)
#pragma unroll
                for (int r = 0; r < 4; ++r) Sb[(rb * 16 + fq * 4 + r) * LB + chh * 32 + c2 * 16 + fr] = f2bf_(accS[c2][r]); }
    }
    __syncthreads();
#pragma unroll
    for (int c2 = 0; c2 < 2; ++c2)
#pragma unroll
        for (int r = 0; r < 4; ++r) sout[(rb * 16 + fq * 4 + r) * 64 + chh * 32 + c2 * 16 + fr] = accS[c2][r];
    float* cout_ = prompt ? p->out + O_CONVP + (size_t)(l * 32 + b) * 3 * 1280 : p->out + O_CONVS + (size_t)(l * 16 + b) * 3 * 1280;
    for (int idx = tid; idx < 3 * 192; idx += 512) { const int k = idx / 192, ch = idx - k * 192;
        if (ch >= 64 && (h & 7) != 0) continue;
        const int col = ch < 64 ? h * 64 + ch : (ch < 128 ? 1024 + g * 64 + (ch - 64) : 1152 + g * 64 + (ch - 128));
        cout_[k * 1280 + col] = bf2f(XBC[(size_t)row_of(s, T - 3 + k) * 1280 + col]); }
    __syncthreads();
#undef SSD_ISSUE
#undef SSD_FRAG
}

__device__ __forceinline__ void s5_item(CPar p, int l, int s, int g, float* wl) {
    const int lane = ltid() & 63, fr = lane & 15, fq = lane >> 4;
    const bool prompt = s < 32; const int b = prompt ? s : s - 32, T = prompt ? TP : TS, nblk = T >> 4;
    constexpr int LBX = 136;
    bf16_t* Xb = (bf16_t*)wl;
    bf16_t* U = (bf16_t*)(p->ws + WS_U);
    const int gp = (l * 32 + g) * 64 + lane;
    const float lr = p->in[I_LRE][gp], li = p->in[I_LIM][gp], step = expf(p->in[I_LSTEP][l * 32 + g]);
    float sn, cs; sincos_red((double)li * (double)step, sn, cs);
    const float mag = expf(lr * step), ab_re = mag * cs, ab_im = mag * sn;
    const float den = lr * lr + li * li, nr = ab_re - 1.f, f_re = (nr * lr + ab_im * li) / den, f_im = (ab_im * lr - nr * li) / den;
    float bbr[16], bbi[16];
#pragma unroll
    for (int hh = 0; hh < 16; ++hh) { const float br = p->in[I_BRE][(size_t)gp * 16 + hh], bi = p->in[I_BIM][(size_t)gp * 16 + hh]; bbr[hh] = f_re * br - f_im * bi; bbi[hh] = f_re * bi + f_im * br; }
    bf16x8 cfrag[4];
#pragma unroll
    for (int ks = 0; ks < 4; ++ks) { const int k0 = ks * 32 + fq * 8; const bool im = k0 >= 64;
        const float* cp = (im ? p->in[I_CIM] : p->in[I_CRE]) + ((size_t)(l * 32 + g) * 16 + fr) * 64 + (k0 & 63);
        const f32x4 c0 = *(const f32x4*)cp, c1 = *(const f32x4*)(cp + 4); const float sg = im ? -1.f : 1.f;
        u32x4 w; w[0] = pk2(sg * c0[0], sg * c0[1]); w[1] = pk2(sg * c0[2], sg * c0[3]); w[2] = pk2(sg * c1[0], sg * c1[1]); w[3] = pk2(sg * c1[2], sg * c1[3]);
        cfrag[ks] = __builtin_bit_cast(bf16x8, w); }
    float xr = prompt ? 0.f : p->in[I_S5R][(size_t)(l * 16 + b) * 2048 + g * 64 + lane], xi = prompt ? 0.f : p->in[I_S5I][(size_t)(l * 16 + b) * 2048 + g * 64 + lane];
    const float dsk = p->in[I_DS5][(size_t)(l * 32 + g) * 16 + fr];
    u32x4 ua = {0, 0, 0, 0}, ub = {0, 0, 0, 0};
    { const int r0 = row_of(s, 0); if (lane < 16) { const u32x4* up = (const u32x4*)(U + (size_t)(r0 + lane) * 512 + g * 16); ua = up[0]; ub = up[1]; } }
    for (int blk = 0; blk < nblk; ++blk) {
        const int r0 = row_of(s, blk * 16);
        const u32x4 ca = ua, cbv = ub;
        if (blk + 1 < nblk && lane < 16) { const int r1 = row_of(s, blk * 16 + 16); const u32x4* up = (const u32x4*)(U + (size_t)(r1 + lane) * 512 + g * 16); ua = up[0]; ub = up[1]; }
#pragma unroll
        for (int i = 0; i < 16; ++i) {
            float bur = 0.f, bui = 0.f;
#pragma unroll
            for (int w = 0; w < 8; ++w) { const unsigned word = (unsigned)__builtin_amdgcn_readlane((int)(w < 4 ? ca[w] : cbv[w - 4]), i);
                const float u0 = lo_f(word), u1 = hi_f(word);
                bur += bbr[2 * w] * u0 + bbr[2 * w + 1] * u1; bui += bbi[2 * w] * u0 + bbi[2 * w + 1] * u1; }
            const float nxr = ab_re * xr - ab_im * xi + bur, nxi = ab_re * xi + ab_im * xr + bui; xr = nxr; xi = nxi;
            Xb[i * LBX + lane] = f2bf_(xr); Xb[i * LBX + 64 + lane] = f2bf_(xi);
        }
        __builtin_amdgcn_wave_barrier(); asm volatile("s_waitcnt lgkmcnt(0)" ::: "memory");
        f32x4 y = {0.f, 0.f, 0.f, 0.f};
#pragma unroll
        for (int ks = 0; ks < 4; ++ks) y = __builtin_amdgcn_mfma_f32_16x16x32_bf16(*(const bf16x8*)(Xb + fr * LBX + ks * 32 + fq * 8), cfrag[ks], y, 0, 0, 0);
#pragma unroll
        for (int r = 0; r < 4; ++r) { bf16_t* up = U + (size_t)(r0 + fq * 4 + r) * 512 + g * 16 + fr; *up = f2bf_(geluf_(y[r] + dsk * bf2f(*up))); }
        __builtin_amdgcn_wave_barrier(); asm volatile("s_waitcnt lgkmcnt(0)" ::: "memory");
    }
    float* ore = prompt ? p->out + O_S5RP + (size_t)(l * 32 + b) * 2048 : p->out + O_S5RS + (size_t)(l * 16 + b) * 2048;
    float* oim = prompt ? p->out + O_S5IP + (size_t)(l * 32 + b) * 2048 : p->out + O_S5IS + (size_t)(l * 16 + b) * 2048;
    ore[g * 64 + lane] = xr; oim[g * 64 + lane] = xi;
}

typedef __bf16 bf2_t __attribute__((ext_vector_type(2)));
__device__ __forceinline__ float dot2bf(unsigned a, unsigned b, float c) { return __builtin_amdgcn_fdot2_f32_bf16(__builtin_bit_cast(bf2_t, a), __builtin_bit_cast(bf2_t, b), c, false); }
__device__ __forceinline__ void attn_item(CPar p, int l, int item, float* wl) {
    const int lane = ltid() & 63;
    int s, h, qt;
    if (item < 8448) { s = item / 264; const int rem = item - s * 264; h = rem / 33; qt = rem - h * 33; } else { const int it = item - 8448; s = 32 + (it >> 3); h = it & 7; qt = 0; }
    const bool prompt = s < 32; const int b = prompt ? s : s - 32, T = prompt ? TP : TS, nh = prompt ? 0 : PAST;
    const int i = qt * 64 + lane; const bool active = i < T; const int row = row_of(s, active ? i : T - 1);
    bf16_t* Q = (bf16_t*)(p->ws + WS_Q);
    unsigned* Kt = (unsigned*)wl; unsigned* Vp = Kt + 32 * 32;
    unsigned q[32]; float o[64];
    { const u32x4* qp = (const u32x4*)(Q + (size_t)row * 512 + h * 64);
#pragma unroll
        for (int e = 0; e < 8; ++e) { const u32x4 w = qp[e];
#pragma unroll
            for (int j = 0; j < 4; ++j) q[e * 4 + j] = pk2(lo_f(w[j]) * 0.125f, hi_f(w[j]) * 0.125f); } }
#pragma unroll
    for (int d = 0; d < 64; ++d) o[d] = 0.f;
    const float* kp_new = prompt ? p->out + O_KP + (size_t)(l * 32 + b) * 2064 * 512 + h * 64 : p->out + O_KS + (size_t)(l * 16 + b) * 64 * 512 + h * 64;
    const float* vp_new = prompt ? p->out + O_VP + (size_t)(l * 32 + b) * 2064 * 512 + h * 64 : p->out + O_VS + (size_t)(l * 16 + b) * 64 * 512 + h * 64;
    const float* kp_old = p->in[I_CK] + (size_t)(l * 16 + b) * 2048 * 512 + h * 64;
    const float* vp_old = p->in[I_CV] + (size_t)(l * 16 + b) * 2048 * 512 + h * 64;
    const int imax = (qt * 64 + 63 < T - 1) ? qt * 64 + 63 : T - 1;
    const int jtop = nh + imax - 1;
    float run = 0.f;
    for (int jt = jtop; jt >= 0; jt -= 32) {
#pragma unroll 4
        for (int e = 0; e < 8; ++e) { const int idx = e * 64 + lane, kr = idx >> 4, pc = idx & 15, j = jt - kr; u32x2 w = {0u, 0u};
            if (j >= 0) { const float* kp = (j < nh) ? kp_old + (size_t)j * 512 : kp_new + (size_t)(j - nh) * 512; const f32x4 f = *(const f32x4*)(kp + pc * 4); w[0] = pk2(f[0], f[1]); w[1] = pk2(f[2], f[3]); }
            *(u32x2*)(Kt + kr * 32 + pc * 2) = w; }
#pragma unroll 2
        for (int e = 0; e < 4; ++e) { const int idx = e * 64 + lane, m = idx >> 4, pc = idx & 15, j0 = jt - 2 * m, j1 = j0 - 1;
            f32x4 fa = {0.f, 0.f, 0.f, 0.f}, fb = {0.f, 0.f, 0.f, 0.f};
            if (j0 >= 0) { const float* vp = (j0 < nh) ? vp_old + (size_t)j0 * 512 : vp_new + (size_t)(j0 - nh) * 512; fa = *(const f32x4*)(vp + pc * 4); }
            if (j1 >= 0) { const float* vp = (j1 < nh) ? vp_old + (size_t)j1 * 512 : vp_new + (size_t)(j1 - nh) * 512; fb = *(const f32x4*)(vp + pc * 4); }
            u32x4 w; w[0] = pk2(fa[0], fb[0]); w[1] = pk2(fa[1], fb[1]); w[2] = pk2(fa[2], fb[2]); w[3] = pk2(fa[3], fb[3]);
            *(u32x4*)(Vp + m * 64 + pc * 4) = w; }
        __builtin_amdgcn_wave_barrier(); asm volatile("s_waitcnt vmcnt(0) lgkmcnt(0)" ::: "memory");
        const int nk = jt + 1 < 32 ? jt + 1 : 32, npair = (nk + 1) >> 1;
        for (int m = 0; m < npair; ++m) { const int j0 = jt - 2 * m, j1 = j0 - 1;
            float z0 = 0.f, z1 = 0.f;
#pragma unroll
            for (int d8 = 0; d8 < 8; ++d8) { const u32x4 k0 = *(const u32x4*)(Kt + (2 * m) * 32 + d8 * 4), k1 = *(const u32x4*)(Kt + (2 * m + 1) * 32 + d8 * 4);
#pragma unroll
                for (int c = 0; c < 4; ++c) { z0 = dot2bf(q[d8 * 4 + c], k0[c], z0); z1 = dot2bf(q[d8 * 4 + c], k1[c], z1); } }
            const bool v0 = active && (j0 < nh + i), v1 = active && (j1 >= 0) && (j1 < nh + i);
            const float e0 = __expf(-z0), ls0 = -__logf(1.f + e0);
            const float w0 = v0 ? __expf(ls0 + run) : 0.f; run += v0 ? (ls0 - z0) : 0.f;
            const float e1 = __expf(-z1), ls1 = -__logf(1.f + e1);
            const float w1 = v1 ? __expf(ls1 + run) : 0.f; run += v1 ? (ls1 - z1) : 0.f;
            const unsigned wp = pk2(w0, w1);
#pragma unroll
            for (int d4 = 0; d4 < 16; ++d4) { const u32x4 vv = *(const u32x4*)(Vp + m * 64 + d4 * 4);
#pragma unroll
                for (int c = 0; c < 4; ++c) o[d4 * 4 + c] = dot2bf(wp, vv[c], o[d4 * 4 + c]); } }
        __builtin_amdgcn_wave_barrier(); asm volatile("s_waitcnt lgkmcnt(0)" ::: "memory");
        const int fin = (!active) || (run < -50.f);
        if (__all(fin)) break;
    }
    if (active) { u32x4* op = (u32x4*)(Q + (size_t)row * 512 + h * 64);
#pragma unroll
        for (int e = 0; e < 8; ++e) { u32x4 w; w[0] = pk2(o[e * 8], o[e * 8 + 1]); w[1] = pk2(o[e * 8 + 2], o[e * 8 + 3]); w[2] = pk2(o[e * 8 + 4], o[e * 8 + 5]); w[3] = pk2(o[e * 8 + 6], o[e * 8 + 7]); op[e] = w; } }
}

__device__ __forceinline__ void phase_mixers(CPar p, int l, float* sm) {
#ifndef SKIP_SSD
    { CPar p1 = params_ptr();
#pragma unroll 1
      for (int it = lbid(); it < 768; it += lgdim()) ssd_item(p1, l, it, sm); }
#endif
    __syncthreads();
    const int wave = __builtin_amdgcn_readfirstlane(ltid() >> 6);
    float* wl = sm + wave * (68 * 64);
#ifndef SKIP_S5
    { CPar p2 = params_ptr();
    if (wave < 4) { for (int it = lbid() * 4 + wave; it < 1024; it += lgdim() * 4) s5_item(p2, l, it >> 5, it & 31, wl); }
    else if (wave < 6) { for (int it = lbid() * 2 + (wave - 4); it < 512; it += lgdim() * 2) s5_item(p2, l, 32 + (it >> 5), it & 31, wl); } }
#endif
#ifndef SKIP_ATT
    CPar p3 = params_ptr();
    unsigned* ctr = (unsigned*)(p3->ws + WS_CTR) + l;
    for (;;) {
        unsigned it = 0; if ((ltid() & 63) == 0) it = atomicAdd(ctr, 1u);
        it = (unsigned)__builtin_amdgcn_readfirstlane((int)it);
        if (it >= 8576u) break;
        attn_item(p3, l, (int)it, wl);
    }
#endif
}

__global__ __launch_bounds__(512, 2) void mega(Params pk) {
    extern __shared__ __attribute__((aligned(16))) unsigned char smem[];
    cg::grid_group grid = cg::this_grid();
    LAS unsigned char* lds = (LAS unsigned char*)smem;
    const int ph_lo = pk.ph_lo, ph_hi = pk.ph_hi;
    for (int ph = ph_lo; ph < ph_hi; ++ph) {
        if (ph > ph_lo) grid.sync();
        CPar p = params_ptr();
        unsigned char* ws = p->ws;
        bf16_t *HB = (bf16_t*)(ws + WS_HB), *Z = (bf16_t*)(ws + WS_Z), *XBC = (bf16_t*)(ws + WS_XBC), *U = (bf16_t*)(ws + WS_U), *Q = (bf16_t*)(ws + WS_Q), *G = (bf16_t*)(ws + WS_G);
        float *DT = (float*)(ws + WS_DT), *XM = (float*)(ws + WS_XMETA);
        const int l = ph / 9, sub = ph - l * 9;
        pg8::StaticOrder S;
        if (sub == 0) {
#ifndef SKIP0
            phase_prep(p, l);
#endif
        } else if (sub == 1) {
            S.init(NROWS, N1, lgdim(), lbid());
            EpiIn E{Z, XBC, U, Q, G, DT, p->out, p->in[I_QN] + l * 64, p->in[I_KN] + l * 64, l};
#ifndef SKIP1
            pg8::gemm_phase(lds, pg8::Gemm{HB, (const bf16_t*)(ws + W_BT1), NROWS, N1, 1024, 1024, 1024}, S, E);
#endif
        } else if (sub == 2) {
#ifndef SKIP2
            phase_mixers(p, l, (float*)smem);
#endif
        } else if (sub == 3) {
            ssd_norm_rows(p);
            S.init(NROWS, 2048, lgdim(), lbid());
            EpiGlu E{XBC};
            pg8::gemm_phase(lds, pg8::Gemm{U, (const bf16_t*)(ws + W_GLU), NROWS, 2048, 512, 512, 512}, S, E);
        } else if (sub == 4) {
            S.init(NROWS, 1024, lgdim(), lbid());
            for (int call = 0; call < 2; ++call) {
                EpiMix E; pg8::Gemm g;
                if (call == 0) { E = EpiMix{HB, G, XBC, 0}; g = pg8::Gemm{Z, (const bf16_t*)(ws + W_LA), NROWS, 1024, 1024, 1024, 1024}; }
                else { E = EpiMix{HB, G + 2048, nullptr, 1}; g = pg8::Gemm{Q, (const bf16_t*)(ws + W_LC), NROWS, 1024, 512, 512, 512}; }
#ifndef SKIP3
                pg8::gemm_phase(lds, g, S, E);
#endif
            }
        } else if (sub == 5) {
            S.init(NROWS, 1024, lgdim(), lbid());
            EpiRes E{p->out, XM};
#ifndef SKIP4
            pg8::gemm_phase(lds, pg8::Gemm{HB, (const bf16_t*)(ws + W_OUT), NROWS, 1024, 1024, 1024, 1024}, S, E);
#endif
        } else if (sub == 6) {
            rmsnorm_rows(p, p->in[I_NFFN] + l * 1024, 0);
        } else if (sub == 7) {
            S.init(NROWS, 4096, lgdim(), lbid());
            EpiUp E{(bf16_t*)(ws + WS_ACT)};
#ifndef SKIP6
            pg8::gemm_phase(lds, pg8::Gemm{HB, (const bf16_t*)(ws + W_UP), NROWS, 4096, 1024, 1024, 1024}, S, E);
#endif
        } else {
            S.init(NROWS, 1024, lgdim(), lbid());
            EpiRes E{p->out, XM};
#ifndef SKIP7
            pg8::gemm_phase(lds, pg8::Gemm{(const bf16_t*)(ws + WS_ACT), (const bf16_t*)(ws + W_DOWN), NROWS, 1024, 4096, 4096, 4096}, S, E);
#endif
        }
    }
}

extern "C" void kernel_launch(void* const* d_in, const int* in_sizes, int n_in, void* d_out, int out_size, void* d_ws, size_t ws_size, hipStream_t stream) {
    static int grid = 0;
    if (grid == 0) {
        if (n_in != 34 || (size_t)out_size != O_END || ws_size < WS_END) { fprintf(stderr, "kernel_launch: unexpected shapes n_in %d out %d ws %zu (need %zu)\n", n_in, out_size, ws_size, (size_t)WS_END); grid = -1; return; }
        int dev = 0, cus = 0, per_cu = 0;
        hipGetDevice(&dev); hipDeviceGetAttribute(&cus, hipDeviceAttributeMultiprocessorCount, dev);
        if (hipFuncSetAttribute((const void*)mega, hipFuncAttributeMaxDynamicSharedMemorySize, LDS_BYTES) != hipSuccess) { fprintf(stderr, "kernel_launch: hipFuncSetAttribute failed\n"); grid = -1; return; }
        if (hipOccupancyMaxActiveBlocksPerMultiprocessor(&per_cu, (const void*)mega, 512, LDS_BYTES) != hipSuccess || per_cu < 1) { fprintf(stderr, "kernel_launch: occupancy query says %d\n", per_cu); per_cu = 1; }
        (void)hipGetLastError();
        grid = cus * per_cu;
    }
    if (grid < 0) return;
    Params p{};
    for (int i = 0; i < 34; ++i) p.in[i] = (const float*)d_in[i];
    p.out = (float*)d_out; p.ws = (unsigned char*)d_ws;
#if MULTI_LAUNCH
    for (int ph = 0; ph < 18; ++ph) { p.ph_lo = ph; p.ph_hi = ph + 1; hipLaunchKernelGGL(mega, dim3(grid), dim3(512), LDS_BYTES, stream, p); }
#else
    p.ph_lo = 0; p.ph_hi = 18;
    void* args[] = {&p};
    hipError_t e = hipLaunchCooperativeKernel((const void*)mega, dim3(grid), dim3(512), args, LDS_BYTES, stream);
    if (e != hipSuccess) fprintf(stderr, "cooperative launch failed: %s (grid %d)\n", hipGetErrorString(e), grid);
#endif
}
```

```cpp
#include <hip/hip_runtime.h>
#include <hip/hip_cooperative_groups.h>
#include <cstdio>
#include <cstdint>
namespace cg = cooperative_groups;

#ifndef MULTI_LAUNCH
#define MULTI_LAUNCH 0
#endif

typedef unsigned short bf16_t;
typedef short bf16x8 __attribute__((ext_vector_type(8)));
typedef float f32x4 __attribute__((ext_vector_type(4)));
typedef unsigned u32x4 __attribute__((ext_vector_type(4)));
typedef unsigned u32x2 __attribute__((ext_vector_type(2)));
#define LAS __attribute__((address_space(3)))

constexpr int D = 1024, NROWS = 67072, NS0 = 65536, NM0 = 66560;
constexpr int TP = 2064, TS = 64, NB_P = 32, NB_S = 16, PAST = 2048;
constexpr int IN_COLS = 7440, N1 = 7680;
constexpr int SSQ_SLOTS = NM0 + 32 * 32;
constexpr float EPS = 1e-6f;
constexpr size_t O_YP = 0, O_YS = 67108864ull, O_KP = O_YS + 1048576ull, SZ_KP = 2ull * 32 * 2064 * 512, O_VP = O_KP + SZ_KP,
                 O_CONVP = O_VP + SZ_KP, O_SSDP = O_CONVP + 2ull * 32 * 3 * 1280, O_S5RP = O_SSDP + 2ull * 32 * 16 * 4096, O_S5IP = O_S5RP + 2ull * 32 * 2048,
                 O_KS = O_S5IP + 2ull * 32 * 2048, O_VS = O_KS + 2ull * 16 * 64 * 512, O_CONVS = O_VS + 2ull * 16 * 64 * 512, O_SSDS = O_CONVS + 2ull * 16 * 3 * 1280,
                 O_S5RS = O_SSDS + 2ull * 16 * 16 * 4096, O_S5IS = O_S5RS + 2ull * 16 * 2048, O_END = O_S5IS + 2ull * 16 * 2048;
constexpr size_t W_BT1 = 0, W_GLU = W_BT1 + (size_t)N1 * 1024 * 2, W_LA = W_GLU + 2048ull * 512 * 2, W_LC = W_LA + 1024ull * 1024 * 2, W_OUT = W_LC + 1024ull * 512 * 2,
                 W_UP = W_OUT + 1024ull * 1024 * 2, W_DOWN = W_UP + 4096ull * 1024 * 2, W_END = W_DOWN + 4096ull * 1024 * 2;
constexpr size_t WS_CTR = W_END, WS_XMETA = WS_CTR + 4096, WS_HB = WS_XMETA + 512ull * 1024 * 4, WS_Z = WS_HB + (size_t)NROWS * 1024 * 2, WS_XBC = WS_Z + (size_t)NROWS * 1024 * 2,
                 WS_U = WS_XBC + (size_t)NROWS * 1280 * 2, WS_Q = WS_U + (size_t)NROWS * 512 * 2, WS_G = WS_Q + (size_t)NROWS * 512 * 2, WS_DT = WS_G + (size_t)NROWS * 3072 * 2,
                 WS_SSQ = WS_DT + (size_t)NROWS * 16 * 4, WS_END = WS_SSQ + (size_t)SSQ_SLOTS * 16 * 4;
constexpr size_t WS_ACT = WS_Z;
static_assert(WS_ACT + (size_t)NROWS * 4096 * 2 <= WS_DT, "ACT overlay");
constexpr int LDS_BYTES = 147456;

struct Params {
    const float* in[34];
    float* out;
    unsigned char* ws;
    int ph_lo, ph_hi;
};
typedef const __attribute__((address_space(4))) Params* CPar;
__device__ __forceinline__ CPar params_ptr() { CPar q = (CPar)__builtin_amdgcn_kernarg_segment_ptr(); asm volatile("" : "+s"(q)); return q; }
#define PIN(i) (p->in[i])
enum { I_XP = 0, I_XS, I_CK, I_CV, I_SCONV, I_SSSD, I_S5R, I_S5I, I_META, I_NMIX, I_WIN, I_CONVW, I_CONVB, I_DTB, I_ALOG, I_DSSD, I_NSSD, I_LRE, I_LIM, I_LSTEP, I_BRE, I_BIM,
       I_CRE, I_CIM, I_DS5, I_WGLU, I_QN, I_KN, I_WLA, I_WLC, I_WOUT, I_NFFN, I_WUP, I_WDOWN };

__device__ __forceinline__ int ltid() { int t = threadIdx.x; asm volatile("" : "+v"(t)); return t; }
__device__ __forceinline__ int lbid() { int t = blockIdx.x; asm volatile("" : "+s"(t)); return t; }
__device__ __forceinline__ int lgdim() { int t = gridDim.x; asm volatile("" : "+s"(t)); return t; }

__device__ __forceinline__ float bf2f(bf16_t v) { return __uint_as_float((unsigned)v << 16); }
__device__ __forceinline__ unsigned pk2(float lo, float hi) { unsigned r; asm volatile("v_cvt_pk_bf16_f32 %0, %1, %2" : "=v"(r) : "v"(lo), "v"(hi)); return r; }
__device__ __forceinline__ float lo_f(unsigned w) { return __uint_as_float(w << 16); }
__device__ __forceinline__ float hi_f(unsigned w) { return __uint_as_float(w & 0xffff0000u); }
__device__ __forceinline__ u32x2 ld_l2_u32x2(const void* ptr) { const unsigned long long v = __hip_atomic_load((const unsigned long long*)ptr, __ATOMIC_RELAXED, __HIP_MEMORY_SCOPE_AGENT); u32x2 r; r[0] = (unsigned)v; r[1] = (unsigned)(v >> 32); return r; }
__device__ __forceinline__ float sigmoidf_(float v) { return __builtin_amdgcn_rcpf(1.f + __expf(-v)); }
__device__ __forceinline__ float siluf_(float v) { return v * sigmoidf_(v); }
__device__ __forceinline__ float geluf_(float y) { const float a = 0.7978845608f * (y + 0.044715f * y * y * y); const float t = __expf(2.f * a); return 0.5f * y * (2.f - 2.f * __builtin_amdgcn_rcpf(t + 1.f)); }
__device__ __forceinline__ float wave_sum(float v) {
#pragma unroll
    for (int o = 1; o < 64; o <<= 1) v += __shfl_xor(v, o);
    return v;
}
__device__ __forceinline__ void sincos_red(double x, float& sn, float& cs) {
    const double k = __builtin_rint(x * 0.63661977236758134308);
    const float r = (float)__builtin_fma(-k, 1.57079632679489661923, x), r2 = r * r;
    const float sp = r + r * r2 * (-1.6666667163e-01f + r2 * (8.3333337680e-03f + r2 * (-1.9841270114e-04f + r2 * 2.7557314297e-06f)));
    const float cp = 1.f + r2 * (-0.5f + r2 * (4.1666667908e-02f + r2 * (-1.3888889225e-03f + r2 * (2.4801587642e-05f - r2 * 2.7557314297e-07f))));
    const int q = ((int)k) & 3;
    sn = (q == 0) ? sp : (q == 1) ? cp : (q == 2) ? -sp : -cp;
    cs = (q == 0) ? cp : (q == 1) ? -sp : (q == 2) ? -cp : sp;
}
__device__ __forceinline__ int row_of(int s, int t) { return s < 32 ? (t < 16 ? NM0 + s * 16 + t : s * 2048 + t - 16) : NS0 + (s - 32) * 64 + t; }
__device__ __forceinline__ int ssq_slot(int r) { return r < NM0 ? r : NM0 + ((r - NM0) >> 4) * 32 + ((r - NM0) & 15); }
__device__ __forceinline__ float* xloc(CPar p, int r) { return r < NM0 ? p->out + (size_t)r * 1024 : (float*)(p->ws + WS_XMETA) + (size_t)(r - NM0) * 1024; }
__device__ __forceinline__ size_t k_off(int l, int r) {
    if (r < NS0) return O_KP + ((size_t)(l * 32 + (r >> 11)) * 2064 + 16 + (r & 2047)) * 512;
    if (r < NM0) { const int rs = r - NS0; return O_KS + ((size_t)(l * 16 + (rs >> 6)) * 64 + (rs & 63)) * 512; }
    const int rm = r - NM0; return O_KP + ((size_t)(l * 32 + (rm >> 4)) * 2064 + (rm & 15)) * 512;
}

namespace pg8 {
constexpr int BM = 256, BK = 64, HALF = 128, HTB = HALF * BK * 2, STAGE_BYTES = 8 * HTB, NXCD = 8, WGM = 8;
__host__ __device__ __forceinline__ int lds_byte(int r, int c) { const int st = (r >> 4) * 2 + (c >> 5), rr = r & 15, cc = c & 31, ob = rr * 64 + cc * 2; return st * 1024 + (ob ^ (((ob >> 9) & 1) << 5)); }
__host__ __device__ __forceinline__ void stage_rc(int b, int& R, int& C) { const int st = b / 1024, sb = b % 1024, swz = sb ^ (((sb >> 9) & 1) << 5); R = (st >> 1) * 16 + swz / 64; C = (st & 1) * 32 + (swz % 64) / 2; }
struct Unit { int pm, pn; };
struct Gemm { const bf16_t* A; const bf16_t* Bt; int M, N, K, lda, ldb; };
struct StaticOrder {
    int nM, nN, nwg, G, c;
    __device__ void init(int M, int N, int G_, int c_) { nM = M / BM; nN = N / BM; nwg = nM * nN; G = G_; c = c_; }
    __device__ bool next(int i, Unit& u) const {
        const long L = (long)i * G + c; if (L >= nwg) return false;
        int wgid = (int)L; { const int q = nwg / NXCD, r = nwg % NXCD, xcd = wgid % NXCD, off = wgid / NXCD; wgid = (xcd < r ? xcd * (q + 1) : r * (q + 1) + (xcd - r) * q) + off; }
        const int nig = WGM * nN, gid = wgid / nig, fm = gid * WGM, gsz = (nM - fm) < WGM ? (nM - fm) : WGM;
        u.pm = fm + ((wgid % nig) % gsz); u.pn = (wgid % nig) / gsz; return true;
    }
};
template <class Epi>
__device__ __forceinline__ void gemm_phase(LAS unsigned char* lds, const Gemm g, const StaticOrder& S, const Epi& E) {
    const int tid = ltid(), wid = __builtin_amdgcn_readfirstlane(tid >> 6), lane = tid & 63, wr = wid >> 2, wc = wid & 3, fr = lane & 15, fq = lane >> 4;
    const int K = g.K, nt = K / BK;
    unsigned voffA[2], voffB[2];
#pragma unroll
    for (int i = 0; i < 2; ++i) { int R, C; stage_rc(tid * 16 + i * 8192, R, C); voffA[i] = (unsigned)(R * g.lda + C) * 2u; voffB[i] = (unsigned)(R * g.ldb + C) * 2u; }
    const size_t kstep = (size_t)(BK * 2);
    const size_t hstepA = (size_t)HALF * g.lda * 2, hstepB = (size_t)HALF * g.ldb * 2;
    const size_t tstepA = 2 * hstepA, tstepB = 2 * hstepB;
    const unsigned ldsw = (unsigned)wid * 1024u;
    const int aoff = lds_byte(wr * 64 + fr, fq * 8), boff = lds_byte(wc * 32 + fr, fq * 8);
#define PG8_SA(b, h) (((b) * 2 + (h)) * HTB)
#define PG8_SB(b, h) ((4 + (b) * 2 + (h)) * HTB)
#define PG8_STAGE(bufoff, gbase, voff) do { _Pragma("unroll") for (int _i = 0; _i < 2; ++_i) \
        __builtin_amdgcn_global_load_lds((const unsigned*)((const char*)(gbase) + (voff)[_i]), (LAS unsigned*)(lds + (bufoff) + ldsw + _i * 8192), 16, 0, 0); } while (0)
#define PG8_LDA(dst, b, h) do { _Pragma("unroll") for (int m = 0; m < 4; ++m) _Pragma("unroll") for (int k = 0; k < 2; ++k) dst[m][k] = *(const LAS bf16x8*)(lds + PG8_SA(b, h) + aoff + m * 2048 + k * 1024); } while (0)
#define PG8_LDB(dst, b, h) do { _Pragma("unroll") for (int n = 0; n < 2; ++n) _Pragma("unroll") for (int k = 0; k < 2; ++k) dst[n][k] = *(const LAS bf16x8*)(lds + PG8_SB(b, h) + boff + n * 2048 + k * 1024); } while (0)
#define PG8_MMA(ai, bj, At, Bt) do { __builtin_amdgcn_s_setprio(1); _Pragma("unroll") for (int m = 0; m < 4; ++m) _Pragma("unroll") for (int n = 0; n < 2; ++n) _Pragma("unroll") for (int k = 0; k < 2; ++k) \
        acc[ai][bj][m][n] = __builtin_amdgcn_mfma_f32_16x16x32_bf16(Bt[n][k], At[m][k], acc[ai][bj][m][n], 0, 0, 0); __builtin_amdgcn_s_setprio(0); } while (0)
#define PG8_WAIT_V(n) asm volatile("s_waitcnt vmcnt(" #n ")" ::: "memory")
#define PG8_WAIT_L(n) asm volatile("s_waitcnt lgkmcnt(" #n ")" ::: "memory")
#define PG8_BAR __builtin_amdgcn_s_barrier()
#define PG8_SCHED __builtin_amdgcn_sched_barrier(0)
    Unit cur, nxt; int ui = 0;
    if (!S.next(0, cur)) return;
    f32x4 acc[2][2][4][2];
#pragma unroll
    for (int a = 0; a < 2; ++a)
#pragma unroll
        for (int b = 0; b < 2; ++b)
#pragma unroll
            for (int m = 0; m < 4; ++m)
#pragma unroll
                for (int n = 0; n < 2; ++n) acc[a][b][m][n] = (f32x4){0.f, 0.f, 0.f, 0.f};
    bf16x8 At[4][2], B0[2][2], B1[2][2];
    const char* cA = (const char*)g.A + (size_t)cur.pm * tstepA; const char* cB = (const char*)g.Bt + (size_t)cur.pn * tstepB;
    PG8_STAGE(PG8_SB(0, 0), cB, voffB); PG8_STAGE(PG8_SA(0, 0), cA, voffA); PG8_STAGE(PG8_SB(0, 1), cB + hstepB, voffB); PG8_STAGE(PG8_SA(0, 1), cA + hstepA, voffA);
    if (wr == 1) PG8_BAR;
    PG8_WAIT_V(4); PG8_BAR;
    PG8_STAGE(PG8_SB(1, 0), cB + kstep, voffB); PG8_STAGE(PG8_SA(1, 0), cA + kstep, voffA); PG8_STAGE(PG8_SB(1, 1), cB + hstepB + kstep, voffB);
    PG8_WAIT_V(6); PG8_BAR;
    for (;;) {
        const bool has_next = S.next(ui + 1, nxt);
        const char* nA = has_next ? (const char*)g.A + (size_t)nxt.pm * tstepA : cA; const char* nB = has_next ? (const char*)g.Bt + (size_t)nxt.pn * tstepB : cB;
        for (int t = 0; t < nt; t += 2) {
            const bool last = (t == nt - 2);
            const char* a1 = cA + (size_t)(t + 1) * kstep;
            const char* a2 = last ? nA : cA + (size_t)(t + 2) * kstep; const char* b2 = last ? nB : cB + (size_t)(t + 2) * kstep;
            const char* a3 = a2 + kstep; const char* b3 = b2 + kstep;
            PG8_LDB(B0, 0, 0); PG8_SCHED; PG8_LDA(At, 0, 0); PG8_STAGE(PG8_SA(1, 1), a1 + hstepA, voffA);
            PG8_WAIT_L(8); PG8_BAR; PG8_WAIT_L(0); PG8_MMA(0, 0, At, B0); PG8_BAR; PG8_SCHED;
            PG8_LDB(B1, 0, 1); PG8_STAGE(PG8_SB(0, 0), b2, voffB);
            PG8_BAR; PG8_WAIT_L(0); PG8_MMA(0, 1, At, B1); PG8_BAR;
            PG8_LDA(At, 0, 1); PG8_STAGE(PG8_SA(0, 0), a2, voffA);
            PG8_BAR; PG8_WAIT_L(0); PG8_MMA(1, 0, At, B0); PG8_BAR; PG8_SCHED;
            PG8_STAGE(PG8_SB(0, 1), b2 + hstepB, voffB);
            PG8_WAIT_V(6); PG8_BAR; PG8_MMA(1, 1, At, B1); PG8_BAR;
            PG8_LDB(B0, 1, 0); PG8_SCHED; PG8_LDA(At, 1, 0); PG8_STAGE(PG8_SA(0, 1), a2 + hstepA, voffA);
            PG8_WAIT_L(8); PG8_BAR; PG8_WAIT_L(0); PG8_MMA(0, 0, At, B0); PG8_BAR; PG8_SCHED;
            PG8_LDB(B1, 1, 1); PG8_STAGE(PG8_SB(1, 0), b3, voffB);
            PG8_BAR; PG8_WAIT_L(0); PG8_MMA(0, 1, At, B1); PG8_BAR;
            PG8_LDA(At, 1, 1); PG8_STAGE(PG8_SA(1, 0), a3, voffA);
            PG8_BAR; PG8_WAIT_L(0); PG8_MMA(1, 0, At, B0); PG8_BAR; PG8_SCHED;
            PG8_STAGE(PG8_SB(1, 1), b3 + hstepB, voffB);
            PG8_WAIT_V(6); PG8_BAR; PG8_MMA(1, 1, At, B1); PG8_BAR;
        }
        E(acc, cur, wr, wc, fr, fq);
        if (!has_next) break;
#pragma unroll
        for (int a = 0; a < 2; ++a)
#pragma unroll
            for (int b = 0; b < 2; ++b)
#pragma unroll
                for (int m = 0; m < 4; ++m)
#pragma unroll
                    for (int n = 0; n < 2; ++n) acc[a][b][m][n] = (f32x4){0.f, 0.f, 0.f, 0.f};
        cur = nxt; cA = nA; cB = nB; ++ui;
    }
    PG8_WAIT_V(0);
    if (wr == 0) PG8_BAR;
    PG8_BAR;
#undef PG8_SA
#undef PG8_SB
#undef PG8_STAGE
#undef PG8_LDA
#undef PG8_LDB
#undef PG8_MMA
#undef PG8_WAIT_V
#undef PG8_WAIT_L
#undef PG8_BAR
#undef PG8_SCHED
}
}
using pg8::Unit;

struct EpiIn {
    bf16_t *Z, *XBC, *U, *Q, *G; float* DT; float* out; const float *qn, *kn; int layer;
    __device__ __forceinline__ void operator()(const f32x4 (&acc)[2][2][4][2], const Unit& u, int wr, int wc, int fr, int fq) const {
        const int pn = u.pn, rowb = u.pm * 256 + wr * 64 + fr, ctb = wc * 32 + fq * 4;
        if (pn < 11 || (pn >= 17 && pn < 29)) {
            bf16_t* base; int ld, col0; bool sig = false;
            if (pn < 4) { base = Z; ld = 1024; col0 = pn * 256; } else if (pn < 9) { base = XBC; ld = 1280; col0 = (pn - 4) * 256; }
            else if (pn < 11) { base = U; ld = 512; col0 = (pn - 9) * 256; } else { base = G; ld = 3072; col0 = (pn - 17) * 256; sig = true; }
#pragma unroll
            for (int ai = 0; ai < 2; ++ai)
#pragma unroll
                for (int m = 0; m < 4; ++m) { bf16_t* rp = base + (size_t)(rowb + ai * 128 + m * 16) * ld + col0 + ctb;
#pragma unroll
                    for (int bj = 0; bj < 2; ++bj)
#pragma unroll
                        for (int n = 0; n < 2; ++n) { f32x4 v = acc[ai][bj][m][n];
                            if (sig) { v[0] = sigmoidf_(v[0]); v[1] = sigmoidf_(v[1]); v[2] = sigmoidf_(v[2]); v[3] = sigmoidf_(v[3]); }
                            u32x2 o; o[0] = pk2(v[0], v[1]); o[1] = pk2(v[2], v[3]); *(u32x2*)(rp + bj * 128 + n * 16) = o; } }
        } else if (pn < 17) {
            const int seg = (pn - 11) >> 1, head = ((pn - 11) & 1) * 4 + wc;
            const float* nw = seg == 0 ? qn : kn;
            f32x4 wv[2][2];
#pragma unroll
            for (int bj = 0; bj < 2; ++bj)
#pragma unroll
                for (int n = 0; n < 2; ++n) wv[bj][n] = (seg < 2) ? *(const f32x4*)(nw + 32 * bj + 16 * n + 4 * fq) : (f32x4){1.f, 1.f, 1.f, 1.f};
#pragma unroll
            for (int ai = 0; ai < 2; ++ai)
#pragma unroll
                for (int m = 0; m < 4; ++m) { const int row = rowb + ai * 128 + m * 16;
                    float rs = 1.f;
                    if (seg < 2) { float ss = 0.f;
#pragma unroll
                        for (int bj = 0; bj < 2; ++bj)
#pragma unroll
                            for (int n = 0; n < 2; ++n) { const f32x4 v = acc[ai][bj][m][n]; ss += v[0] * v[0] + v[1] * v[1] + v[2] * v[2] + v[3] * v[3]; }
                        ss += __shfl_xor(ss, 16); ss += __shfl_xor(ss, 32);
                        rs = rsqrtf(ss * (1.f / 64.f) + EPS); }
                    if (seg == 0) { bf16_t* rp = Q + (size_t)row * 512 + head * 64 + 4 * fq;
#pragma unroll
                        for (int bj = 0; bj < 2; ++bj)
#pragma unroll
                            for (int n = 0; n < 2; ++n) { const f32x4 v = acc[ai][bj][m][n] * rs * wv[bj][n]; u32x2 o; o[0] = pk2(v[0], v[1]); o[1] = pk2(v[2], v[3]); *(u32x2*)(rp + 32 * bj + 16 * n) = o; }
                    } else { float* rp = out + k_off(layer, row) + (seg == 2 ? (row >= NS0 && row < NM0 ? (O_VS - O_KS) : (O_VP - O_KP)) : 0) + head * 64 + 4 * fq;
#pragma unroll
                        for (int bj = 0; bj < 2; ++bj)
#pragma unroll
                            for (int n = 0; n < 2; ++n) { const f32x4 v = acc[ai][bj][m][n] * rs * wv[bj][n]; *(f32x4*)(rp + 32 * bj + 16 * n) = v; } } }
        } else {
            if (wc == 0) {
#pragma unroll
                for (int ai = 0; ai < 2; ++ai)
#pragma unroll
                    for (int m = 0; m < 4; ++m) *(f32x4*)(DT + (size_t)(rowb + ai * 128 + m * 16) * 16 + 4 * fq) = acc[ai][0][m][0];
            }
        }
    }
};
struct EpiGlu {
    bf16_t* OB;
    __device__ __forceinline__ void operator()(const f32x4 (&acc)[2][2][4][2], const Unit& u, int wr, int wc, int fr, int fq) const {
        const int rowb = u.pm * 256 + wr * 64 + fr, colb = u.pn * 128 + wc * 32 + fq * 4;
#pragma unroll
        for (int ai = 0; ai < 2; ++ai)
#pragma unroll
            for (int m = 0; m < 4; ++m) { bf16_t* rp = OB + (size_t)(rowb + ai * 128 + m * 16) * 1024 + colb;
#pragma unroll
                for (int n = 0; n < 2; ++n) { const f32x4 a = acc[ai][0][m][n], g = acc[ai][1][m][n];
                    u32x2 o; o[0] = pk2(a[0] * sigmoidf_(g[0]), a[1] * sigmoidf_(g[1])); o[1] = pk2(a[2] * sigmoidf_(g[2]), a[3] * sigmoidf_(g[3])); *(u32x2*)(rp + n * 16) = o; } }
    }
};
struct EpiMix {
    bf16_t* R; const bf16_t* G; const bf16_t* OB; int accum;
    __device__ __forceinline__ void operator()(const f32x4 (&acc)[2][2][4][2], const Unit& u, int wr, int wc, int fr, int fq) const {
        const int rowb = u.pm * 256 + wr * 64 + fr, colb = u.pn * 256 + wc * 32 + fq * 4;
#pragma unroll
        for (int ai = 0; ai < 2; ++ai)
#pragma unroll
            for (int m = 0; m < 4; ++m) { const int row = rowb + ai * 128 + m * 16;
#pragma unroll
                for (int bj = 0; bj < 2; ++bj)
#pragma unroll
                    for (int n = 0; n < 2; ++n) { const int col = colb + bj * 128 + n * 16; f32x4 v = acc[ai][bj][m][n];
                        const u32x2 gw = *(const u32x2*)(G + (size_t)row * 3072 + col);
                        v = v * (f32x4){lo_f(gw[0]), hi_f(gw[0]), lo_f(gw[1]), hi_f(gw[1])};
                        if (OB) { const u32x2 g1 = *(const u32x2*)(G + (size_t)row * 3072 + 1024 + col), ob = *(const u32x2*)(OB + (size_t)row * 1024 + col);
                            v = v + (f32x4){lo_f(g1[0]), hi_f(g1[0]), lo_f(g1[1]), hi_f(g1[1])} * (f32x4){lo_f(ob[0]), hi_f(ob[0]), lo_f(ob[1]), hi_f(ob[1])}; }
                        bf16_t* rp = R + (size_t)row * 1024 + col;
                        if (accum) { const u32x2 rw = ld_l2_u32x2(rp); v = v + (f32x4){lo_f(rw[0]), hi_f(rw[0]), lo_f(rw[1]), hi_f(rw[1])}; }
                        u32x2 o; o[0] = pk2(v[0], v[1]); o[1] = pk2(v[2], v[3]); *(u32x2*)rp = o; } }
    }
};
struct EpiRes {
    float* out; float* xmeta;
    __device__ __forceinline__ void operator()(const f32x4 (&acc)[2][2][4][2], const Unit& u, int wr, int wc, int fr, int fq) const {
        const int rowb = u.pm * 256 + wr * 64 + fr, colb = u.pn * 256 + wc * 32 + fq * 4;
        float* base = (u.pm * 256 < NM0) ? out : xmeta - (size_t)NM0 * 1024;
#pragma unroll
        for (int ai = 0; ai < 2; ++ai)
#pragma unroll
            for (int m = 0; m < 4; ++m) { float* rp = base + (size_t)(rowb + ai * 128 + m * 16) * 1024 + colb;
#pragma unroll
                for (int bj = 0; bj < 2; ++bj)
#pragma unroll
                    for (int n = 0; n < 2; ++n) { f32x4* q = (f32x4*)(rp + bj * 128 + n * 16); *q = *q + acc[ai][bj][m][n]; } }
    }
};
struct EpiUp {
    bf16_t* ACT;
    __device__ __forceinline__ void operator()(const f32x4 (&acc)[2][2][4][2], const Unit& u, int wr, int wc, int fr, int fq) const {
        const int rowb = u.pm * 256 + wr * 64 + fr, colb = u.pn * 256 + wc * 32 + fq * 4;
#pragma unroll
        for (int ai = 0; ai < 2; ++ai)
#pragma unroll
            for (int m = 0; m < 4; ++m) { bf16_t* rp = ACT + (size_t)(rowb + ai * 128 + m * 16) * 4096 + colb;
#pragma unroll
                for (int bj = 0; bj < 2; ++bj)
#pragma unroll
                    for (int n = 0; n < 2; ++n) { f32x4 v = acc[ai][bj][m][n];
#pragma unroll
                        for (int j = 0; j < 4; ++j) { const float r = fmaxf(v[j], 0.f); v[j] = r * r; }
                        u32x2 o; o[0] = pk2(v[0], v[1]); o[1] = pk2(v[2], v[3]); *(u32x2*)(rp + bj * 128 + n * 16) = o; } }
    }
};

__device__ __forceinline__ int col_in(int n) {
    if (n < 2304) return n;
    if (n < 2816) return n + 16;
    if (n < 4352) { const int w0 = n - 2816, seg = w0 >> 9, w = w0 & 511, tile = w >> 8, ct = w & 255, bj = ct >> 7, wc = (ct >> 5) & 3, ww = ct & 31;
        return 2832 + seg * 512 + (tile * 4 + wc) * 64 + 32 * bj + ww; }
    if (n < 7424) return n + 16;
    if (n < 7440) return 2304 + (n - 7424);
    return -1;
}
template <int MAP>
__device__ __forceinline__ void prep_w(bf16_t* dst, const float* src, int K, int N, int ld, const float* scale, size_t gtid, size_t gsz) {
    const size_t items = (size_t)(K / 8) * N;
    for (size_t it = gtid; it < items; it += gsz) {
        const int n = (int)(it % N), k8 = (int)(it / N);
        const int c = MAP == 1 ? col_in(n) : (MAP == 2 ? (((n >> 7) & 1) * 1024 + (n >> 8) * 128 + (n & 127)) : n);
        float v[8];
#pragma unroll
        for (int kk = 0; kk < 8; ++kk) { const int k = k8 * 8 + kk; float x = (c >= 0) ? src[(size_t)k * ld + c] : 0.f; if (scale) x *= scale[k]; v[kk] = x; }
        u32x4 o; o[0] = pk2(v[0], v[1]); o[1] = pk2(v[2], v[3]); o[2] = pk2(v[4], v[5]); o[3] = pk2(v[6], v[7]);
        *(u32x4*)(dst + (size_t)n * K + k8 * 8) = o;
    }
}
__device__ __forceinline__ void rmsnorm_rows(CPar p, const float* g, int from_inputs) {
    const int lane = ltid() & 63, gw = lbid() * 8 + (ltid() >> 6), ngw = lgdim() * 8;
    bf16_t* HB = (bf16_t*)(p->ws + WS_HB);
    f32x4 gv[4];
#pragma unroll
    for (int j = 0; j < 4; ++j) gv[j] = *(const f32x4*)(g + lane * 4 + 256 * j);
    for (int r = gw; r < NROWS; r += ngw) {
        float* xl = xloc(p, r);
        const float* src = xl;
        if (from_inputs) src = r < NS0 ? p->in[I_XP] + (size_t)r * 1024 : (r < NM0 ? p->in[I_XS] + (size_t)(r - NS0) * 1024 : p->in[I_META] + (size_t)((r - NM0) & 15) * 1024);
        f32x4 v[4]; float s = 0.f;
#pragma unroll
        for (int j = 0; j < 4; ++j) { v[j] = *(const f32x4*)(src + lane * 4 + 256 * j); s += (v[j][0] * v[j][0] + v[j][1] * v[j][1]) + (v[j][2] * v[j][2] + v[j][3] * v[j][3]); }
        const float rstd = rsqrtf(wave_sum(s) * (1.f / 1024.f) + EPS);
#pragma unroll
        for (int j = 0; j < 4; ++j) { if (from_inputs) *(f32x4*)(xl + lane * 4 + 256 * j) = v[j];
            const f32x4 h = v[j] * rstd * gv[j]; u32x2 o; o[0] = pk2(h[0], h[1]); o[1] = pk2(h[2], h[3]); *(u32x2*)(HB + (size_t)r * 1024 + lane * 4 + 256 * j) = o; }
    }
}
__device__ __forceinline__ void ssd_norm_rows(CPar p) {
    const int lane = ltid() & 63, gw = lbid() * 8 + (ltid() >> 6), ngw = lgdim() * 8;
    bf16_t* Z = (bf16_t*)(p->ws + WS_Z);
    for (int r = gw; r < NROWS; r += ngw) {
#pragma unroll
        for (int j = 0; j < 2; ++j) { u32x4* zp = (u32x4*)(Z + (size_t)r * 1024 + j * 512 + lane * 8); const u32x4 w = *zp;
            float f[8] = {lo_f(w[0]), hi_f(w[0]), lo_f(w[1]), hi_f(w[1]), lo_f(w[2]), hi_f(w[2]), lo_f(w[3]), hi_f(w[3])};
            float ss = 0.f;
#pragma unroll
            for (int i = 0; i < 8; ++i) ss += f[i] * f[i];
            const float rs = rsqrtf(wave_sum(ss) * (1.f / 512.f) + EPS);
            u32x4 o; o[0] = pk2(f[0] * rs, f[1] * rs); o[1] = pk2(f[2] * rs, f[3] * rs); o[2] = pk2(f[4] * rs, f[5] * rs); o[3] = pk2(f[6] * rs, f[7] * rs); *zp = o; }
    }
}
__device__ __forceinline__ void phase_prep(CPar p, int l) {
    const size_t gtid = (size_t)lbid() * 512 + ltid(), gsz = (size_t)lgdim() * 512;
    unsigned char* ws = p->ws;
    prep_w<1>((bf16_t*)(ws + W_BT1), p->in[I_WIN] + (size_t)l * 1024 * IN_COLS, 1024, N1, IN_COLS, nullptr, gtid, gsz);
    prep_w<2>((bf16_t*)(ws + W_GLU), p->in[I_WGLU] + (size_t)l * 512 * 2048, 512, 2048, 2048, nullptr, gtid, gsz);
    prep_w<0>((bf16_t*)(ws + W_LA), p->in[I_WLA] + (size_t)l * 1024 * 1024, 1024, 1024, 1024, p->in[I_NSSD] + l * 1024, gtid, gsz);
    prep_w<0>((bf16_t*)(ws + W_LC), p->in[I_WLC] + (size_t)l * 512 * 1024, 512, 1024, 1024, nullptr, gtid, gsz);
    prep_w<0>((bf16_t*)(ws + W_OUT), p->in[I_WOUT] + (size_t)l * 1024 * 1024, 1024, 1024, 1024, nullptr, gtid, gsz);
    prep_w<0>((bf16_t*)(ws + W_UP), p->in[I_WUP] + (size_t)l * 1024 * 4096, 1024, 4096, 4096, nullptr, gtid, gsz);
    prep_w<0>((bf16_t*)(ws + W_DOWN), p->in[I_WDOWN] + (size_t)l * 4096 * 1024, 4096, 1024, 1024, nullptr, gtid, gsz);
    rmsnorm_rows(p, p->in[I_NMIX] + l * 1024, l == 0);
}

__device__ __forceinline__ bf16_t f2bf_(float v) { return (bf16_t)(pk2(v, v) & 0xffffu); }
__device__ __forceinline__ void ssd_item(CPar p, int l, int item, float* sm) {
    const int tid = ltid(), lane = tid & 63, wave = __builtin_amdgcn_readfirstlane(tid >> 6), rb = wave >> 1, chh = wave & 1, fr = lane & 15, fq = lane >> 4;
    const int s = item < 512 ? (item >> 4) : 32 + ((item - 512) >> 4), h = item & 15, g = h >> 3;
    const bool prompt = s < 32; const int b = prompt ? s : s - 32, T = prompt ? TP : TS;
    constexpr int LB = 72;
    bf16_t *Cb = (bf16_t*)sm, *Bb = Cb + 64 * LB, *XT = Bb + 64 * LB, *WB = XT + 64 * LB, *Mb = WB + 64 * LB, *Sb = Mb + 64 * LB;
    float *sRaw = (float*)(Sb + 64 * LB), *sW = sRaw + 67 * 192, *sdtA = sW + 5 * 192, *sacA = sdtA + 33 * 64, *sw = sacA + 33 * 64;
    const bf16_t* XBC = (const bf16_t*)(p->ws + WS_XBC); bf16_t* Z = (bf16_t*)(p->ws + WS_Z);
    const float* DT = (const float*)(p->ws + WS_DT);
    const float* cw = p->in[I_CONVW] + (size_t)l * 4 * 1280; const float* cb = p->in[I_CONVB] + (size_t)l * 1280;
    const float* hist = p->in[I_SCONV] + (size_t)(l * 16 + b) * 3 * 1280;
    const float dtb = p->in[I_DTB][l * 16 + h], aneg = -__expf(p->in[I_ALOG][l * 16 + h]), dsk = p->in[I_DSSD][l * 16 + h];
    float* sout = prompt ? p->out + O_SSDP + ((size_t)(l * 32 + b) * 16 + h) * 4096 : p->out + O_SSDS + ((size_t)(l * 16 + b) * 16 + h) * 4096;
    for (int i = tid; i < 5 * 192; i += 512) { const int k = i / 192, ch = i - k * 192; const int col = ch < 64 ? h * 64 + ch : (ch < 128 ? 1024 + g * 64 + (ch - 64) : 1152 + g * 64 + (ch - 128));
        sW[i] = k < 4 ? cw[k * 1280 + col] : cb[col]; }
    f32x4 accS[2];
#pragma unroll
    for (int c2 = 0; c2 < 2; ++c2)
#pragma unroll
        for (int r = 0; r < 4; ++r) { const int pp = rb * 16 + fq * 4 + r, n = chh * 32 + c2 * 16 + fr;
            const float v = prompt ? 0.f : p->in[I_SSSD][((size_t)(l * 16 + b) * 16 + h) * 4096 + pp * 64 + n]; accS[c2][r] = v; Sb[pp * LB + n] = f2bf_(v); }
    const int nch = (T + 63) >> 6;
    { const int wv = tid >> 6, ln = tid & 63; float xv[5];
#pragma unroll
        for (int r = 0; r < 5; ++r) { const int c = wv + 8 * r, t = c * 64 + ln; xv[r] = (c < nch && t < T) ? DT[(size_t)row_of(s, t) * 16 + h] + dtb : -1e30f; }
#pragma unroll
        for (int r = 0; r < 5; ++r) { const int c = wv + 8 * r;
            if (c < nch) { const float x = xv[r]; const float dtv = x < -1e29f ? 0.f : (x > 20.f ? x : log1pf(__expf(x))); float cs = dtv * aneg;
#pragma unroll
                for (int o = 1; o < 64; o <<= 1) { const float nb = __shfl_up(cs, o); if (ln >= o) cs += nb; }
                sdtA[c * 64 + ln] = dtv; sacA[c * 64 + ln] = cs; } } }
    u32x4 pf[4];
#define SSD_ISSUE(cc) do { _Pragma("unroll") for (int it4 = 0; it4 < 4; ++it4) { const int pi = tid + it4 * 512; pf[it4] = (u32x4){0u, 0u, 0u, 0u}; \
        if (pi < 67 * 24) { const int rl = pi / 24, pc = pi - rl * 24, seg = pc >> 3, q8 = pc & 7, tt = (cc) * 64 - 3 + rl; \
            const int col = (seg == 0 ? h * 64 : (seg == 1 ? 1024 + g * 64 : 1152 + g * 64)) + q8 * 8; \
            if (tt >= 0 && tt < T) pf[it4] = *(const u32x4*)(XBC + (size_t)row_of(s, tt) * 1280 + col); } } } while (0)
#define SSD_FRAG(P, r0, ks) (*(const bf16x8*)((P) + ((r0) + fr) * LB + (ks) * 32 + fq * 8))
    SSD_ISSUE(0);
#pragma unroll 1
    for (int c = 0; c < nch; ++c) {
        const int t0 = c * 64; const float* sdt = sdtA + t0; const float* sac = sacA + t0;
        __syncthreads();
#pragma unroll
        for (int it4 = 0; it4 < 4; ++it4) { const int pi = tid + it4 * 512;
            if (pi < 67 * 24) { const int rl = pi / 24, pc = pi - rl * 24, seg = pc >> 3, q8 = pc & 7, tt = t0 - 3 + rl;
                const u32x4 w = pf[it4];
                f32x4 f0 = {lo_f(w[0]), hi_f(w[0]), lo_f(w[1]), hi_f(w[1])}, f1 = {lo_f(w[2]), hi_f(w[2]), lo_f(w[3]), hi_f(w[3])};
                if (tt < 0 && !prompt) { const int col = (seg == 0 ? h * 64 : (seg == 1 ? 1024 + g * 64 : 1152 + g * 64)) + q8 * 8; const float* hp = hist + (3 + tt) * 1280 + col; f0 = *(const f32x4*)hp; f1 = *(const f32x4*)(hp + 4); }
                float* dp = sRaw + rl * 192 + seg * 64 + q8 * 8; *(f32x4*)dp = f0; *(f32x4*)(dp + 4) = f1; } }
        if (tid < 64) sw[tid] = __expf(sac[63] - sac[tid]) * sdt[tid];
        if (c + 1 < nch) SSD_ISSUE(c + 1);
        __syncthreads();
#pragma unroll 4
        for (int idx = tid; idx < 64 * 192; idx += 512) {
            const int tl = idx / 192, ch = idx - tl * 192, t = t0 + tl;
            float v = 0.f;
            if (t < T) { v = sW[4 * 192 + ch];
#pragma unroll
                for (int k = 0; k < 4; ++k) v += sRaw[(tl + k) * 192 + ch] * sW[k * 192 + ch];
                v = siluf_(v); }
            const int cc = ch & 63;
            if (ch < 64) XT[cc * LB + tl] = f2bf_(v);
            else if (ch < 128) { Bb[tl * LB + cc] = f2bf_(v); WB[cc * LB + tl] = f2bf_(v * sw[tl]); }
            else Cb[tl * LB + cc] = f2bf_(v);
        }
        __syncthreads();
        f32x4 acc2[2];
        { const bf16x8 aC0 = SSD_FRAG(Cb, rb * 16, 0), aC1 = SSD_FRAG(Cb, rb * 16, 1);
#pragma unroll
            for (int c2 = 0; c2 < 2; ++c2) { const int j0 = chh * 32 + c2 * 16;
                f32x4 m = {0.f, 0.f, 0.f, 0.f};
                if (j0 <= rb * 16 + 15) { m = __builtin_amdgcn_mfma_f32_16x16x32_bf16(aC0, SSD_FRAG(Bb, j0, 0), m, 0, 0, 0); m = __builtin_amdgcn_mfma_f32_16x16x32_bf16(aC1, SSD_FRAG(Bb, j0, 1), m, 0, 0, 0); }
                const int j = j0 + fr; const float acj = sac[j], dtj = sdt[j];
#pragma unroll
                for (int r = 0; r < 4; ++r) { const int tl = rb * 16 + fq * 4 + r; Mb[tl * LB + j] = f2bf_(j <= tl ? m[r] * __expf(sac[tl] - acj) * dtj : 0.f); }
                f32x4 y = {0.f, 0.f, 0.f, 0.f};
                y = __builtin_amdgcn_mfma_f32_16x16x32_bf16(aC0, SSD_FRAG(Sb, j0, 0), y, 0, 0, 0); y = __builtin_amdgcn_mfma_f32_16x16x32_bf16(aC1, SSD_FRAG(Sb, j0, 1), y, 0, 0, 0);
#pragma unroll
                for (int r = 0; r < 4; ++r) y[r] *= __expf(sac[rb * 16 + fq * 4 + r]);
                acc2[c2] = y; }
            const bf16x8 aX0 = SSD_FRAG(XT, rb * 16, 0), aX1 = SSD_FRAG(XT, rb * 16, 1); const float eL = __expf(sac[63]);
#pragma unroll
            for (int c2 = 0; c2 < 2; ++c2) { const int n0 = chh * 32 + c2 * 16; f32x4 sv = accS[c2] * eL;
                sv = __builtin_amdgcn_mfma_f32_16x16x32_bf16(aX0, SSD_FRAG(WB, n0, 0), sv, 0, 0, 0); sv = __builtin_amdgcn_mfma_f32_16x16x32_bf16(aX1, SSD_FRAG(WB, n0, 1), sv, 0, 0, 0); accS[c2] = sv; } }
        __syncthreads();
        { const bf16x8 aM0 = SSD_FRAG(Mb, rb * 16, 0), aM1 = SSD_FRAG(Mb, rb * 16, 1);
#pragma unroll
            for (int c2 = 0; c2 < 2; ++c2) { const int p0 = chh * 32 + c2 * 16, pp = p0 + fr; f32x4 y = acc2[c2];
                y = __builtin_amdgcn_mfma_f32_16x16x32_bf16(aM0, SSD_FRAG(XT, p0, 0), y, 0, 0, 0); y = __builtin_amdgcn_mfma_f32_16x16x32_bf16(aM1, SSD_FRAG(XT, p0, 1), y, 0, 0, 0);
#pragma unroll
                for (int r = 0; r < 4; ++r) { const int tl = rb * 16 + fq * 4 + r, t = t0 + tl;
                    if (t < T) { bf16_t* zp = Z + (size_t)row_of(s, t) * 1024 + h * 64 + pp; const float yy = (y[r] + dsk * bf2f(XT[pp * LB + tl])) * siluf_(bf2f(*zp)); *zp = f2bf_(yy); } } }
#pragma unroll
            for (int c2 = 0; c2 < 2; ++c2)
#pragma unroll
                for (int r = 0; r < 4; ++r) Sb[(rb * 16 + fq * 4 + r) * LB + chh * 32 + c2 * 16 + fr] = f2bf_(accS[c2][r]); }
    }
    __syncthreads();
#pragma unroll
    for (int c2 = 0; c2 < 2; ++c2)
#pragma unroll
        for (int r = 0; r < 4; ++r) sout[(rb * 16 + fq * 4 + r) * 64 + chh * 32 + c2 * 16 + fr] = accS[c2][r];
    float* cout_ = prompt ? p->out + O_CONVP + (size_t)(l * 32 + b) * 3 * 1280 : p->out + O_CONVS + (size_t)(l * 16 + b) * 3 * 1280;
    for (int idx = tid; idx < 3 * 192; idx += 512) { const int k = idx / 192, ch = idx - k * 192;
        if (ch >= 64 && (h & 7) != 0) continue;
        const int col = ch < 64 ? h * 64 + ch : (ch < 128 ? 1024 + g * 64 + (ch - 64) : 1152 + g * 64 + (ch - 128));
        cout_[k * 1280 + col] = bf2f(XBC[(size_t)row_of(s, T - 3 + k) * 1280 + col]); }
    __syncthreads();
#undef SSD_ISSUE
#undef SSD_FRAG
}

__device__ __forceinline__ void s5_item(CPar p, int l, int s, int g, float* wl) {
    const int lane = ltid() & 63, fr = lane & 15, fq = lane >> 4;
    const bool prompt = s < 32; const int b = prompt ? s : s - 32, T = prompt ? TP : TS, nblk = T >> 4;
    constexpr int LBX = 136;
    bf16_t* Xb = (bf16_t*)wl;
    bf16_t* U = (bf16_t*)(p->ws + WS_U);
    const int gp = (l * 32 + g) * 64 + lane;
    const float lr = p->in[I_LRE][gp], li = p->in[I_LIM][gp], step = expf(p->in[I_LSTEP][l * 32 + g]);
    float sn, cs; sincos_red((double)li * (double)step, sn, cs);
    const float mag = expf(lr * step), ab_re = mag * cs, ab_im = mag * sn;
    const float den = lr * lr + li * li, nr = ab_re - 1.f, f_re = (nr * lr + ab_im * li) / den, f_im = (ab_im * lr - nr * li) / den;
    float bbr[16], bbi[16];
#pragma unroll
    for (int hh = 0; hh < 16; ++hh) { const float br = p->in[I_BRE][(size_t)gp * 16 + hh], bi = p->in[I_BIM][(size_t)gp * 16 + hh]; bbr[hh] = f_re * br - f_im * bi; bbi[hh] = f_re * bi + f_im * br; }
    bf16x8 cfrag[4];
#pragma unroll
    for (int ks = 0; ks < 4; ++ks) { const int k0 = ks * 32 + fq * 8; const bool im = k0 >= 64;
        const float* cp = (im ? p->in[I_CIM] : p->in[I_CRE]) + ((size_t)(l * 32 + g) * 16 + fr) * 64 + (k0 & 63);
        const f32x4 c0 = *(const f32x4*)cp, c1 = *(const f32x4*)(cp + 4); const float sg = im ? -1.f : 1.f;
        u32x4 w; w[0] = pk2(sg * c0[0], sg * c0[1]); w[1] = pk2(sg * c0[2], sg * c0[3]); w[2] = pk2(sg * c1[0], sg * c1[1]); w[3] = pk2(sg * c1[2], sg * c1[3]);
        cfrag[ks] = __builtin_bit_cast(bf16x8, w); }
    float xr = prompt ? 0.f : p->in[I_S5R][(size_t)(l * 16 + b) * 2048 + g * 64 + lane], xi = prompt ? 0.f : p->in[I_S5I][(size_t)(l * 16 + b) * 2048 + g * 64 + lane];
    const float dsk = p->in[I_DS5][(size_t)(l * 32 + g) * 16 + fr];
    u32x4 ua = {0, 0, 0, 0}, ub = {0, 0, 0, 0};
    { const int r0 = row_of(s, 0); if (lane < 16) { const u32x4* up = (const u32x4*)(U + (size_t)(r0 + lane) * 512 + g * 16); ua = up[0]; ub = up[1]; } }
    for (int blk = 0; blk < nblk; ++blk) {
        const int r0 = row_of(s, blk * 16);
        const u32x4 ca = ua, cbv = ub;
        if (blk + 1 < nblk && lane < 16) { const int r1 = row_of(s, blk * 16 + 16); const u32x4* up = (const u32x4*)(U + (size_t)(r1 + lane) * 512 + g * 16); ua = up[0]; ub = up[1]; }
#pragma unroll
        for (int i = 0; i < 16; ++i) {
            float bur = 0.f, bui = 0.f;
#pragma unroll
            for (int w = 0; w < 8; ++w) { const unsigned word = (unsigned)__builtin_amdgcn_readlane((int)(w < 4 ? ca[w] : cbv[w - 4]), i);
                const float u0 = lo_f(word), u1 = hi_f(word);
                bur += bbr[2 * w] * u0 + bbr[2 * w + 1] * u1; bui += bbi[2 * w] * u0 + bbi[2 * w + 1] * u1; }
            const float nxr = ab_re * xr - ab_im * xi + bur, nxi = ab_re * xi + ab_im * xr + bui; xr = nxr; xi = nxi;
            Xb[i * LBX + lane] = f2bf_(xr); Xb[i * LBX + 64 + lane] = f2bf_(xi);
        }
        __builtin_amdgcn_wave_barrier(); asm volatile("s_waitcnt lgkmcnt(0)" ::: "memory");
        f32x4 y = {0.f, 0.f, 0.f, 0.f};
#pragma unroll
        for (int ks = 0; ks < 4; ++ks) y = __builtin_amdgcn_mfma_f32_16x16x32_bf16(*(const bf16x8*)(Xb + fr * LBX + ks * 32 + fq * 8), cfrag[ks], y, 0, 0, 0);
#pragma unroll
        for (int r = 0; r < 4; ++r) { bf16_t* up = U + (size_t)(r0 + fq * 4 + r) * 512 + g * 16 + fr; *up = f2bf_(geluf_(y[r] + dsk * bf2f(*up))); }
        __builtin_amdgcn_wave_barrier(); asm volatile("s_waitcnt lgkmcnt(0)" ::: "memory");
    }
    float* ore = prompt ? p->out + O_S5RP + (size_t)(l * 32 + b) * 2048 : p->out + O_S5RS + (size_t)(l * 16 + b) * 2048;
    float* oim = prompt ? p->out + O_S5IP + (size_t)(l * 32 + b) * 2048 : p->out + O_S5IS + (size_t)(l * 16 + b) * 2048;
    ore[g * 64 + lane] = xr; oim[g * 64 + lane] = xi;
}

typedef __bf16 bf2_t __attribute__((ext_vector_type(2)));
__device__ __forceinline__ float dot2bf(unsigned a, unsigned b, float c) { return __builtin_amdgcn_fdot2_f32_bf16(__builtin_bit_cast(bf2_t, a), __builtin_bit_cast(bf2_t, b), c, false); }
__device__ __forceinline__ void attn_item(CPar p, int l, int item, float* wl) {
    const int lane = ltid() & 63;
    int s, h, qt;
    if (item < 8448) { s = item / 264; const int rem = item - s * 264; h = rem / 33; qt = rem - h * 33; } else { const int it = item - 8448; s = 32 + (it >> 3); h = it & 7; qt = 0; }
    const bool prompt = s < 32; const int b = prompt ? s : s - 32, T = prompt ? TP : TS, nh = prompt ? 0 : PAST;
    const int i = qt * 64 + lane; const bool active = i < T; const int row = row_of(s, active ? i : T - 1);
    bf16_t* Q = (bf16_t*)(p->ws + WS_Q);
    unsigned* Kt = (unsigned*)wl; unsigned* Vp = Kt + 32 * 32;
    unsigned q[32]; float o[64];
    { const u32x4* qp = (const u32x4*)(Q + (size_t)row * 512 + h * 64);
#pragma unroll
        for (int e = 0; e < 8; ++e) { const u32x4 w = qp[e];
#pragma unroll
            for (int j = 0; j < 4; ++j) q[e * 4 + j] = pk2(lo_f(w[j]) * 0.125f, hi_f(w[j]) * 0.125f); } }
#pragma unroll
    for (int d = 0; d < 64; ++d) o[d] = 0.f;
    const float* kp_new = prompt ? p->out + O_KP + (size_t)(l * 32 + b) * 2064 * 512 + h * 64 : p->out + O_KS + (size_t)(l * 16 + b) * 64 * 512 + h * 64;
    const float* vp_new = prompt ? p->out + O_VP + (size_t)(l * 32 + b) * 2064 * 512 + h * 64 : p->out + O_VS + (size_t)(l * 16 + b) * 64 * 512 + h * 64;
    const float* kp_old = p->in[I_CK] + (size_t)(l * 16 + b) * 2048 * 512 + h * 64;
    const float* vp_old = p->in[I_CV] + (size_t)(l * 16 + b) * 2048 * 512 + h * 64;
    const int imax = (qt * 64 + 63 < T - 1) ? qt * 64 + 63 : T - 1;
    const int jtop = nh + imax - 1;
    float run = 0.f;
    for (int jt = jtop; jt >= 0; jt -= 32) {
#pragma unroll 4
        for (int e = 0; e < 8; ++e) { const int idx = e * 64 + lane, kr = idx >> 4, pc = idx & 15, j = jt - kr; u32x2 w = {0u, 0u};
            if (j >= 0) { const float* kp = (j < nh) ? kp_old + (size_t)j * 512 : kp_new + (size_t)(j - nh) * 512; const f32x4 f = *(const f32x4*)(kp + pc * 4); w[0] = pk2(f[0], f[1]); w[1] = pk2(f[2], f[3]); }
            *(u32x2*)(Kt + kr * 32 + pc * 2) = w; }
#pragma unroll 2
        for (int e = 0; e < 4; ++e) { const int idx = e * 64 + lane, m = idx >> 4, pc = idx & 15, j0 = jt - 2 * m, j1 = j0 - 1;
            f32x4 fa = {0.f, 0.f, 0.f, 0.f}, fb = {0.f, 0.f, 0.f, 0.f};
            if (j0 >= 0) { const float* vp = (j0 < nh) ? vp_old + (size_t)j0 * 512 : vp_new + (size_t)(j0 - nh) * 512; fa = *(const f32x4*)(vp + pc * 4); }
            if (j1 >= 0) { const float* vp = (j1 < nh) ? vp_old + (size_t)j1 * 512 : vp_new + (size_t)(j1 - nh) * 512; fb = *(const f32x4*)(vp + pc * 4); }
            u32x4 w; w[0] = pk2(fa[0], fb[0]); w[1] = pk2(fa[1], fb[1]); w[2] = pk2(fa[2], fb[2]); w[3] = pk2(fa[3], fb[3]);
            *(u32x4*)(Vp + m * 64 + pc * 4) = w; }
        __builtin_amdgcn_wave_barrier(); asm volatile("s_waitcnt vmcnt(0) lgkmcnt(0)" ::: "memory");
        const int nk = jt + 1 < 32 ? jt + 1 : 32, npair = (nk + 1) >> 1;
        for (int m = 0; m < npair; ++m) { const int j0 = jt - 2 * m, j1 = j0 - 1;
            float z0 = 0.f, z1 = 0.f;
#pragma unroll
            for (int d8 = 0; d8 < 8; ++d8) { const u32x4 k0 = *(const u32x4*)(Kt + (2 * m) * 32 + d8 * 4), k1 = *(const u32x4*)(Kt + (2 * m + 1) * 32 + d8 * 4);
#pragma unroll
                for (int c = 0; c < 4; ++c) { z0 = dot2bf(q[d8 * 4 + c], k0[c], z0); z1 = dot2bf(q[d8 * 4 + c], k1[c], z1); } }
            const bool v0 = active && (j0 < nh + i), v1 = active && (j1 >= 0) && (j1 < nh + i);
            const float e0 = __expf(-z0), ls0 = -__logf(1.f + e0);
            const float w0 = v0 ? __expf(ls0 + run) : 0.f; run += v0 ? (ls0 - z0) : 0.f;
            const float e1 = __expf(-z1), ls1 = -__logf(1.f + e1);
            const float w1 = v1 ? __expf(ls1 + run) : 0.f; run += v1 ? (ls1 - z1) : 0.f;
            const unsigned wp = pk2(w0, w1);
#pragma unroll
            for (int d4 = 0; d4 < 16; ++d4) { const u32x4 vv = *(const u32x4*)(Vp + m * 64 + d4 * 4);
#pragma unroll
                for (int c = 0; c < 4; ++c) o[d4 * 4 + c] = dot2bf(wp, vv[c], o[d4 * 4 + c]); } }
        __builtin_amdgcn_wave_barrier(); asm volatile("s_waitcnt lgkmcnt(0)" ::: "memory");
        const int fin = (!active) || (run < -50.f);
        if (__all(fin)) break;
    }
    if (active) { u32x4* op = (u32x4*)(Q + (size_t)row * 512 + h * 64);
#pragma unroll
        for (int e = 0; e < 8; ++e) { u32x4 w; w[0] = pk2(o[e * 8], o[e * 8 + 1]); w[1] = pk2(o[e * 8 + 2], o[e * 8 + 3]); w[2] = pk2(o[e * 8 + 4], o[e * 8 + 5]); w[3] = pk2(o[e * 8 + 6], o[e * 8 + 7]); op[e] = w; } }
}

__device__ __forceinline__ void phase_mixers(CPar p, int l, float* sm) {
#ifndef SKIP_SSD
    { CPar p1 = params_ptr();
#pragma unroll 1
      for (int it = lbid(); it < 768; it += lgdim()) ssd_item(p1, l, it, sm); }
#endif
    __syncthreads();
    const int wave = __builtin_amdgcn_readfirstlane(ltid() >> 6);
    float* wl = sm + wave * (68 * 64);
#ifndef SKIP_S5
    { CPar p2 = params_ptr();
    if (wave < 4) { for (int it = lbid() * 4 + wave; it < 1024; it += lgdim() * 4) s5_item(p2, l, it >> 5, it & 31, wl); }
    else if (wave < 6) { for (int it = lbid() * 2 + (wave - 4); it < 512; it += lgdim() * 2) s5_item(p2, l, 32 + (it >> 5), it & 31, wl); } }
#endif
#ifndef SKIP_ATT
    CPar p3 = params_ptr();
    unsigned* ctr = (unsigned*)(p3->ws + WS_CTR) + l;
    for (;;) {
        unsigned it = 0; if ((ltid() & 63) == 0) it = atomicAdd(ctr, 1u);
        it = (unsigned)__builtin_amdgcn_readfirstlane((int)it);
        if (it >= 8576u) break;
        attn_item(p3, l, (int)it, wl);
    }
#endif
}

#define XB_TMO      128
#define XB_XCNT(j)  (256  + 64 * (j))
#define XB_XSUB(j)  (1280 + 64 * (j))
#define XB_XGEN(j)  (2304 + 64 * (j))
#define XB_TOP      3328
#define XB_TOPGEN   3392
#define XCD_BAR_WORDS 3456
#define XB_SPIN_CAP (1u << 18)

__device__ __forceinline__ unsigned xb_ld(unsigned* p)              { return __hip_atomic_load(p, __ATOMIC_RELAXED, __HIP_MEMORY_SCOPE_AGENT); }
__device__ __forceinline__ unsigned xb_add(unsigned* p, unsigned v) { return __hip_atomic_fetch_add(p, v, __ATOMIC_RELAXED, __HIP_MEMORY_SCOPE_AGENT); }
__device__ __forceinline__ unsigned xb_xcc_id() { return (unsigned)__builtin_amdgcn_s_getreg((3 << 11) | 20) & 0xFu; }
#define XB_SPIN(cond, bar) do { unsigned _sp = 0; while (cond) { __builtin_amdgcn_s_sleep(1); \
    if ((++_sp & 255u) == 0u) { if (xb_ld(&(bar)[XB_TMO])) break; if (_sp > XB_SPIN_CAP) { atomicAdd(&(bar)[XB_TMO], 1u); break; } } } } while (0)

struct XcdBarrier {
    unsigned* bar; unsigned x;
    volatile LAS unsigned* st;
};

__device__ __forceinline__ XcdBarrier xcd_barrier_post(unsigned* bar, volatile LAS unsigned* st) {
    XcdBarrier b; b.bar = bar; b.x = xb_xcc_id(); b.st = st;
    if (threadIdx.x == 0) (void)xb_add(&bar[XB_XCNT(b.x)], 1u);
    return b;
}
__device__ __forceinline__ void xcd_barrier_complete(unsigned* bar, unsigned x, unsigned& nloc, unsigned& nx) {
    const unsigned G = gridDim.x * gridDim.y * gridDim.z;
    unsigned sum, cnt, mine, sp = 0u;
    for (;;) {
        sum = 0u; cnt = 0u; mine = 0u;
#pragma unroll
        for (unsigned j = 0; j < 16; ++j) { const unsigned c = xb_ld(&bar[XB_XCNT(j)]); sum += c; cnt += (c > 0u) ? 1u : 0u; mine = (j == x) ? c : mine; }
        if (sum == G) break;
        __builtin_amdgcn_s_sleep(1);
        if ((++sp & 255u) == 0u) { if (xb_ld(&bar[XB_TMO])) break; if (sp > XB_SPIN_CAP) { atomicAdd(&bar[XB_TMO], 1u); break; } }
    }
    nloc = mine > 0u ? mine : 1u; nx = cnt > 0u ? cnt : 1u;
}

__device__ __forceinline__ void xcd_barrier(const XcdBarrier& b) {
    asm volatile("s_waitcnt vmcnt(0)" ::: "memory");
    __syncthreads();
    if (threadIdx.x == 0) {
        unsigned* bar = b.bar;
        __builtin_amdgcn_s_waitcnt(0);
        unsigned nloc = b.st[0], nx = b.st[1];
        if (nloc == 0u) { xcd_barrier_complete(bar, b.x, nloc, nx); b.st[0] = nloc; b.st[1] = nx; }
        const unsigned old = xb_add(&bar[XB_XSUB(b.x)], 1u);
        const unsigned gen = old / nloc;
        if (old + 1u == (gen + 1u) * nloc) {
            __builtin_amdgcn_fence(__ATOMIC_RELEASE, "agent");
            asm volatile("s_waitcnt vmcnt(0)" ::: "memory");
            const unsigned og = xb_add(&bar[XB_TOP], 1u);
            const unsigned tg = og / nx;
            if (og + 1u == (tg + 1u) * nx) xb_add(&bar[XB_TOPGEN], 1u);
            else XB_SPIN(xb_ld(&bar[XB_TOPGEN]) == tg, bar);
            __builtin_amdgcn_fence(__ATOMIC_ACQUIRE, "agent");
            xb_add(&bar[XB_XGEN(b.x)], 1u);
            asm volatile("s_waitcnt vmcnt(0)" ::: "memory");
        } else {
            XB_SPIN(xb_ld(&bar[XB_XGEN(b.x)]) == gen, bar);
            __builtin_amdgcn_fence(__ATOMIC_ACQUIRE, "agent");
            asm volatile("s_waitcnt vmcnt(0)" ::: "memory");
        }
    }
    __syncthreads();
}
__global__ __launch_bounds__(512, 2) void mega(Params pk) {
    extern __shared__ __attribute__((aligned(16))) unsigned char smem[];
    cg::grid_group grid = cg::this_grid();
    LAS unsigned char* lds = (LAS unsigned char*)smem;
    const int ph_lo = pk.ph_lo, ph_hi = pk.ph_hi;
    volatile LAS unsigned* xst = (volatile LAS unsigned*)(lds + (LDS_BYTES - 16));
    if (threadIdx.x == 0) { xst[0] = 0u; xst[1] = 0u; }
    const XcdBarrier xb = xcd_barrier_post((unsigned*)(pk.ws + WS_SSQ), xst);
    for (int ph = ph_lo; ph < ph_hi; ++ph) {
        if (ph == ph_lo + 1) grid.sync();
        else if (ph > ph_lo + 1) xcd_barrier(xb);
        CPar p = params_ptr();
        unsigned char* ws = p->ws;
        bf16_t *HB = (bf16_t*)(ws + WS_HB), *Z = (bf16_t*)(ws + WS_Z), *XBC = (bf16_t*)(ws + WS_XBC), *U = (bf16_t*)(ws + WS_U), *Q = (bf16_t*)(ws + WS_Q), *G = (bf16_t*)(ws + WS_G);
        float *DT = (float*)(ws + WS_DT), *XM = (float*)(ws + WS_XMETA);
        const int l = ph / 9, sub = ph - l * 9;
        pg8::StaticOrder S;
        if (sub == 0) {
#ifndef SKIP0
            phase_prep(p, l);
#endif
        } else if (sub == 1) {
            S.init(NROWS, N1, lgdim(), lbid());
            EpiIn E{Z, XBC, U, Q, G, DT, p->out, p->in[I_QN] + l * 64, p->in[I_KN] + l * 64, l};
#ifndef SKIP1
            pg8::gemm_phase(lds, pg8::Gemm{HB, (const bf16_t*)(ws + W_BT1), NROWS, N1, 1024, 1024, 1024}, S, E);
#endif
        } else if (sub == 2) {
#ifndef SKIP2
            phase_mixers(p, l, (float*)smem);
#endif
        } else if (sub == 3) {
            ssd_norm_rows(p);
            S.init(NROWS, 2048, lgdim(), lbid());
            EpiGlu E{XBC};
            pg8::gemm_phase(lds, pg8::Gemm{U, (const bf16_t*)(ws + W_GLU), NROWS, 2048, 512, 512, 512}, S, E);
        } else if (sub == 4) {
            S.init(NROWS, 1024, lgdim(), lbid());
            for (int call = 0; call < 2; ++call) {
                EpiMix E; pg8::Gemm g;
                if (call == 0) { E = EpiMix{HB, G, XBC, 0}; g = pg8::Gemm{Z, (const bf16_t*)(ws + W_LA), NROWS, 1024, 1024, 1024, 1024}; }
                else { E = EpiMix{HB, G + 2048, nullptr, 1}; g = pg8::Gemm{Q, (const bf16_t*)(ws + W_LC), NROWS, 1024, 512, 512, 512}; }
#ifndef SKIP3
                pg8::gemm_phase(lds, g, S, E);
#endif
            }
        } else if (sub == 5) {
            S.init(NROWS, 1024, lgdim(), lbid());
            EpiRes E{p->out, XM};
#ifndef SKIP4
            pg8::gemm_phase(lds, pg8::Gemm{HB, (const bf16_t*)(ws + W_OUT), NROWS, 1024, 1024, 1024, 1024}, S, E);
#endif
        } else if (sub == 6) {
            rmsnorm_rows(p, p->in[I_NFFN] + l * 1024, 0);
        } else if (sub == 7) {
            S.init(NROWS, 4096, lgdim(), lbid());
            EpiUp E{(bf16_t*)(ws + WS_ACT)};
#ifndef SKIP6
            pg8::gemm_phase(lds, pg8::Gemm{HB, (const bf16_t*)(ws + W_UP), NROWS, 4096, 1024, 1024, 1024}, S, E);
#endif
        } else {
            S.init(NROWS, 1024, lgdim(), lbid());
            EpiRes E{p->out, XM};
#ifndef SKIP7
            pg8::gemm_phase(lds, pg8::Gemm{(const bf16_t*)(ws + WS_ACT), (const bf16_t*)(ws + W_DOWN), NROWS, 1024, 4096, 4096, 4096}, S, E);
#endif
        }
    }
}

extern "C" void kernel_launch(void* const* d_in, const int* in_sizes, int n_in, void* d_out, int out_size, void* d_ws, size_t ws_size, hipStream_t stream) {
    static int grid = 0;
    if (grid == 0) {
        if (n_in != 34 || (size_t)out_size != O_END || ws_size < WS_END) { fprintf(stderr, "kernel_launch: unexpected shapes n_in %d out %d ws %zu (need %zu)\n", n_in, out_size, ws_size, (size_t)WS_END); grid = -1; return; }
        int dev = 0, cus = 0, per_cu = 0;
        hipGetDevice(&dev); hipDeviceGetAttribute(&cus, hipDeviceAttributeMultiprocessorCount, dev);
        if (hipFuncSetAttribute((const void*)mega, hipFuncAttributeMaxDynamicSharedMemorySize, LDS_BYTES) != hipSuccess) { fprintf(stderr, "kernel_launch: hipFuncSetAttribute failed\n"); grid = -1; return; }
        if (hipOccupancyMaxActiveBlocksPerMultiprocessor(&per_cu, (const void*)mega, 512, LDS_BYTES) != hipSuccess || per_cu < 1) { fprintf(stderr, "kernel_launch: occupancy query says %d\n", per_cu); per_cu = 1; }
        (void)hipGetLastError();
        grid = cus * per_cu;
    }
    if (grid < 0) return;
    if (hipMemsetAsync((char*)d_ws + WS_CTR, 0, 4096, stream) != hipSuccess || hipMemsetAsync((char*)d_ws + WS_SSQ, 0, XCD_BAR_WORDS * 4, stream) != hipSuccess) { fprintf(stderr, "kernel_launch: memset failed\n"); return; }
    Params p{};
    for (int i = 0; i < 34; ++i) p.in[i] = (const float*)d_in[i];
    p.out = (float*)d_out; p.ws = (unsigned char*)d_ws;
#if MULTI_LAUNCH
    for (int ph = 0; ph < 18; ++ph) { p.ph_lo = ph; p.ph_hi = ph + 1; hipLaunchKernelGGL(mega, dim3(grid), dim3(512), LDS_BYTES, stream, p); }
#else
    p.ph_lo = 0; p.ph_hi = 18;
    void* args[] = {&p};
    hipError_t e = hipLaunchCooperativeKernel((const void*)mega, dim3(grid), dim3(512), args, LDS_BYTES, stream);
    if (e != hipSuccess) fprintf(stderr, "cooperative launch failed: %s (grid %d)\n", hipGetErrorString(e), grid);
#endif
}
```

```cpp
#include <hip/hip_runtime.h>
#include <hip/hip_cooperative_groups.h>
#include <cstdio>
#include <cstdint>
namespace cg = cooperative_groups;

#ifndef MULTI_LAUNCH
#define MULTI_LAUNCH 0
#endif

typedef unsigned short bf16_t;
typedef short bf16x8 __attribute__((ext_vector_type(8)));
typedef float f32x4 __attribute__((ext_vector_type(4)));
typedef unsigned u32x4 __attribute__((ext_vector_type(4)));
typedef unsigned u32x2 __attribute__((ext_vector_type(2)));
#define LAS __attribute__((address_space(3)))

constexpr int D = 1024, NROWS = 67072, NS0 = 65536, NM0 = 66560;
constexpr int TP = 2064, TS = 64, NB_P = 32, NB_S = 16, PAST = 2048;
constexpr int IN_COLS = 7440, N1 = 7680;
constexpr int SSQ_SLOTS = NM0 + 32 * 32;
constexpr float EPS = 1e-6f;
constexpr size_t O_YP = 0, O_YS = 67108864ull, O_KP = O_YS + 1048576ull, SZ_KP = 2ull * 32 * 2064 * 512, O_VP = O_KP + SZ_KP,
                 O_CONVP = O_VP + SZ_KP, O_SSDP = O_CONVP + 2ull * 32 * 3 * 1280, O_S5RP = O_SSDP + 2ull * 32 * 16 * 4096, O_S5IP = O_S5RP + 2ull * 32 * 2048,
                 O_KS = O_S5IP + 2ull * 32 * 2048, O_VS = O_KS + 2ull * 16 * 64 * 512, O_CONVS = O_VS + 2ull * 16 * 64 * 512, O_SSDS = O_CONVS + 2ull * 16 * 3 * 1280,
                 O_S5RS = O_SSDS + 2ull * 16 * 16 * 4096, O_S5IS = O_S5RS + 2ull * 16 * 2048, O_END = O_S5IS + 2ull * 16 * 2048;
constexpr size_t W_BT1 = 0, W_GLU = W_BT1 + (size_t)N1 * 1024 * 2, W_LA = W_GLU + 2048ull * 512 * 2, W_LC = W_LA + 1024ull * 1024 * 2, W_OUT = W_LC + 1024ull * 512 * 2,
                 W_UP = W_OUT + 1024ull * 1024 * 2, W_DOWN = W_UP + 4096ull * 1024 * 2, W_END = W_DOWN + 4096ull * 1024 * 2;
constexpr size_t WS_CTR = W_END, WS_XMETA = WS_CTR + 4096, WS_HB = WS_XMETA + 512ull * 1024 * 4, WS_Z = WS_HB + (size_t)NROWS * 1024 * 2, WS_XBC = WS_Z + (size_t)NROWS * 1024 * 2,
                 WS_U = WS_XBC + (size_t)NROWS * 1280 * 2, WS_Q = WS_U + (size_t)NROWS * 512 * 2, WS_G = WS_Q + (size_t)NROWS * 512 * 2, WS_DT = WS_G + (size_t)NROWS * 3072 * 2,
                 WS_SSQ = WS_DT + (size_t)NROWS * 16 * 4, WS_END = WS_SSQ + (size_t)SSQ_SLOTS * 16 * 4;
constexpr size_t WS_ACT = WS_Z;
static_assert(WS_ACT + (size_t)NROWS * 4096 * 2 <= WS_DT, "ACT overlay");
constexpr int LDS_BYTES = 147456;

struct Params {
    const float* in[34];
    float* out;
    unsigned char* ws;
    int ph_lo, ph_hi;
};
typedef const __attribute__((address_space(4))) Params* CPar;
__device__ __forceinline__ CPar params_ptr() { CPar q = (CPar)__builtin_amdgcn_kernarg_segment_ptr(); asm volatile("" : "+s"(q)); return q; }
#define PIN(i) (p->in[i])
enum { I_XP = 0, I_XS, I_CK, I_CV, I_SCONV, I_SSSD, I_S5R, I_S5I, I_META, I_NMIX, I_WIN, I_CONVW, I_CONVB, I_DTB, I_ALOG, I_DSSD, I_NSSD, I_LRE, I_LIM, I_LSTEP, I_BRE, I_BIM,
       I_CRE, I_CIM, I_DS5, I_WGLU, I_QN, I_KN, I_WLA, I_WLC, I_WOUT, I_NFFN, I_WUP, I_WDOWN };

__device__ __forceinline__ int ltid() { int t = threadIdx.x; asm volatile("" : "+v"(t)); return t; }
__device__ __forceinline__ int lbid() { int t = blockIdx.x; asm volatile("" : "+s"(t)); return t; }
__device__ __forceinline__ int lgdim() { int t = gridDim.x; asm volatile("" : "+s"(t)); return t; }

__device__ __forceinline__ float bf2f(bf16_t v) { return __uint_as_float((unsigned)v << 16); }
__device__ __forceinline__ unsigned pk2(float lo, float hi) { unsigned r; asm volatile("v_cvt_pk_bf16_f32 %0, %1, %2" : "=v"(r) : "v"(lo), "v"(hi)); return r; }
__device__ __forceinline__ float lo_f(unsigned w) { return __uint_as_float(w << 16); }
__device__ __forceinline__ float hi_f(unsigned w) { return __uint_as_float(w & 0xffff0000u); }
__device__ __forceinline__ u32x2 ld_l2_u32x2(const void* ptr) { const unsigned long long v = __hip_atomic_load((const unsigned long long*)ptr, __ATOMIC_RELAXED, __HIP_MEMORY_SCOPE_AGENT); u32x2 r; r[0] = (unsigned)v; r[1] = (unsigned)(v >> 32); return r; }
__device__ __forceinline__ float sigmoidf_(float v) { return __builtin_amdgcn_rcpf(1.f + __expf(-v)); }
__device__ __forceinline__ float siluf_(float v) { return v * sigmoidf_(v); }
__device__ __forceinline__ float geluf_(float y) { const float a = 0.7978845608f * (y + 0.044715f * y * y * y); const float t = __expf(2.f * a); return 0.5f * y * (2.f - 2.f * __builtin_amdgcn_rcpf(t + 1.f)); }
__device__ __forceinline__ float wave_sum(float v) {
#pragma unroll
    for (int o = 1; o < 64; o <<= 1) v += __shfl_xor(v, o);
    return v;
}
__device__ __forceinline__ void sincos_red(double x, float& sn, float& cs) {
    const double k = __builtin_rint(x * 0.63661977236758134308);
    const float r = (float)__builtin_fma(-k, 1.57079632679489661923, x), r2 = r * r;
    const float sp = r + r * r2 * (-1.6666667163e-01f + r2 * (8.3333337680e-03f + r2 * (-1.9841270114e-04f + r2 * 2.7557314297e-06f)));
    const float cp = 1.f + r2 * (-0.5f + r2 * (4.1666667908e-02f + r2 * (-1.3888889225e-03f + r2 * (2.4801587642e-05f - r2 * 2.7557314297e-07f))));
    const int q = ((int)k) & 3;
    sn = (q == 0) ? sp : (q == 1) ? cp : (q == 2) ? -sp : -cp;
    cs = (q == 0) ? cp : (q == 1) ? -sp : (q == 2) ? -cp : sp;
}
__device__ __forceinline__ int row_of(int s, int t) { return s < 32 ? (t < 16 ? NM0 + s * 16 + t : s * 2048 + t - 16) : NS0 + (s - 32) * 64 + t; }
__device__ __forceinline__ int ssq_slot(int r) { return r < NM0 ? r : NM0 + ((r - NM0) >> 4) * 32 + ((r - NM0) & 15); }
__device__ __forceinline__ float* xloc(CPar p, int r) { return r < NM0 ? p->out + (size_t)r * 1024 : (float*)(p->ws + WS_XMETA) + (size_t)(r - NM0) * 1024; }
__device__ __forceinline__ size_t k_off(int l, int r) {
    if (r < NS0) return O_KP + ((size_t)(l * 32 + (r >> 11)) * 2064 + 16 + (r & 2047)) * 512;
    if (r < NM0) { const int rs = r - NS0; return O_KS + ((size_t)(l * 16 + (rs >> 6)) * 64 + (rs & 63)) * 512; }
    const int rm = r - NM0; return O_KP + ((size_t)(l * 32 + (rm >> 4)) * 2064 + (rm & 15)) * 512;
}

namespace pg8 {
constexpr int BM = 256, BK = 64, HALF = 128, HTB = HALF * BK * 2, STAGE_BYTES = 8 * HTB, NXCD = 8, WGM = 8;
__host__ __device__ __forceinline__ int lds_byte(int r, int c) { const int st = (r >> 4) * 2 + (c >> 5), rr = r & 15, cc = c & 31, ob = rr * 64 + cc * 2; return st * 1024 + (ob ^ (((ob >> 9) & 1) << 5)); }
__host__ __device__ __forceinline__ void stage_rc(int b, int& R, int& C) { const int st = b / 1024, sb = b % 1024, swz = sb ^ (((sb >> 9) & 1) << 5); R = (st >> 1) * 16 + swz / 64; C = (st & 1) * 32 + (swz % 64) / 2; }
struct Unit { int pm, pn; };
struct Gemm { const bf16_t* A; const bf16_t* Bt; int M, N, K, lda, ldb; };
struct StaticOrder {
    int nM, nN, nwg, G, c;
    __device__ void init(int M, int N, int G_, int c_) { nM = M / BM; nN = N / BM; nwg = nM * nN; G = G_; c = c_; }
    __device__ bool next(int i, Unit& u) const {
        const long L = (long)i * G + c; if (L >= nwg) return false;
        int wgid = (int)L; { const int q = nwg / NXCD, r = nwg % NXCD, xcd = wgid % NXCD, off = wgid / NXCD; wgid = (xcd < r ? xcd * (q + 1) : r * (q + 1) + (xcd - r) * q) + off; }
        const int nig = WGM * nN, gid = wgid / nig, fm = gid * WGM, gsz = (nM - fm) < WGM ? (nM - fm) : WGM;
        u.pm = fm + ((wgid % nig) % gsz); u.pn = (wgid % nig) / gsz; return true;
    }
};
template <class Epi>
__device__ __forceinline__ void gemm_phase(LAS unsigned char* lds, const Gemm g, const StaticOrder& S, const Epi& E) {
    const int tid = ltid(), wid = __builtin_amdgcn_readfirstlane(tid >> 6), lane = tid & 63, wr = wid >> 2, wc = wid & 3, fr = lane & 15, fq = lane >> 4;
    const int K = g.K, nt = K / BK;
    unsigned voffA[2], voffB[2];
#pragma unroll
    for (int i = 0; i < 2; ++i) { int R, C; stage_rc(tid * 16 + i * 8192, R, C); voffA[i] = (unsigned)(R * g.lda + C) * 2u; voffB[i] = (unsigned)(R * g.ldb + C) * 2u; }
    const size_t kstep = (size_t)(BK * 2);
    const size_t hstepA = (size_t)HALF * g.lda * 2, hstepB = (size_t)HALF * g.ldb * 2;
    const size_t tstepA = 2 * hstepA, tstepB = 2 * hstepB;
    const unsigned ldsw = (unsigned)wid * 1024u;
    const int aoff = lds_byte(wr * 64 + fr, fq * 8), boff = lds_byte(wc * 32 + fr, fq * 8);
#define PG8_SA(b, h) (((b) * 2 + (h)) * HTB)
#define PG8_SB(b, h) ((4 + (b) * 2 + (h)) * HTB)
#define PG8_STAGE(bufoff, gbase, voff) do { _Pragma("unroll") for (int _i = 0; _i < 2; ++_i) \
        __builtin_amdgcn_global_load_lds((const unsigned*)((const char*)(gbase) + (voff)[_i]), (LAS unsigned*)(lds + (bufoff) + ldsw + _i * 8192), 16, 0, 0); } while (0)
#define PG8_LDA(dst, b, h) do { _Pragma("unroll") for (int m = 0; m < 4; ++m) _Pragma("unroll") for (int k = 0; k < 2; ++k) dst[m][k] = *(const LAS bf16x8*)(lds + PG8_SA(b, h) + aoff + m * 2048 + k * 1024); } while (0)
#define PG8_LDB(dst, b, h) do { _Pragma("unroll") for (int n = 0; n < 2; ++n) _Pragma("unroll") for (int k = 0; k < 2; ++k) dst[n][k] = *(const LAS bf16x8*)(lds + PG8_SB(b, h) + boff + n * 2048 + k * 1024); } while (0)
#define PG8_MMA(ai, bj, At, Bt) do { __builtin_amdgcn_s_setprio(1); _Pragma("unroll") for (int m = 0; m < 4; ++m) _Pragma("unroll") for (int n = 0; n < 2; ++n) _Pragma("unroll") for (int k = 0; k < 2; ++k) \
        acc[ai][bj][m][n] = __builtin_amdgcn_mfma_f32_16x16x32_bf16(Bt[n][k], At[m][k], acc[ai][bj][m][n], 0, 0, 0); __builtin_amdgcn_s_setprio(0); } while (0)
#define PG8_WAIT_V(n) asm volatile("s_waitcnt vmcnt(" #n ")" ::: "memory")
#define PG8_WAIT_L(n) asm volatile("s_waitcnt lgkmcnt(" #n ")" ::: "memory")
#define PG8_BAR __builtin_amdgcn_s_barrier()
#define PG8_SCHED __builtin_amdgcn_sched_barrier(0)
    Unit cur, nxt; int ui = 0;
    if (!S.next(0, cur)) return;
    f32x4 acc[2][2][4][2];
#pragma unroll
    for (int a = 0; a < 2; ++a)
#pragma unroll
        for (int b = 0; b < 2; ++b)
#pragma unroll
            for (int m = 0; m < 4; ++m)
#pragma unroll
                for (int n = 0; n < 2; ++n) acc[a][b][m][n] = (f32x4){0.f, 0.f, 0.f, 0.f};
    bf16x8 At[4][2], B0[2][2], B1[2][2];
    const char* cA = (const char*)g.A + (size_t)cur.pm * tstepA; const char* cB = (const char*)g.Bt + (size_t)cur.pn * tstepB;
    PG8_STAGE(PG8_SB(0, 0), cB, voffB); PG8_STAGE(PG8_SA(0, 0), cA, voffA); PG8_STAGE(PG8_SB(0, 1), cB + hstepB, voffB); PG8_STAGE(PG8_SA(0, 1), cA + hstepA, voffA);
    if (wr == 1) PG8_BAR;
    PG8_WAIT_V(4); PG8_BAR;
    PG8_STAGE(PG8_SB(1, 0), cB + kstep, voffB); PG8_STAGE(PG8_SA(1, 0), cA + kstep, voffA); PG8_STAGE(PG8_SB(1, 1), cB + hstepB + kstep, voffB);
    PG8_WAIT_V(6); PG8_BAR;
    for (;;) {
        const bool has_next = S.next(ui + 1, nxt);
        const char* nA = has_next ? (const char*)g.A + (size_t)nxt.pm * tstepA : cA; const char* nB = has_next ? (const char*)g.Bt + (size_t)nxt.pn * tstepB : cB;
        for (int t = 0; t < nt; t += 2) {
            const bool last = (t == nt - 2);
            const char* a1 = cA + (size_t)(t + 1) * kstep;
            const char* a2 = last ? nA : cA + (size_t)(t + 2) * kstep; const char* b2 = last ? nB : cB + (size_t)(t + 2) * kstep;
            const char* a3 = a2 + kstep; const char* b3 = b2 + kstep;
            PG8_LDB(B0, 0, 0); PG8_SCHED; PG8_LDA(At, 0, 0); PG8_STAGE(PG8_SA(1, 1), a1 + hstepA, voffA);
            PG8_WAIT_L(8); PG8_BAR; PG8_WAIT_L(0); PG8_MMA(0, 0, At, B0); PG8_BAR; PG8_SCHED;
            PG8_LDB(B1, 0, 1); PG8_STAGE(PG8_SB(0, 0), b2, voffB);
            PG8_BAR; PG8_WAIT_L(0); PG8_MMA(0, 1, At, B1); PG8_BAR;
            PG8_LDA(At, 0, 1); PG8_STAGE(PG8_SA(0, 0), a2, voffA);
            PG8_BAR; PG8_WAIT_L(0); PG8_MMA(1, 0, At, B0); PG8_BAR; PG8_SCHED;
            PG8_STAGE(PG8_SB(0, 1), b2 + hstepB, voffB);
            PG8_WAIT_V(6); PG8_BAR; PG8_MMA(1, 1, At, B1); PG8_BAR;
            PG8_LDB(B0, 1, 0); PG8_SCHED; PG8_LDA(At, 1, 0); PG8_STAGE(PG8_SA(0, 1), a2 + hstepA, voffA);
            PG8_WAIT_L(8); PG8_BAR; PG8_WAIT_L(0); PG8_MMA(0, 0, At, B0); PG8_BAR; PG8_SCHED;
            PG8_LDB(B1, 1, 1); PG8_STAGE(PG8_SB(1, 0), b3, voffB);
            PG8_BAR; PG8_WAIT_L(0); PG8_MMA(0, 1, At, B1); PG8_BAR;
            PG8_LDA(At, 1, 1); PG8_STAGE(PG8_SA(1, 0), a3, voffA);
            PG8_BAR; PG8_WAIT_L(0); PG8_MMA(1, 0, At, B0); PG8_BAR; PG8_SCHED;
            PG8_STAGE(PG8_SB(1, 1), b3 + hstepB, voffB);
            PG8_WAIT_V(6); PG8_BAR; PG8_MMA(1, 1, At, B1); PG8_BAR;
        }
        E(acc, cur, wr, wc, fr, fq);
        if (!has_next) break;
#pragma unroll
        for (int a = 0; a < 2; ++a)
#pragma unroll
            for (int b = 0; b < 2; ++b)
#pragma unroll
                for (int m = 0; m < 4; ++m)
#pragma unroll
                    for (int n = 0; n < 2; ++n) acc[a][b][m][n] = (f32x4){0.f, 0.f, 0.f, 0.f};
        cur = nxt; cA = nA; cB = nB; ++ui;
    }
    PG8_WAIT_V(0);
    if (wr == 0) PG8_BAR;
    PG8_BAR;
#undef PG8_SA
#undef PG8_SB
#undef PG8_STAGE
#undef PG8_LDA
#undef PG8_LDB
#undef PG8_MMA
#undef PG8_WAIT_V
#undef PG8_WAIT_L
#undef PG8_BAR
#undef PG8_SCHED
}
}
using pg8::Unit;

struct EpiIn {
    bf16_t *Z, *XBC, *U, *Q, *G; float* DT; float* out; const float *qn, *kn; int layer;
    __device__ __forceinline__ void operator()(const f32x4 (&acc)[2][2][4][2], const Unit& u, int wr, int wc, int fr, int fq) const {
        const int pn = u.pn, rowb = u.pm * 256 + wr * 64 + fr, ctb = wc * 32 + fq * 4;
        if (pn < 11 || (pn >= 17 && pn < 29)) {
            bf16_t* base; int ld, col0; bool sig = false;
            if (pn < 4) { base = Z; ld = 1024; col0 = pn * 256; } else if (pn < 9) { base = XBC; ld = 1280; col0 = (pn - 4) * 256; }
            else if (pn < 11) { base = U; ld = 512; col0 = (pn - 9) * 256; } else { base = G; ld = 3072; col0 = (pn - 17) * 256; sig = true; }
#pragma unroll
            for (int ai = 0; ai < 2; ++ai)
#pragma unroll
                for (int m = 0; m < 4; ++m) { bf16_t* rp = base + (size_t)(rowb + ai * 128 + m * 16) * ld + col0 + ctb;
#pragma unroll
                    for (int bj = 0; bj < 2; ++bj)
#pragma unroll
                        for (int n = 0; n < 2; ++n) { f32x4 v = acc[ai][bj][m][n];
                            if (sig) { v[0] = sigmoidf_(v[0]); v[1] = sigmoidf_(v[1]); v[2] = sigmoidf_(v[2]); v[3] = sigmoidf_(v[3]); }
                            u32x2 o; o[0] = pk2(v[0], v[1]); o[1] = pk2(v[2], v[3]); *(u32x2*)(rp + bj * 128 + n * 16) = o; } }
        } else if (pn < 17) {
            const int seg = (pn - 11) >> 1, head = ((pn - 11) & 1) * 4 + wc;
            const float* nw = seg == 0 ? qn : kn;
            f32x4 wv[2][2];
#pragma unroll
            for (int bj = 0; bj < 2; ++bj)
#pragma unroll
                for (int n = 0; n < 2; ++n) wv[bj][n] = (seg < 2) ? *(const f32x4*)(nw + 32 * bj + 16 * n + 4 * fq) : (f32x4){1.f, 1.f, 1.f, 1.f};
#pragma unroll
            for (int ai = 0; ai < 2; ++ai)
#pragma unroll
                for (int m = 0; m < 4; ++m) { const int row = rowb + ai * 128 + m * 16;
                    float rs = 1.f;
                    if (seg < 2) { float ss = 0.f;
#pragma unroll
                        for (int bj = 0; bj < 2; ++bj)
#pragma unroll
                            for (int n = 0; n < 2; ++n) { const f32x4 v = acc[ai][bj][m][n]; ss += v[0] * v[0] + v[1] * v[1] + v[2] * v[2] + v[3] * v[3]; }
                        ss += __shfl_xor(ss, 16); ss += __shfl_xor(ss, 32);
                        rs = rsqrtf(ss * (1.f / 64.f) + EPS); }
                    if (seg == 0) { bf16_t* rp = Q + (size_t)row * 512 + head * 64 + 4 * fq;
#pragma unroll
                        for (int bj = 0; bj < 2; ++bj)
#pragma unroll
                            for (int n = 0; n < 2; ++n) { const f32x4 v = acc[ai][bj][m][n] * rs * wv[bj][n]; u32x2 o; o[0] = pk2(v[0], v[1]); o[1] = pk2(v[2], v[3]); *(u32x2*)(rp + 32 * bj + 16 * n) = o; }
                    } else { float* rp = out + k_off(layer, row) + (seg == 2 ? (row >= NS0 && row < NM0 ? (O_VS - O_KS) : (O_VP - O_KP)) : 0) + head * 64 + 4 * fq;
#pragma unroll
                        for (int bj = 0; bj < 2; ++bj)
#pragma unroll
                            for (int n = 0; n < 2; ++n) { const f32x4 v = acc[ai][bj][m][n] * rs * wv[bj][n]; *(f32x4*)(rp + 32 * bj + 16 * n) = v; } } }
        } else {
            if (wc == 0) {
#pragma unroll
                for (int ai = 0; ai < 2; ++ai)
#pragma unroll
                    for (int m = 0; m < 4; ++m) *(f32x4*)(DT + (size_t)(rowb + ai * 128 + m * 16) * 16 + 4 * fq) = acc[ai][0][m][0];
            }
        }
    }
};
struct EpiGlu {
    bf16_t* OB;
    __device__ __forceinline__ void operator()(const f32x4 (&acc)[2][2][4][2], const Unit& u, int wr, int wc, int fr, int fq) const {
        const int rowb = u.pm * 256 + wr * 64 + fr, colb = u.pn * 128 + wc * 32 + fq * 4;
#pragma unroll
        for (int ai = 0; ai < 2; ++ai)
#pragma unroll
            for (int m = 0; m < 4; ++m) { bf16_t* rp = OB + (size_t)(rowb + ai * 128 + m * 16) * 1024 + colb;
#pragma unroll
                for (int n = 0; n < 2; ++n) { const f32x4 a = acc[ai][0][m][n], g = acc[ai][1][m][n];
                    u32x2 o; o[0] = pk2(a[0] * sigmoidf_(g[0]), a[1] * sigmoidf_(g[1])); o[1] = pk2(a[2] * sigmoidf_(g[2]), a[3] * sigmoidf_(g[3])); *(u32x2*)(rp + n * 16) = o; } }
    }
};
struct EpiMix {
    bf16_t* R; const bf16_t* G; const bf16_t* OB; int accum;
    __device__ __forceinline__ void operator()(const f32x4 (&acc)[2][2][4][2], const Unit& u, int wr, int wc, int fr, int fq) const {
        const int rowb = u.pm * 256 + wr * 64 + fr, colb = u.pn * 256 + wc * 32 + fq * 4;
#pragma unroll
        for (int ai = 0; ai < 2; ++ai)
#pragma unroll
            for (int m = 0; m < 4; ++m) { const int row = rowb + ai * 128 + m * 16;
#pragma unroll
                for (int bj = 0; bj < 2; ++bj)
#pragma unroll
                    for (int n = 0; n < 2; ++n) { const int col = colb + bj * 128 + n * 16; f32x4 v = acc[ai][bj][m][n];
                        const u32x2 gw = *(const u32x2*)(G + (size_t)row * 3072 + col);
                        v = v * (f32x4){lo_f(gw[0]), hi_f(gw[0]), lo_f(gw[1]), hi_f(gw[1])};
                        if (OB) { const u32x2 g1 = *(const u32x2*)(G + (size_t)row * 3072 + 1024 + col), ob = *(const u32x2*)(OB + (size_t)row * 1024 + col);
                            v = v + (f32x4){lo_f(g1[0]), hi_f(g1[0]), lo_f(g1[1]), hi_f(g1[1])} * (f32x4){lo_f(ob[0]), hi_f(ob[0]), lo_f(ob[1]), hi_f(ob[1])}; }
                        bf16_t* rp = R + (size_t)row * 1024 + col;
                        if (accum) { const u32x2 rw = ld_l2_u32x2(rp); v = v + (f32x4){lo_f(rw[0]), hi_f(rw[0]), lo_f(rw[1]), hi_f(rw[1])}; }
                        u32x2 o; o[0] = pk2(v[0], v[1]); o[1] = pk2(v[2], v[3]); *(u32x2*)rp = o; } }
    }
};
struct EpiRes {
    float* out; float* xmeta;
    __device__ __forceinline__ void operator()(const f32x4 (&acc)[2][2][4][2], const Unit& u, int wr, int wc, int fr, int fq) const {
        const int rowb = u.pm * 256 + wr * 64 + fr, colb = u.pn * 256 + wc * 32 + fq * 4;
        float* base = (u.pm * 256 < NM0) ? out : xmeta - (size_t)NM0 * 1024;
#pragma unroll
        for (int ai = 0; ai < 2; ++ai)
#pragma unroll
            for (int m = 0; m < 4; ++m) { float* rp = base + (size_t)(rowb + ai * 128 + m * 16) * 1024 + colb;
#pragma unroll
                for (int bj = 0; bj < 2; ++bj)
#pragma unroll
                    for (int n = 0; n < 2; ++n) { f32x4* q = (f32x4*)(rp + bj * 128 + n * 16); *q = *q + acc[ai][bj][m][n]; } }
    }
};
struct EpiUp {
    bf16_t* ACT;
    __device__ __forceinline__ void operator()(const f32x4 (&acc)[2][2][4][2], const Unit& u, int wr, int wc, int fr, int fq) const {
        const int rowb = u.pm * 256 + wr * 64 + fr, colb = u.pn * 256 + wc * 32 + fq * 4;
#pragma unroll
        for (int ai = 0; ai < 2; ++ai)
#pragma unroll
            for (int m = 0; m < 4; ++m) { bf16_t* rp = ACT + (size_t)(rowb + ai * 128 + m * 16) * 4096 + colb;
#pragma unroll
                for (int bj = 0; bj < 2; ++bj)
#pragma unroll
                    for (int n = 0; n < 2; ++n) { f32x4 v = acc[ai][bj][m][n];
#pragma unroll
                        for (int j = 0; j < 4; ++j) { const float r = fmaxf(v[j], 0.f); v[j] = r * r; }
                        u32x2 o; o[0] = pk2(v[0], v[1]); o[1] = pk2(v[2], v[3]); *(u32x2*)(rp + bj * 128 + n * 16) = o; } }
    }
};

__device__ __forceinline__ int col_in(int n) {
    if (n < 2304) return n;
    if (n < 2816) return n + 16;
    if (n < 4352) { const int w0 = n - 2816, seg = w0 >> 9, w = w0 & 511, tile = w >> 8, ct = w & 255, bj = ct >> 7, wc = (ct >> 5) & 3, ww = ct & 31;
        return 2832 + seg * 512 + (tile * 4 + wc) * 64 + 32 * bj + ww; }
    if (n < 7424) return n + 16;
    if (n < 7440) return 2304 + (n - 7424);
    return -1;
}
template <int MAP>
__device__ __forceinline__ void prep_w(bf16_t* dst, const float* src, int K, int N, int ld, const float* scale, size_t gtid, size_t gsz) {
    const size_t items = (size_t)(K / 8) * N;
    for (size_t it = gtid; it < items; it += gsz) {
        const int n = (int)(it % N), k8 = (int)(it / N);
        const int c = MAP == 1 ? col_in(n) : (MAP == 2 ? (((n >> 7) & 1) * 1024 + (n >> 8) * 128 + (n & 127)) : n);
        float v[8];
#pragma unroll
        for (int kk = 0; kk < 8; ++kk) { const int k = k8 * 8 + kk; float x = (c >= 0) ? src[(size_t)k * ld + c] : 0.f; if (scale) x *= scale[k]; v[kk] = x; }
        u32x4 o; o[0] = pk2(v[0], v[1]); o[1] = pk2(v[2], v[3]); o[2] = pk2(v[4], v[5]); o[3] = pk2(v[6], v[7]);
        *(u32x4*)(dst + (size_t)n * K + k8 * 8) = o;
    }
}
__device__ __forceinline__ void rmsnorm_rows(CPar p, const float* g, int from_inputs) {
    const int lane = ltid() & 63, gw = lbid() * 8 + (ltid() >> 6), ngw = lgdim() * 8;
    bf16_t* HB = (bf16_t*)(p->ws + WS_HB);
    f32x4 gv[4];
#pragma unroll
    for (int j = 0; j < 4; ++j) gv[j] = *(const f32x4*)(g + lane * 4 + 256 * j);
    for (int r = gw; r < NROWS; r += ngw) {
        float* xl = xloc(p, r);
        const float* src = xl;
        if (from_inputs) src = r < NS0 ? p->in[I_XP] + (size_t)r * 1024 : (r < NM0 ? p->in[I_XS] + (size_t)(r - NS0) * 1024 : p->in[I_META] + (size_t)((r - NM0) & 15) * 1024);
        f32x4 v[4]; float s = 0.f;
#pragma unroll
        for (int j = 0; j < 4; ++j) { v[j] = *(const f32x4*)(src + lane * 4 + 256 * j); s += (v[j][0] * v[j][0] + v[j][1] * v[j][1]) + (v[j][2] * v[j][2] + v[j][3] * v[j][3]); }
        const float rstd = rsqrtf(wave_sum(s) * (1.f / 1024.f) + EPS);
#pragma unroll
        for (int j = 0; j < 4; ++j) { if (from_inputs) *(f32x4*)(xl + lane * 4 + 256 * j) = v[j];
            const f32x4 h = v[j] * rstd * gv[j]; u32x2 o; o[0] = pk2(h[0], h[1]); o[1] = pk2(h[2], h[3]); *(u32x2*)(HB + (size_t)r * 1024 + lane * 4 + 256 * j) = o; }
    }
}
__device__ __forceinline__ void ssd_norm_rows(CPar p) {
    const int lane = ltid() & 63, gw = lbid() * 8 + (ltid() >> 6), ngw = lgdim() * 8;
    bf16_t* Z = (bf16_t*)(p->ws + WS_Z);
    for (int r = gw; r < NROWS; r += ngw) {
#pragma unroll
        for (int j = 0; j < 2; ++j) { u32x4* zp = (u32x4*)(Z + (size_t)r * 1024 + j * 512 + lane * 8); const u32x4 w = *zp;
            float f[8] = {lo_f(w[0]), hi_f(w[0]), lo_f(w[1]), hi_f(w[1]), lo_f(w[2]), hi_f(w[2]), lo_f(w[3]), hi_f(w[3])};
            float ss = 0.f;
#pragma unroll
            for (int i = 0; i < 8; ++i) ss += f[i] * f[i];
            const float rs = rsqrtf(wave_sum(ss) * (1.f / 512.f) + EPS);
            u32x4 o; o[0] = pk2(f[0] * rs, f[1] * rs); o[1] = pk2(f[2] * rs, f[3] * rs); o[2] = pk2(f[4] * rs, f[5] * rs); o[3] = pk2(f[6] * rs, f[7] * rs); *zp = o; }
    }
}
__device__ __forceinline__ void phase_prep(CPar p, int l) {
    const size_t gtid = (size_t)lbid() * 512 + ltid(), gsz = (size_t)lgdim() * 512;
    unsigned char* ws = p->ws;
    prep_w<1>((bf16_t*)(ws + W_BT1), p->in[I_WIN] + (size_t)l * 1024 * IN_COLS, 1024, N1, IN_COLS, nullptr, gtid, gsz);
    prep_w<2>((bf16_t*)(ws + W_GLU), p->in[I_WGLU] + (size_t)l * 512 * 2048, 512, 2048, 2048, nullptr, gtid, gsz);
    prep_w<0>((bf16_t*)(ws + W_LA), p->in[I_WLA] + (size_t)l * 1024 * 1024, 1024, 1024, 1024, p->in[I_NSSD] + l * 1024, gtid, gsz);
    prep_w<0>((bf16_t*)(ws + W_LC), p->in[I_WLC] + (size_t)l * 512 * 1024, 512, 1024, 1024, nullptr, gtid, gsz);
    prep_w<0>((bf16_t*)(ws + W_OUT), p->in[I_WOUT] + (size_t)l * 1024 * 1024, 1024, 1024, 1024, nullptr, gtid, gsz);
    prep_w<0>((bf16_t*)(ws + W_UP), p->in[I_WUP] + (size_t)l * 1024 * 4096, 1024, 4096, 4096, nullptr, gtid, gsz);
    prep_w<0>((bf16_t*)(ws + W_DOWN), p->in[I_WDOWN] + (size_t)l * 4096 * 1024, 4096, 1024, 1024, nullptr, gtid, gsz);
    rmsnorm_rows(p, p->in[I_NMIX] + l * 1024, l == 0);
}

__device__ __forceinline__ bf16_t f2bf_(float v) { return (bf16_t)(pk2(v, v) & 0xffffu); }
__device__ __forceinline__ void ssd_item(CPar p, int l, int item, float* sm) {
    const int tid = ltid(), lane = tid & 63, wave = __builtin_amdgcn_readfirstlane(tid >> 6), rb = wave >> 1, chh = wave & 1, fr = lane & 15, fq = lane >> 4;
    const int s = item < 512 ? (item >> 4) : 32 + ((item - 512) >> 4), h = item & 15, g = h >> 3;
    const bool prompt = s < 32; const int b = prompt ? s : s - 32, T = prompt ? TP : TS;
    constexpr int LB = 72;
    bf16_t *Cb = (bf16_t*)sm, *Bb = Cb + 64 * LB, *XT = Bb + 64 * LB, *WB = XT + 64 * LB, *Mb = WB + 64 * LB, *Sb = Mb + 64 * LB;
    float *sRaw = (float*)(Sb + 64 * LB), *sW = sRaw + 67 * 192, *sdtA = sW + 5 * 192, *sacA = sdtA + 33 * 64, *sw = sacA + 33 * 64;
    const bf16_t* XBC = (const bf16_t*)(p->ws + WS_XBC); bf16_t* Z = (bf16_t*)(p->ws + WS_Z);
    const float* DT = (const float*)(p->ws + WS_DT);
    const float* cw = p->in[I_CONVW] + (size_t)l * 4 * 1280; const float* cb = p->in[I_CONVB] + (size_t)l * 1280;
    const float* hist = p->in[I_SCONV] + (size_t)(l * 16 + b) * 3 * 1280;
    const float dtb = p->in[I_DTB][l * 16 + h], aneg = -__expf(p->in[I_ALOG][l * 16 + h]), dsk = p->in[I_DSSD][l * 16 + h];
    float* sout = prompt ? p->out + O_SSDP + ((size_t)(l * 32 + b) * 16 + h) * 4096 : p->out + O_SSDS + ((size_t)(l * 16 + b) * 16 + h) * 4096;
    for (int i = tid; i < 5 * 192; i += 512) { const int k = i / 192, ch = i - k * 192; const int col = ch < 64 ? h * 64 + ch : (ch < 128 ? 1024 + g * 64 + (ch - 64) : 1152 + g * 64 + (ch - 128));
        sW[i] = k < 4 ? cw[k * 1280 + col] : cb[col]; }
    f32x4 accS[2];
#pragma unroll
    for (int c2 = 0; c2 < 2; ++c2)
#pragma unroll
        for (int r = 0; r < 4; ++r) { const int pp = rb * 16 + fq * 4 + r, n = chh * 32 + c2 * 16 + fr;
            const float v = prompt ? 0.f : p->in[I_SSSD][((size_t)(l * 16 + b) * 16 + h) * 4096 + pp * 64 + n]; accS[c2][r] = v; Sb[pp * LB + n] = f2bf_(v); }
    const int nch = (T + 63) >> 6;
    { const int wv = tid >> 6, ln = tid & 63; float xv[5];
#pragma unroll
        for (int r = 0; r < 5; ++r) { const int c = wv + 8 * r, t = c * 64 + ln; xv[r] = (c < nch && t < T) ? DT[(size_t)row_of(s, t) * 16 + h] + dtb : -1e30f; }
#pragma unroll
        for (int r = 0; r < 5; ++r) { const int c = wv + 8 * r;
            if (c < nch) { const float x = xv[r]; const float dtv = x < -1e29f ? 0.f : (x > 20.f ? x : log1pf(__expf(x))); float cs = dtv * aneg;
#pragma unroll
                for (int o = 1; o < 64; o <<= 1) { const float nb = __shfl_up(cs, o); if (ln >= o) cs += nb; }
                sdtA[c * 64 + ln] = dtv; sacA[c * 64 + ln] = cs; } } }
    u32x4 pf[4];
#define SSD_ISSUE(cc) do { _Pragma("unroll") for (int it4 = 0; it4 < 4; ++it4) { const int pi = tid + it4 * 512; pf[it4] = (u32x4){0u, 0u, 0u, 0u}; \
        if (pi < 67 * 24) { const int rl = pi / 24, pc = pi - rl * 24, seg = pc >> 3, q8 = pc & 7, tt = (cc) * 64 - 3 + rl; \
            const int col = (seg == 0 ? h * 64 : (seg == 1 ? 1024 + g * 64 : 1152 + g * 64)) + q8 * 8; \
            if (tt >= 0 && tt < T) pf[it4] = *(const u32x4*)(XBC + (size_t)row_of(s, tt) * 1280 + col); } } } while (0)
#define SSD_FRAG(P, r0, ks) (*(const bf16x8*)((P) + ((r0) + fr) * LB + (ks) * 32 + fq * 8))
    SSD_ISSUE(0);
#pragma unroll 1
    for (int c = 0; c < nch; ++c) {
        const int t0 = c * 64; const float* sdt = sdtA + t0; const float* sac = sacA + t0;
        __syncthreads();
#pragma unroll
        for (int it4 = 0; it4 < 4; ++it4) { const int pi = tid + it4 * 512;
            if (pi < 67 * 24) { const int rl = pi / 24, pc = pi - rl * 24, seg = pc >> 3, q8 = pc & 7, tt = t0 - 3 + rl;
                const u32x4 w = pf[it4];
                f32x4 f0 = {lo_f(w[0]), hi_f(w[0]), lo_f(w[1]), hi_f(w[1])}, f1 = {lo_f(w[2]), hi_f(w[2]), lo_f(w[3]), hi_f(w[3])};
                if (tt < 0 && !prompt) { const int col = (seg == 0 ? h * 64 : (seg == 1 ? 1024 + g * 64 : 1152 + g * 64)) + q8 * 8; const float* hp = hist + (3 + tt) * 1280 + col; f0 = *(const f32x4*)hp; f1 = *(const f32x4*)(hp + 4); }
                float* dp = sRaw + rl * 192 + seg * 64 + q8 * 8; *(f32x4*)dp = f0; *(f32x4*)(dp + 4) = f1; } }
        if (tid < 64) sw[tid] = __expf(sac[63] - sac[tid]) * sdt[tid];
        if (c + 1 < nch) SSD_ISSUE(c + 1);
        bf16_t zq[2][4];
#pragma unroll
        for (int c2 = 0; c2 < 2; ++c2)
#pragma unroll
            for (int r = 0; r < 4; ++r) { const int t = t0 + rb * 16 + fq * 4 + r; zq[c2][r] = (t < T) ? Z[(size_t)row_of(s, t) * 1024 + h * 64 + chh * 32 + c2 * 16 + fr] : (bf16_t)0; }
        __syncthreads();
        if (tid < 384) { const int ch = tid % 192, tlb = (tid / 192) * 32, cc = ch & 63;
            const float w0 = sW[ch], w1 = sW[192 + ch], w2 = sW[384 + ch], w3 = sW[576 + ch], bias = sW[768 + ch];
            float r0 = sRaw[(tlb + 0) * 192 + ch], r1 = sRaw[(tlb + 1) * 192 + ch], r2 = sRaw[(tlb + 2) * 192 + ch];
            float ov[32];
#pragma unroll
            for (int i2 = 0; i2 < 32; ++i2) { const float r3 = sRaw[(tlb + i2 + 3) * 192 + ch];
                const float v = bias + w0 * r0 + w1 * r1 + w2 * r2 + w3 * r3; ov[i2] = (t0 + tlb + i2 < T) ? siluf_(v) : 0.f; r0 = r1; r1 = r2; r2 = r3; }
            if (ch < 128) { bf16_t* dst = (ch < 64 ? XT : WB) + cc * LB + tlb;
#pragma unroll
                for (int q4 = 0; q4 < 4; ++q4) { u32x4 w;
#pragma unroll
                    for (int c4 = 0; c4 < 4; ++c4) { const int i2 = q4 * 8 + c4 * 2; const float s0 = ch < 64 ? 1.f : sw[tlb + i2], s1 = ch < 64 ? 1.f : sw[tlb + i2 + 1]; w[c4] = pk2(ov[i2] * s0, ov[i2 + 1] * s1); }
                    *(u32x4*)(dst + q4 * 8) = w; } }
            if (ch >= 64) { bf16_t* dst = (ch < 128 ? Bb : Cb) + tlb * LB + cc;
#pragma unroll
                for (int i2 = 0; i2 < 32; ++i2) dst[i2 * LB] = f2bf_(ov[i2]); } }
        __syncthreads();
        f32x4 acc2[2];
        { const bf16x8 aC0 = SSD_FRAG(Cb, rb * 16, 0), aC1 = SSD_FRAG(Cb, rb * 16, 1);
#pragma unroll
            for (int c2 = 0; c2 < 2; ++c2) { const int j0 = chh * 32 + c2 * 16;
                f32x4 m = {0.f, 0.f, 0.f, 0.f};
                if (j0 <= rb * 16 + 15) { m = __builtin_amdgcn_mfma_f32_16x16x32_bf16(aC0, SSD_FRAG(Bb, j0, 0), m, 0, 0, 0); m = __builtin_amdgcn_mfma_f32_16x16x32_bf16(aC1, SSD_FRAG(Bb, j0, 1), m, 0, 0, 0); }
                const int j = j0 + fr; const float acj = sac[j], dtj = sdt[j];
#pragma unroll
                for (int r = 0; r < 4; ++r) { const int tl = rb * 16 + fq * 4 + r; Mb[tl * LB + j] = f2bf_(j <= tl ? m[r] * __expf(sac[tl] - acj) * dtj : 0.f); }
                f32x4 y = {0.f, 0.f, 0.f, 0.f};
                y = __builtin_amdgcn_mfma_f32_16x16x32_bf16(aC0, SSD_FRAG(Sb, j0, 0), y, 0, 0, 0); y = __builtin_amdgcn_mfma_f32_16x16x32_bf16(aC1, SSD_FRAG(Sb, j0, 1), y, 0, 0, 0);
#pragma unroll
                for (int r = 0; r < 4; ++r) y[r] *= __expf(sac[rb * 16 + fq * 4 + r]);
                acc2[c2] = y; }
            const bf16x8 aX0 = SSD_FRAG(XT, rb * 16, 0), aX1 = SSD_FRAG(XT, rb * 16, 1); const float eL = __expf(sac[63]);
#pragma unroll
            for (int c2 = 0; c2 < 2; ++c2) { const int n0 = chh * 32 + c2 * 16; f32x4 sv = accS[c2] * eL;
                sv = __builtin_amdgcn_mfma_f32_16x16x32_bf16(aX0, SSD_FRAG(WB, n0, 0), sv, 0, 0, 0); sv = __builtin_amdgcn_mfma_f32_16x16x32_bf16(aX1, SSD_FRAG(WB, n0, 1), sv, 0, 0, 0); accS[c2] = sv; } }
        __syncthreads();
        { const bf16x8 aM0 = SSD_FRAG(Mb, rb * 16, 0), aM1 = SSD_FRAG(Mb, rb * 16, 1);
#pragma unroll
            for (int c2 = 0; c2 < 2; ++c2) { const int p0 = chh * 32 + c2 * 16, pp = p0 + fr; f32x4 y = acc2[c2];
                y = __builtin_amdgcn_mfma_f32_16x16x32_bf16(aM0, SSD_FRAG(XT, p0, 0), y, 0, 0, 0); y = __builtin_amdgcn_mfma_f32_16x16x32_bf16(aM1, SSD_FRAG(XT, p0, 1), y, 0, 0, 0);
#pragma unroll
                for (int r = 0; r < 4; ++r) { const int tl = rb * 16 + fq * 4 + r, t = t0 + tl;
                    if (t < T) { bf16_t* zp = Z + (size_t)row_of(s, t) * 1024 + h * 64 + pp; const float yy = (y[r] + dsk * bf2f(XT[pp * LB + tl])) * siluf_(bf2f(zq[c2][r])); *zp = f2bf_(yy); } } }
#pragma unroll
            for (int c2 = 0; c2 < 2; ++c2)
#pragma unroll
                for (int r = 0; r < 4; ++r) Sb[(rb * 16 + fq * 4 + r) * LB + chh * 32 + c2 * 16 + fr] = f2bf_(accS[c2][r]); }
    }
    __syncthreads();
#pragma unroll
    for (int c2 = 0; c2 < 2; ++c2)
#pragma unroll
        for (int r = 0; r < 4; ++r) sout[(rb * 16 + fq * 4 + r) * 64 + chh * 32 + c2 * 16 + fr] = accS[c2][r];
    float* cout_ = prompt ? p->out + O_CONVP + (size_t)(l * 32 + b) * 3 * 1280 : p->out + O_CONVS + (size_t)(l * 16 + b) * 3 * 1280;
    for (int idx = tid; idx < 3 * 192; idx += 512) { const int k = idx / 192, ch = idx - k * 192;
        if (ch >= 64 && (h & 7) != 0) continue;
        const int col = ch < 64 ? h * 64 + ch : (ch < 128 ? 1024 + g * 64 + (ch - 64) : 1152 + g * 64 + (ch - 128));
        cout_[k * 1280 + col] = bf2f(XBC[(size_t)row_of(s, T - 3 + k) * 1280 + col]); }
    __syncthreads();
#undef SSD_ISSUE
#undef SSD_FRAG
}

__device__ __forceinline__ void s5_item(CPar p, int l, int s, int g, float* wl) {
    const int lane = ltid() & 63, fr = lane & 15, fq = lane >> 4;
    const bool prompt = s < 32; const int b = prompt ? s : s - 32, T = prompt ? TP : TS, nblk = T >> 4;
    constexpr int LBX = 136;
    bf16_t* Xb = (bf16_t*)wl;
    bf16_t* U = (bf16_t*)(p->ws + WS_U);
    const int gp = (l * 32 + g) * 64 + lane;
    const float lr = p->in[I_LRE][gp], li = p->in[I_LIM][gp], step = expf(p->in[I_LSTEP][l * 32 + g]);
    float sn, cs; sincos_red((double)li * (double)step, sn, cs);
    const float mag = expf(lr * step), ab_re = mag * cs, ab_im = mag * sn;
    const float den = lr * lr + li * li, nr = ab_re - 1.f, f_re = (nr * lr + ab_im * li) / den, f_im = (ab_im * lr - nr * li) / den;
    float bbr[16], bbi[16];
#pragma unroll
    for (int hh = 0; hh < 16; ++hh) { const float br = p->in[I_BRE][(size_t)gp * 16 + hh], bi = p->in[I_BIM][(size_t)gp * 16 + hh]; bbr[hh] = f_re * br - f_im * bi; bbi[hh] = f_re * bi + f_im * br; }
    bf16x8 cfrag[4];
#pragma unroll
    for (int ks = 0; ks < 4; ++ks) { const int k0 = ks * 32 + fq * 8; const bool im = k0 >= 64;
        const float* cp = (im ? p->in[I_CIM] : p->in[I_CRE]) + ((size_t)(l * 32 + g) * 16 + fr) * 64 + (k0 & 63);
        const f32x4 c0 = *(const f32x4*)cp, c1 = *(const f32x4*)(cp + 4); const float sg = im ? -1.f : 1.f;
        u32x4 w; w[0] = pk2(sg * c0[0], sg * c0[1]); w[1] = pk2(sg * c0[2], sg * c0[3]); w[2] = pk2(sg * c1[0], sg * c1[1]); w[3] = pk2(sg * c1[2], sg * c1[3]);
        cfrag[ks] = __builtin_bit_cast(bf16x8, w); }
    float xr = prompt ? 0.f : p->in[I_S5R][(size_t)(l * 16 + b) * 2048 + g * 64 + lane], xi = prompt ? 0.f : p->in[I_S5I][(size_t)(l * 16 + b) * 2048 + g * 64 + lane];
    const float dsk = p->in[I_DS5][(size_t)(l * 32 + g) * 16 + fr];
    u32x4 ua = {0, 0, 0, 0}, ub = {0, 0, 0, 0};
    { const int r0 = row_of(s, 0); if (lane < 16) { const u32x4* up = (const u32x4*)(U + (size_t)(r0 + lane) * 512 + g * 16); ua = up[0]; ub = up[1]; } }
    for (int blk = 0; blk < nblk; ++blk) {
        const int r0 = row_of(s, blk * 16);
        const u32x4 ca = ua, cbv = ub;
        if (blk + 1 < nblk && lane < 16) { const int r1 = row_of(s, blk * 16 + 16); const u32x4* up = (const u32x4*)(U + (size_t)(r1 + lane) * 512 + g * 16); ua = up[0]; ub = up[1]; }
#pragma unroll
        for (int i = 0; i < 16; ++i) {
            float bur = 0.f, bui = 0.f;
#pragma unroll
            for (int w = 0; w < 8; ++w) { const unsigned word = (unsigned)__builtin_amdgcn_readlane((int)(w < 4 ? ca[w] : cbv[w - 4]), i);
                const float u0 = lo_f(word), u1 = hi_f(word);
                bur += bbr[2 * w] * u0 + bbr[2 * w + 1] * u1; bui += bbi[2 * w] * u0 + bbi[2 * w + 1] * u1; }
            const float nxr = ab_re * xr - ab_im * xi + bur, nxi = ab_re * xi + ab_im * xr + bui; xr = nxr; xi = nxi;
            Xb[i * LBX + lane] = f2bf_(xr); Xb[i * LBX + 64 + lane] = f2bf_(xi);
        }
        __builtin_amdgcn_wave_barrier(); asm volatile("s_waitcnt lgkmcnt(0)" ::: "memory");
        f32x4 y = {0.f, 0.f, 0.f, 0.f};
#pragma unroll
        for (int ks = 0; ks < 4; ++ks) y = __builtin_amdgcn_mfma_f32_16x16x32_bf16(*(const bf16x8*)(Xb + fr * LBX + ks * 32 + fq * 8), cfrag[ks], y, 0, 0, 0);
#pragma unroll
        for (int r = 0; r < 4; ++r) { bf16_t* up = U + (size_t)(r0 + fq * 4 + r) * 512 + g * 16 + fr; *up = f2bf_(geluf_(y[r] + dsk * bf2f(*up))); }
        __builtin_amdgcn_wave_barrier(); asm volatile("s_waitcnt lgkmcnt(0)" ::: "memory");
    }
    float* ore = prompt ? p->out + O_S5RP + (size_t)(l * 32 + b) * 2048 : p->out + O_S5RS + (size_t)(l * 16 + b) * 2048;
    float* oim = prompt ? p->out + O_S5IP + (size_t)(l * 32 + b) * 2048 : p->out + O_S5IS + (size_t)(l * 16 + b) * 2048;
    ore[g * 64 + lane] = xr; oim[g * 64 + lane] = xi;
}

typedef __bf16 bf2_t __attribute__((ext_vector_type(2)));
__device__ __forceinline__ float dot2bf(unsigned a, unsigned b, float c) { return __builtin_amdgcn_fdot2_f32_bf16(__builtin_bit_cast(bf2_t, a), __builtin_bit_cast(bf2_t, b), c, false); }
__device__ __forceinline__ void attn_item(CPar p, int l, int item, float* wl) {
    const int lane = ltid() & 63;
    int s, h, qt;
    if (item < 8448) { s = item / 264; const int rem = item - s * 264; h = rem / 33; qt = rem - h * 33; } else { const int it = item - 8448; s = 32 + (it >> 3); h = it & 7; qt = 0; }
    const bool prompt = s < 32; const int b = prompt ? s : s - 32, T = prompt ? TP : TS, nh = prompt ? 0 : PAST;
    const int i = qt * 64 + lane; const bool active = i < T; const int row = row_of(s, active ? i : T - 1);
    bf16_t* Q = (bf16_t*)(p->ws + WS_Q);
    unsigned* Kt = (unsigned*)wl; unsigned* Vp = Kt + 32 * 32;
    unsigned q[32]; float o[64];
    { const u32x4* qp = (const u32x4*)(Q + (size_t)row * 512 + h * 64);
#pragma unroll
        for (int e = 0; e < 8; ++e) { const u32x4 w = qp[e];
#pragma unroll
            for (int j = 0; j < 4; ++j) q[e * 4 + j] = pk2(lo_f(w[j]) * 0.125f, hi_f(w[j]) * 0.125f); } }
#pragma unroll
    for (int d = 0; d < 64; ++d) o[d] = 0.f;
    const float* kp_new = prompt ? p->out + O_KP + (size_t)(l * 32 + b) * 2064 * 512 + h * 64 : p->out + O_KS + (size_t)(l * 16 + b) * 64 * 512 + h * 64;
    const float* vp_new = prompt ? p->out + O_VP + (size_t)(l * 32 + b) * 2064 * 512 + h * 64 : p->out + O_VS + (size_t)(l * 16 + b) * 64 * 512 + h * 64;
    const float* kp_old = p->in[I_CK] + (size_t)(l * 16 + b) * 2048 * 512 + h * 64;
    const float* vp_old = p->in[I_CV] + (size_t)(l * 16 + b) * 2048 * 512 + h * 64;
    const int imax = (qt * 64 + 63 < T - 1) ? qt * 64 + 63 : T - 1;
    const int jtop = nh + imax - 1;
    float run = 0.f;
    for (int jt = jtop; jt >= 0; jt -= 32) {
#pragma unroll 4
        for (int e = 0; e < 8; ++e) { const int idx = e * 64 + lane, kr = idx >> 4, pc = idx & 15, j = jt - kr; u32x2 w = {0u, 0u};
            if (j >= 0) { const float* kp = (j < nh) ? kp_old + (size_t)j * 512 : kp_new + (size_t)(j - nh) * 512; const f32x4 f = *(const f32x4*)(kp + pc * 4); w[0] = pk2(f[0], f[1]); w[1] = pk2(f[2], f[3]); }
            *(u32x2*)(Kt + kr * 32 + pc * 2) = w; }
#pragma unroll 2
        for (int e = 0; e < 4; ++e) { const int idx = e * 64 + lane, m = idx >> 4, pc = idx & 15, j0 = jt - 2 * m, j1 = j0 - 1;
            f32x4 fa = {0.f, 0.f, 0.f, 0.f}, fb = {0.f, 0.f, 0.f, 0.f};
            if (j0 >= 0) { const float* vp = (j0 < nh) ? vp_old + (size_t)j0 * 512 : vp_new + (size_t)(j0 - nh) * 512; fa = *(const f32x4*)(vp + pc * 4); }
            if (j1 >= 0) { const float* vp = (j1 < nh) ? vp_old + (size_t)j1 * 512 : vp_new + (size_t)(j1 - nh) * 512; fb = *(const f32x4*)(vp + pc * 4); }
            u32x4 w; w[0] = pk2(fa[0], fb[0]); w[1] = pk2(fa[1], fb[1]); w[2] = pk2(fa[2], fb[2]); w[3] = pk2(fa[3], fb[3]);
            *(u32x4*)(Vp + m * 64 + pc * 4) = w; }
        __builtin_amdgcn_wave_barrier(); asm volatile("s_waitcnt vmcnt(0) lgkmcnt(0)" ::: "memory");
        const int nk = jt + 1 < 32 ? jt + 1 : 32, npair = (nk + 1) >> 1;
        for (int m = 0; m < npair; ++m) { const int j0 = jt - 2 * m, j1 = j0 - 1;
            float z0 = 0.f, z1 = 0.f;
#pragma unroll
            for (int d8 = 0; d8 < 8; ++d8) { const u32x4 k0 = *(const u32x4*)(Kt + (2 * m) * 32 + d8 * 4), k1 = *(const u32x4*)(Kt + (2 * m + 1) * 32 + d8 * 4);
#pragma unroll
                for (int c = 0; c < 4; ++c) { z0 = dot2bf(q[d8 * 4 + c], k0[c], z0); z1 = dot2bf(q[d8 * 4 + c], k1[c], z1); } }
            const bool v0 = active && (j0 < nh + i), v1 = active && (j1 >= 0) && (j1 < nh + i);
            const float e0 = __expf(-z0), ls0 = -__logf(1.f + e0);
            const float w0 = v0 ? __expf(ls0 + run) : 0.f; run += v0 ? (ls0 - z0) : 0.f;
            const float e1 = __expf(-z1), ls1 = -__logf(1.f + e1);
            const float w1 = v1 ? __expf(ls1 + run) : 0.f; run += v1 ? (ls1 - z1) : 0.f;
            const unsigned wp = pk2(w0, w1);
#pragma unroll
            for (int d4 = 0; d4 < 16; ++d4) { const u32x4 vv = *(const u32x4*)(Vp + m * 64 + d4 * 4);
#pragma unroll
                for (int c = 0; c < 4; ++c) o[d4 * 4 + c] = dot2bf(wp, vv[c], o[d4 * 4 + c]); } }
        __builtin_amdgcn_wave_barrier(); asm volatile("s_waitcnt lgkmcnt(0)" ::: "memory");
        const int fin = (!active) || (run < -50.f);
        if (__all(fin)) break;
    }
    if (active) { u32x4* op = (u32x4*)(Q + (size_t)row * 512 + h * 64);
#pragma unroll
        for (int e = 0; e < 8; ++e) { u32x4 w; w[0] = pk2(o[e * 8], o[e * 8 + 1]); w[1] = pk2(o[e * 8 + 2], o[e * 8 + 3]); w[2] = pk2(o[e * 8 + 4], o[e * 8 + 5]); w[3] = pk2(o[e * 8 + 6], o[e * 8 + 7]); op[e] = w; } }
}

__device__ __forceinline__ void phase_mixers(CPar p, int l, float* sm) {
#ifndef SKIP_SSD
    { CPar p1 = params_ptr();
#pragma unroll 1
      for (int it = lbid(); it < 768; it += lgdim()) ssd_item(p1, l, it, sm); }
#endif
    __syncthreads();
    const int wave = __builtin_amdgcn_readfirstlane(ltid() >> 6);
    float* wl = sm + wave * (68 * 64);
#ifndef SKIP_S5
    { CPar p2 = params_ptr();
    if (wave < 4) { for (int it = lbid() * 4 + wave; it < 1024; it += lgdim() * 4) s5_item(p2, l, it >> 5, it & 31, wl); }
    else if (wave < 6) { for (int it = lbid() * 2 + (wave - 4); it < 512; it += lgdim() * 2) s5_item(p2, l, 32 + (it >> 5), it & 31, wl); } }
#endif
#ifndef SKIP_ATT
    CPar p3 = params_ptr();
    unsigned* ctr = (unsigned*)(p3->ws + WS_CTR) + l;
    for (;;) {
        unsigned it = 0; if ((ltid() & 63) == 0) it = atomicAdd(ctr, 1u);
        it = (unsigned)__builtin_amdgcn_readfirstlane((int)it);
        if (it >= 8576u) break;
        attn_item(p3, l, (int)it, wl);
    }
#endif
}

#define XB_TMO      128
#define XB_XCNT(j)  (256  + 64 * (j))
#define XB_XSUB(j)  (1280 + 64 * (j))
#define XB_XGEN(j)  (2304 + 64 * (j))
#define XB_TOP      3328
#define XB_TOPGEN   3392
#define XCD_BAR_WORDS 3456
#define XB_SPIN_CAP (1u << 18)

__device__ __forceinline__ unsigned xb_ld(unsigned* p)              { return __hip_atomic_load(p, __ATOMIC_RELAXED, __HIP_MEMORY_SCOPE_AGENT); }
__device__ __forceinline__ unsigned xb_add(unsigned* p, unsigned v) { return __hip_atomic_fetch_add(p, v, __ATOMIC_RELAXED, __HIP_MEMORY_SCOPE_AGENT); }
__device__ __forceinline__ unsigned xb_xcc_id() { return (unsigned)__builtin_amdgcn_s_getreg((3 << 11) | 20) & 0xFu; }
#define XB_SPIN(cond, bar) do { unsigned _sp = 0; while (cond) { __builtin_amdgcn_s_sleep(1); \
    if ((++_sp & 255u) == 0u) { if (xb_ld(&(bar)[XB_TMO])) break; if (_sp > XB_SPIN_CAP) { atomicAdd(&(bar)[XB_TMO], 1u); break; } } } } while (0)

struct XcdBarrier {
    unsigned* bar; unsigned x;
    volatile LAS unsigned* st;
};

__device__ __forceinline__ XcdBarrier xcd_barrier_post(unsigned* bar, volatile LAS unsigned* st) {
    XcdBarrier b; b.bar = bar; b.x = xb_xcc_id(); b.st = st;
    if (threadIdx.x == 0) (void)xb_add(&bar[XB_XCNT(b.x)], 1u);
    return b;
}
__device__ __forceinline__ void xcd_barrier_complete(unsigned* bar, unsigned x, unsigned& nloc, unsigned& nx) {
    const unsigned G = gridDim.x * gridDim.y * gridDim.z;
    unsigned sum, cnt, mine, sp = 0u;
    for (;;) {
        sum = 0u; cnt = 0u; mine = 0u;
#pragma unroll
        for (unsigned j = 0; j < 16; ++j) { const unsigned c = xb_ld(&bar[XB_XCNT(j)]); sum += c; cnt += (c > 0u) ? 1u : 0u; mine = (j == x) ? c : mine; }
        if (sum == G) break;
        __builtin_amdgcn_s_sleep(1);
        if ((++sp & 255u) == 0u) { if (xb_ld(&bar[XB_TMO])) break; if (sp > XB_SPIN_CAP) { atomicAdd(&bar[XB_TMO], 1u); break; } }
    }
    nloc = mine > 0u ? mine : 1u; nx = cnt > 0u ? cnt : 1u;
}

__device__ __forceinline__ void xcd_barrier(const XcdBarrier& b) {
    asm volatile("s_waitcnt vmcnt(0)" ::: "memory");
    __syncthreads();
    if (threadIdx.x == 0) {
        unsigned* bar = b.bar;
        __builtin_amdgcn_s_waitcnt(0);
        unsigned nloc = b.st[0], nx = b.st[1];
        if (nloc == 0u) { xcd_barrier_complete(bar, b.x, nloc, nx); b.st[0] = nloc; b.st[1] = nx; }
        const unsigned old = xb_add(&bar[XB_XSUB(b.x)], 1u);
        const unsigned gen = old / nloc;
        if (old + 1u == (gen + 1u) * nloc) {
            __builtin_amdgcn_fence(__ATOMIC_RELEASE, "agent");
            asm volatile("s_waitcnt vmcnt(0)" ::: "memory");
            const unsigned og = xb_add(&bar[XB_TOP], 1u);
            const unsigned tg = og / nx;
            if (og + 1u == (tg + 1u) * nx) xb_add(&bar[XB_TOPGEN], 1u);
            else XB_SPIN(xb_ld(&bar[XB_TOPGEN]) == tg, bar);
            __builtin_amdgcn_fence(__ATOMIC_ACQUIRE, "agent");
            xb_add(&bar[XB_XGEN(b.x)], 1u);
            asm volatile("s_waitcnt vmcnt(0)" ::: "memory");
        } else {
            XB_SPIN(xb_ld(&bar[XB_XGEN(b.x)]) == gen, bar);
            __builtin_amdgcn_fence(__ATOMIC_ACQUIRE, "agent");
            asm volatile("s_waitcnt vmcnt(0)" ::: "memory");
        }
    }
    __syncthreads();
}
__global__ __launch_bounds__(512, 2) void mega(Params pk) {
    extern __shared__ __attribute__((aligned(16))) unsigned char smem[];
    cg::grid_group grid = cg::this_grid();
    LAS unsigned char* lds = (LAS unsigned char*)smem;
    const int ph_lo = pk.ph_lo, ph_hi = pk.ph_hi;
    volatile LAS unsigned* xst = (volatile LAS unsigned*)(lds + (LDS_BYTES - 16));
    if (threadIdx.x == 0) { xst[0] = 0u; xst[1] = 0u; }
    const XcdBarrier xb = xcd_barrier_post((unsigned*)(pk.ws + WS_SSQ), xst);
    for (int ph = ph_lo; ph < ph_hi; ++ph) {
        if (ph == ph_lo + 1) grid.sync();
        else if (ph > ph_lo + 1) xcd_barrier(xb);
        CPar p = params_ptr();
        unsigned char* ws = p->ws;
        bf16_t *HB = (bf16_t*)(ws + WS_HB), *Z = (bf16_t*)(ws + WS_Z), *XBC = (bf16_t*)(ws + WS_XBC), *U = (bf16_t*)(ws + WS_U), *Q = (bf16_t*)(ws + WS_Q), *G = (bf16_t*)(ws + WS_G);
        float *DT = (float*)(ws + WS_DT), *XM = (float*)(ws + WS_XMETA);
        const int l = ph / 9, sub = ph - l * 9;
        pg8::StaticOrder S;
        if (sub == 0) {
#ifndef SKIP0
            phase_prep(p, l);
#endif
        } else if (sub == 1) {
            S.init(NROWS, N1, lgdim(), lbid());
            EpiIn E{Z, XBC, U, Q, G, DT, p->out, p->in[I_QN] + l * 64, p->in[I_KN] + l * 64, l};
#ifndef SKIP1
            pg8::gemm_phase(lds, pg8::Gemm{HB, (const bf16_t*)(ws + W_BT1), NROWS, N1, 1024, 1024, 1024}, S, E);
#endif
        } else if (sub == 2) {
#ifndef SKIP2
            phase_mixers(p, l, (float*)smem);
#endif
        } else if (sub == 3) {
            ssd_norm_rows(p);
            S.init(NROWS, 2048, lgdim(), lbid());
            EpiGlu E{XBC};
            pg8::gemm_phase(lds, pg8::Gemm{U, (const bf16_t*)(ws + W_GLU), NROWS, 2048, 512, 512, 512}, S, E);
        } else if (sub == 4) {
            S.init(NROWS, 1024, lgdim(), lbid());
            for (int call = 0; call < 2; ++call) {
                EpiMix E; pg8::Gemm g;
                if (call == 0) { E = EpiMix{HB, G, XBC, 0}; g = pg8::Gemm{Z, (const bf16_t*)(ws + W_LA), NROWS, 1024, 1024, 1024, 1024}; }
                else { E = EpiMix{HB, G + 2048, nullptr, 1}; g = pg8::Gemm{Q, (const bf16_t*)(ws + W_LC), NROWS, 1024, 512, 512, 512}; }
#ifndef SKIP3
                pg8::gemm_phase(lds, g, S, E);
#endif
            }
        } else if (sub == 5) {
            S.init(NROWS, 1024, lgdim(), lbid());
            EpiRes E{p->out, XM};
#ifndef SKIP4
            pg8::gemm_phase(lds, pg8::Gemm{HB, (const bf16_t*)(ws + W_OUT), NROWS, 1024, 1024, 1024, 1024}, S, E);
#endif
        } else if (sub == 6) {
            rmsnorm_rows(p, p->in[I_NFFN] + l * 1024, 0);
        } else if (sub == 7) {
            S.init(NROWS, 4096, lgdim(), lbid());
            EpiUp E{(bf16_t*)(ws + WS_ACT)};
#ifndef SKIP6
            pg8::gemm_phase(lds, pg8::Gemm{HB, (const bf16_t*)(ws + W_UP), NROWS, 4096, 1024, 1024, 1024}, S, E);
#endif
        } else {
            S.init(NROWS, 1024, lgdim(), lbid());
            EpiRes E{p->out, XM};
#ifndef SKIP7
            pg8::gemm_phase(lds, pg8::Gemm{(const bf16_t*)(ws + WS_ACT), (const bf16_t*)(ws + W_DOWN), NROWS, 1024, 4096, 4096, 4096}, S, E);
#endif
        }
    }
}

extern "C" void kernel_launch(void* const* d_in, const int* in_sizes, int n_in, void* d_out, int out_size, void* d_ws, size_t ws_size, hipStream_t stream) {
    static int grid = 0;
    if (grid == 0) {
        if (n_in != 34 || (size_t)out_size != O_END || ws_size < WS_END) { fprintf(stderr, "kernel_launch: unexpected shapes n_in %d out %d ws %zu (need %zu)\n", n_in, out_size, ws_size, (size_t)WS_END); grid = -1; return; }
        int dev = 0, cus = 0, per_cu = 0;
        hipGetDevice(&dev); hipDeviceGetAttribute(&cus, hipDeviceAttributeMultiprocessorCount, dev);
        if (hipFuncSetAttribute((const void*)mega, hipFuncAttributeMaxDynamicSharedMemorySize, LDS_BYTES) != hipSuccess) { fprintf(stderr, "kernel_launch: hipFuncSetAttribute failed\n"); grid = -1; return; }
        if (hipOccupancyMaxActiveBlocksPerMultiprocessor(&per_cu, (const void*)mega, 512, LDS_BYTES) != hipSuccess || per_cu < 1) { fprintf(stderr, "kernel_launch: occupancy query says %d\n", per_cu); per_cu = 1; }
        (void)hipGetLastError();
        grid = cus * per_cu;
    }
    if (grid < 0) return;
    if (hipMemsetAsync((char*)d_ws + WS_CTR, 0, 4096, stream) != hipSuccess || hipMemsetAsync((char*)d_ws + WS_SSQ, 0, XCD_BAR_WORDS * 4, stream) != hipSuccess) { fprintf(stderr, "kernel_launch: memset failed\n"); return; }
    Params p{};
    for (int i = 0; i < 34; ++i) p.in[i] = (const float*)d_in[i];
    p.out = (float*)d_out; p.ws = (unsigned char*)d_ws;
#if MULTI_LAUNCH
    for (int ph = 0; ph < 18; ++ph) { p.ph_lo = ph; p.ph_hi = ph + 1; hipLaunchKernelGGL(mega, dim3(grid), dim3(512), LDS_BYTES, stream, p); }
#else
    p.ph_lo = 0; p.ph_hi = 18;
    void* args[] = {&p};
    hipError_t e = hipLaunchCooperativeKernel((const void*)mega, dim3(grid), dim3(512), args, LDS_BYTES, stream);
    if (e != hipSuccess) fprintf(stderr, "cooperative launch failed: %s (grid %d)\n", hipGetErrorString(e), grid);
#endif
}
```

```cpp
#include <hip/hip_runtime.h>
#include <hip/hip_cooperative_groups.h>
#include <cstdio>
#include <cstdint>
namespace cg = cooperative_groups;

#ifndef MULTI_LAUNCH
#define MULTI_LAUNCH 0
#endif

typedef unsigned short bf16_t;
typedef short bf16x8 __attribute__((ext_vector_type(8)));
typedef float f32x4 __attribute__((ext_vector_type(4)));
typedef unsigned u32x4 __attribute__((ext_vector_type(4)));
typedef unsigned u32x2 __attribute__((ext_vector_type(2)));
#define LAS __attribute__((address_space(3)))

constexpr int D = 1024, NROWS = 67072, NS0 = 65536, NM0 = 66560;
constexpr int TP = 2064, TS = 64, NB_P = 32, NB_S = 16, PAST = 2048;
constexpr int IN_COLS = 7440, N1 = 7680;
constexpr int SSQ_SLOTS = NM0 + 32 * 32;
constexpr float EPS = 1e-6f;
constexpr size_t O_YP = 0, O_YS = 67108864ull, O_KP = O_YS + 1048576ull, SZ_KP = 2ull * 32 * 2064 * 512, O_VP = O_KP + SZ_KP,
                 O_CONVP = O_VP + SZ_KP, O_SSDP = O_CONVP + 2ull * 32 * 3 * 1280, O_S5RP = O_SSDP + 2ull * 32 * 16 * 4096, O_S5IP = O_S5RP + 2ull * 32 * 2048,
                 O_KS = O_S5IP + 2ull * 32 * 2048, O_VS = O_KS + 2ull * 16 * 64 * 512, O_CONVS = O_VS + 2ull * 16 * 64 * 512, O_SSDS = O_CONVS + 2ull * 16 * 3 * 1280,
                 O_S5RS = O_SSDS + 2ull * 16 * 16 * 4096, O_S5IS = O_S5RS + 2ull * 16 * 2048, O_END = O_S5IS + 2ull * 16 * 2048;
constexpr size_t W_BT1 = 0, W_GLU = W_BT1 + (size_t)N1 * 1024 * 2, W_LA = W_GLU + 2048ull * 512 * 2, W_LC = W_LA + 1024ull * 1024 * 2, W_OUT = W_LC + 1024ull * 512 * 2,
                 W_UP = W_OUT + 1024ull * 1024 * 2, W_DOWN = W_UP + 4096ull * 1024 * 2, W_END = W_DOWN + 4096ull * 1024 * 2;
constexpr size_t WS_CTR = W_END, WS_XMETA = WS_CTR + 4096, WS_HB = WS_XMETA + 512ull * 1024 * 4, WS_Z = WS_HB + (size_t)NROWS * 1024 * 2, WS_XBC = WS_Z + (size_t)NROWS * 1024 * 2,
                 WS_U = WS_XBC + (size_t)NROWS * 1280 * 2, WS_Q = WS_U + (size_t)NROWS * 512 * 2, WS_G = WS_Q + (size_t)NROWS * 512 * 2, WS_DT = WS_G + (size_t)NROWS * 3072 * 2,
                 WS_SSQ = WS_DT + (size_t)NROWS * 16 * 4, WS_END = WS_SSQ + (size_t)SSQ_SLOTS * 16 * 4;
constexpr size_t WS_ACT = WS_Z;
static_assert(WS_ACT + (size_t)NROWS * 4096 * 2 <= WS_DT, "ACT overlay");
constexpr int LDS_BYTES = 147456;

struct Params {
    const float* in[34];
    float* out;
    unsigned char* ws;
    int ph_lo, ph_hi;
};
typedef const __attribute__((address_space(4))) Params* CPar;
__device__ __forceinline__ CPar params_ptr() { CPar q = (CPar)__builtin_amdgcn_kernarg_segment_ptr(); asm volatile("" : "+s"(q)); return q; }
#define PIN(i) (p->in[i])
enum { I_XP = 0, I_XS, I_CK, I_CV, I_SCONV, I_SSSD, I_S5R, I_S5I, I_META, I_NMIX, I_WIN, I_CONVW, I_CONVB, I_DTB, I_ALOG, I_DSSD, I_NSSD, I_LRE, I_LIM, I_LSTEP, I_BRE, I_BIM,
       I_CRE, I_CIM, I_DS5, I_WGLU, I_QN, I_KN, I_WLA, I_WLC, I_WOUT, I_NFFN, I_WUP, I_WDOWN };

__device__ __forceinline__ int ltid() { int t = threadIdx.x; asm volatile("" : "+v"(t)); return t; }
__device__ __forceinline__ int lbid() { int t = blockIdx.x; asm volatile("" : "+s"(t)); return t; }
__device__ __forceinline__ int lgdim() { int t = gridDim.x; asm volatile("" : "+s"(t)); return t; }

__device__ __forceinline__ float bf2f(bf16_t v) { return __uint_as_float((unsigned)v << 16); }
__device__ __forceinline__ unsigned pk2(float lo, float hi) { unsigned r; asm volatile("v_cvt_pk_bf16_f32 %0, %1, %2" : "=v"(r) : "v"(lo), "v"(hi)); return r; }
__device__ __forceinline__ float lo_f(unsigned w) { return __uint_as_float(w << 16); }
__device__ __forceinline__ float hi_f(unsigned w) { return __uint_as_float(w & 0xffff0000u); }
__device__ __forceinline__ u32x2 ld_l2_u32x2(const void* ptr) { const unsigned long long v = __hip_atomic_load((const unsigned long long*)ptr, __ATOMIC_RELAXED, __HIP_MEMORY_SCOPE_AGENT); u32x2 r; r[0] = (unsigned)v; r[1] = (unsigned)(v >> 32); return r; }
__device__ __forceinline__ float sigmoidf_(float v) { return __builtin_amdgcn_rcpf(1.f + __expf(-v)); }
__device__ __forceinline__ float siluf_(float v) { return v * sigmoidf_(v); }
__device__ __forceinline__ float geluf_(float y) { const float a = 0.7978845608f * (y + 0.044715f * y * y * y); const float t = __expf(2.f * a); return 0.5f * y * (2.f - 2.f * __builtin_amdgcn_rcpf(t + 1.f)); }
__device__ __forceinline__ float wave_sum(float v) {
#pragma unroll
    for (int o = 1; o < 64; o <<= 1) v += __shfl_xor(v, o);
    return v;
}
__device__ __forceinline__ void sincos_red(double x, float& sn, float& cs) {
    const double k = __builtin_rint(x * 0.63661977236758134308);
    const float r = (float)__builtin_fma(-k, 1.57079632679489661923, x), r2 = r * r;
    const float sp = r + r * r2 * (-1.6666667163e-01f + r2 * (8.3333337680e-03f + r2 * (-1.9841270114e-04f + r2 * 2.7557314297e-06f)));
    const float cp = 1.f + r2 * (-0.5f + r2 * (4.1666667908e-02f + r2 * (-1.3888889225e-03f + r2 * (2.4801587642e-05f - r2 * 2.7557314297e-07f))));
    const int q = ((int)k) & 3;
    sn = (q == 0) ? sp : (q == 1) ? cp : (q == 2) ? -sp : -cp;
    cs = (q == 0) ? cp : (q == 1) ? -sp : (q == 2) ? -cp : sp;
}
__device__ __forceinline__ int row_of(int s, int t) { return s < 32 ? (t < 16 ? NM0 + s * 16 + t : s * 2048 + t - 16) : NS0 + (s - 32) * 64 + t; }
__device__ __forceinline__ int ssq_slot(int r) { return r < NM0 ? r : NM0 + ((r - NM0) >> 4) * 32 + ((r - NM0) & 15); }
__device__ __forceinline__ float* xloc(CPar p, int r) { return r < NM0 ? p->out + (size_t)r * 1024 : (float*)(p->ws + WS_XMETA) + (size_t)(r - NM0) * 1024; }
__device__ __forceinline__ size_t k_off(int l, int r) {
    if (r < NS0) return O_KP + ((size_t)(l * 32 + (r >> 11)) * 2064 + 16 + (r & 2047)) * 512;
    if (r < NM0) { const int rs = r - NS0; return O_KS + ((size_t)(l * 16 + (rs >> 6)) * 64 + (rs & 63)) * 512; }
    const int rm = r - NM0; return O_KP + ((size_t)(l * 32 + (rm >> 4)) * 2064 + (rm & 15)) * 512;
}

namespace pg8 {
constexpr int BM = 256, BK = 64, HALF = 128, HTB = HALF * BK * 2, STAGE_BYTES = 8 * HTB, NXCD = 8, WGM = 8;
__host__ __device__ __forceinline__ int lds_byte(int r, int c) { const int st = (r >> 4) * 2 + (c >> 5), rr = r & 15, cc = c & 31, ob = rr * 64 + cc * 2; return st * 1024 + (ob ^ (((ob >> 9) & 1) << 5)); }
__host__ __device__ __forceinline__ void stage_rc(int b, int& R, int& C) { const int st = b / 1024, sb = b % 1024, swz = sb ^ (((sb >> 9) & 1) << 5); R = (st >> 1) * 16 + swz / 64; C = (st & 1) * 32 + (swz % 64) / 2; }
struct Unit { int pm, pn; };
struct Gemm { const bf16_t* A; const bf16_t* Bt; int M, N, K, lda, ldb; };
struct StaticOrder {
    int nM, nN, nwg, G, c;
    __device__ void init(int M, int N, int G_, int c_) { nM = M / BM; nN = N / BM; nwg = nM * nN; G = G_; c = c_; }
    __device__ bool next(int i, Unit& u) const {
        const long L = (long)i * G + c; if (L >= nwg) return false;
        int wgid = (int)L; { const int q = nwg / NXCD, r = nwg % NXCD, xcd = wgid % NXCD, off = wgid / NXCD; wgid = (xcd < r ? xcd * (q + 1) : r * (q + 1) + (xcd - r) * q) + off; }
        const int nig = WGM * nN, gid = wgid / nig, fm = gid * WGM, gsz = (nM - fm) < WGM ? (nM - fm) : WGM;
        u.pm = fm + ((wgid % nig) % gsz); u.pn = (wgid % nig) / gsz; return true;
    }
};
template <class Epi>
__device__ __forceinline__ void gemm_phase(LAS unsigned char* lds, const Gemm g, const StaticOrder& S, const Epi& E) {
    const int tid = ltid(), wid = __builtin_amdgcn_readfirstlane(tid >> 6), lane = tid & 63, wr = wid >> 2, wc = wid & 3, fr = lane & 15, fq = lane >> 4;
    const int K = g.K, nt = K / BK;
    unsigned voffA[2], voffB[2];
#pragma unroll
    for (int i = 0; i < 2; ++i) { int R, C; stage_rc(tid * 16 + i * 8192, R, C); voffA[i] = (unsigned)(R * g.lda + C) * 2u; voffB[i] = (unsigned)(R * g.ldb + C) * 2u; }
    const size_t kstep = (size_t)(BK * 2);
    const size_t hstepA = (size_t)HALF * g.lda * 2, hstepB = (size_t)HALF * g.ldb * 2;
    const size_t tstepA = 2 * hstepA, tstepB = 2 * hstepB;
    const unsigned ldsw = (unsigned)wid * 1024u;
    const int aoff = lds_byte(wr * 64 + fr, fq * 8), boff = lds_byte(wc * 32 + fr, fq * 8);
#define PG8_SA(b, h) (((b) * 2 + (h)) * HTB)
#define PG8_SB(b, h) ((4 + (b) * 2 + (h)) * HTB)
#define PG8_STAGE(bufoff, gbase, voff) do { _Pragma("unroll") for (int _i = 0; _i < 2; ++_i) \
        __builtin_amdgcn_global_load_lds((const unsigned*)((const char*)(gbase) + (voff)[_i]), (LAS unsigned*)(lds + (bufoff) + ldsw + _i * 8192), 16, 0, 0); } while (0)
#define PG8_LDA(dst, b, h) do { _Pragma("unroll") for (int m = 0; m < 4; ++m) _Pragma("unroll") for (int k = 0; k < 2; ++k) dst[m][k] = *(const LAS bf16x8*)(lds + PG8_SA(b, h) + aoff + m * 2048 + k * 1024); } while (0)
#define PG8_LDB(dst, b, h) do { _Pragma("unroll") for (int n = 0; n < 2; ++n) _Pragma("unroll") for (int k = 0; k < 2; ++k) dst[n][k] = *(const LAS bf16x8*)(lds + PG8_SB(b, h) + boff + n * 2048 + k * 1024); } while (0)
#define PG8_MMA(ai, bj, At, Bt) do { __builtin_amdgcn_s_setprio(1); _Pragma("unroll") for (int m = 0; m < 4; ++m) _Pragma("unroll") for (int n = 0; n < 2; ++n) _Pragma("unroll") for (int k = 0; k < 2; ++k) \
        acc[ai][bj][m][n] = __builtin_amdgcn_mfma_f32_16x16x32_bf16(Bt[n][k], At[m][k], acc[ai][bj][m][n], 0, 0, 0); __builtin_amdgcn_s_setprio(0); } while (0)
#define PG8_WAIT_V(n) asm volatile("s_waitcnt vmcnt(" #n ")" ::: "memory")
#define PG8_WAIT_L(n) asm volatile("s_waitcnt lgkmcnt(" #n ")" ::: "memory")
#define PG8_BAR __builtin_amdgcn_s_barrier()
#define PG8_SCHED __builtin_amdgcn_sched_barrier(0)
    Unit cur, nxt; int ui = 0;
    if (!S.next(0, cur)) return;
    f32x4 acc[2][2][4][2];
#pragma unroll
    for (int a = 0; a < 2; ++a)
#pragma unroll
        for (int b = 0; b < 2; ++b)
#pragma unroll
            for (int m = 0; m < 4; ++m)
#pragma unroll
                for (int n = 0; n < 2; ++n) acc[a][b][m][n] = (f32x4){0.f, 0.f, 0.f, 0.f};
    bf16x8 At[4][2], B0[2][2], B1[2][2];
    const char* cA = (const char*)g.A + (size_t)cur.pm * tstepA; const char* cB = (const char*)g.Bt + (size_t)cur.pn * tstepB;
    PG8_STAGE(PG8_SB(0, 0), cB, voffB); PG8_STAGE(PG8_SA(0, 0), cA, voffA); PG8_STAGE(PG8_SB(0, 1), cB + hstepB, voffB); PG8_STAGE(PG8_SA(0, 1), cA + hstepA, voffA);
    if (wr == 1) PG8_BAR;
    PG8_WAIT_V(4); PG8_BAR;
    PG8_STAGE(PG8_SB(1, 0), cB + kstep, voffB); PG8_STAGE(PG8_SA(1, 0), cA + kstep, voffA); PG8_STAGE(PG8_SB(1, 1), cB + hstepB + kstep, voffB);
    PG8_WAIT_V(6); PG8_BAR;
    for (;;) {
        const bool has_next = S.next(ui + 1, nxt);
        const char* nA = has_next ? (const char*)g.A + (size_t)nxt.pm * tstepA : cA; const char* nB = has_next ? (const char*)g.Bt + (size_t)nxt.pn * tstepB : cB;
        for (int t = 0; t < nt; t += 2) {
            const bool last = (t == nt - 2);
            const char* a1 = cA + (size_t)(t + 1) * kstep;
            const char* a2 = last ? nA : cA + (size_t)(t + 2) * kstep; const char* b2 = last ? nB : cB + (size_t)(t + 2) * kstep;
            const char* a3 = a2 + kstep; const char* b3 = b2 + kstep;
            PG8_LDB(B0, 0, 0); PG8_SCHED; PG8_LDA(At, 0, 0); PG8_STAGE(PG8_SA(1, 1), a1 + hstepA, voffA);
            PG8_WAIT_L(8); PG8_BAR; PG8_WAIT_L(0); PG8_MMA(0, 0, At, B0); PG8_BAR; PG8_SCHED;
            PG8_LDB(B1, 0, 1); PG8_STAGE(PG8_SB(0, 0), b2, voffB);
            PG8_BAR; PG8_WAIT_L(0); PG8_MMA(0, 1, At, B1); PG8_BAR;
            PG8_LDA(At, 0, 1); PG8_STAGE(PG8_SA(0, 0), a2, voffA);
            PG8_BAR; PG8_WAIT_L(0); PG8_MMA(1, 0, At, B0); PG8_BAR; PG8_SCHED;
            PG8_STAGE(PG8_SB(0, 1), b2 + hstepB, voffB);
            PG8_WAIT_V(6); PG8_BAR; PG8_MMA(1, 1, At, B1); PG8_BAR;
            PG8_LDB(B0, 1, 0); PG8_SCHED; PG8_LDA(At, 1, 0); PG8_STAGE(PG8_SA(0, 1), a2 + hstepA, voffA);
            PG8_WAIT_L(8); PG8_BAR; PG8_WAIT_L(0); PG8_MMA(0, 0, At, B0); PG8_BAR; PG8_SCHED;
            PG8_LDB(B1, 1, 1); PG8_STAGE(PG8_SB(1, 0), b3, voffB);
            PG8_BAR; PG8_WAIT_L(0); PG8_MMA(0, 1, At, B1); PG8_BAR;
            PG8_LDA(At, 1, 1); PG8_STAGE(PG8_SA(1, 0), a3, voffA);
            PG8_BAR; PG8_WAIT_L(0); PG8_MMA(1, 0, At, B0); PG8_BAR; PG8_SCHED;
            PG8_STAGE(PG8_SB(1, 1), b3 + hstepB, voffB);
            PG8_WAIT_V(6); PG8_BAR; PG8_MMA(1, 1, At, B1); PG8_BAR;
        }
        E(acc, cur, wr, wc, fr, fq);
        if (!has_next) break;
#pragma unroll
        for (int a = 0; a < 2; ++a)
#pragma unroll
            for (int b = 0; b < 2; ++b)
#pragma unroll
                for (int m = 0; m < 4; ++m)
#pragma unroll
                    for (int n = 0; n < 2; ++n) acc[a][b][m][n] = (f32x4){0.f, 0.f, 0.f, 0.f};
        cur = nxt; cA = nA; cB = nB; ++ui;
    }
    PG8_WAIT_V(0);
    if (wr == 0) PG8_BAR;
    PG8_BAR;
#undef PG8_SA
#undef PG8_SB
#undef PG8_STAGE
#undef PG8_LDA
#undef PG8_LDB
#undef PG8_MMA
#undef PG8_WAIT_V
#undef PG8_WAIT_L
#undef PG8_BAR
#undef PG8_SCHED
}
}
using pg8::Unit;

struct EpiIn {
    bf16_t *Z, *XBC, *U, *Q, *G; float* DT; float* out; const float *qn, *kn; int layer;
    __device__ __forceinline__ void operator()(const f32x4 (&acc)[2][2][4][2], const Unit& u, int wr, int wc, int fr, int fq) const {
        const int pn = u.pn, rowb = u.pm * 256 + wr * 64 + fr, ctb = wc * 32 + fq * 4;
        if (pn < 11 || (pn >= 17 && pn < 29)) {
            bf16_t* base; int ld, col0; bool sig = false;
            if (pn < 4) { base = Z; ld = 1024; col0 = pn * 256; } else if (pn < 9) { base = XBC; ld = 1280; col0 = (pn - 4) * 256; }
            else if (pn < 11) { base = U; ld = 512; col0 = (pn - 9) * 256; } else { base = G; ld = 3072; col0 = (pn - 17) * 256; sig = true; }
#pragma unroll
            for (int ai = 0; ai < 2; ++ai)
#pragma unroll
                for (int m = 0; m < 4; ++m) { bf16_t* rp = base + (size_t)(rowb + ai * 128 + m * 16) * ld + col0 + ctb;
#pragma unroll
                    for (int bj = 0; bj < 2; ++bj)
#pragma unroll
                        for (int n = 0; n < 2; ++n) { f32x4 v = acc[ai][bj][m][n];
                            if (sig) { v[0] = sigmoidf_(v[0]); v[1] = sigmoidf_(v[1]); v[2] = sigmoidf_(v[2]); v[3] = sigmoidf_(v[3]); }
                            u32x2 o; o[0] = pk2(v[0], v[1]); o[1] = pk2(v[2], v[3]); *(u32x2*)(rp + bj * 128 + n * 16) = o; } }
        } else if (pn < 17) {
            const int seg = (pn - 11) >> 1, head = ((pn - 11) & 1) * 4 + wc;
            const float* nw = seg == 0 ? qn : kn;
            f32x4 wv[2][2];
#pragma unroll
            for (int bj = 0; bj < 2; ++bj)
#pragma unroll
                for (int n = 0; n < 2; ++n) wv[bj][n] = (seg < 2) ? *(const f32x4*)(nw + 32 * bj + 16 * n + 4 * fq) : (f32x4){1.f, 1.f, 1.f, 1.f};
#pragma unroll
            for (int ai = 0; ai < 2; ++ai)
#pragma unroll
                for (int m = 0; m < 4; ++m) { const int row = rowb + ai * 128 + m * 16;
                    float rs = 1.f;
                    if (seg < 2) { float ss = 0.f;
#pragma unroll
                        for (int bj = 0; bj < 2; ++bj)
#pragma unroll
                            for (int n = 0; n < 2; ++n) { const f32x4 v = acc[ai][bj][m][n]; ss += v[0] * v[0] + v[1] * v[1] + v[2] * v[2] + v[3] * v[3]; }
                        ss += __shfl_xor(ss, 16); ss += __shfl_xor(ss, 32);
                        rs = rsqrtf(ss * (1.f / 64.f) + EPS); }
                    if (seg == 0) { bf16_t* rp = Q + (size_t)row * 512 + head * 64 + 4 * fq;
#pragma unroll
                        for (int bj = 0; bj < 2; ++bj)
#pragma unroll
                            for (int n = 0; n < 2; ++n) { const f32x4 v = acc[ai][bj][m][n] * rs * wv[bj][n]; u32x2 o; o[0] = pk2(v[0], v[1]); o[1] = pk2(v[2], v[3]); *(u32x2*)(rp + 32 * bj + 16 * n) = o; }
                    } else { float* rp = out + k_off(layer, row) + (seg == 2 ? (row >= NS0 && row < NM0 ? (O_VS - O_KS) : (O_VP - O_KP)) : 0) + head * 64 + 4 * fq;
#pragma unroll
                        for (int bj = 0; bj < 2; ++bj)
#pragma unroll
                            for (int n = 0; n < 2; ++n) { const f32x4 v = acc[ai][bj][m][n] * rs * wv[bj][n]; *(f32x4*)(rp + 32 * bj + 16 * n) = v; } } }
        } else {
            if (wc == 0) {
#pragma unroll
                for (int ai = 0; ai < 2; ++ai)
#pragma unroll
                    for (int m = 0; m < 4; ++m) *(f32x4*)(DT + (size_t)(rowb + ai * 128 + m * 16) * 16 + 4 * fq) = acc[ai][0][m][0];
            }
        }
    }
};
struct EpiGlu {
    bf16_t* OB;
    __device__ __forceinline__ void operator()(const f32x4 (&acc)[2][2][4][2], const Unit& u, int wr, int wc, int fr, int fq) const {
        const int rowb = u.pm * 256 + wr * 64 + fr, colb = u.pn * 128 + wc * 32 + fq * 4;
#pragma unroll
        for (int ai = 0; ai < 2; ++ai)
#pragma unroll
            for (int m = 0; m < 4; ++m) { bf16_t* rp = OB + (size_t)(rowb + ai * 128 + m * 16) * 1024 + colb;
#pragma unroll
                for (int n = 0; n < 2; ++n) { const f32x4 a = acc[ai][0][m][n], g = acc[ai][1][m][n];
                    u32x2 o; o[0] = pk2(a[0] * sigmoidf_(g[0]), a[1] * sigmoidf_(g[1])); o[1] = pk2(a[2] * sigmoidf_(g[2]), a[3] * sigmoidf_(g[3])); *(u32x2*)(rp + n * 16) = o; } }
    }
};
struct EpiMix {
    bf16_t* R; const bf16_t* G; const bf16_t* OB; int accum;
    __device__ __forceinline__ void operator()(const f32x4 (&acc)[2][2][4][2], const Unit& u, int wr, int wc, int fr, int fq) const {
        const int rowb = u.pm * 256 + wr * 64 + fr, colb = u.pn * 256 + wc * 32 + fq * 4;
#pragma unroll
        for (int ai = 0; ai < 2; ++ai)
#pragma unroll
            for (int m = 0; m < 4; ++m) { const int row = rowb + ai * 128 + m * 16;
#pragma unroll
                for (int bj = 0; bj < 2; ++bj)
#pragma unroll
                    for (int n = 0; n < 2; ++n) { const int col = colb + bj * 128 + n * 16; f32x4 v = acc[ai][bj][m][n];
                        const u32x2 gw = *(const u32x2*)(G + (size_t)row * 3072 + col);
                        v = v * (f32x4){lo_f(gw[0]), hi_f(gw[0]), lo_f(gw[1]), hi_f(gw[1])};
                        if (OB) { const u32x2 g1 = *(const u32x2*)(G + (size_t)row * 3072 + 1024 + col), ob = *(const u32x2*)(OB + (size_t)row * 1024 + col);
                            v = v + (f32x4){lo_f(g1[0]), hi_f(g1[0]), lo_f(g1[1]), hi_f(g1[1])} * (f32x4){lo_f(ob[0]), hi_f(ob[0]), lo_f(ob[1]), hi_f(ob[1])}; }
                        bf16_t* rp = R + (size_t)row * 1024 + col;
                        if (accum) { const u32x2 rw = ld_l2_u32x2(rp); v = v + (f32x4){lo_f(rw[0]), hi_f(rw[0]), lo_f(rw[1]), hi_f(rw[1])}; }
                        u32x2 o; o[0] = pk2(v[0], v[1]); o[1] = pk2(v[2], v[3]); *(u32x2*)rp = o; } }
    }
};
struct EpiRes {
    float* out; float* xmeta;
    __device__ __forceinline__ void operator()(const f32x4 (&acc)[2][2][4][2], const Unit& u, int wr, int wc, int fr, int fq) const {
        const int rowb = u.pm * 256 + wr * 64 + fr, colb = u.pn * 256 + wc * 32 + fq * 4;
        float* base = (u.pm * 256 < NM0) ? out : xmeta - (size_t)NM0 * 1024;
#pragma unroll
        for (int ai = 0; ai < 2; ++ai)
#pragma unroll
            for (int m = 0; m < 4; ++m) { float* rp = base + (size_t)(rowb + ai * 128 + m * 16) * 1024 + colb;
#pragma unroll
                for (int bj = 0; bj < 2; ++bj)
#pragma unroll
                    for (int n = 0; n < 2; ++n) { f32x4* q = (f32x4*)(rp + bj * 128 + n * 16); *q = *q + acc[ai][bj][m][n]; } }
    }
};
struct EpiUp {
    bf16_t* ACT;
    __device__ __forceinline__ void operator()(const f32x4 (&acc)[2][2][4][2], const Unit& u, int wr, int wc, int fr, int fq) const {
        const int rowb = u.pm * 256 + wr * 64 + fr, colb = u.pn * 256 + wc * 32 + fq * 4;
#pragma unroll
        for (int ai = 0; ai < 2; ++ai)
#pragma unroll
            for (int m = 0; m < 4; ++m) { bf16_t* rp = ACT + (size_t)(rowb + ai * 128 + m * 16) * 4096 + colb;
#pragma unroll
                for (int bj = 0; bj < 2; ++bj)
#pragma unroll
                    for (int n = 0; n < 2; ++n) { f32x4 v = acc[ai][bj][m][n];
#pragma unroll
                        for (int j = 0; j < 4; ++j) { const float r = fmaxf(v[j], 0.f); v[j] = r * r; }
                        u32x2 o; o[0] = pk2(v[0], v[1]); o[1] = pk2(v[2], v[3]); *(u32x2*)(rp + bj * 128 + n * 16) = o; } }
    }
};

__device__ __forceinline__ int col_in(int n) {
    if (n < 2304) return n;
    if (n < 2816) return n + 16;
    if (n < 4352) { const int w0 = n - 2816, seg = w0 >> 9, w = w0 & 511, tile = w >> 8, ct = w & 255, bj = ct >> 7, wc = (ct >> 5) & 3, ww = ct & 31;
        return 2832 + seg * 512 + (tile * 4 + wc) * 64 + 32 * bj + ww; }
    if (n < 7424) return n + 16;
    if (n < 7440) return 2304 + (n - 7424);
    return -1;
}
template <int MAP>
__device__ __forceinline__ void prep_w(bf16_t* dst, const float* src, int K, int N, int ld, const float* scale, size_t gtid, size_t gsz) {
    const size_t items = (size_t)(K / 8) * N;
    for (size_t it = gtid; it < items; it += gsz) {
        const int n = (int)(it % N), k8 = (int)(it / N);
        const int c = MAP == 1 ? col_in(n) : (MAP == 2 ? (((n >> 7) & 1) * 1024 + (n >> 8) * 128 + (n & 127)) : n);
        float v[8];
#pragma unroll
        for (int kk = 0; kk < 8; ++kk) { const int k = k8 * 8 + kk; float x = (c >= 0) ? src[(size_t)k * ld + c] : 0.f; if (scale) x *= scale[k]; v[kk] = x; }
        u32x4 o; o[0] = pk2(v[0], v[1]); o[1] = pk2(v[2], v[3]); o[2] = pk2(v[4], v[5]); o[3] = pk2(v[6], v[7]);
        *(u32x4*)(dst + (size_t)n * K + k8 * 8) = o;
    }
}
__device__ __forceinline__ void rmsnorm_rows(CPar p, const float* g, int from_inputs) {
    const int lane = ltid() & 63, gw = lbid() * 8 + (ltid() >> 6), ngw = lgdim() * 8;
    bf16_t* HB = (bf16_t*)(p->ws + WS_HB);
    f32x4 gv[4];
#pragma unroll
    for (int j = 0; j < 4; ++j) gv[j] = *(const f32x4*)(g + lane * 4 + 256 * j);
    for (int r = gw; r < NROWS; r += ngw) {
        float* xl = xloc(p, r);
        const float* src = xl;
        if (from_inputs) src = r < NS0 ? p->in[I_XP] + (size_t)r * 1024 : (r < NM0 ? p->in[I_XS] + (size_t)(r - NS0) * 1024 : p->in[I_META] + (size_t)((r - NM0) & 15) * 1024);
        f32x4 v[4]; float s = 0.f;
#pragma unroll
        for (int j = 0; j < 4; ++j) { v[j] = *(const f32x4*)(src + lane * 4 + 256 * j); s += (v[j][0] * v[j][0] + v[j][1] * v[j][1]) + (v[j][2] * v[j][2] + v[j][3] * v[j][3]); }
        const float rstd = rsqrtf(wave_sum(s) * (1.f / 1024.f) + EPS);
#pragma unroll
        for (int j = 0; j < 4; ++j) { if (from_inputs) *(f32x4*)(xl + lane * 4 + 256 * j) = v[j];
            const f32x4 h = v[j] * rstd * gv[j]; u32x2 o; o[0] = pk2(h[0], h[1]); o[1] = pk2(h[2], h[3]); *(u32x2*)(HB + (size_t)r * 1024 + lane * 4 + 256 * j) = o; }
    }
}
__device__ __forceinline__ void ssd_norm_rows(CPar p) {
    const int lane = ltid() & 63, gw = lbid() * 8 + (ltid() >> 6), ngw = lgdim() * 8;
    bf16_t* Z = (bf16_t*)(p->ws + WS_Z);
    for (int r = gw; r < NROWS; r += ngw) {
#pragma unroll
        for (int j = 0; j < 2; ++j) { u32x4* zp = (u32x4*)(Z + (size_t)r * 1024 + j * 512 + lane * 8); const u32x4 w = *zp;
            float f[8] = {lo_f(w[0]), hi_f(w[0]), lo_f(w[1]), hi_f(w[1]), lo_f(w[2]), hi_f(w[2]), lo_f(w[3]), hi_f(w[3])};
            float ss = 0.f;
#pragma unroll
            for (int i = 0; i < 8; ++i) ss += f[i] * f[i];
            const float rs = rsqrtf(wave_sum(ss) * (1.f / 512.f) + EPS);
            u32x4 o; o[0] = pk2(f[0] * rs, f[1] * rs); o[1] = pk2(f[2] * rs, f[3] * rs); o[2] = pk2(f[4] * rs, f[5] * rs); o[3] = pk2(f[6] * rs, f[7] * rs); *zp = o; }
    }
}
__device__ __forceinline__ void phase_prep(CPar p, int l) {
    const size_t gtid = (size_t)lbid() * 512 + ltid(), gsz = (size_t)lgdim() * 512;
    unsigned char* ws = p->ws;
    prep_w<1>((bf16_t*)(ws + W_BT1), p->in[I_WIN] + (size_t)l * 1024 * IN_COLS, 1024, N1, IN_COLS, nullptr, gtid, gsz);
    prep_w<2>((bf16_t*)(ws + W_GLU), p->in[I_WGLU] + (size_t)l * 512 * 2048, 512, 2048, 2048, nullptr, gtid, gsz);
    prep_w<0>((bf16_t*)(ws + W_LA), p->in[I_WLA] + (size_t)l * 1024 * 1024, 1024, 1024, 1024, p->in[I_NSSD] + l * 1024, gtid, gsz);
    prep_w<0>((bf16_t*)(ws + W_LC), p->in[I_WLC] + (size_t)l * 512 * 1024, 512, 1024, 1024, nullptr, gtid, gsz);
    prep_w<0>((bf16_t*)(ws + W_OUT), p->in[I_WOUT] + (size_t)l * 1024 * 1024, 1024, 1024, 1024, nullptr, gtid, gsz);
    prep_w<0>((bf16_t*)(ws + W_UP), p->in[I_WUP] + (size_t)l * 1024 * 4096, 1024, 4096, 4096, nullptr, gtid, gsz);
    prep_w<0>((bf16_t*)(ws + W_DOWN), p->in[I_WDOWN] + (size_t)l * 4096 * 1024, 4096, 1024, 1024, nullptr, gtid, gsz);
    rmsnorm_rows(p, p->in[I_NMIX] + l * 1024, l == 0);
}

__device__ __forceinline__ bf16_t f2bf_(float v) { return (bf16_t)(pk2(v, v) & 0xffffu); }
__device__ __forceinline__ void ssd_item(CPar p, int l, int item, float* sm) {
    const int tid = ltid(), lane = tid & 63, wave = __builtin_amdgcn_readfirstlane(tid >> 6), rb = wave >> 1, chh = wave & 1, fr = lane & 15, fq = lane >> 4;
    const int s = item < 512 ? (item >> 4) : 32 + ((item - 512) >> 4), h = item & 15, g = h >> 3;
    const bool prompt = s < 32; const int b = prompt ? s : s - 32, T = prompt ? TP : TS;
    constexpr int LB = 72;
    bf16_t *Cb = (bf16_t*)sm, *Bb = Cb + 64 * LB, *XT = Bb + 64 * LB, *WB = XT + 64 * LB, *Mb = WB + 64 * LB, *Sb = Mb + 64 * LB;
    float *sRaw = (float*)(Sb + 64 * LB), *sW = sRaw + 67 * 192, *sdtA = sW + 5 * 192, *sacA = sdtA + 33 * 64, *sw = sacA + 33 * 64;
    const bf16_t* XBC = (const bf16_t*)(p->ws + WS_XBC); bf16_t* Z = (bf16_t*)(p->ws + WS_Z);
    const float* DT = (const float*)(p->ws + WS_DT);
    const float* cw = p->in[I_CONVW] + (size_t)l * 4 * 1280; const float* cb = p->in[I_CONVB] + (size_t)l * 1280;
    const float* hist = p->in[I_SCONV] + (size_t)(l * 16 + b) * 3 * 1280;
    const float dtb = p->in[I_DTB][l * 16 + h], aneg = -__expf(p->in[I_ALOG][l * 16 + h]), dsk = p->in[I_DSSD][l * 16 + h];
    float* sout = prompt ? p->out + O_SSDP + ((size_t)(l * 32 + b) * 16 + h) * 4096 : p->out + O_SSDS + ((size_t)(l * 16 + b) * 16 + h) * 4096;
    for (int i = tid; i < 5 * 192; i += 512) { const int k = i / 192, ch = i - k * 192; const int col = ch < 64 ? h * 64 + ch : (ch < 128 ? 1024 + g * 64 + (ch - 64) : 1152 + g * 64 + (ch - 128));
        sW[i] = k < 4 ? cw[k * 1280 + col] : cb[col]; }
    f32x4 accS[2];
#pragma unroll
    for (int c2 = 0; c2 < 2; ++c2)
#pragma unroll
        for (int r = 0; r < 4; ++r) { const int pp = rb * 16 + fq * 4 + r, n = chh * 32 + c2 * 16 + fr;
            const float v = prompt ? 0.f : p->in[I_SSSD][((size_t)(l * 16 + b) * 16 + h) * 4096 + pp * 64 + n]; accS[c2][r] = v; Sb[pp * LB + n] = f2bf_(v); }
    const int nch = (T + 63) >> 6;
    { const int wv = tid >> 6, ln = tid & 63; float xv[5];
#pragma unroll
        for (int r = 0; r < 5; ++r) { const int c = wv + 8 * r, t = c * 64 + ln; xv[r] = (c < nch && t < T) ? DT[(size_t)row_of(s, t) * 16 + h] + dtb : -1e30f; }
#pragma unroll
        for (int r = 0; r < 5; ++r) { const int c = wv + 8 * r;
            if (c < nch) { const float x = xv[r]; const float dtv = x < -1e29f ? 0.f : (x > 20.f ? x : log1pf(__expf(x))); float cs = dtv * aneg;
#pragma unroll
                for (int o = 1; o < 64; o <<= 1) { const float nb = __shfl_up(cs, o); if (ln >= o) cs += nb; }
                sdtA[c * 64 + ln] = dtv; sacA[c * 64 + ln] = cs; } } }
    u32x4 pf[4];
#define SSD_ISSUE(cc) do { _Pragma("unroll") for (int it4 = 0; it4 < 4; ++it4) { const int pi = tid + it4 * 512; pf[it4] = (u32x4){0u, 0u, 0u, 0u}; \
        if (pi < 67 * 24) { const int rl = pi / 24, pc = pi - rl * 24, seg = pc >> 3, q8 = pc & 7, tt = (cc) * 64 - 3 + rl; \
            const int col = (seg == 0 ? h * 64 : (seg == 1 ? 1024 + g * 64 : 1152 + g * 64)) + q8 * 8; \
            if (tt >= 0 && tt < T) pf[it4] = *(const u32x4*)(XBC + (size_t)row_of(s, tt) * 1280 + col); } } } while (0)
#define SSD_FRAG(P, r0, ks) (*(const bf16x8*)((P) + ((r0) + fr) * LB + (ks) * 32 + fq * 8))
    SSD_ISSUE(0);
#pragma unroll 1
    for (int c = 0; c < nch; ++c) {
        const int t0 = c * 64; const float* sdt = sdtA + t0; const float* sac = sacA + t0;
        __syncthreads();
#pragma unroll
        for (int it4 = 0; it4 < 4; ++it4) { const int pi = tid + it4 * 512;
            if (pi < 67 * 24) { const int rl = pi / 24, pc = pi - rl * 24, seg = pc >> 3, q8 = pc & 7, tt = t0 - 3 + rl;
                const u32x4 w = pf[it4];
                f32x4 f0 = {lo_f(w[0]), hi_f(w[0]), lo_f(w[1]), hi_f(w[1])}, f1 = {lo_f(w[2]), hi_f(w[2]), lo_f(w[3]), hi_f(w[3])};
                if (tt < 0 && !prompt) { const int col = (seg == 0 ? h * 64 : (seg == 1 ? 1024 + g * 64 : 1152 + g * 64)) + q8 * 8; const float* hp = hist + (3 + tt) * 1280 + col; f0 = *(const f32x4*)hp; f1 = *(const f32x4*)(hp + 4); }
                float* dp = sRaw + rl * 192 + seg * 64 + q8 * 8; *(f32x4*)dp = f0; *(f32x4*)(dp + 4) = f1; } }
        if (tid < 64) sw[tid] = __expf(sac[63] - sac[tid]) * sdt[tid];
        if (c + 1 < nch) SSD_ISSUE(c + 1);
        bf16_t zq[2][4];
#pragma unroll
        for (int c2 = 0; c2 < 2; ++c2)
#pragma unroll
            for (int r = 0; r < 4; ++r) { const int t = t0 + rb * 16 + fq * 4 + r; zq[c2][r] = (t < T) ? Z[(size_t)row_of(s, t) * 1024 + h * 64 + chh * 32 + c2 * 16 + fr] : (bf16_t)0; }
        __syncthreads();
        if (tid < 384) { const int ch = tid % 192, tlb = (tid / 192) * 32, cc = ch & 63;
            const float w0 = sW[ch], w1 = sW[192 + ch], w2 = sW[384 + ch], w3 = sW[576 + ch], bias = sW[768 + ch];
            float r0 = sRaw[(tlb + 0) * 192 + ch], r1 = sRaw[(tlb + 1) * 192 + ch], r2 = sRaw[(tlb + 2) * 192 + ch];
            float ov[32];
#pragma unroll
            for (int i2 = 0; i2 < 32; ++i2) { const float r3 = sRaw[(tlb + i2 + 3) * 192 + ch];
                const float v = bias + w0 * r0 + w1 * r1 + w2 * r2 + w3 * r3; ov[i2] = (t0 + tlb + i2 < T) ? siluf_(v) : 0.f; r0 = r1; r1 = r2; r2 = r3; }
            if (ch < 128) { bf16_t* dst = (ch < 64 ? XT : WB) + cc * LB + tlb;
#pragma unroll
                for (int q4 = 0; q4 < 4; ++q4) { u32x4 w;
#pragma unroll
                    for (int c4 = 0; c4 < 4; ++c4) { const int i2 = q4 * 8 + c4 * 2; const float s0 = ch < 64 ? 1.f : sw[tlb + i2], s1 = ch < 64 ? 1.f : sw[tlb + i2 + 1]; w[c4] = pk2(ov[i2] * s0, ov[i2 + 1] * s1); }
                    *(u32x4*)(dst + q4 * 8) = w; } }
            if (ch >= 64) { bf16_t* dst = (ch < 128 ? Bb : Cb) + tlb * LB + cc;
#pragma unroll
                for (int i2 = 0; i2 < 32; ++i2) dst[i2 * LB] = f2bf_(ov[i2]); } }
        __syncthreads();
        f32x4 acc2[2];
        { const bf16x8 aC0 = SSD_FRAG(Cb, rb * 16, 0), aC1 = SSD_FRAG(Cb, rb * 16, 1);
#pragma unroll
            for (int c2 = 0; c2 < 2; ++c2) { const int j0 = chh * 32 + c2 * 16;
                f32x4 m = {0.f, 0.f, 0.f, 0.f};
                if (j0 <= rb * 16 + 15) { m = __builtin_amdgcn_mfma_f32_16x16x32_bf16(aC0, SSD_FRAG(Bb, j0, 0), m, 0, 0, 0); m = __builtin_amdgcn_mfma_f32_16x16x32_bf16(aC1, SSD_FRAG(Bb, j0, 1), m, 0, 0, 0); }
                const int j = j0 + fr; const float acj = sac[j], dtj = sdt[j];
#pragma unroll
                for (int r = 0; r < 4; ++r) { const int tl = rb * 16 + fq * 4 + r; Mb[tl * LB + j] = f2bf_(j <= tl ? m[r] * __expf(sac[tl] - acj) * dtj : 0.f); }
                f32x4 y = {0.f, 0.f, 0.f, 0.f};
                y = __builtin_amdgcn_mfma_f32_16x16x32_bf16(aC0, SSD_FRAG(Sb, j0, 0), y, 0, 0, 0); y = __builtin_amdgcn_mfma_f32_16x16x32_bf16(aC1, SSD_FRAG(Sb, j0, 1), y, 0, 0, 0);
#pragma unroll
                for (int r = 0; r < 4; ++r) y[r] *= __expf(sac[rb * 16 + fq * 4 + r]);
                acc2[c2] = y; }
            const bf16x8 aX0 = SSD_FRAG(XT, rb * 16, 0), aX1 = SSD_FRAG(XT, rb * 16, 1); const float eL = __expf(sac[63]);
#pragma unroll
            for (int c2 = 0; c2 < 2; ++c2) { const int n0 = chh * 32 + c2 * 16; f32x4 sv = accS[c2] * eL;
                sv = __builtin_amdgcn_mfma_f32_16x16x32_bf16(aX0, SSD_FRAG(WB, n0, 0), sv, 0, 0, 0); sv = __builtin_amdgcn_mfma_f32_16x16x32_bf16(aX1, SSD_FRAG(WB, n0, 1), sv, 0, 0, 0); accS[c2] = sv; } }
        __syncthreads();
        { const bf16x8 aM0 = SSD_FRAG(Mb, rb * 16, 0), aM1 = SSD_FRAG(Mb, rb * 16, 1);
#pragma unroll
            for (int c2 = 0; c2 < 2; ++c2) { const int p0 = chh * 32 + c2 * 16, pp = p0 + fr; f32x4 y = acc2[c2];
                y = __builtin_amdgcn_mfma_f32_16x16x32_bf16(aM0, SSD_FRAG(XT, p0, 0), y, 0, 0, 0); y = __builtin_amdgcn_mfma_f32_16x16x32_bf16(aM1, SSD_FRAG(XT, p0, 1), y, 0, 0, 0);
#pragma unroll
                for (int r = 0; r < 4; ++r) { const int tl = rb * 16 + fq * 4 + r, t = t0 + tl;
                    if (t < T) { bf16_t* zp = Z + (size_t)row_of(s, t) * 1024 + h * 64 + pp; const float yy = (y[r] + dsk * bf2f(XT[pp * LB + tl])) * siluf_(bf2f(zq[c2][r])); *zp = f2bf_(yy); } } }
#pragma unroll
            for (int c2 = 0; c2 < 2; ++c2)
#pragma unroll
                for (int r = 0; r < 4; ++r) Sb[(rb * 16 + fq * 4 + r) * LB + chh * 32 + c2 * 16 + fr] = f2bf_(accS[c2][r]); }
    }
    __syncthreads();
#pragma unroll
    for (int c2 = 0; c2 < 2; ++c2)
#pragma unroll
        for (int r = 0; r < 4; ++r) sout[(rb * 16 + fq * 4 + r) * 64 + chh * 32 + c2 * 16 + fr] = accS[c2][r];
    float* cout_ = prompt ? p->out + O_CONVP + (size_t)(l * 32 + b) * 3 * 1280 : p->out + O_CONVS + (size_t)(l * 16 + b) * 3 * 1280;
    for (int idx = tid; idx < 3 * 192; idx += 512) { const int k = idx / 192, ch = idx - k * 192;
        if (ch >= 64 && (h & 7) != 0) continue;
        const int col = ch < 64 ? h * 64 + ch : (ch < 128 ? 1024 + g * 64 + (ch - 64) : 1152 + g * 64 + (ch - 128));
        cout_[k * 1280 + col] = bf2f(XBC[(size_t)row_of(s, T - 3 + k) * 1280 + col]); }
    __syncthreads();
#undef SSD_ISSUE
#undef SSD_FRAG
}

__device__ __forceinline__ void s5_item(CPar p, int l, int s, int g, float* wl) {
    const int lane = ltid() & 63, fr = lane & 15, fq = lane >> 4;
    const bool prompt = s < 32; const int b = prompt ? s : s - 32, T = prompt ? TP : TS, nblk = T >> 4;
    constexpr int LBX = 136;
    bf16_t* Xb = (bf16_t*)wl;
    bf16_t* U = (bf16_t*)(p->ws + WS_U);
    const int gp = (l * 32 + g) * 64 + lane;
    const float lr = p->in[I_LRE][gp], li = p->in[I_LIM][gp], step = expf(p->in[I_LSTEP][l * 32 + g]);
    float sn, cs; sincos_red((double)li * (double)step, sn, cs);
    const float mag = expf(lr * step), ab_re = mag * cs, ab_im = mag * sn;
    const float den = lr * lr + li * li, nr = ab_re - 1.f, f_re = (nr * lr + ab_im * li) / den, f_im = (ab_im * lr - nr * li) / den;
    float bbr[16], bbi[16];
#pragma unroll
    for (int hh = 0; hh < 16; ++hh) { const float br = p->in[I_BRE][(size_t)gp * 16 + hh], bi = p->in[I_BIM][(size_t)gp * 16 + hh]; bbr[hh] = f_re * br - f_im * bi; bbi[hh] = f_re * bi + f_im * br; }
    bf16x8 cfrag[4];
#pragma unroll
    for (int ks = 0; ks < 4; ++ks) { const int k0 = ks * 32 + fq * 8; const bool im = k0 >= 64;
        const float* cp = (im ? p->in[I_CIM] : p->in[I_CRE]) + ((size_t)(l * 32 + g) * 16 + fr) * 64 + (k0 & 63);
        const f32x4 c0 = *(const f32x4*)cp, c1 = *(const f32x4*)(cp + 4); const float sg = im ? -1.f : 1.f;
        u32x4 w; w[0] = pk2(sg * c0[0], sg * c0[1]); w[1] = pk2(sg * c0[2], sg * c0[3]); w[2] = pk2(sg * c1[0], sg * c1[1]); w[3] = pk2(sg * c1[2], sg * c1[3]);
        cfrag[ks] = __builtin_bit_cast(bf16x8, w); }
    float xr = prompt ? 0.f : p->in[I_S5R][(size_t)(l * 16 + b) * 2048 + g * 64 + lane], xi = prompt ? 0.f : p->in[I_S5I][(size_t)(l * 16 + b) * 2048 + g * 64 + lane];
    const float dsk = p->in[I_DS5][(size_t)(l * 32 + g) * 16 + fr];
    u32x4 ua = {0, 0, 0, 0}, ub = {0, 0, 0, 0};
    { const int r0 = row_of(s, 0); if (lane < 16) { const u32x4* up = (const u32x4*)(U + (size_t)(r0 + lane) * 512 + g * 16); ua = up[0]; ub = up[1]; } }
    for (int blk = 0; blk < nblk; ++blk) {
        const int r0 = row_of(s, blk * 16);
        const u32x4 ca = ua, cbv = ub;
        if (blk + 1 < nblk && lane < 16) { const int r1 = row_of(s, blk * 16 + 16); const u32x4* up = (const u32x4*)(U + (size_t)(r1 + lane) * 512 + g * 16); ua = up[0]; ub = up[1]; }
#pragma unroll
        for (int i = 0; i < 16; ++i) {
            float br4[4] = {0.f, 0.f, 0.f, 0.f}, bi4[4] = {0.f, 0.f, 0.f, 0.f};
#pragma unroll
            for (int w = 0; w < 8; ++w) { const unsigned word = (unsigned)__builtin_amdgcn_readlane((int)(w < 4 ? ca[w] : cbv[w - 4]), i);
                const float u0 = lo_f(word), u1 = hi_f(word);
                br4[w & 3] += bbr[2 * w] * u0 + bbr[2 * w + 1] * u1; bi4[w & 3] += bbi[2 * w] * u0 + bbi[2 * w + 1] * u1; }
            const float bur = (br4[0] + br4[1]) + (br4[2] + br4[3]), bui = (bi4[0] + bi4[1]) + (bi4[2] + bi4[3]);
            const float nxr = ab_re * xr - ab_im * xi + bur, nxi = ab_re * xi + ab_im * xr + bui; xr = nxr; xi = nxi;
            Xb[i * LBX + lane] = f2bf_(xr); Xb[i * LBX + 64 + lane] = f2bf_(xi);
        }
        __builtin_amdgcn_wave_barrier(); asm volatile("s_waitcnt lgkmcnt(0)" ::: "memory");
        f32x4 y = {0.f, 0.f, 0.f, 0.f};
#pragma unroll
        for (int ks = 0; ks < 4; ++ks) y = __builtin_amdgcn_mfma_f32_16x16x32_bf16(*(const bf16x8*)(Xb + fr * LBX + ks * 32 + fq * 8), cfrag[ks], y, 0, 0, 0);
#pragma unroll
        for (int r = 0; r < 4; ++r) { bf16_t* up = U + (size_t)(r0 + fq * 4 + r) * 512 + g * 16 + fr; *up = f2bf_(geluf_(y[r] + dsk * bf2f(*up))); }
        __builtin_amdgcn_wave_barrier(); asm volatile("s_waitcnt lgkmcnt(0)" ::: "memory");
    }
    float* ore = prompt ? p->out + O_S5RP + (size_t)(l * 32 + b) * 2048 : p->out + O_S5RS + (size_t)(l * 16 + b) * 2048;
    float* oim = prompt ? p->out + O_S5IP + (size_t)(l * 32 + b) * 2048 : p->out + O_S5IS + (size_t)(l * 16 + b) * 2048;
    ore[g * 64 + lane] = xr; oim[g * 64 + lane] = xi;
}

typedef __bf16 bf2_t __attribute__((ext_vector_type(2)));
__device__ __forceinline__ float dot2bf(unsigned a, unsigned b, float c) { return __builtin_amdgcn_fdot2_f32_bf16(__builtin_bit_cast(bf2_t, a), __builtin_bit_cast(bf2_t, b), c, false); }
__device__ __forceinline__ void attn_item(CPar p, int l, int item, float* wl) {
    const int lane = ltid() & 63;
    int s, h, qt;
    if (item < 8448) { s = item / 264; const int rem = item - s * 264; h = rem / 33; qt = rem - h * 33; } else { const int it = item - 8448; s = 32 + (it >> 3); h = it & 7; qt = 0; }
    const bool prompt = s < 32; const int b = prompt ? s : s - 32, T = prompt ? TP : TS, nh = prompt ? 0 : PAST;
    const int i = qt * 64 + lane; const bool active = i < T; const int row = row_of(s, active ? i : T - 1);
    bf16_t* Q = (bf16_t*)(p->ws + WS_Q);
    unsigned* Kt = (unsigned*)wl; unsigned* Vp = Kt + 32 * 32;
    unsigned q[32]; float o[64];
    { const u32x4* qp = (const u32x4*)(Q + (size_t)row * 512 + h * 64);
#pragma unroll
        for (int e = 0; e < 8; ++e) { const u32x4 w = qp[e];
#pragma unroll
            for (int j = 0; j < 4; ++j) q[e * 4 + j] = pk2(lo_f(w[j]) * 0.125f, hi_f(w[j]) * 0.125f); } }
#pragma unroll
    for (int d = 0; d < 64; ++d) o[d] = 0.f;
    const float* kp_new = prompt ? p->out + O_KP + (size_t)(l * 32 + b) * 2064 * 512 + h * 64 : p->out + O_KS + (size_t)(l * 16 + b) * 64 * 512 + h * 64;
    const float* vp_new = prompt ? p->out + O_VP + (size_t)(l * 32 + b) * 2064 * 512 + h * 64 : p->out + O_VS + (size_t)(l * 16 + b) * 64 * 512 + h * 64;
    const float* kp_old = p->in[I_CK] + (size_t)(l * 16 + b) * 2048 * 512 + h * 64;
    const float* vp_old = p->in[I_CV] + (size_t)(l * 16 + b) * 2048 * 512 + h * 64;
    const int imax = (qt * 64 + 63 < T - 1) ? qt * 64 + 63 : T - 1;
    const int jtop = nh + imax - 1;
    float run = 0.f;
    f32x4 kreg[8], va[4], vb[4];
#define ATT_FETCH(JT) do { _Pragma("unroll") for (int e = 0; e < 8; ++e) { const int idx = e * 64 + lane, kr = idx >> 4, pc = idx & 15, j = (JT) - kr; kreg[e] = (f32x4){0.f, 0.f, 0.f, 0.f}; \
            if (j >= 0) { const float* kp = (j < nh) ? kp_old + (size_t)j * 512 : kp_new + (size_t)(j - nh) * 512; kreg[e] = *(const f32x4*)(kp + pc * 4); } } \
        _Pragma("unroll") for (int e = 0; e < 4; ++e) { const int idx = e * 64 + lane, m = idx >> 4, pc = idx & 15, j0 = (JT) - 2 * m, j1 = j0 - 1; va[e] = (f32x4){0.f, 0.f, 0.f, 0.f}; vb[e] = (f32x4){0.f, 0.f, 0.f, 0.f}; \
            if (j0 >= 0) { const float* vp = (j0 < nh) ? vp_old + (size_t)j0 * 512 : vp_new + (size_t)(j0 - nh) * 512; va[e] = *(const f32x4*)(vp + pc * 4); } \
            if (j1 >= 0) { const float* vp = (j1 < nh) ? vp_old + (size_t)j1 * 512 : vp_new + (size_t)(j1 - nh) * 512; vb[e] = *(const f32x4*)(vp + pc * 4); } } } while (0)
    if (jtop >= 0) ATT_FETCH(jtop);
    for (int jt = jtop; jt >= 0; jt -= 32) {
#pragma unroll
        for (int e = 0; e < 8; ++e) { const int idx = e * 64 + lane, kr = idx >> 4, pc = idx & 15; u32x2 w; w[0] = pk2(kreg[e][0], kreg[e][1]); w[1] = pk2(kreg[e][2], kreg[e][3]); *(u32x2*)(Kt + kr * 32 + pc * 2) = w; }
#pragma unroll
        for (int e = 0; e < 4; ++e) { const int idx = e * 64 + lane, m = idx >> 4, pc = idx & 15;
            u32x4 w; w[0] = pk2(va[e][0], vb[e][0]); w[1] = pk2(va[e][1], vb[e][1]); w[2] = pk2(va[e][2], vb[e][2]); w[3] = pk2(va[e][3], vb[e][3]); *(u32x4*)(Vp + m * 64 + pc * 4) = w; }
        __builtin_amdgcn_wave_barrier(); asm volatile("s_waitcnt lgkmcnt(0)" ::: "memory");
        if (jt - 32 >= 0) ATT_FETCH(jt - 32);
        const int nk = jt + 1 < 32 ? jt + 1 : 32, npair = (nk + 1) >> 1;
        for (int m = 0; m < npair; ++m) { const int j0 = jt - 2 * m, j1 = j0 - 1;
            float z0 = 0.f, z1 = 0.f;
#pragma unroll
            for (int d8 = 0; d8 < 8; ++d8) { const u32x4 k0 = *(const u32x4*)(Kt + (2 * m) * 32 + d8 * 4), k1 = *(const u32x4*)(Kt + (2 * m + 1) * 32 + d8 * 4);
#pragma unroll
                for (int c = 0; c < 4; ++c) { z0 = dot2bf(q[d8 * 4 + c], k0[c], z0); z1 = dot2bf(q[d8 * 4 + c], k1[c], z1); } }
            const bool v0 = active && (j0 < nh + i), v1 = active && (j1 >= 0) && (j1 < nh + i);
            const float e0 = __expf(-z0), ls0 = -__logf(1.f + e0);
            const float w0 = v0 ? __expf(ls0 + run) : 0.f; run += v0 ? (ls0 - z0) : 0.f;
            const float e1 = __expf(-z1), ls1 = -__logf(1.f + e1);
            const float w1 = v1 ? __expf(ls1 + run) : 0.f; run += v1 ? (ls1 - z1) : 0.f;
            const unsigned wp = pk2(w0, w1);
#pragma unroll
            for (int d4 = 0; d4 < 16; ++d4) { const u32x4 vv = *(const u32x4*)(Vp + m * 64 + d4 * 4);
#pragma unroll
                for (int c = 0; c < 4; ++c) o[d4 * 4 + c] = dot2bf(wp, vv[c], o[d4 * 4 + c]); } }
        __builtin_amdgcn_wave_barrier(); asm volatile("s_waitcnt lgkmcnt(0)" ::: "memory");
        const int fin = (!active) || (run < -50.f);
        if (__all(fin)) break;
    }
#undef ATT_FETCH
    if (active) { u32x4* op = (u32x4*)(Q + (size_t)row * 512 + h * 64);
#pragma unroll
        for (int e = 0; e < 8; ++e) { u32x4 w; w[0] = pk2(o[e * 8], o[e * 8 + 1]); w[1] = pk2(o[e * 8 + 2], o[e * 8 + 3]); w[2] = pk2(o[e * 8 + 4], o[e * 8 + 5]); w[3] = pk2(o[e * 8 + 6], o[e * 8 + 7]); op[e] = w; } }
}

__device__ __forceinline__ void phase_mixers(CPar p, int l, float* sm) {
#ifndef SKIP_SSD
    { CPar p1 = params_ptr();
#pragma unroll 1
      for (int it = lbid(); it < 768; it += lgdim()) ssd_item(p1, l, it, sm); }
#endif
    __syncthreads();
    const int wave = __builtin_amdgcn_readfirstlane(ltid() >> 6);
    float* wl = sm + wave * (68 * 64);
#ifndef SKIP_S5
    { CPar p2 = params_ptr();
    if (wave < 4) { for (int it = lbid() * 4 + wave; it < 1024; it += lgdim() * 4) s5_item(p2, l, it >> 5, it & 31, wl); }
    else if (wave < 6) { for (int it = lbid() * 2 + (wave - 4); it < 512; it += lgdim() * 2) s5_item(p2, l, 32 + (it >> 5), it & 31, wl); } }
#endif
#ifndef SKIP_ATT
    CPar p3 = params_ptr();
    unsigned* ctr = (unsigned*)(p3->ws + WS_CTR) + l;
    for (;;) {
        unsigned it = 0; if ((ltid() & 63) == 0) it = atomicAdd(ctr, 1u);
        it = (unsigned)__builtin_amdgcn_readfirstlane((int)it);
        if (it >= 8576u) break;
        attn_item(p3, l, (int)it, wl);
    }
#endif
}

#define XB_TMO      128
#define XB_XCNT(j)  (256  + 64 * (j))
#define XB_XSUB(j)  (1280 + 64 * (j))
#define XB_XGEN(j)  (2304 + 64 * (j))
#define XB_TOP      3328
#define XB_TOPGEN   3392
#define XCD_BAR_WORDS 3456
#define XB_SPIN_CAP (1u << 18)

__device__ __forceinline__ unsigned xb_ld(unsigned* p)              { return __hip_atomic_load(p, __ATOMIC_RELAXED, __HIP_MEMORY_SCOPE_AGENT); }
__device__ __forceinline__ unsigned xb_add(unsigned* p, unsigned v) { return __hip_atomic_fetch_add(p, v, __ATOMIC_RELAXED, __HIP_MEMORY_SCOPE_AGENT); }
__device__ __forceinline__ unsigned xb_xcc_id() { return (unsigned)__builtin_amdgcn_s_getreg((3 << 11) | 20) & 0xFu; }
#define XB_SPIN(cond, bar) do { unsigned _sp = 0; while (cond) { __builtin_amdgcn_s_sleep(1); \
    if ((++_sp & 255u) == 0u) { if (xb_ld(&(bar)[XB_TMO])) break; if (_sp > XB_SPIN_CAP) { atomicAdd(&(bar)[XB_TMO], 1u); break; } } } } while (0)

struct XcdBarrier {
    unsigned* bar; unsigned x;
    volatile LAS unsigned* st;
};

__device__ __forceinline__ XcdBarrier xcd_barrier_post(unsigned* bar, volatile LAS unsigned* st) {
    XcdBarrier b; b.bar = bar; b.x = xb_xcc_id(); b.st = st;
    if (threadIdx.x == 0) (void)xb_add(&bar[XB_XCNT(b.x)], 1u);
    return b;
}
__device__ __forceinline__ void xcd_barrier_complete(unsigned* bar, unsigned x, unsigned& nloc, unsigned& nx) {
    const unsigned G = gridDim.x * gridDim.y * gridDim.z;
    unsigned sum, cnt, mine, sp = 0u;
    for (;;) {
        sum = 0u; cnt = 0u; mine = 0u;
#pragma unroll
        for (unsigned j = 0; j < 16; ++j) { const unsigned c = xb_ld(&bar[XB_XCNT(j)]); sum += c; cnt += (c > 0u) ? 1u : 0u; mine = (j == x) ? c : mine; }
        if (sum == G) break;
        __builtin_amdgcn_s_sleep(1);
        if ((++sp & 255u) == 0u) { if (xb_ld(&bar[XB_TMO])) break; if (sp > XB_SPIN_CAP) { atomicAdd(&bar[XB_TMO], 1u); break; } }
    }
    nloc = mine > 0u ? mine : 1u; nx = cnt > 0u ? cnt : 1u;
}

__device__ __forceinline__ void xcd_barrier(const XcdBarrier& b) {
    asm volatile("s_waitcnt vmcnt(0)" ::: "memory");
    __syncthreads();
    if (threadIdx.x == 0) {
        unsigned* bar = b.bar;
        __builtin_amdgcn_s_waitcnt(0);
        unsigned nloc = b.st[0], nx = b.st[1];
        if (nloc == 0u) { xcd_barrier_complete(bar, b.x, nloc, nx); b.st[0] = nloc; b.st[1] = nx; }
        const unsigned old = xb_add(&bar[XB_XSUB(b.x)], 1u);
        const unsigned gen = old / nloc;
        if (old + 1u == (gen + 1u) * nloc) {
            __builtin_amdgcn_fence(__ATOMIC_RELEASE, "agent");
            asm volatile("s_waitcnt vmcnt(0)" ::: "memory");
            const unsigned og = xb_add(&bar[XB_TOP], 1u);
            const unsigned tg = og / nx;
            if (og + 1u == (tg + 1u) * nx) xb_add(&bar[XB_TOPGEN], 1u);
            else XB_SPIN(xb_ld(&bar[XB_TOPGEN]) == tg, bar);
            __builtin_amdgcn_fence(__ATOMIC_ACQUIRE, "agent");
            xb_add(&bar[XB_XGEN(b.x)], 1u);
            asm volatile("s_waitcnt vmcnt(0)" ::: "memory");
        } else {
            XB_SPIN(xb_ld(&bar[XB_XGEN(b.x)]) == gen, bar);
            __builtin_amdgcn_fence(__ATOMIC_ACQUIRE, "agent");
            asm volatile("s_waitcnt vmcnt(0)" ::: "memory");
        }
    }
    __syncthreads();
}
__global__ __launch_bounds__(512, 2) void mega(Params pk) {
    extern __shared__ __attribute__((aligned(16))) unsigned char smem[];
    cg::grid_group grid = cg::this_grid();
    LAS unsigned char* lds = (LAS unsigned char*)smem;
    const int ph_lo = pk.ph_lo, ph_hi = pk.ph_hi;
    volatile LAS unsigned* xst = (volatile LAS unsigned*)(lds + (LDS_BYTES - 16));
    if (threadIdx.x == 0) { xst[0] = 0u; xst[1] = 0u; }
    const XcdBarrier xb = xcd_barrier_post((unsigned*)(pk.ws + WS_SSQ), xst);
    for (int ph = ph_lo; ph < ph_hi; ++ph) {
        if (ph == ph_lo + 1) grid.sync();
        else if (ph > ph_lo + 1) xcd_barrier(xb);
        CPar p = params_ptr();
        unsigned char* ws = p->ws;
        bf16_t *HB = (bf16_t*)(ws + WS_HB), *Z = (bf16_t*)(ws + WS_Z), *XBC = (bf16_t*)(ws + WS_XBC), *U = (bf16_t*)(ws + WS_U), *Q = (bf16_t*)(ws + WS_Q), *G = (bf16_t*)(ws + WS_G);
        float *DT = (float*)(ws + WS_DT), *XM = (float*)(ws + WS_XMETA);
        const int l = ph / 9, sub = ph - l * 9;
        pg8::StaticOrder S;
        if (sub == 0) {
#ifndef SKIP0
            phase_prep(p, l);
#endif
        } else if (sub == 1) {
            S.init(NROWS, N1, lgdim(), lbid());
            EpiIn E{Z, XBC, U, Q, G, DT, p->out, p->in[I_QN] + l * 64, p->in[I_KN] + l * 64, l};
#ifndef SKIP1
            pg8::gemm_phase(lds, pg8::Gemm{HB, (const bf16_t*)(ws + W_BT1), NROWS, N1, 1024, 1024, 1024}, S, E);
#endif
        } else if (sub == 2) {
#ifndef SKIP2
            phase_mixers(p, l, (float*)smem);
#endif
        } else if (sub == 3) {
            ssd_norm_rows(p);
            S.init(NROWS, 2048, lgdim(), lbid());
            EpiGlu E{XBC};
            pg8::gemm_phase(lds, pg8::Gemm{U, (const bf16_t*)(ws + W_GLU), NROWS, 2048, 512, 512, 512}, S, E);
        } else if (sub == 4) {
            S.init(NROWS, 1024, lgdim(), lbid());
            for (int call = 0; call < 2; ++call) {
                EpiMix E; pg8::Gemm g;
                if (call == 0) { E = EpiMix{HB, G, XBC, 0}; g = pg8::Gemm{Z, (const bf16_t*)(ws + W_LA), NROWS, 1024, 1024, 1024, 1024}; }
                else { E = EpiMix{HB, G + 2048, nullptr, 1}; g = pg8::Gemm{Q, (const bf16_t*)(ws + W_LC), NROWS, 1024, 512, 512, 512}; }
#ifndef SKIP3
                pg8::gemm_phase(lds, g, S, E);
#endif
            }
        } else if (sub == 5) {
            S.init(NROWS, 1024, lgdim(), lbid());
            EpiRes E{p->out, XM};
#ifndef SKIP4
            pg8::gemm_phase(lds, pg8::Gemm{HB, (const bf16_t*)(ws + W_OUT), NROWS, 1024, 1024, 1024, 1024}, S, E);
#endif
        } else if (sub == 6) {
            rmsnorm_rows(p, p->in[I_NFFN] + l * 1024, 0);
        } else if (sub == 7) {
            S.init(NROWS, 4096, lgdim(), lbid());
            EpiUp E{(bf16_t*)(ws + WS_ACT)};
#ifndef SKIP6
            pg8::gemm_phase(lds, pg8::Gemm{HB, (const bf16_t*)(ws + W_UP), NROWS, 4096, 1024, 1024, 1024}, S, E);
#endif
        } else {
            S.init(NROWS, 1024, lgdim(), lbid());
            EpiRes E{p->out, XM};
#ifndef SKIP7
            pg8::gemm_phase(lds, pg8::Gemm{(const bf16_t*)(ws + WS_ACT), (const bf16_t*)(ws + W_DOWN), NROWS, 1024, 4096, 4096, 4096}, S, E);
#endif
        }
    }
}

extern "C" void kernel_launch(void* const* d_in, const int* in_sizes, int n_in, void* d_out, int out_size, void* d_ws, size_t ws_size, hipStream_t stream) {
    static int grid = 0;
    if (grid == 0) {
        if (n_in != 34 || (size_t)out_size != O_END || ws_size < WS_END) { fprintf(stderr, "kernel_launch: unexpected shapes n_in %d out %d ws %zu (need %zu)\n", n_in, out_size, ws_size, (size_t)WS_END); grid = -1; return; }
        int dev = 0, cus = 0, per_cu = 0;
        hipGetDevice(&dev); hipDeviceGetAttribute(&cus, hipDeviceAttributeMultiprocessorCount, dev);
        if (hipFuncSetAttribute((const void*)mega, hipFuncAttributeMaxDynamicSharedMemorySize, LDS_BYTES) != hipSuccess) { fprintf(stderr, "kernel_launch: hipFuncSetAttribute failed\n"); grid = -1; return; }
        if (hipOccupancyMaxActiveBlocksPerMultiprocessor(&per_cu, (const void*)mega, 512, LDS_BYTES) != hipSuccess || per_cu < 1) { fprintf(stderr, "kernel_launch: occupancy query says %d\n", per_cu); per_cu = 1; }
        (void)hipGetLastError();
        grid = cus * per_cu;
    }
    if (grid < 0) return;
    if (hipMemsetAsync((char*)d_ws + WS_CTR, 0, 4096, stream) != hipSuccess || hipMemsetAsync((char*)d_ws + WS_SSQ, 0, XCD_BAR_WORDS * 4, stream) != hipSuccess) { fprintf(stderr, "kernel_launch: memset failed\n"); return; }
    Params p{};
    for (int i = 0; i < 34; ++i) p.in[i] = (const float*)d_in[i];
    p.out = (float*)d_out; p.ws = (unsigned char*)d_ws;
#if MULTI_LAUNCH
    for (int ph = 0; ph < 18; ++ph) { p.ph_lo = ph; p.ph_hi = ph + 1; hipLaunchKernelGGL(mega, dim3(grid), dim3(512), LDS_BYTES, stream, p); }
#else
    p.ph_lo = 0; p.ph_hi = 18;
    void* args[] = {&p};
    hipError_t e = hipLaunchCooperativeKernel((const void*)mega, dim3(grid), dim3(512), args, LDS_BYTES, stream);
    if (e != hipSuccess) fprintf(stderr, "cooperative launch failed: %s (grid %d)\n", hipGetErrorString(e), grid);
#endif
}
```

```cpp
#include <hip/hip_runtime.h>
#include <hip/hip_cooperative_groups.h>
#include <cstdio>
#include <cstdint>
namespace cg = cooperative_groups;

#ifndef MULTI_LAUNCH
#define MULTI_LAUNCH 0
#endif

typedef unsigned short bf16_t;
typedef short bf16x8 __attribute__((ext_vector_type(8)));
typedef float f32x4 __attribute__((ext_vector_type(4)));
typedef unsigned u32x4 __attribute__((ext_vector_type(4)));
typedef unsigned u32x2 __attribute__((ext_vector_type(2)));
#define LAS __attribute__((address_space(3)))

constexpr int D = 1024, NROWS = 67072, NS0 = 65536, NM0 = 66560;
constexpr int TP = 2064, TS = 64, NB_P = 32, NB_S = 16, PAST = 2048;
constexpr int IN_COLS = 7440, N1 = 7680;
constexpr int SSQ_SLOTS = NM0 + 32 * 32;
constexpr float EPS = 1e-6f;
constexpr size_t O_YP = 0, O_YS = 67108864ull, O_KP = O_YS + 1048576ull, SZ_KP = 2ull * 32 * 2064 * 512, O_VP = O_KP + SZ_KP,
                 O_CONVP = O_VP + SZ_KP, O_SSDP = O_CONVP + 2ull * 32 * 3 * 1280, O_S5RP = O_SSDP + 2ull * 32 * 16 * 4096, O_S5IP = O_S5RP + 2ull * 32 * 2048,
                 O_KS = O_S5IP + 2ull * 32 * 2048, O_VS = O_KS + 2ull * 16 * 64 * 512, O_CONVS = O_VS + 2ull * 16 * 64 * 512, O_SSDS = O_CONVS + 2ull * 16 * 3 * 1280,
                 O_S5RS = O_SSDS + 2ull * 16 * 16 * 4096, O_S5IS = O_S5RS + 2ull * 16 * 2048, O_END = O_S5IS + 2ull * 16 * 2048;
constexpr size_t W_BT1 = 0, W_GLU = W_BT1 + (size_t)N1 * 1024 * 2, W_LA = W_GLU + 2048ull * 512 * 2, W_LC = W_LA + 1024ull * 1024 * 2, W_OUT = W_LC + 1024ull * 512 * 2,
                 W_UP = W_OUT + 1024ull * 1024 * 2, W_DOWN = W_UP + 4096ull * 1024 * 2, W_END = W_DOWN + 4096ull * 1024 * 2;
constexpr size_t WS_CTR = W_END, WS_XMETA = WS_CTR + 4096, WS_HB = WS_XMETA + 512ull * 1024 * 4, WS_Z = WS_HB + (size_t)NROWS * 1024 * 2, WS_XBC = WS_Z + (size_t)NROWS * 1024 * 2,
                 WS_U = WS_XBC + (size_t)NROWS * 1280 * 2, WS_Q = WS_U + (size_t)NROWS * 512 * 2, WS_G = WS_Q + (size_t)NROWS * 512 * 2, WS_DT = WS_G + (size_t)NROWS * 3072 * 2,
                 WS_SSQ = WS_DT + (size_t)NROWS * 16 * 4, WS_END = WS_SSQ + (size_t)SSQ_SLOTS * 16 * 4;
constexpr size_t WS_XB2 = WS_DT - (size_t)NROWS * 1024 * 2;
constexpr size_t WS_SSQX = WS_SSQ + 16384;
constexpr size_t WS_ACT = WS_Z;
static_assert(WS_ACT + (size_t)NROWS * 4096 * 2 <= WS_XB2, "ACT overlay");
static_assert(WS_SSQX + 2ull * NROWS * 4 <= WS_END, "ssqx");
constexpr int LDS_BYTES = 147456;

struct Params {
    const float* in[34];
    float* out;
    unsigned char* ws;
    int ph_lo, ph_hi;
};
typedef const __attribute__((address_space(4))) Params* CPar;
__device__ __forceinline__ CPar params_ptr() { CPar q = (CPar)__builtin_amdgcn_kernarg_segment_ptr(); asm volatile("" : "+s"(q)); return q; }
#define PIN(i) (p->in[i])
enum { I_XP = 0, I_XS, I_CK, I_CV, I_SCONV, I_SSSD, I_S5R, I_S5I, I_META, I_NMIX, I_WIN, I_CONVW, I_CONVB, I_DTB, I_ALOG, I_DSSD, I_NSSD, I_LRE, I_LIM, I_LSTEP, I_BRE, I_BIM,
       I_CRE, I_CIM, I_DS5, I_WGLU, I_QN, I_KN, I_WLA, I_WLC, I_WOUT, I_NFFN, I_WUP, I_WDOWN };

__device__ __forceinline__ int ltid() { int t = threadIdx.x; asm volatile("" : "+v"(t)); return t; }
__device__ __forceinline__ int lbid() { int t = blockIdx.x; asm volatile("" : "+s"(t)); return t; }
__device__ __forceinline__ int lgdim() { int t = gridDim.x; asm volatile("" : "+s"(t)); return t; }

__device__ __forceinline__ float bf2f(bf16_t v) { return __uint_as_float((unsigned)v << 16); }
__device__ __forceinline__ unsigned pk2(float lo, float hi) { unsigned r; asm volatile("v_cvt_pk_bf16_f32 %0, %1, %2" : "=v"(r) : "v"(lo), "v"(hi)); return r; }
__device__ __forceinline__ float lo_f(unsigned w) { return __uint_as_float(w << 16); }
__device__ __forceinline__ float hi_f(unsigned w) { return __uint_as_float(w & 0xffff0000u); }
__device__ __forceinline__ u32x2 ld_l2_u32x2(const void* ptr) { const unsigned long long v = __hip_atomic_load((const unsigned long long*)ptr, __ATOMIC_RELAXED, __HIP_MEMORY_SCOPE_AGENT); u32x2 r; r[0] = (unsigned)v; r[1] = (unsigned)(v >> 32); return r; }
__device__ __forceinline__ float sigmoidf_(float v) { return __builtin_amdgcn_rcpf(1.f + __expf(-v)); }
__device__ __forceinline__ float siluf_(float v) { return v * sigmoidf_(v); }
__device__ __forceinline__ float geluf_(float y) { const float a = 0.7978845608f * (y + 0.044715f * y * y * y); const float t = __expf(2.f * a); return 0.5f * y * (2.f - 2.f * __builtin_amdgcn_rcpf(t + 1.f)); }
__device__ __forceinline__ float wave_sum(float v) {
#pragma unroll
    for (int o = 1; o < 64; o <<= 1) v += __shfl_xor(v, o);
    return v;
}
__device__ __forceinline__ void sincos_red(double x, float& sn, float& cs) {
    const double k = __builtin_rint(x * 0.63661977236758134308);
    const float r = (float)__builtin_fma(-k, 1.57079632679489661923, x), r2 = r * r;
    const float sp = r + r * r2 * (-1.6666667163e-01f + r2 * (8.3333337680e-03f + r2 * (-1.9841270114e-04f + r2 * 2.7557314297e-06f)));
    const float cp = 1.f + r2 * (-0.5f + r2 * (4.1666667908e-02f + r2 * (-1.3888889225e-03f + r2 * (2.4801587642e-05f - r2 * 2.7557314297e-07f))));
    const int q = ((int)k) & 3;
    sn = (q == 0) ? sp : (q == 1) ? cp : (q == 2) ? -sp : -cp;
    cs = (q == 0) ? cp : (q == 1) ? -sp : (q == 2) ? -cp : sp;
}
__device__ __forceinline__ int row_of(int s, int t) { return s < 32 ? (t < 16 ? NM0 + s * 16 + t : s * 2048 + t - 16) : NS0 + (s - 32) * 64 + t; }
__device__ __forceinline__ int ssq_slot(int r) { return r < NM0 ? r : NM0 + ((r - NM0) >> 4) * 32 + ((r - NM0) & 15); }
__device__ __forceinline__ float* xloc(CPar p, int r) { return r < NM0 ? p->out + (size_t)r * 1024 : (float*)(p->ws + WS_XMETA) + (size_t)(r - NM0) * 1024; }
__device__ __forceinline__ size_t k_off(int l, int r) {
    if (r < NS0) return O_KP + ((size_t)(l * 32 + (r >> 11)) * 2064 + 16 + (r & 2047)) * 512;
    if (r < NM0) { const int rs = r - NS0; return O_KS + ((size_t)(l * 16 + (rs >> 6)) * 64 + (rs & 63)) * 512; }
    const int rm = r - NM0; return O_KP + ((size_t)(l * 32 + (rm >> 4)) * 2064 + (rm & 15)) * 512;
}

namespace pg8 {
constexpr int BM = 256, BK = 64, HALF = 128, HTB = HALF * BK * 2, STAGE_BYTES = 8 * HTB, NXCD = 8, WGM = 8;
__host__ __device__ __forceinline__ int lds_byte(int r, int c) { const int st = (r >> 4) * 2 + (c >> 5), rr = r & 15, cc = c & 31, ob = rr * 64 + cc * 2; return st * 1024 + (ob ^ (((ob >> 9) & 1) << 5)); }
__host__ __device__ __forceinline__ void stage_rc(int b, int& R, int& C) { const int st = b / 1024, sb = b % 1024, swz = sb ^ (((sb >> 9) & 1) << 5); R = (st >> 1) * 16 + swz / 64; C = (st & 1) * 32 + (swz % 64) / 2; }
struct Unit { int pm, pn; };
struct Gemm { const bf16_t* A; const bf16_t* Bt; int M, N, K, lda, ldb; };
struct StaticOrder {
    int nM, nN, nwg, G, c;
    __device__ void init(int M, int N, int G_, int c_) { nM = M / BM; nN = N / BM; nwg = nM * nN; G = G_; c = c_; }
    __device__ bool next(int i, Unit& u) const {
        const long L = (long)i * G + c; if (L >= nwg) return false;
        int wgid = (int)L; { const int q = nwg / NXCD, r = nwg % NXCD, xcd = wgid % NXCD, off = wgid / NXCD; wgid = (xcd < r ? xcd * (q + 1) : r * (q + 1) + (xcd - r) * q) + off; }
        const int nig = WGM * nN, gid = wgid / nig, fm = gid * WGM, gsz = (nM - fm) < WGM ? (nM - fm) : WGM;
        u.pm = fm + ((wgid % nig) % gsz); u.pn = (wgid % nig) / gsz; return true;
    }
};
template <class Epi>
__device__ __forceinline__ void gemm_phase(LAS unsigned char* lds, const Gemm g, const StaticOrder& S, const Epi& E) {
    const int tid = ltid(), wid = __builtin_amdgcn_readfirstlane(tid >> 6), lane = tid & 63, wr = wid >> 2, wc = wid & 3, fr = lane & 15, fq = lane >> 4;
    const int K = g.K, nt = K / BK;
    unsigned voffA[2], voffB[2];
#pragma unroll
    for (int i = 0; i < 2; ++i) { int R, C; stage_rc(tid * 16 + i * 8192, R, C); voffA[i] = (unsigned)(R * g.lda + C) * 2u; voffB[i] = (unsigned)(R * g.ldb + C) * 2u; }
    const size_t kstep = (size_t)(BK * 2);
    const size_t hstepA = (size_t)HALF * g.lda * 2, hstepB = (size_t)HALF * g.ldb * 2;
    const size_t tstepA = 2 * hstepA, tstepB = 2 * hstepB;
    const unsigned ldsw = (unsigned)wid * 1024u;
    const int aoff = lds_byte(wr * 64 + fr, fq * 8), boff = lds_byte(wc * 32 + fr, fq * 8);
#define PG8_SA(b, h) (((b) * 2 + (h)) * HTB)
#define PG8_SB(b, h) ((4 + (b) * 2 + (h)) * HTB)
#define PG8_STAGE(bufoff, gbase, voff) do { _Pragma("unroll") for (int _i = 0; _i < 2; ++_i) \
        __builtin_amdgcn_global_load_lds((const unsigned*)((const char*)(gbase) + (voff)[_i]), (LAS unsigned*)(lds + (bufoff) + ldsw + _i * 8192), 16, 0, 0); } while (0)
#define PG8_LDA(dst, b, h) do { _Pragma("unroll") for (int m = 0; m < 4; ++m) _Pragma("unroll") for (int k = 0; k < 2; ++k) dst[m][k] = *(const LAS bf16x8*)(lds + PG8_SA(b, h) + aoff + m * 2048 + k * 1024); } while (0)
#define PG8_LDB(dst, b, h) do { _Pragma("unroll") for (int n = 0; n < 2; ++n) _Pragma("unroll") for (int k = 0; k < 2; ++k) dst[n][k] = *(const LAS bf16x8*)(lds + PG8_SB(b, h) + boff + n * 2048 + k * 1024); } while (0)
#define PG8_MMA(ai, bj, At, Bt) do { __builtin_amdgcn_s_setprio(1); _Pragma("unroll") for (int m = 0; m < 4; ++m) _Pragma("unroll") for (int n = 0; n < 2; ++n) _Pragma("unroll") for (int k = 0; k < 2; ++k) \
        acc[ai][bj][m][n] = __builtin_amdgcn_mfma_f32_16x16x32_bf16(Bt[n][k], At[m][k], acc[ai][bj][m][n], 0, 0, 0); __builtin_amdgcn_s_setprio(0); } while (0)
#define PG8_WAIT_V(n) asm volatile("s_waitcnt vmcnt(" #n ")" ::: "memory")
#define PG8_WAIT_L(n) asm volatile("s_waitcnt lgkmcnt(" #n ")" ::: "memory")
#define PG8_BAR __builtin_amdgcn_s_barrier()
#define PG8_SCHED __builtin_amdgcn_sched_barrier(0)
    Unit cur, nxt; int ui = 0;
    if (!S.next(0, cur)) return;
    f32x4 acc[2][2][4][2];
#pragma unroll
    for (int a = 0; a < 2; ++a)
#pragma unroll
        for (int b = 0; b < 2; ++b)
#pragma unroll
            for (int m = 0; m < 4; ++m)
#pragma unroll
                for (int n = 0; n < 2; ++n) acc[a][b][m][n] = (f32x4){0.f, 0.f, 0.f, 0.f};
    bf16x8 At[4][2], B0[2][2], B1[2][2];
    const char* cA = (const char*)g.A + (size_t)cur.pm * tstepA; const char* cB = (const char*)g.Bt + (size_t)cur.pn * tstepB;
    PG8_STAGE(PG8_SB(0, 0), cB, voffB); PG8_STAGE(PG8_SA(0, 0), cA, voffA); PG8_STAGE(PG8_SB(0, 1), cB + hstepB, voffB); PG8_STAGE(PG8_SA(0, 1), cA + hstepA, voffA);
    if (wr == 1) PG8_BAR;
    PG8_WAIT_V(4); PG8_BAR;
    PG8_STAGE(PG8_SB(1, 0), cB + kstep, voffB); PG8_STAGE(PG8_SA(1, 0), cA + kstep, voffA); PG8_STAGE(PG8_SB(1, 1), cB + hstepB + kstep, voffB);
    PG8_WAIT_V(6); PG8_BAR;
    for (;;) {
        const bool has_next = S.next(ui + 1, nxt);
        const char* nA = has_next ? (const char*)g.A + (size_t)nxt.pm * tstepA : cA; const char* nB = has_next ? (const char*)g.Bt + (size_t)nxt.pn * tstepB : cB;
        for (int t = 0; t < nt; t += 2) {
            const bool last = (t == nt - 2);
            const char* a1 = cA + (size_t)(t + 1) * kstep;
            const char* a2 = last ? nA : cA + (size_t)(t + 2) * kstep; const char* b2 = last ? nB : cB + (size_t)(t + 2) * kstep;
            const char* a3 = a2 + kstep; const char* b3 = b2 + kstep;
            PG8_LDB(B0, 0, 0); PG8_SCHED; PG8_LDA(At, 0, 0); PG8_STAGE(PG8_SA(1, 1), a1 + hstepA, voffA);
            PG8_WAIT_L(8); PG8_BAR; PG8_WAIT_L(0); PG8_MMA(0, 0, At, B0); PG8_BAR; PG8_SCHED;
            PG8_LDB(B1, 0, 1); PG8_STAGE(PG8_SB(0, 0), b2, voffB);
            PG8_BAR; PG8_WAIT_L(0); PG8_MMA(0, 1, At, B1); PG8_BAR;
            PG8_LDA(At, 0, 1); PG8_STAGE(PG8_SA(0, 0), a2, voffA);
            PG8_BAR; PG8_WAIT_L(0); PG8_MMA(1, 0, At, B0); PG8_BAR; PG8_SCHED;
            PG8_STAGE(PG8_SB(0, 1), b2 + hstepB, voffB);
            PG8_WAIT_V(6); PG8_BAR; PG8_MMA(1, 1, At, B1); PG8_BAR;
            PG8_LDB(B0, 1, 0); PG8_SCHED; PG8_LDA(At, 1, 0); PG8_STAGE(PG8_SA(0, 1), a2 + hstepA, voffA);
            PG8_WAIT_L(8); PG8_BAR; PG8_WAIT_L(0); PG8_MMA(0, 0, At, B0); PG8_BAR; PG8_SCHED;
            PG8_LDB(B1, 1, 1); PG8_STAGE(PG8_SB(1, 0), b3, voffB);
            PG8_BAR; PG8_WAIT_L(0); PG8_MMA(0, 1, At, B1); PG8_BAR;
            PG8_LDA(At, 1, 1); PG8_STAGE(PG8_SA(1, 0), a3, voffA);
            PG8_BAR; PG8_WAIT_L(0); PG8_MMA(1, 0, At, B0); PG8_BAR; PG8_SCHED;
            PG8_STAGE(PG8_SB(1, 1), b3 + hstepB, voffB);
            PG8_WAIT_V(6); PG8_BAR; PG8_MMA(1, 1, At, B1); PG8_BAR;
        }
        E(acc, cur, wr, wc, fr, fq);
        if (!has_next) break;
#pragma unroll
        for (int a = 0; a < 2; ++a)
#pragma unroll
            for (int b = 0; b < 2; ++b)
#pragma unroll
                for (int m = 0; m < 4; ++m)
#pragma unroll
                    for (int n = 0; n < 2; ++n) acc[a][b][m][n] = (f32x4){0.f, 0.f, 0.f, 0.f};
        cur = nxt; cA = nA; cB = nB; ++ui;
    }
    PG8_WAIT_V(0);
    if (wr == 0) PG8_BAR;
    PG8_BAR;
#undef PG8_SA
#undef PG8_SB
#undef PG8_STAGE
#undef PG8_LDA
#undef PG8_LDB
#undef PG8_MMA
#undef PG8_WAIT_V
#undef PG8_WAIT_L
#undef PG8_BAR
#undef PG8_SCHED
}
}
using pg8::Unit;

struct EpiIn {
    bf16_t *Z, *XBC, *U, *Q, *G; float* DT; float* out; const float *qn, *kn; int layer;
    __device__ __forceinline__ void operator()(const f32x4 (&acc)[2][2][4][2], const Unit& u, int wr, int wc, int fr, int fq) const {
        const int pn = u.pn, rowb = u.pm * 256 + wr * 64 + fr, ctb = wc * 32 + fq * 4;
        if (pn < 11 || (pn >= 17 && pn < 29)) {
            bf16_t* base; int ld, col0; bool sig = false;
            if (pn < 4) { base = Z; ld = 1024; col0 = pn * 256; } else if (pn < 9) { base = XBC; ld = 1280; col0 = (pn - 4) * 256; }
            else if (pn < 11) { base = U; ld = 512; col0 = (pn - 9) * 256; } else { base = G; ld = 3072; col0 = (pn - 17) * 256; sig = true; }
#pragma unroll
            for (int ai = 0; ai < 2; ++ai)
#pragma unroll
                for (int m = 0; m < 4; ++m) { bf16_t* rp = base + (size_t)(rowb + ai * 128 + m * 16) * ld + col0 + ctb;
#pragma unroll
                    for (int bj = 0; bj < 2; ++bj)
#pragma unroll
                        for (int n = 0; n < 2; ++n) { f32x4 v = acc[ai][bj][m][n];
                            if (sig) { v[0] = sigmoidf_(v[0]); v[1] = sigmoidf_(v[1]); v[2] = sigmoidf_(v[2]); v[3] = sigmoidf_(v[3]); }
                            u32x2 o; o[0] = pk2(v[0], v[1]); o[1] = pk2(v[2], v[3]); *(u32x2*)(rp + bj * 128 + n * 16) = o; } }
        } else if (pn < 17) {
            const int seg = (pn - 11) >> 1, head = ((pn - 11) & 1) * 4 + wc;
            const float* nw = seg == 0 ? qn : kn;
            f32x4 wv[2][2];
#pragma unroll
            for (int bj = 0; bj < 2; ++bj)
#pragma unroll
                for (int n = 0; n < 2; ++n) wv[bj][n] = (seg < 2) ? *(const f32x4*)(nw + 32 * bj + 16 * n + 4 * fq) : (f32x4){1.f, 1.f, 1.f, 1.f};
#pragma unroll
            for (int ai = 0; ai < 2; ++ai)
#pragma unroll
                for (int m = 0; m < 4; ++m) { const int row = rowb + ai * 128 + m * 16;
                    float rs = 1.f;
                    if (seg < 2) { float ss = 0.f;
#pragma unroll
                        for (int bj = 0; bj < 2; ++bj)
#pragma unroll
                            for (int n = 0; n < 2; ++n) { const f32x4 v = acc[ai][bj][m][n]; ss += v[0] * v[0] + v[1] * v[1] + v[2] * v[2] + v[3] * v[3]; }
                        ss += __shfl_xor(ss, 16); ss += __shfl_xor(ss, 32);
                        rs = rsqrtf(ss * (1.f / 64.f) + EPS); }
                    if (seg == 0) { bf16_t* rp = Q + (size_t)row * 512 + head * 64 + 4 * fq;
#pragma unroll
                        for (int bj = 0; bj < 2; ++bj)
#pragma unroll
                            for (int n = 0; n < 2; ++n) { const f32x4 v = acc[ai][bj][m][n] * rs * wv[bj][n]; u32x2 o; o[0] = pk2(v[0], v[1]); o[1] = pk2(v[2], v[3]); *(u32x2*)(rp + 32 * bj + 16 * n) = o; }
                    } else { float* rp = out + k_off(layer, row) + (seg == 2 ? (row >= NS0 && row < NM0 ? (O_VS - O_KS) : (O_VP - O_KP)) : 0) + head * 64 + 4 * fq;
#pragma unroll
                        for (int bj = 0; bj < 2; ++bj)
#pragma unroll
                            for (int n = 0; n < 2; ++n) { const f32x4 v = acc[ai][bj][m][n] * rs * wv[bj][n]; *(f32x4*)(rp + 32 * bj + 16 * n) = v; } } }
        } else {
            if (wc == 0) {
#pragma unroll
                for (int ai = 0; ai < 2; ++ai)
#pragma unroll
                    for (int m = 0; m < 4; ++m) *(f32x4*)(DT + (size_t)(rowb + ai * 128 + m * 16) * 16 + 4 * fq) = acc[ai][0][m][0];
            }
        }
    }
};
struct EpiGlu {
    bf16_t* OB;
    __device__ __forceinline__ void operator()(const f32x4 (&acc)[2][2][4][2], const Unit& u, int wr, int wc, int fr, int fq) const {
        const int rowb = u.pm * 256 + wr * 64 + fr, colb = u.pn * 128 + wc * 32 + fq * 4;
#pragma unroll
        for (int ai = 0; ai < 2; ++ai)
#pragma unroll
            for (int m = 0; m < 4; ++m) { bf16_t* rp = OB + (size_t)(rowb + ai * 128 + m * 16) * 1024 + colb;
#pragma unroll
                for (int n = 0; n < 2; ++n) { const f32x4 a = acc[ai][0][m][n], g = acc[ai][1][m][n];
                    u32x2 o; o[0] = pk2(a[0] * sigmoidf_(g[0]), a[1] * sigmoidf_(g[1])); o[1] = pk2(a[2] * sigmoidf_(g[2]), a[3] * sigmoidf_(g[3])); *(u32x2*)(rp + n * 16) = o; } }
    }
};
struct EpiMix {
    bf16_t* R; const bf16_t* G; const bf16_t* OB; int accum;
    __device__ __forceinline__ void operator()(const f32x4 (&acc)[2][2][4][2], const Unit& u, int wr, int wc, int fr, int fq) const {
        const int rowb = u.pm * 256 + wr * 64 + fr, colb = u.pn * 256 + wc * 32 + fq * 4;
#pragma unroll
        for (int ai = 0; ai < 2; ++ai)
#pragma unroll
            for (int m = 0; m < 4; ++m) { const int row = rowb + ai * 128 + m * 16;
#pragma unroll
                for (int bj = 0; bj < 2; ++bj)
#pragma unroll
                    for (int n = 0; n < 2; ++n) { const int col = colb + bj * 128 + n * 16; f32x4 v = acc[ai][bj][m][n];
                        const u32x2 gw = *(const u32x2*)(G + (size_t)row * 3072 + col);
                        v = v * (f32x4){lo_f(gw[0]), hi_f(gw[0]), lo_f(gw[1]), hi_f(gw[1])};
                        if (OB) { const u32x2 g1 = *(const u32x2*)(G + (size_t)row * 3072 + 1024 + col), ob = *(const u32x2*)(OB + (size_t)row * 1024 + col);
                            v = v + (f32x4){lo_f(g1[0]), hi_f(g1[0]), lo_f(g1[1]), hi_f(g1[1])} * (f32x4){lo_f(ob[0]), hi_f(ob[0]), lo_f(ob[1]), hi_f(ob[1])}; }
                        bf16_t* rp = R + (size_t)row * 1024 + col;
                        if (accum) { const u32x2 rw = ld_l2_u32x2(rp); v = v + (f32x4){lo_f(rw[0]), hi_f(rw[0]), lo_f(rw[1]), hi_f(rw[1])}; }
                        u32x2 o; o[0] = pk2(v[0], v[1]); o[1] = pk2(v[2], v[3]); *(u32x2*)rp = o; } }
    }
};
struct EpiRes {
    float* out; float* xmeta; bf16_t* XB; float* ssq;
    __device__ __forceinline__ void operator()(const f32x4 (&acc)[2][2][4][2], const Unit& u, int wr, int wc, int fr, int fq) const {
        const int rowb = u.pm * 256 + wr * 64 + fr, colb = u.pn * 256 + wc * 32 + fq * 4;
        float* base = (u.pm * 256 < NM0) ? out : xmeta - (size_t)NM0 * 1024;
#pragma unroll
        for (int ai = 0; ai < 2; ++ai)
#pragma unroll
            for (int m = 0; m < 4; ++m) { const int row = rowb + ai * 128 + m * 16; float* rp = base + (size_t)row * 1024 + colb; float ss = 0.f;
#pragma unroll
                for (int bj = 0; bj < 2; ++bj)
#pragma unroll
                    for (int n = 0; n < 2; ++n) { f32x4* q = (f32x4*)(rp + bj * 128 + n * 16); const f32x4 v = *q + acc[ai][bj][m][n]; *q = v;
                        if (XB) { u32x2 o; o[0] = pk2(v[0], v[1]); o[1] = pk2(v[2], v[3]); *(u32x2*)(XB + (size_t)row * 1024 + colb + bj * 128 + n * 16) = o; ss += (v[0] * v[0] + v[1] * v[1]) + (v[2] * v[2] + v[3] * v[3]); } }
                if (XB) { ss += __shfl_xor(ss, 16); ss += __shfl_xor(ss, 32); if (fq == 0) __hip_atomic_fetch_add(ssq + row, ss, __ATOMIC_RELAXED, __HIP_MEMORY_SCOPE_AGENT); } }
    }
};
struct EpiUp {
    bf16_t* ACT; const float* ssq;
    __device__ __forceinline__ void operator()(const f32x4 (&acc)[2][2][4][2], const Unit& u, int wr, int wc, int fr, int fq) const {
        const int rowb = u.pm * 256 + wr * 64 + fr, colb = u.pn * 256 + wc * 32 + fq * 4;
#pragma unroll
        for (int ai = 0; ai < 2; ++ai)
#pragma unroll
            for (int m = 0; m < 4; ++m) { bf16_t* rp = ACT + (size_t)(rowb + ai * 128 + m * 16) * 4096 + colb; const float rs = rsqrtf(ssq[rowb + ai * 128 + m * 16] * (1.f / 1024.f) + EPS);
#pragma unroll
                for (int bj = 0; bj < 2; ++bj)
#pragma unroll
                    for (int n = 0; n < 2; ++n) { f32x4 v = acc[ai][bj][m][n];
#pragma unroll
                        for (int j = 0; j < 4; ++j) { const float r = fmaxf(v[j] * rs, 0.f); v[j] = r * r; }
                        u32x2 o; o[0] = pk2(v[0], v[1]); o[1] = pk2(v[2], v[3]); *(u32x2*)(rp + bj * 128 + n * 16) = o; } }
    }
};

__device__ __forceinline__ int col_in(int n) {
    if (n < 2304) return n;
    if (n < 2816) return n + 16;
    if (n < 4352) { const int w0 = n - 2816, seg = w0 >> 9, w = w0 & 511, tile = w >> 8, ct = w & 255, bj = ct >> 7, wc = (ct >> 5) & 3, ww = ct & 31;
        return 2832 + seg * 512 + (tile * 4 + wc) * 64 + 32 * bj + ww; }
    if (n < 7424) return n + 16;
    if (n < 7440) return 2304 + (n - 7424);
    return -1;
}
template <int MAP>
__device__ __forceinline__ void prep_w(bf16_t* dst, const float* src, int K, int N, int ld, const float* scale, size_t gtid, size_t gsz) {
    const size_t items = (size_t)(K / 8) * N;
    for (size_t it = gtid; it < items; it += gsz) {
        const int n = (int)(it % N), k8 = (int)(it / N);
        const int c = MAP == 1 ? col_in(n) : (MAP == 2 ? (((n >> 7) & 1) * 1024 + (n >> 8) * 128 + (n & 127)) : n);
        float v[8];
#pragma unroll
        for (int kk = 0; kk < 8; ++kk) { const int k = k8 * 8 + kk; float x = (c >= 0) ? src[(size_t)k * ld + c] : 0.f; if (scale) x *= scale[k]; v[kk] = x; }
        u32x4 o; o[0] = pk2(v[0], v[1]); o[1] = pk2(v[2], v[3]); o[2] = pk2(v[4], v[5]); o[3] = pk2(v[6], v[7]);
        *(u32x4*)(dst + (size_t)n * K + k8 * 8) = o;
    }
}
__device__ __forceinline__ void rmsnorm_rows(CPar p, const float* g, int from_inputs) {
    const int lane = ltid() & 63, gw = lbid() * 8 + (ltid() >> 6), ngw = lgdim() * 8;
    bf16_t* HB = (bf16_t*)(p->ws + WS_HB);
    f32x4 gv[4];
#pragma unroll
    for (int j = 0; j < 4; ++j) gv[j] = *(const f32x4*)(g + lane * 4 + 256 * j);
    for (int r = gw; r < NROWS; r += ngw) {
        float* xl = xloc(p, r);
        const float* src = xl;
        if (from_inputs) src = r < NS0 ? p->in[I_XP] + (size_t)r * 1024 : (r < NM0 ? p->in[I_XS] + (size_t)(r - NS0) * 1024 : p->in[I_META] + (size_t)((r - NM0) & 15) * 1024);
        f32x4 v[4]; float s = 0.f;
#pragma unroll
        for (int j = 0; j < 4; ++j) { v[j] = *(const f32x4*)(src + lane * 4 + 256 * j); s += (v[j][0] * v[j][0] + v[j][1] * v[j][1]) + (v[j][2] * v[j][2] + v[j][3] * v[j][3]); }
        const float rstd = rsqrtf(wave_sum(s) * (1.f / 1024.f) + EPS);
#pragma unroll
        for (int j = 0; j < 4; ++j) { if (from_inputs) *(f32x4*)(xl + lane * 4 + 256 * j) = v[j];
            const f32x4 h = v[j] * rstd * gv[j]; u32x2 o; o[0] = pk2(h[0], h[1]); o[1] = pk2(h[2], h[3]); *(u32x2*)(HB + (size_t)r * 1024 + lane * 4 + 256 * j) = o; }
    }
}
__device__ __forceinline__ void ssd_norm_rows(CPar p) {
    const int lane = ltid() & 63, gw = lbid() * 8 + (ltid() >> 6), ngw = lgdim() * 8;
    bf16_t* Z = (bf16_t*)(p->ws + WS_Z);
    for (int r = gw; r < NROWS; r += ngw) {
#pragma unroll
        for (int j = 0; j < 2; ++j) { u32x4* zp = (u32x4*)(Z + (size_t)r * 1024 + j * 512 + lane * 8); const u32x4 w = *zp;
            float f[8] = {lo_f(w[0]), hi_f(w[0]), lo_f(w[1]), hi_f(w[1]), lo_f(w[2]), hi_f(w[2]), lo_f(w[3]), hi_f(w[3])};
            float ss = 0.f;
#pragma unroll
            for (int i = 0; i < 8; ++i) ss += f[i] * f[i];
            const float rs = rsqrtf(wave_sum(ss) * (1.f / 512.f) + EPS);
            u32x4 o; o[0] = pk2(f[0] * rs, f[1] * rs); o[1] = pk2(f[2] * rs, f[3] * rs); o[2] = pk2(f[4] * rs, f[5] * rs); o[3] = pk2(f[6] * rs, f[7] * rs); *zp = o; }
    }
}
__device__ __forceinline__ void phase_prep(CPar p, int l) {
    const size_t gtid = (size_t)lbid() * 512 + ltid(), gsz = (size_t)lgdim() * 512;
    unsigned char* ws = p->ws;
    prep_w<1>((bf16_t*)(ws + W_BT1), p->in[I_WIN] + (size_t)l * 1024 * IN_COLS, 1024, N1, IN_COLS, nullptr, gtid, gsz);
    prep_w<2>((bf16_t*)(ws + W_GLU), p->in[I_WGLU] + (size_t)l * 512 * 2048, 512, 2048, 2048, nullptr, gtid, gsz);
    prep_w<0>((bf16_t*)(ws + W_LA), p->in[I_WLA] + (size_t)l * 1024 * 1024, 1024, 1024, 1024, p->in[I_NSSD] + l * 1024, gtid, gsz);
    prep_w<0>((bf16_t*)(ws + W_LC), p->in[I_WLC] + (size_t)l * 512 * 1024, 512, 1024, 1024, nullptr, gtid, gsz);
    prep_w<0>((bf16_t*)(ws + W_OUT), p->in[I_WOUT] + (size_t)l * 1024 * 1024, 1024, 1024, 1024, nullptr, gtid, gsz);
    prep_w<0>((bf16_t*)(ws + W_UP), p->in[I_WUP] + (size_t)l * 1024 * 4096, 1024, 4096, 4096, p->in[I_NFFN] + l * 1024, gtid, gsz);
    prep_w<0>((bf16_t*)(ws + W_DOWN), p->in[I_WDOWN] + (size_t)l * 4096 * 1024, 4096, 1024, 1024, nullptr, gtid, gsz);
    rmsnorm_rows(p, p->in[I_NMIX] + l * 1024, l == 0);
}

__device__ __forceinline__ bf16_t f2bf_(float v) { return (bf16_t)(pk2(v, v) & 0xffffu); }
__device__ __forceinline__ void ssd_item(CPar p, int l, int item, float* sm) {
    const int tid = ltid(), lane = tid & 63, wave = __builtin_amdgcn_readfirstlane(tid >> 6), rb = wave >> 1, chh = wave & 1, fr = lane & 15, fq = lane >> 4;
    const int s = item < 512 ? (item >> 4) : 32 + ((item - 512) >> 4), h = item & 15, g = h >> 3;
    const bool prompt = s < 32; const int b = prompt ? s : s - 32, T = prompt ? TP : TS;
    constexpr int LB = 72;
    bf16_t *Cb = (bf16_t*)sm, *Bb = Cb + 64 * LB, *XT = Bb + 64 * LB, *WB = XT + 64 * LB, *Mb = WB + 64 * LB, *Sb = Mb + 64 * LB;
    float *sRaw = (float*)(Sb + 64 * LB), *sW = sRaw + 67 * 192, *sdtA = sW + 5 * 192, *sacA = sdtA + 33 * 64, *sw = sacA + 33 * 64;
    const bf16_t* XBC = (const bf16_t*)(p->ws + WS_XBC); bf16_t* Z = (bf16_t*)(p->ws + WS_Z);
    const float* DT = (const float*)(p->ws + WS_DT);
    const float* cw = p->in[I_CONVW] + (size_t)l * 4 * 1280; const float* cb = p->in[I_CONVB] + (size_t)l * 1280;
    const float* hist = p->in[I_SCONV] + (size_t)(l * 16 + b) * 3 * 1280;
    const float dtb = p->in[I_DTB][l * 16 + h], aneg = -__expf(p->in[I_ALOG][l * 16 + h]), dsk = p->in[I_DSSD][l * 16 + h];
    float* sout = prompt ? p->out + O_SSDP + ((size_t)(l * 32 + b) * 16 + h) * 4096 : p->out + O_SSDS + ((size_t)(l * 16 + b) * 16 + h) * 4096;
    for (int i = tid; i < 5 * 192; i += 512) { const int k = i / 192, ch = i - k * 192; const int col = ch < 64 ? h * 64 + ch : (ch < 128 ? 1024 + g * 64 + (ch - 64) : 1152 + g * 64 + (ch - 128));
        sW[i] = k < 4 ? cw[k * 1280 + col] : cb[col]; }
    f32x4 accS[2];
#pragma unroll
    for (int c2 = 0; c2 < 2; ++c2)
#pragma unroll
        for (int r = 0; r < 4; ++r) { const int pp = rb * 16 + fq * 4 + r, n = chh * 32 + c2 * 16 + fr;
            const float v = prompt ? 0.f : p->in[I_SSSD][((size_t)(l * 16 + b) * 16 + h) * 4096 + pp * 64 + n]; accS[c2][r] = v; Sb[pp * LB + n] = f2bf_(v); }
    const int nch = (T + 63) >> 6;
    { const int wv = tid >> 6, ln = tid & 63; float xv[5];
#pragma unroll
        for (int r = 0; r < 5; ++r) { const int c = wv + 8 * r, t = c * 64 + ln; xv[r] = (c < nch && t < T) ? DT[(size_t)row_of(s, t) * 16 + h] + dtb : -1e30f; }
#pragma unroll
        for (int r = 0; r < 5; ++r) { const int c = wv + 8 * r;
            if (c < nch) { const float x = xv[r]; const float dtv = x < -1e29f ? 0.f : (x > 20.f ? x : log1pf(__expf(x))); float cs = dtv * aneg;
#pragma unroll
                for (int o = 1; o < 64; o <<= 1) { const float nb = __shfl_up(cs, o); if (ln >= o) cs += nb; }
                sdtA[c * 64 + ln] = dtv; sacA[c * 64 + ln] = cs; } } }
    u32x4 pf[4];
#define SSD_ISSUE(cc) do { _Pragma("unroll") for (int it4 = 0; it4 < 4; ++it4) { const int pi = tid + it4 * 512; pf[it4] = (u32x4){0u, 0u, 0u, 0u}; \
        if (pi < 67 * 24) { const int rl = pi / 24, pc = pi - rl * 24, seg = pc >> 3, q8 = pc & 7, tt = (cc) * 64 - 3 + rl; \
            const int col = (seg == 0 ? h * 64 : (seg == 1 ? 1024 + g * 64 : 1152 + g * 64)) + q8 * 8; \
            if (tt >= 0 && tt < T) pf[it4] = *(const u32x4*)(XBC + (size_t)row_of(s, tt) * 1280 + col); } } } while (0)
#define SSD_FRAG(P, r0, ks) (*(const bf16x8*)((P) + ((r0) + fr) * LB + (ks) * 32 + fq * 8))
    SSD_ISSUE(0);
#pragma unroll 1
    for (int c = 0; c < nch; ++c) {
        const int t0 = c * 64; const float* sdt = sdtA + t0; const float* sac = sacA + t0;
        __syncthreads();
#pragma unroll
        for (int it4 = 0; it4 < 4; ++it4) { const int pi = tid + it4 * 512;
            if (pi < 67 * 24) { const int rl = pi / 24, pc = pi - rl * 24, seg = pc >> 3, q8 = pc & 7, tt = t0 - 3 + rl;
                const u32x4 w = pf[it4];
                f32x4 f0 = {lo_f(w[0]), hi_f(w[0]), lo_f(w[1]), hi_f(w[1])}, f1 = {lo_f(w[2]), hi_f(w[2]), lo_f(w[3]), hi_f(w[3])};
                if (tt < 0 && !prompt) { const int col = (seg == 0 ? h * 64 : (seg == 1 ? 1024 + g * 64 : 1152 + g * 64)) + q8 * 8; const float* hp = hist + (3 + tt) * 1280 + col; f0 = *(const f32x4*)hp; f1 = *(const f32x4*)(hp + 4); }
                float* dp = sRaw + rl * 192 + seg * 64 + q8 * 8; *(f32x4*)dp = f0; *(f32x4*)(dp + 4) = f1; } }
        if (tid < 64) sw[tid] = __expf(sac[63] - sac[tid]) * sdt[tid];
        if (c + 1 < nch) SSD_ISSUE(c + 1);
        bf16_t zq[2][4];
#pragma unroll
        for (int c2 = 0; c2 < 2; ++c2)
#pragma unroll
            for (int r = 0; r < 4; ++r) { const int t = t0 + rb * 16 + fq * 4 + r; zq[c2][r] = (t < T) ? Z[(size_t)row_of(s, t) * 1024 + h * 64 + chh * 32 + c2 * 16 + fr] : (bf16_t)0; }
        __syncthreads();
        if (tid < 384) { const int ch = tid % 192, tlb = (tid / 192) * 32, cc = ch & 63;
            const float w0 = sW[ch], w1 = sW[192 + ch], w2 = sW[384 + ch], w3 = sW[576 + ch], bias = sW[768 + ch];
            float r0 = sRaw[(tlb + 0) * 192 + ch], r1 = sRaw[(tlb + 1) * 192 + ch], r2 = sRaw[(tlb + 2) * 192 + ch];
            float ov[32];
#pragma unroll
            for (int i2 = 0; i2 < 32; ++i2) { const float r3 = sRaw[(tlb + i2 + 3) * 192 + ch];
                const float v = bias + w0 * r0 + w1 * r1 + w2 * r2 + w3 * r3; ov[i2] = (t0 + tlb + i2 < T) ? siluf_(v) : 0.f; r0 = r1; r1 = r2; r2 = r3; }
            if (ch < 128) { bf16_t* dst = (ch < 64 ? XT : WB) + cc * LB + tlb;
#pragma unroll
                for (int q4 = 0; q4 < 4; ++q4) { u32x4 w;
#pragma unroll
                    for (int c4 = 0; c4 < 4; ++c4) { const int i2 = q4 * 8 + c4 * 2; const float s0 = ch < 64 ? 1.f : sw[tlb + i2], s1 = ch < 64 ? 1.f : sw[tlb + i2 + 1]; w[c4] = pk2(ov[i2] * s0, ov[i2 + 1] * s1); }
                    *(u32x4*)(dst + q4 * 8) = w; } }
            if (ch >= 64) { bf16_t* dst = (ch < 128 ? Bb : Cb) + tlb * LB + cc;
#pragma unroll
                for (int i2 = 0; i2 < 32; ++i2) dst[i2 * LB] = f2bf_(ov[i2]); } }
        __syncthreads();
        f32x4 acc2[2];
        { const bf16x8 aC0 = SSD_FRAG(Cb, rb * 16, 0), aC1 = SSD_FRAG(Cb, rb * 16, 1);
#pragma unroll
            for (int c2 = 0; c2 < 2; ++c2) { const int j0 = chh * 32 + c2 * 16;
                f32x4 m = {0.f, 0.f, 0.f, 0.f};
                if (j0 <= rb * 16 + 15) { m = __builtin_amdgcn_mfma_f32_16x16x32_bf16(aC0, SSD_FRAG(Bb, j0, 0), m, 0, 0, 0); m = __builtin_amdgcn_mfma_f32_16x16x32_bf16(aC1, SSD_FRAG(Bb, j0, 1), m, 0, 0, 0); }
                const int j = j0 + fr; const float acj = sac[j], dtj = sdt[j];
#pragma unroll
                for (int r = 0; r < 4; ++r) { const int tl = rb * 16 + fq * 4 + r; Mb[tl * LB + j] = f2bf_(j <= tl ? m[r] * __expf(sac[tl] - acj) * dtj : 0.f); }
                f32x4 y = {0.f, 0.f, 0.f, 0.f};
                y = __builtin_amdgcn_mfma_f32_16x16x32_bf16(aC0, SSD_FRAG(Sb, j0, 0), y, 0, 0, 0); y = __builtin_amdgcn_mfma_f32_16x16x32_bf16(aC1, SSD_FRAG(Sb, j0, 1), y, 0, 0, 0);
#pragma unroll
                for (int r = 0; r < 4; ++r) y[r] *= __expf(sac[rb * 16 + fq * 4 + r]);
                acc2[c2] = y; }
            const bf16x8 aX0 = SSD_FRAG(XT, rb * 16, 0), aX1 = SSD_FRAG(XT, rb * 16, 1); const float eL = __expf(sac[63]);
#pragma unroll
            for (int c2 = 0; c2 < 2; ++c2) { const int n0 = chh * 32 + c2 * 16; f32x4 sv = accS[c2] * eL;
                sv = __builtin_amdgcn_mfma_f32_16x16x32_bf16(aX0, SSD_FRAG(WB, n0, 0), sv, 0, 0, 0); sv = __builtin_amdgcn_mfma_f32_16x16x32_bf16(aX1, SSD_FRAG(WB, n0, 1), sv, 0, 0, 0); accS[c2] = sv; } }
        __syncthreads();
        { const bf16x8 aM0 = SSD_FRAG(Mb, rb * 16, 0), aM1 = SSD_FRAG(Mb, rb * 16, 1);
#pragma unroll
            for (int c2 = 0; c2 < 2; ++c2) { const int p0 = chh * 32 + c2 * 16, pp = p0 + fr; f32x4 y = acc2[c2];
                y = __builtin_amdgcn_mfma_f32_16x16x32_bf16(aM0, SSD_FRAG(XT, p0, 0), y, 0, 0, 0); y = __builtin_amdgcn_mfma_f32_16x16x32_bf16(aM1, SSD_FRAG(XT, p0, 1), y, 0, 0, 0);
#pragma unroll
                for (int r = 0; r < 4; ++r) { const int tl = rb * 16 + fq * 4 + r, t = t0 + tl;
                    if (t < T) { bf16_t* zp = Z + (size_t)row_of(s, t) * 1024 + h * 64 + pp; const float yy = (y[r] + dsk * bf2f(XT[pp * LB + tl])) * siluf_(bf2f(zq[c2][r])); *zp = f2bf_(yy); } } }
#pragma unroll
            for (int c2 = 0; c2 < 2; ++c2)
#pragma unroll
                for (int r = 0; r < 4; ++r) Sb[(rb * 16 + fq * 4 + r) * LB + chh * 32 + c2 * 16 + fr] = f2bf_(accS[c2][r]); }
    }
    __syncthreads();
#pragma unroll
    for (int c2 = 0; c2 < 2; ++c2)
#pragma unroll
        for (int r = 0; r < 4; ++r) sout[(rb * 16 + fq * 4 + r) * 64 + chh * 32 + c2 * 16 + fr] = accS[c2][r];
    float* cout_ = prompt ? p->out + O_CONVP + (size_t)(l * 32 + b) * 3 * 1280 : p->out + O_CONVS + (size_t)(l * 16 + b) * 3 * 1280;
    for (int idx = tid; idx < 3 * 192; idx += 512) { const int k = idx / 192, ch = idx - k * 192;
        if (ch >= 64 && (h & 7) != 0) continue;
        const int col = ch < 64 ? h * 64 + ch : (ch < 128 ? 1024 + g * 64 + (ch - 64) : 1152 + g * 64 + (ch - 128));
        cout_[k * 1280 + col] = bf2f(XBC[(size_t)row_of(s, T - 3 + k) * 1280 + col]); }
    __syncthreads();
#undef SSD_ISSUE
#undef SSD_FRAG
}

__device__ __forceinline__ void s5_item(CPar p, int l, int s, int g, float* wl) {
    const int lane = ltid() & 63, fr = lane & 15, fq = lane >> 4;
    const bool prompt = s < 32; const int b = prompt ? s : s - 32, T = prompt ? TP : TS, nblk = T >> 4;
    constexpr int LBX = 136;
    bf16_t* Xb = (bf16_t*)wl;
    bf16_t* U = (bf16_t*)(p->ws + WS_U);
    const int gp = (l * 32 + g) * 64 + lane;
    const float lr = p->in[I_LRE][gp], li = p->in[I_LIM][gp], step = expf(p->in[I_LSTEP][l * 32 + g]);
    float sn, cs; sincos_red((double)li * (double)step, sn, cs);
    const float mag = expf(lr * step), ab_re = mag * cs, ab_im = mag * sn;
    const float den = lr * lr + li * li, nr = ab_re - 1.f, f_re = (nr * lr + ab_im * li) / den, f_im = (ab_im * lr - nr * li) / den;
    float bbr[16], bbi[16];
#pragma unroll
    for (int hh = 0; hh < 16; ++hh) { const float br = p->in[I_BRE][(size_t)gp * 16 + hh], bi = p->in[I_BIM][(size_t)gp * 16 + hh]; bbr[hh] = f_re * br - f_im * bi; bbi[hh] = f_re * bi + f_im * br; }
    bf16x8 cfrag[4];
#pragma unroll
    for (int ks = 0; ks < 4; ++ks) { const int k0 = ks * 32 + fq * 8; const bool im = k0 >= 64;
        const float* cp = (im ? p->in[I_CIM] : p->in[I_CRE]) + ((size_t)(l * 32 + g) * 16 + fr) * 64 + (k0 & 63);
        const f32x4 c0 = *(const f32x4*)cp, c1 = *(const f32x4*)(cp + 4); const float sg = im ? -1.f : 1.f;
        u32x4 w; w[0] = pk2(sg * c0[0], sg * c0[1]); w[1] = pk2(sg * c0[2], sg * c0[3]); w[2] = pk2(sg * c1[0], sg * c1[1]); w[3] = pk2(sg * c1[2], sg * c1[3]);
        cfrag[ks] = __builtin_bit_cast(bf16x8, w); }
    float xr = prompt ? 0.f : p->in[I_S5R][(size_t)(l * 16 + b) * 2048 + g * 64 + lane], xi = prompt ? 0.f : p->in[I_S5I][(size_t)(l * 16 + b) * 2048 + g * 64 + lane];
    const float dsk = p->in[I_DS5][(size_t)(l * 32 + g) * 16 + fr];
    u32x4 ua = {0, 0, 0, 0}, ub = {0, 0, 0, 0};
    { const int r0 = row_of(s, 0); if (lane < 16) { const u32x4* up = (const u32x4*)(U + (size_t)(r0 + lane) * 512 + g * 16); ua = up[0]; ub = up[1]; } }
    for (int blk = 0; blk < nblk; ++blk) {
        const int r0 = row_of(s, blk * 16);
        const u32x4 ca = ua, cbv = ub;
        if (blk + 1 < nblk && lane < 16) { const int r1 = row_of(s, blk * 16 + 16); const u32x4* up = (const u32x4*)(U + (size_t)(r1 + lane) * 512 + g * 16); ua = up[0]; ub = up[1]; }
#pragma unroll
        for (int i = 0; i < 16; ++i) {
            float br4[4] = {0.f, 0.f, 0.f, 0.f}, bi4[4] = {0.f, 0.f, 0.f, 0.f};
#pragma unroll
            for (int w = 0; w < 8; ++w) { const unsigned word = (unsigned)__builtin_amdgcn_readlane((int)(w < 4 ? ca[w] : cbv[w - 4]), i);
                const float u0 = lo_f(word), u1 = hi_f(word);
                br4[w & 3] += bbr[2 * w] * u0 + bbr[2 * w + 1] * u1; bi4[w & 3] += bbi[2 * w] * u0 + bbi[2 * w + 1] * u1; }
            const float bur = (br4[0] + br4[1]) + (br4[2] + br4[3]), bui = (bi4[0] + bi4[1]) + (bi4[2] + bi4[3]);
            const float nxr = ab_re * xr - ab_im * xi + bur, nxi = ab_re * xi + ab_im * xr + bui; xr = nxr; xi = nxi;
            Xb[i * LBX + lane] = f2bf_(xr); Xb[i * LBX + 64 + lane] = f2bf_(xi);
        }
        __builtin_amdgcn_wave_barrier(); asm volatile("s_waitcnt lgkmcnt(0)" ::: "memory");
        f32x4 y = {0.f, 0.f, 0.f, 0.f};
#pragma unroll
        for (int ks = 0; ks < 4; ++ks) y = __builtin_amdgcn_mfma_f32_16x16x32_bf16(*(const bf16x8*)(Xb + fr * LBX + ks * 32 + fq * 8), cfrag[ks], y, 0, 0, 0);
#pragma unroll
        for (int r = 0; r < 4; ++r) { bf16_t* up = U + (size_t)(r0 + fq * 4 + r) * 512 + g * 16 + fr; *up = f2bf_(geluf_(y[r] + dsk * bf2f(*up))); }
        __builtin_amdgcn_wave_barrier(); asm volatile("s_waitcnt lgkmcnt(0)" ::: "memory");
    }
    float* ore = prompt ? p->out + O_S5RP + (size_t)(l * 32 + b) * 2048 : p->out + O_S5RS + (size_t)(l * 16 + b) * 2048;
    float* oim = prompt ? p->out + O_S5IP + (size_t)(l * 32 + b) * 2048 : p->out + O_S5IS + (size_t)(l * 16 + b) * 2048;
    ore[g * 64 + lane] = xr; oim[g * 64 + lane] = xi;
}

typedef __bf16 bf2_t __attribute__((ext_vector_type(2)));
__device__ __forceinline__ float dot2bf(unsigned a, unsigned b, float c) { return __builtin_amdgcn_fdot2_f32_bf16(__builtin_bit_cast(bf2_t, a), __builtin_bit_cast(bf2_t, b), c, false); }
__device__ __forceinline__ void attn_item(CPar p, int l, int item, float* wl) {
    const int lane = ltid() & 63;
    int s, h, qt;
    if (item < 8448) { s = item / 264; const int rem = item - s * 264; h = rem / 33; qt = rem - h * 33; } else { const int it = item - 8448; s = 32 + (it >> 3); h = it & 7; qt = 0; }
    const bool prompt = s < 32; const int b = prompt ? s : s - 32, T = prompt ? TP : TS, nh = prompt ? 0 : PAST;
    const int i = qt * 64 + lane; const bool active = i < T; const int row = row_of(s, active ? i : T - 1);
    bf16_t* Q = (bf16_t*)(p->ws + WS_Q);
    unsigned* Kt = (unsigned*)wl; unsigned* Vp = Kt + 32 * 32;
    unsigned q[32]; float o[64];
    { const u32x4* qp = (const u32x4*)(Q + (size_t)row * 512 + h * 64);
#pragma unroll
        for (int e = 0; e < 8; ++e) { const u32x4 w = qp[e];
#pragma unroll
            for (int j = 0; j < 4; ++j) q[e * 4 + j] = pk2(lo_f(w[j]) * 0.125f, hi_f(w[j]) * 0.125f); } }
#pragma unroll
    for (int d = 0; d < 64; ++d) o[d] = 0.f;
    const float* kp_new = prompt ? p->out + O_KP + (size_t)(l * 32 + b) * 2064 * 512 + h * 64 : p->out + O_KS + (size_t)(l * 16 + b) * 64 * 512 + h * 64;
    const float* vp_new = prompt ? p->out + O_VP + (size_t)(l * 32 + b) * 2064 * 512 + h * 64 : p->out + O_VS + (size_t)(l * 16 + b) * 64 * 512 + h * 64;
    const float* kp_old = p->in[I_CK] + (size_t)(l * 16 + b) * 2048 * 512 + h * 64;
    const float* vp_old = p->in[I_CV] + (size_t)(l * 16 + b) * 2048 * 512 + h * 64;
    const int imax = (qt * 64 + 63 < T - 1) ? qt * 64 + 63 : T - 1;
    const int jtop = nh + imax - 1;
    float run = 0.f;
    f32x4 kreg[8], va[4], vb[4];
#define ATT_FETCH(JT) do { _Pragma("unroll") for (int e = 0; e < 8; ++e) { const int idx = e * 64 + lane, kr = idx >> 4, pc = idx & 15, j = (JT) - kr; kreg[e] = (f32x4){0.f, 0.f, 0.f, 0.f}; \
            if (j >= 0) { const float* kp = (j < nh) ? kp_old + (size_t)j * 512 : kp_new + (size_t)(j - nh) * 512; kreg[e] = *(const f32x4*)(kp + pc * 4); } } \
        _Pragma("unroll") for (int e = 0; e < 4; ++e) { const int idx = e * 64 + lane, m = idx >> 4, pc = idx & 15, j0 = (JT) - 2 * m, j1 = j0 - 1; va[e] = (f32x4){0.f, 0.f, 0.f, 0.f}; vb[e] = (f32x4){0.f, 0.f, 0.f, 0.f}; \
            if (j0 >= 0) { const float* vp = (j0 < nh) ? vp_old + (size_t)j0 * 512 : vp_new + (size_t)(j0 - nh) * 512; va[e] = *(const f32x4*)(vp + pc * 4); } \
            if (j1 >= 0) { const float* vp = (j1 < nh) ? vp_old + (size_t)j1 * 512 : vp_new + (size_t)(j1 - nh) * 512; vb[e] = *(const f32x4*)(vp + pc * 4); } } } while (0)
    if (jtop >= 0) ATT_FETCH(jtop);
    for (int jt = jtop; jt >= 0; jt -= 32) {
#pragma unroll
        for (int e = 0; e < 8; ++e) { const int idx = e * 64 + lane, kr = idx >> 4, pc = idx & 15; u32x2 w; w[0] = pk2(kreg[e][0], kreg[e][1]); w[1] = pk2(kreg[e][2], kreg[e][3]); *(u32x2*)(Kt + kr * 32 + pc * 2) = w; }
#pragma unroll
        for (int e = 0; e < 4; ++e) { const int idx = e * 64 + lane, m = idx >> 4, pc = idx & 15;
            u32x4 w; w[0] = pk2(va[e][0], vb[e][0]); w[1] = pk2(va[e][1], vb[e][1]); w[2] = pk2(va[e][2], vb[e][2]); w[3] = pk2(va[e][3], vb[e][3]); *(u32x4*)(Vp + m * 64 + pc * 4) = w; }
        __builtin_amdgcn_wave_barrier(); asm volatile("s_waitcnt lgkmcnt(0)" ::: "memory");
        if (jt - 32 >= 0) ATT_FETCH(jt - 32);
        const int nk = jt + 1 < 32 ? jt + 1 : 32, npair = (nk + 1) >> 1;
        for (int m = 0; m < npair; ++m) { const int j0 = jt - 2 * m, j1 = j0 - 1;
            float z0 = 0.f, z1 = 0.f;
#pragma unroll
            for (int d8 = 0; d8 < 8; ++d8) { const u32x4 k0 = *(const u32x4*)(Kt + (2 * m) * 32 + d8 * 4), k1 = *(const u32x4*)(Kt + (2 * m + 1) * 32 + d8 * 4);
#pragma unroll
                for (int c = 0; c < 4; ++c) { z0 = dot2bf(q[d8 * 4 + c], k0[c], z0); z1 = dot2bf(q[d8 * 4 + c], k1[c], z1); } }
            const bool v0 = active && (j0 < nh + i), v1 = active && (j1 >= 0) && (j1 < nh + i);
            const float e0 = __expf(-z0), ls0 = -__logf(1.f + e0);
            const float w0 = v0 ? __expf(ls0 + run) : 0.f; run += v0 ? (ls0 - z0) : 0.f;
            const float e1 = __expf(-z1), ls1 = -__logf(1.f + e1);
            const float w1 = v1 ? __expf(ls1 + run) : 0.f; run += v1 ? (ls1 - z1) : 0.f;
            const unsigned wp = pk2(w0, w1);
#pragma unroll
            for (int d4 = 0; d4 < 16; ++d4) { const u32x4 vv = *(const u32x4*)(Vp + m * 64 + d4 * 4);
#pragma unroll
                for (int c = 0; c < 4; ++c) o[d4 * 4 + c] = dot2bf(wp, vv[c], o[d4 * 4 + c]); } }
        __builtin_amdgcn_wave_barrier(); asm volatile("s_waitcnt lgkmcnt(0)" ::: "memory");
        const int fin = (!active) || (run < -50.f);
        if (__all(fin)) break;
    }
#undef ATT_FETCH
    if (active) { u32x4* op = (u32x4*)(Q + (size_t)row * 512 + h * 64);
#pragma unroll
        for (int e = 0; e < 8; ++e) { u32x4 w; w[0] = pk2(o[e * 8], o[e * 8 + 1]); w[1] = pk2(o[e * 8 + 2], o[e * 8 + 3]); w[2] = pk2(o[e * 8 + 4], o[e * 8 + 5]); w[3] = pk2(o[e * 8 + 6], o[e * 8 + 7]); op[e] = w; } }
}

__device__ __forceinline__ void phase_mixers(CPar p, int l, float* sm) {
#ifndef SKIP_SSD
    { CPar p1 = params_ptr();
#pragma unroll 1
      for (int it = lbid(); it < 768; it += lgdim()) ssd_item(p1, l, it, sm); }
#endif
    __syncthreads();
    const int wave = __builtin_amdgcn_readfirstlane(ltid() >> 6);
    float* wl = sm + wave * (68 * 64);
#ifndef SKIP_S5
    { CPar p2 = params_ptr();
    if (wave < 4) { for (int it = lbid() * 4 + wave; it < 1024; it += lgdim() * 4) s5_item(p2, l, it >> 5, it & 31, wl); }
    else if (wave < 6) { for (int it = lbid() * 2 + (wave - 4); it < 512; it += lgdim() * 2) s5_item(p2, l, 32 + (it >> 5), it & 31, wl); } }
#endif
#ifndef SKIP_ATT
    CPar p3 = params_ptr();
    unsigned* ctr = (unsigned*)(p3->ws + WS_CTR) + l;
    for (;;) {
        unsigned it = 0; if ((ltid() & 63) == 0) it = atomicAdd(ctr, 1u);
        it = (unsigned)__builtin_amdgcn_readfirstlane((int)it);
        if (it >= 8576u) break;
        attn_item(p3, l, (int)it, wl);
    }
#endif
}

#define XB_TMO      128
#define XB_XCNT(j)  (256  + 64 * (j))
#define XB_XSUB(j)  (1280 + 64 * (j))
#define XB_XGEN(j)  (2304 + 64 * (j))
#define XB_TOP      3328
#define XB_TOPGEN   3392
#define XCD_BAR_WORDS 3456
#define XB_SPIN_CAP (1u << 18)

__device__ __forceinline__ unsigned xb_ld(unsigned* p)              { return __hip_atomic_load(p, __ATOMIC_RELAXED, __HIP_MEMORY_SCOPE_AGENT); }
__device__ __forceinline__ unsigned xb_add(unsigned* p, unsigned v) { return __hip_atomic_fetch_add(p, v, __ATOMIC_RELAXED, __HIP_MEMORY_SCOPE_AGENT); }
__device__ __forceinline__ unsigned xb_xcc_id() { return (unsigned)__builtin_amdgcn_s_getreg((3 << 11) | 20) & 0xFu; }
#define XB_SPIN(cond, bar) do { unsigned _sp = 0; while (cond) { __builtin_amdgcn_s_sleep(1); \
    if ((++_sp & 255u) == 0u) { if (xb_ld(&(bar)[XB_TMO])) break; if (_sp > XB_SPIN_CAP) { atomicAdd(&(bar)[XB_TMO], 1u); break; } } } } while (0)

struct XcdBarrier {
    unsigned* bar; unsigned x;
    volatile LAS unsigned* st;
};

__device__ __forceinline__ XcdBarrier xcd_barrier_post(unsigned* bar, volatile LAS unsigned* st) {
    XcdBarrier b; b.bar = bar; b.x = xb_xcc_id(); b.st = st;
    if (threadIdx.x == 0) (void)xb_add(&bar[XB_XCNT(b.x)], 1u);
    return b;
}
__device__ __forceinline__ void xcd_barrier_complete(unsigned* bar, unsigned x, unsigned& nloc, unsigned& nx) {
    const unsigned G = gridDim.x * gridDim.y * gridDim.z;
    unsigned sum, cnt, mine, sp = 0u;
    for (;;) {
        sum = 0u; cnt = 0u; mine = 0u;
#pragma unroll
        for (unsigned j = 0; j < 16; ++j) { const unsigned c = xb_ld(&bar[XB_XCNT(j)]); sum += c; cnt += (c > 0u) ? 1u : 0u; mine = (j == x) ? c : mine; }
        if (sum == G) break;
        __builtin_amdgcn_s_sleep(1);
        if ((++sp & 255u) == 0u) { if (xb_ld(&bar[XB_TMO])) break; if (sp > XB_SPIN_CAP) { atomicAdd(&bar[XB_TMO], 1u); break; } }
    }
    nloc = mine > 0u ? mine : 1u; nx = cnt > 0u ? cnt : 1u;
}

__device__ __forceinline__ void xcd_barrier(const XcdBarrier& b) {
    asm volatile("s_waitcnt vmcnt(0)" ::: "memory");
    __syncthreads();
    if (threadIdx.x == 0) {
        unsigned* bar = b.bar;
        __builtin_amdgcn_s_waitcnt(0);
        unsigned nloc = b.st[0], nx = b.st[1];
        if (nloc == 0u) { xcd_barrier_complete(bar, b.x, nloc, nx); b.st[0] = nloc; b.st[1] = nx; }
        const unsigned old = xb_add(&bar[XB_XSUB(b.x)], 1u);
        const unsigned gen = old / nloc;
        if (old + 1u == (gen + 1u) * nloc) {
            __builtin_amdgcn_fence(__ATOMIC_RELEASE, "agent");
            asm volatile("s_waitcnt vmcnt(0)" ::: "memory");
            const unsigned og = xb_add(&bar[XB_TOP], 1u);
            const unsigned tg = og / nx;
            if (og + 1u == (tg + 1u) * nx) xb_add(&bar[XB_TOPGEN], 1u);
            else XB_SPIN(xb_ld(&bar[XB_TOPGEN]) == tg, bar);
            __builtin_amdgcn_fence(__ATOMIC_ACQUIRE, "agent");
            xb_add(&bar[XB_XGEN(b.x)], 1u);
            asm volatile("s_waitcnt vmcnt(0)" ::: "memory");
        } else {
            XB_SPIN(xb_ld(&bar[XB_XGEN(b.x)]) == gen, bar);
            __builtin_amdgcn_fence(__ATOMIC_ACQUIRE, "agent");
            asm volatile("s_waitcnt vmcnt(0)" ::: "memory");
        }
    }
    __syncthreads();
}
__global__ __launch_bounds__(512, 2) void mega(Params pk) {
    extern __shared__ __attribute__((aligned(16))) unsigned char smem[];
    cg::grid_group grid = cg::this_grid();
    LAS unsigned char* lds = (LAS unsigned char*)smem;
    const int ph_lo = pk.ph_lo, ph_hi = pk.ph_hi;
    volatile LAS unsigned* xst = (volatile LAS unsigned*)(lds + (LDS_BYTES - 16));
    if (threadIdx.x == 0) { xst[0] = 0u; xst[1] = 0u; }
    const XcdBarrier xb = xcd_barrier_post((unsigned*)(pk.ws + WS_SSQ), xst);
    for (int ph = ph_lo; ph < ph_hi; ++ph) {
        if (ph == ph_lo + 1) grid.sync();
        else if (ph > ph_lo + 1) xcd_barrier(xb);
        CPar p = params_ptr();
        unsigned char* ws = p->ws;
        bf16_t *HB = (bf16_t*)(ws + WS_HB), *Z = (bf16_t*)(ws + WS_Z), *XBC = (bf16_t*)(ws + WS_XBC), *U = (bf16_t*)(ws + WS_U), *Q = (bf16_t*)(ws + WS_Q), *G = (bf16_t*)(ws + WS_G);
        float *DT = (float*)(ws + WS_DT), *XM = (float*)(ws + WS_XMETA);
        const int l = ph >> 3, sub = ph & 7;
        pg8::StaticOrder S;
        if (sub == 0) {
#ifndef SKIP0
            phase_prep(p, l);
#endif
        } else if (sub == 1) {
            S.init(NROWS, N1, lgdim(), lbid());
            EpiIn E{Z, XBC, U, Q, G, DT, p->out, p->in[I_QN] + l * 64, p->in[I_KN] + l * 64, l};
#ifndef SKIP1
            pg8::gemm_phase(lds, pg8::Gemm{HB, (const bf16_t*)(ws + W_BT1), NROWS, N1, 1024, 1024, 1024}, S, E);
#endif
        } else if (sub == 2) {
#ifndef SKIP2
            phase_mixers(p, l, (float*)smem);
#endif
        } else if (sub == 3) {
            ssd_norm_rows(p);
            S.init(NROWS, 2048, lgdim(), lbid());
            EpiGlu E{XBC};
            pg8::gemm_phase(lds, pg8::Gemm{U, (const bf16_t*)(ws + W_GLU), NROWS, 2048, 512, 512, 512}, S, E);
        } else if (sub == 4) {
            S.init(NROWS, 1024, lgdim(), lbid());
            for (int call = 0; call < 2; ++call) {
                EpiMix E; pg8::Gemm g;
                if (call == 0) { E = EpiMix{HB, G, XBC, 0}; g = pg8::Gemm{Z, (const bf16_t*)(ws + W_LA), NROWS, 1024, 1024, 1024, 1024}; }
                else { E = EpiMix{HB, G + 2048, nullptr, 1}; g = pg8::Gemm{Q, (const bf16_t*)(ws + W_LC), NROWS, 1024, 512, 512, 512}; }
#ifndef SKIP3
                pg8::gemm_phase(lds, g, S, E);
#endif
            }
        } else if (sub == 5) {
            S.init(NROWS, 1024, lgdim(), lbid());
            EpiRes E{p->out, XM, (bf16_t*)(ws + WS_XB2), (float*)(ws + WS_SSQX) + (size_t)l * NROWS};
            pg8::gemm_phase(lds, pg8::Gemm{HB, (const bf16_t*)(ws + W_OUT), NROWS, 1024, 1024, 1024, 1024}, S, E);
        } else if (sub == 6) {
            S.init(NROWS, 4096, lgdim(), lbid());
            EpiUp E{(bf16_t*)(ws + WS_ACT), (const float*)(ws + WS_SSQX) + (size_t)l * NROWS};
            pg8::gemm_phase(lds, pg8::Gemm{(const bf16_t*)(ws + WS_XB2), (const bf16_t*)(ws + W_UP), NROWS, 4096, 1024, 1024, 1024}, S, E);
        } else {
            S.init(NROWS, 1024, lgdim(), lbid());
            EpiRes E{p->out, XM, nullptr, nullptr};
            pg8::gemm_phase(lds, pg8::Gemm{(const bf16_t*)(ws + WS_ACT), (const bf16_t*)(ws + W_DOWN), NROWS, 1024, 4096, 4096, 4096}, S, E);
        }
    }
}

extern "C" void kernel_launch(void* const* d_in, const int* in_sizes, int n_in, void* d_out, int out_size, void* d_ws, size_t ws_size, hipStream_t stream) {
    static int grid = 0;
    if (grid == 0) {
        if (n_in != 34 || (size_t)out_size != O_END || ws_size < WS_END) { fprintf(stderr, "kernel_launch: unexpected shapes n_in %d out %d ws %zu (need %zu)\n", n_in, out_size, ws_size, (size_t)WS_END); grid = -1; return; }
        int dev = 0, cus = 0, per_cu = 0;
        hipGetDevice(&dev); hipDeviceGetAttribute(&cus, hipDeviceAttributeMultiprocessorCount, dev);
        if (hipFuncSetAttribute((const void*)mega, hipFuncAttributeMaxDynamicSharedMemorySize, LDS_BYTES) != hipSuccess) { fprintf(stderr, "kernel_launch: hipFuncSetAttribute failed\n"); grid = -1; return; }
        if (hipOccupancyMaxActiveBlocksPerMultiprocessor(&per_cu, (const void*)mega, 512, LDS_BYTES) != hipSuccess || per_cu < 1) { fprintf(stderr, "kernel_launch: occupancy query says %d\n", per_cu); per_cu = 1; }
        (void)hipGetLastError();
        grid = cus * per_cu;
    }
    if (grid < 0) return;
    if (hipMemsetAsync((char*)d_ws + WS_CTR, 0, 4096, stream) != hipSuccess || hipMemsetAsync((char*)d_ws + WS_SSQ, 0, 16384 + 2ull * NROWS * 4, stream) != hipSuccess) { fprintf(stderr, "kernel_launch: memset failed\n"); return; }
    Params p{};
    for (int i = 0; i < 34; ++i) p.in[i] = (const float*)d_in[i];
    p.out = (float*)d_out; p.ws = (unsigned char*)d_ws;
#if MULTI_LAUNCH
    for (int ph = 0; ph < 16; ++ph) { p.ph_lo = ph; p.ph_hi = ph + 1; hipLaunchKernelGGL(mega, dim3(grid), dim3(512), LDS_BYTES, stream, p); }
#else
    p.ph_lo = 0; p.ph_hi = 16;
    void* args[] = {&p};
    hipError_t e = hipLaunchCooperativeKernel((const void*)mega, dim3(grid), dim3(512), args, LDS_BYTES, stream);
    if (e != hipSuccess) fprintf(stderr, "cooperative launch failed: %s (grid %d)\n", hipGetErrorString(e), grid);
#endif
}
```

```cpp
#include <hip/hip_runtime.h>
#include <hip/hip_cooperative_groups.h>
#include <cstdio>
#include <cstdint>
namespace cg = cooperative_groups;

#ifndef MULTI_LAUNCH
#define MULTI_LAUNCH 0
#endif

typedef unsigned short bf16_t;
typedef short bf16x8 __attribute__((ext_vector_type(8)));
typedef float f32x4 __attribute__((ext_vector_type(4)));
typedef unsigned u32x4 __attribute__((ext_vector_type(4)));
typedef unsigned u32x2 __attribute__((ext_vector_type(2)));
#define LAS __attribute__((address_space(3)))

constexpr int D = 1024, NROWS = 67072, NS0 = 65536, NM0 = 66560;
constexpr int TP = 2064, TS = 64, NB_P = 32, NB_S = 16, PAST = 2048;
constexpr int IN_COLS = 7440, N1 = 7680;
constexpr int SSQ_SLOTS = NM0 + 32 * 32;
constexpr float EPS = 1e-6f;
constexpr size_t O_YP = 0, O_YS = 67108864ull, O_KP = O_YS + 1048576ull, SZ_KP = 2ull * 32 * 2064 * 512, O_VP = O_KP + SZ_KP,
                 O_CONVP = O_VP + SZ_KP, O_SSDP = O_CONVP + 2ull * 32 * 3 * 1280, O_S5RP = O_SSDP + 2ull * 32 * 16 * 4096, O_S5IP = O_S5RP + 2ull * 32 * 2048,
                 O_KS = O_S5IP + 2ull * 32 * 2048, O_VS = O_KS + 2ull * 16 * 64 * 512, O_CONVS = O_VS + 2ull * 16 * 64 * 512, O_SSDS = O_CONVS + 2ull * 16 * 3 * 1280,
                 O_S5RS = O_SSDS + 2ull * 16 * 16 * 4096, O_S5IS = O_S5RS + 2ull * 16 * 2048, O_END = O_S5IS + 2ull * 16 * 2048;
constexpr size_t W_BT1 = 0, W_GLU = W_BT1 + (size_t)N1 * 1024 * 2, W_LA = W_GLU + 2048ull * 512 * 2, W_LC = W_LA + 1024ull * 1024 * 2, W_OUT = W_LC + 1024ull * 512 * 2,
                 W_UP = W_OUT + 1024ull * 1024 * 2, W_DOWN = W_UP + 4096ull * 1024 * 2, W_END = W_DOWN + 4096ull * 1024 * 2;
constexpr size_t WS_CTR = W_END, WS_XMETA = WS_CTR + 4096, WS_HB = WS_XMETA + 512ull * 1024 * 4, WS_Z = WS_HB + (size_t)NROWS * 1024 * 2, WS_XBC = WS_Z + (size_t)NROWS * 1024 * 2,
                 WS_U = WS_XBC + (size_t)NROWS * 1280 * 2, WS_Q = WS_U + (size_t)NROWS * 512 * 2, WS_G = WS_Q + (size_t)NROWS * 512 * 2, WS_DT = WS_G + (size_t)NROWS * 3072 * 2,
                 WS_SSQ = WS_DT + (size_t)NROWS * 16 * 4, WS_END = WS_SSQ + (size_t)SSQ_SLOTS * 16 * 4;
constexpr size_t WS_XB2 = WS_DT - (size_t)NROWS * 1024 * 2;
constexpr size_t WS_SSQX = WS_SSQ + 16384;
constexpr size_t WS_ACT = WS_Z;
static_assert(WS_ACT + (size_t)NROWS * 4096 * 2 <= WS_XB2, "ACT overlay");
static_assert(WS_SSQX + 2ull * NROWS * 4 <= WS_END, "ssqx");
constexpr int LDS_BYTES = 147456;

struct Params {
    const float* in[34];
    float* out;
    unsigned char* ws;
    int ph_lo, ph_hi;
};
typedef const __attribute__((address_space(4))) Params* CPar;
__device__ __forceinline__ CPar params_ptr() { CPar q = (CPar)__builtin_amdgcn_kernarg_segment_ptr(); asm volatile("" : "+s"(q)); return q; }
#define PIN(i) (p->in[i])
enum { I_XP = 0, I_XS, I_CK, I_CV, I_SCONV, I_SSSD, I_S5R, I_S5I, I_META, I_NMIX, I_WIN, I_CONVW, I_CONVB, I_DTB, I_ALOG, I_DSSD, I_NSSD, I_LRE, I_LIM, I_LSTEP, I_BRE, I_BIM,
       I_CRE, I_CIM, I_DS5, I_WGLU, I_QN, I_KN, I_WLA, I_WLC, I_WOUT, I_NFFN, I_WUP, I_WDOWN };

__device__ __forceinline__ int ltid() { int t = threadIdx.x; asm volatile("" : "+v"(t)); return t; }
__device__ __forceinline__ int lbid() { int t = blockIdx.x; asm volatile("" : "+s"(t)); return t; }
__device__ __forceinline__ int lgdim() { int t = gridDim.x; asm volatile("" : "+s"(t)); return t; }

__device__ __forceinline__ float bf2f(bf16_t v) { return __uint_as_float((unsigned)v << 16); }
__device__ __forceinline__ unsigned pk2(float lo, float hi) { unsigned r; asm volatile("v_cvt_pk_bf16_f32 %0, %1, %2" : "=v"(r) : "v"(lo), "v"(hi)); return r; }
__device__ __forceinline__ float lo_f(unsigned w) { return __uint_as_float(w << 16); }
__device__ __forceinline__ float hi_f(unsigned w) { return __uint_as_float(w & 0xffff0000u); }
__device__ __forceinline__ u32x2 ld_l2_u32x2(const void* ptr) { const unsigned long long v = __hip_atomic_load((const unsigned long long*)ptr, __ATOMIC_RELAXED, __HIP_MEMORY_SCOPE_AGENT); u32x2 r; r[0] = (unsigned)v; r[1] = (unsigned)(v >> 32); return r; }
__device__ __forceinline__ float sigmoidf_(float v) { return __builtin_amdgcn_rcpf(1.f + __expf(-v)); }
__device__ __forceinline__ float siluf_(float v) { return v * sigmoidf_(v); }
__device__ __forceinline__ float geluf_(float y) { const float a = 0.7978845608f * (y + 0.044715f * y * y * y); const float t = __expf(2.f * a); return 0.5f * y * (2.f - 2.f * __builtin_amdgcn_rcpf(t + 1.f)); }
__device__ __forceinline__ float wave_sum(float v) {
#pragma unroll
    for (int o = 1; o < 64; o <<= 1) v += __shfl_xor(v, o);
    return v;
}
__device__ __forceinline__ void sincos_red(double x, float& sn, float& cs) {
    const double k = __builtin_rint(x * 0.63661977236758134308);
    const float r = (float)__builtin_fma(-k, 1.57079632679489661923, x), r2 = r * r;
    const float sp = r + r * r2 * (-1.6666667163e-01f + r2 * (8.3333337680e-03f + r2 * (-1.9841270114e-04f + r2 * 2.7557314297e-06f)));
    const float cp = 1.f + r2 * (-0.5f + r2 * (4.1666667908e-02f + r2 * (-1.3888889225e-03f + r2 * (2.4801587642e-05f - r2 * 2.7557314297e-07f))));
    const int q = ((int)k) & 3;
    sn = (q == 0) ? sp : (q == 1) ? cp : (q == 2) ? -sp : -cp;
    cs = (q == 0) ? cp : (q == 1) ? -sp : (q == 2) ? -cp : sp;
}
__device__ __forceinline__ int row_of(int s, int t) { return s < 32 ? (t < 16 ? NM0 + s * 16 + t : s * 2048 + t - 16) : NS0 + (s - 32) * 64 + t; }
__device__ __forceinline__ int ssq_slot(int r) { return r < NM0 ? r : NM0 + ((r - NM0) >> 4) * 32 + ((r - NM0) & 15); }
__device__ __forceinline__ float* xloc(CPar p, int r) { return r < NM0 ? p->out + (size_t)r * 1024 : (float*)(p->ws + WS_XMETA) + (size_t)(r - NM0) * 1024; }
__device__ __forceinline__ size_t k_off(int l, int r) {
    if (r < NS0) return O_KP + ((size_t)(l * 32 + (r >> 11)) * 2064 + 16 + (r & 2047)) * 512;
    if (r < NM0) { const int rs = r - NS0; return O_KS + ((size_t)(l * 16 + (rs >> 6)) * 64 + (rs & 63)) * 512; }
    const int rm = r - NM0; return O_KP + ((size_t)(l * 32 + (rm >> 4)) * 2064 + (rm & 15)) * 512;
}

namespace pg8 {
constexpr int BM = 256, BK = 64, HALF = 128, HTB = HALF * BK * 2, STAGE_BYTES = 8 * HTB, NXCD = 8, WGM = 8;
__host__ __device__ __forceinline__ int lds_byte(int r, int c) { const int st = (r >> 4) * 2 + (c >> 5), rr = r & 15, cc = c & 31, ob = rr * 64 + cc * 2; return st * 1024 + (ob ^ (((ob >> 9) & 1) << 5)); }
__host__ __device__ __forceinline__ void stage_rc(int b, int& R, int& C) { const int st = b / 1024, sb = b % 1024, swz = sb ^ (((sb >> 9) & 1) << 5); R = (st >> 1) * 16 + swz / 64; C = (st & 1) * 32 + (swz % 64) / 2; }
struct Unit { int pm, pn; };
struct Gemm { const bf16_t* A; const bf16_t* Bt; int M, N, K, lda, ldb; };
struct StaticOrder {
    int nM, nN, nwg, G, c;
    __device__ void init(int M, int N, int G_, int c_) { nM = M / BM; nN = N / BM; nwg = nM * nN; G = G_; c = c_; }
    __device__ bool next(int i, Unit& u) const {
        const long L = (long)i * G + c; if (L >= nwg) return false;
        int wgid = (int)L; { const int q = nwg / NXCD, r = nwg % NXCD, xcd = wgid % NXCD, off = wgid / NXCD; wgid = (xcd < r ? xcd * (q + 1) : r * (q + 1) + (xcd - r) * q) + off; }
        const int nig = WGM * nN, gid = wgid / nig, fm = gid * WGM, gsz = (nM - fm) < WGM ? (nM - fm) : WGM;
        u.pm = fm + ((wgid % nig) % gsz); u.pn = (wgid % nig) / gsz; return true;
    }
};
template <class Epi>
__device__ __forceinline__ void gemm_phase(LAS unsigned char* lds, const Gemm g, const StaticOrder& S, const Epi& E) {
    const int tid = ltid(), wid = __builtin_amdgcn_readfirstlane(tid >> 6), lane = tid & 63, wr = wid >> 2, wc = wid & 3, fr = lane & 15, fq = lane >> 4;
    const int K = g.K, nt = K / BK;
    unsigned voffA[2], voffB[2];
#pragma unroll
    for (int i = 0; i < 2; ++i) { int R, C; stage_rc(tid * 16 + i * 8192, R, C); voffA[i] = (unsigned)(R * g.lda + C) * 2u; voffB[i] = (unsigned)(R * g.ldb + C) * 2u; }
    const size_t kstep = (size_t)(BK * 2);
    const size_t hstepA = (size_t)HALF * g.lda * 2, hstepB = (size_t)HALF * g.ldb * 2;
    const size_t tstepA = 2 * hstepA, tstepB = 2 * hstepB;
    const unsigned ldsw = (unsigned)wid * 1024u;
    const int aoff = lds_byte(wr * 64 + fr, fq * 8), boff = lds_byte(wc * 32 + fr, fq * 8);
#define PG8_SA(b, h) (((b) * 2 + (h)) * HTB)
#define PG8_SB(b, h) ((4 + (b) * 2 + (h)) * HTB)
#define PG8_STAGE(bufoff, gbase, voff) do { _Pragma("unroll") for (int _i = 0; _i < 2; ++_i) \
        __builtin_amdgcn_global_load_lds((const unsigned*)((const char*)(gbase) + (voff)[_i]), (LAS unsigned*)(lds + (bufoff) + ldsw + _i * 8192), 16, 0, 0); } while (0)
#define PG8_LDA(dst, b, h) do { _Pragma("unroll") for (int m = 0; m < 4; ++m) _Pragma("unroll") for (int k = 0; k < 2; ++k) dst[m][k] = *(const LAS bf16x8*)(lds + PG8_SA(b, h) + aoff + m * 2048 + k * 1024); } while (0)
#define PG8_LDB(dst, b, h) do { _Pragma("unroll") for (int n = 0; n < 2; ++n) _Pragma("unroll") for (int k = 0; k < 2; ++k) dst[n][k] = *(const LAS bf16x8*)(lds + PG8_SB(b, h) + boff + n * 2048 + k * 1024); } while (0)
#define PG8_MMA(ai, bj, At, Bt) do { __builtin_amdgcn_s_setprio(1); _Pragma("unroll") for (int m = 0; m < 4; ++m) _Pragma("unroll") for (int n = 0; n < 2; ++n) _Pragma("unroll") for (int k = 0; k < 2; ++k) \
        acc[ai][bj][m][n] = __builtin_amdgcn_mfma_f32_16x16x32_bf16(Bt[n][k], At[m][k], acc[ai][bj][m][n], 0, 0, 0); __builtin_amdgcn_s_setprio(0); } while (0)
#define PG8_WAIT_V(n) asm volatile("s_waitcnt vmcnt(" #n ")" ::: "memory")
#define PG8_WAIT_L(n) asm volatile("s_waitcnt lgkmcnt(" #n ")" ::: "memory")
#define PG8_BAR __builtin_amdgcn_s_barrier()
#define PG8_SCHED __builtin_amdgcn_sched_barrier(0)
    Unit cur, nxt; int ui = 0;
    if (!S.next(0, cur)) return;
    f32x4 acc[2][2][4][2];
#pragma unroll
    for (int a = 0; a < 2; ++a)
#pragma unroll
        for (int b = 0; b < 2; ++b)
#pragma unroll
            for (int m = 0; m < 4; ++m)
#pragma unroll
                for (int n = 0; n < 2; ++n) acc[a][b][m][n] = (f32x4){0.f, 0.f, 0.f, 0.f};
    bf16x8 At[4][2], B0[2][2], B1[2][2];
    const char* cA = (const char*)g.A + (size_t)cur.pm * tstepA; const char* cB = (const char*)g.Bt + (size_t)cur.pn * tstepB;
    PG8_STAGE(PG8_SB(0, 0), cB, voffB); PG8_STAGE(PG8_SA(0, 0), cA, voffA); PG8_STAGE(PG8_SB(0, 1), cB + hstepB, voffB); PG8_STAGE(PG8_SA(0, 1), cA + hstepA, voffA);
    if (wr == 1) PG8_BAR;
    PG8_WAIT_V(4); PG8_BAR;
    PG8_STAGE(PG8_SB(1, 0), cB + kstep, voffB); PG8_STAGE(PG8_SA(1, 0), cA + kstep, voffA); PG8_STAGE(PG8_SB(1, 1), cB + hstepB + kstep, voffB);
    PG8_WAIT_V(6); PG8_BAR;
    for (;;) {
        const bool has_next = S.next(ui + 1, nxt);
        const char* nA = has_next ? (const char*)g.A + (size_t)nxt.pm * tstepA : cA; const char* nB = has_next ? (const char*)g.Bt + (size_t)nxt.pn * tstepB : cB;
        for (int t = 0; t < nt; t += 2) {
            const bool last = (t == nt - 2);
            const char* a1 = cA + (size_t)(t + 1) * kstep;
            const char* a2 = last ? nA : cA + (size_t)(t + 2) * kstep; const char* b2 = last ? nB : cB + (size_t)(t + 2) * kstep;
            const char* a3 = a2 + kstep; const char* b3 = b2 + kstep;
            PG8_LDB(B0, 0, 0); PG8_SCHED; PG8_LDA(At, 0, 0); PG8_STAGE(PG8_SA(1, 1), a1 + hstepA, voffA);
            PG8_WAIT_L(8); PG8_BAR; PG8_WAIT_L(0); PG8_MMA(0, 0, At, B0); PG8_BAR; PG8_SCHED;
            PG8_LDB(B1, 0, 1); PG8_STAGE(PG8_SB(0, 0), b2, voffB);
            PG8_BAR; PG8_WAIT_L(0); PG8_MMA(0, 1, At, B1); PG8_BAR;
            PG8_LDA(At, 0, 1); PG8_STAGE(PG8_SA(0, 0), a2, voffA);
            PG8_BAR; PG8_WAIT_L(0); PG8_MMA(1, 0, At, B0); PG8_BAR; PG8_SCHED;
            PG8_STAGE(PG8_SB(0, 1), b2 + hstepB, voffB);
            PG8_WAIT_V(6); PG8_BAR; PG8_MMA(1, 1, At, B1); PG8_BAR;
            PG8_LDB(B0, 1, 0); PG8_SCHED; PG8_LDA(At, 1, 0); PG8_STAGE(PG8_SA(0, 1), a2 + hstepA, voffA);
            PG8_WAIT_L(8); PG8_BAR; PG8_WAIT_L(0); PG8_MMA(0, 0, At, B0); PG8_BAR; PG8_SCHED;
            PG8_LDB(B1, 1, 1); PG8_STAGE(PG8_SB(1, 0), b3, voffB);
            PG8_BAR; PG8_WAIT_L(0); PG8_MMA(0, 1, At, B1); PG8_BAR;
            PG8_LDA(At, 1, 1); PG8_STAGE(PG8_SA(1, 0), a3, voffA);
            PG8_BAR; PG8_WAIT_L(0); PG8_MMA(1, 0, At, B0); PG8_BAR; PG8_SCHED;
            PG8_STAGE(PG8_SB(1, 1), b3 + hstepB, voffB);
            PG8_WAIT_V(6); PG8_BAR; PG8_MMA(1, 1, At, B1); PG8_BAR;
        }
        E(acc, cur, wr, wc, fr, fq);
        if (!has_next) break;
#pragma unroll
        for (int a = 0; a < 2; ++a)
#pragma unroll
            for (int b = 0; b < 2; ++b)
#pragma unroll
                for (int m = 0; m < 4; ++m)
#pragma unroll
                    for (int n = 0; n < 2; ++n) acc[a][b][m][n] = (f32x4){0.f, 0.f, 0.f, 0.f};
        cur = nxt; cA = nA; cB = nB; ++ui;
    }
    PG8_WAIT_V(0);
    if (wr == 0) PG8_BAR;
    PG8_BAR;
#undef PG8_SA
#undef PG8_SB
#undef PG8_STAGE
#undef PG8_LDA
#undef PG8_LDB
#undef PG8_MMA
#undef PG8_WAIT_V
#undef PG8_WAIT_L
#undef PG8_BAR
#undef PG8_SCHED
}
}
using pg8::Unit;

struct EpiIn {
    bf16_t *Z, *XBC, *U, *Q, *G; float* DT; float* out; const float *qn, *kn; int layer;
    __device__ __forceinline__ void operator()(const f32x4 (&acc)[2][2][4][2], const Unit& u, int wr, int wc, int fr, int fq) const {
        const int pn = u.pn, rowb = u.pm * 256 + wr * 64 + fr, ctb = wc * 32 + fq * 4;
        if (pn < 11 || (pn >= 17 && pn < 29)) {
            bf16_t* base; int ld, col0; bool sig = false;
            if (pn < 4) { base = Z; ld = 1024; col0 = pn * 256; } else if (pn < 9) { base = XBC; ld = 1280; col0 = (pn - 4) * 256; }
            else if (pn < 11) { base = U; ld = 512; col0 = (pn - 9) * 256; } else { base = G; ld = 3072; col0 = (pn - 17) * 256; sig = true; }
#pragma unroll
            for (int ai = 0; ai < 2; ++ai)
#pragma unroll
                for (int m = 0; m < 4; ++m) { bf16_t* rp = base + (size_t)(rowb + ai * 128 + m * 16) * ld + col0 + ctb;
#pragma unroll
                    for (int bj = 0; bj < 2; ++bj)
#pragma unroll
                        for (int n = 0; n < 2; ++n) { f32x4 v = acc[ai][bj][m][n];
                            if (sig) { v[0] = sigmoidf_(v[0]); v[1] = sigmoidf_(v[1]); v[2] = sigmoidf_(v[2]); v[3] = sigmoidf_(v[3]); }
                            u32x2 o; o[0] = pk2(v[0], v[1]); o[1] = pk2(v[2], v[3]); *(u32x2*)(rp + bj * 128 + n * 16) = o; } }
        } else if (pn < 17) {
            const int seg = (pn - 11) >> 1, head = ((pn - 11) & 1) * 4 + wc;
            const float* nw = seg == 0 ? qn : kn;
            f32x4 wv[2][2];
#pragma unroll
            for (int bj = 0; bj < 2; ++bj)
#pragma unroll
                for (int n = 0; n < 2; ++n) wv[bj][n] = (seg < 2) ? *(const f32x4*)(nw + 32 * bj + 16 * n + 4 * fq) : (f32x4){1.f, 1.f, 1.f, 1.f};
#pragma unroll
            for (int ai = 0; ai < 2; ++ai)
#pragma unroll
                for (int m = 0; m < 4; ++m) { const int row = rowb + ai * 128 + m * 16;
                    float rs = 1.f;
                    if (seg < 2) { float ss = 0.f;
#pragma unroll
                        for (int bj = 0; bj < 2; ++bj)
#pragma unroll
                            for (int n = 0; n < 2; ++n) { const f32x4 v = acc[ai][bj][m][n]; ss += v[0] * v[0] + v[1] * v[1] + v[2] * v[2] + v[3] * v[3]; }
                        ss += __shfl_xor(ss, 16); ss += __shfl_xor(ss, 32);
                        rs = rsqrtf(ss * (1.f / 64.f) + EPS); }
                    if (seg == 0) { bf16_t* rp = Q + (size_t)row * 512 + head * 64 + 4 * fq;
#pragma unroll
                        for (int bj = 0; bj < 2; ++bj)
#pragma unroll
                            for (int n = 0; n < 2; ++n) { const f32x4 v = acc[ai][bj][m][n] * rs * wv[bj][n]; u32x2 o; o[0] = pk2(v[0], v[1]); o[1] = pk2(v[2], v[3]); *(u32x2*)(rp + 32 * bj + 16 * n) = o; }
                    } else { float* rp = out + k_off(layer, row) + (seg == 2 ? (row >= NS0 && row < NM0 ? (O_VS - O_KS) : (O_VP - O_KP)) : 0) + head * 64 + 4 * fq;
#pragma unroll
                        for (int bj = 0; bj < 2; ++bj)
#pragma unroll
                            for (int n = 0; n < 2; ++n) { const f32x4 v = acc[ai][bj][m][n] * rs * wv[bj][n]; *(f32x4*)(rp + 32 * bj + 16 * n) = v; } } }
        } else {
            if (wc == 0) {
#pragma unroll
                for (int ai = 0; ai < 2; ++ai)
#pragma unroll
                    for (int m = 0; m < 4; ++m) *(f32x4*)(DT + (size_t)(rowb + ai * 128 + m * 16) * 16 + 4 * fq) = acc[ai][0][m][0];
            }
        }
    }
};
struct EpiGlu {
    bf16_t* OB;
    __device__ __forceinline__ void operator()(const f32x4 (&acc)[2][2][4][2], const Unit& u, int wr, int wc, int fr, int fq) const {
        const int rowb = u.pm * 256 + wr * 64 + fr, colb = u.pn * 128 + wc * 32 + fq * 4;
#pragma unroll
        for (int ai = 0; ai < 2; ++ai)
#pragma unroll
            for (int m = 0; m < 4; ++m) { bf16_t* rp = OB + (size_t)(rowb + ai * 128 + m * 16) * 1024 + colb;
#pragma unroll
                for (int n = 0; n < 2; ++n) { const f32x4 a = acc[ai][0][m][n], g = acc[ai][1][m][n];
                    u32x2 o; o[0] = pk2(a[0] * sigmoidf_(g[0]), a[1] * sigmoidf_(g[1])); o[1] = pk2(a[2] * sigmoidf_(g[2]), a[3] * sigmoidf_(g[3])); *(u32x2*)(rp + n * 16) = o; } }
    }
};
struct EpiMix {
    bf16_t* R; const bf16_t* G; const bf16_t* OB; int accum;
    __device__ __forceinline__ void operator()(const f32x4 (&acc)[2][2][4][2], const Unit& u, int wr, int wc, int fr, int fq) const {
        const int rowb = u.pm * 256 + wr * 64 + fr, colb = u.pn * 256 + wc * 32 + fq * 4;
#pragma unroll
        for (int ai = 0; ai < 2; ++ai)
#pragma unroll
            for (int m = 0; m < 4; ++m) { const int row = rowb + ai * 128 + m * 16;
                u32x2 gw[2][2], g1[2][2], ob[2][2], rw[2][2];
#pragma unroll
                for (int bj = 0; bj < 2; ++bj)
#pragma unroll
                    for (int n = 0; n < 2; ++n) { const int col = colb + bj * 128 + n * 16;
                        gw[bj][n] = *(const u32x2*)(G + (size_t)row * 3072 + col);
                        g1[bj][n] = (u32x2){0u, 0u}; ob[bj][n] = (u32x2){0u, 0u}; rw[bj][n] = (u32x2){0u, 0u};
                        if (OB) { g1[bj][n] = *(const u32x2*)(G + (size_t)row * 3072 + 1024 + col); ob[bj][n] = *(const u32x2*)(OB + (size_t)row * 1024 + col); }
                        if (accum) rw[bj][n] = ld_l2_u32x2(R + (size_t)row * 1024 + col); }
#pragma unroll
                for (int bj = 0; bj < 2; ++bj)
#pragma unroll
                    for (int n = 0; n < 2; ++n) { const int col = colb + bj * 128 + n * 16; f32x4 v = acc[ai][bj][m][n];
                        v = v * (f32x4){lo_f(gw[bj][n][0]), hi_f(gw[bj][n][0]), lo_f(gw[bj][n][1]), hi_f(gw[bj][n][1])};
                        v = v + (f32x4){lo_f(g1[bj][n][0]), hi_f(g1[bj][n][0]), lo_f(g1[bj][n][1]), hi_f(g1[bj][n][1])} * (f32x4){lo_f(ob[bj][n][0]), hi_f(ob[bj][n][0]), lo_f(ob[bj][n][1]), hi_f(ob[bj][n][1])};
                        v = v + (f32x4){lo_f(rw[bj][n][0]), hi_f(rw[bj][n][0]), lo_f(rw[bj][n][1]), hi_f(rw[bj][n][1])};
                        u32x2 o; o[0] = pk2(v[0], v[1]); o[1] = pk2(v[2], v[3]); *(u32x2*)(R + (size_t)row * 1024 + col) = o; } }
    }
};
struct EpiRes {
    float* out; float* xmeta; bf16_t* XB; float* ssq;
    __device__ __forceinline__ void operator()(const f32x4 (&acc)[2][2][4][2], const Unit& u, int wr, int wc, int fr, int fq) const {
        const int rowb = u.pm * 256 + wr * 64 + fr, colb = u.pn * 256 + wc * 32 + fq * 4;
        float* base = (u.pm * 256 < NM0) ? out : xmeta - (size_t)NM0 * 1024;
#pragma unroll
        for (int ai = 0; ai < 2; ++ai)
#pragma unroll
            for (int mh = 0; mh < 2; ++mh) {
                f32x4 xv[2][2][2];
#pragma unroll
                for (int m2 = 0; m2 < 2; ++m2)
#pragma unroll
                    for (int bj = 0; bj < 2; ++bj)
#pragma unroll
                        for (int n = 0; n < 2; ++n) xv[m2][bj][n] = __builtin_nontemporal_load((const f32x4*)(base + (size_t)(rowb + ai * 128 + (mh * 2 + m2) * 16) * 1024 + colb + bj * 128 + n * 16));
#pragma unroll
                for (int m2 = 0; m2 < 2; ++m2) { const int m = mh * 2 + m2, row = rowb + ai * 128 + m * 16; float* rp = base + (size_t)row * 1024 + colb; float ss = 0.f;
#pragma unroll
                    for (int bj = 0; bj < 2; ++bj)
#pragma unroll
                        for (int n = 0; n < 2; ++n) { const f32x4 v = xv[m2][bj][n] + acc[ai][bj][m][n]; *(f32x4*)(rp + bj * 128 + n * 16) = v;
                            if (XB) { u32x2 o; o[0] = pk2(v[0], v[1]); o[1] = pk2(v[2], v[3]); *(u32x2*)(XB + (size_t)row * 1024 + colb + bj * 128 + n * 16) = o; ss += (v[0] * v[0] + v[1] * v[1]) + (v[2] * v[2] + v[3] * v[3]); } }
                    if (XB) { ss += __shfl_xor(ss, 16); ss += __shfl_xor(ss, 32); if (fq == 0) __hip_atomic_fetch_add(ssq + row, ss, __ATOMIC_RELAXED, __HIP_MEMORY_SCOPE_AGENT); } } }
    }
};
struct EpiUp {
    bf16_t* ACT; const float* ssq;
    __device__ __forceinline__ void operator()(const f32x4 (&acc)[2][2][4][2], const Unit& u, int wr, int wc, int fr, int fq) const {
        const int rowb = u.pm * 256 + wr * 64 + fr, colb = u.pn * 256 + wc * 32 + fq * 4;
        float rs[2][4];
#pragma unroll
        for (int ai = 0; ai < 2; ++ai)
#pragma unroll
            for (int m = 0; m < 4; ++m) rs[ai][m] = ssq[rowb + ai * 128 + m * 16];
#pragma unroll
        for (int ai = 0; ai < 2; ++ai)
#pragma unroll
            for (int m = 0; m < 4; ++m) { bf16_t* rp = ACT + (size_t)(rowb + ai * 128 + m * 16) * 4096 + colb; const float r_ = rsqrtf(rs[ai][m] * (1.f / 1024.f) + EPS);
#pragma unroll
                for (int bj = 0; bj < 2; ++bj)
#pragma unroll
                    for (int n = 0; n < 2; ++n) { f32x4 v = acc[ai][bj][m][n];
#pragma unroll
                        for (int j = 0; j < 4; ++j) { const float r = fmaxf(v[j] * r_, 0.f); v[j] = r * r; }
                        u32x2 o; o[0] = pk2(v[0], v[1]); o[1] = pk2(v[2], v[3]); *(u32x2*)(rp + bj * 128 + n * 16) = o; } }
    }
};

__device__ __forceinline__ int col_in(int n) {
    if (n < 2304) return n;
    if (n < 2816) return n + 16;
    if (n < 4352) { const int w0 = n - 2816, seg = w0 >> 9, w = w0 & 511, tile = w >> 8, ct = w & 255, bj = ct >> 7, wc = (ct >> 5) & 3, ww = ct & 31;
        return 2832 + seg * 512 + (tile * 4 + wc) * 64 + 32 * bj + ww; }
    if (n < 7424) return n + 16;
    if (n < 7440) return 2304 + (n - 7424);
    return -1;
}
template <int MAP>
__device__ __forceinline__ void prep_w(bf16_t* dst, const float* src, int K, int N, int ld, const float* scale, size_t gtid, size_t gsz) {
    const size_t items = (size_t)(K / 8) * N;
    for (size_t it = gtid; it < items; it += gsz) {
        const int n = (int)(it % N), k8 = (int)(it / N);
        const int c = MAP == 1 ? col_in(n) : (MAP == 2 ? (((n >> 7) & 1) * 1024 + (n >> 8) * 128 + (n & 127)) : n);
        float v[8];
#pragma unroll
        for (int kk = 0; kk < 8; ++kk) { const int k = k8 * 8 + kk; float x = (c >= 0) ? src[(size_t)k * ld + c] : 0.f; if (scale) x *= scale[k]; v[kk] = x; }
        u32x4 o; o[0] = pk2(v[0], v[1]); o[1] = pk2(v[2], v[3]); o[2] = pk2(v[4], v[5]); o[3] = pk2(v[6], v[7]);
        *(u32x4*)(dst + (size_t)n * K + k8 * 8) = o;
    }
}
__device__ __forceinline__ void rmsnorm_rows(CPar p, const float* g, int from_inputs) {
    const int lane = ltid() & 63, gw = lbid() * 8 + (ltid() >> 6), ngw = lgdim() * 8;
    bf16_t* HB = (bf16_t*)(p->ws + WS_HB);
    f32x4 gv[4];
#pragma unroll
    for (int j = 0; j < 4; ++j) gv[j] = *(const f32x4*)(g + lane * 4 + 256 * j);
    for (int r = gw; r < NROWS; r += ngw) {
        float* xl = xloc(p, r);
        const float* src = xl;
        if (from_inputs) src = r < NS0 ? p->in[I_XP] + (size_t)r * 1024 : (r < NM0 ? p->in[I_XS] + (size_t)(r - NS0) * 1024 : p->in[I_META] + (size_t)((r - NM0) & 15) * 1024);
        f32x4 v[4]; float s = 0.f;
#pragma unroll
        for (int j = 0; j < 4; ++j) { v[j] = *(const f32x4*)(src + lane * 4 + 256 * j); s += (v[j][0] * v[j][0] + v[j][1] * v[j][1]) + (v[j][2] * v[j][2] + v[j][3] * v[j][3]); }
        const float rstd = rsqrtf(wave_sum(s) * (1.f / 1024.f) + EPS);
#pragma unroll
        for (int j = 0; j < 4; ++j) { if (from_inputs) *(f32x4*)(xl + lane * 4 + 256 * j) = v[j];
            const f32x4 h = v[j] * rstd * gv[j]; u32x2 o; o[0] = pk2(h[0], h[1]); o[1] = pk2(h[2], h[3]); *(u32x2*)(HB + (size_t)r * 1024 + lane * 4 + 256 * j) = o; }
    }
}
__device__ __forceinline__ void ssd_norm_rows(CPar p) {
    const int lane = ltid() & 63, gw = lbid() * 8 + (ltid() >> 6), ngw = lgdim() * 8;
    bf16_t* Z = (bf16_t*)(p->ws + WS_Z);
    for (int r = gw; r < NROWS; r += ngw) {
#pragma unroll
        for (int j = 0; j < 2; ++j) { u32x4* zp = (u32x4*)(Z + (size_t)r * 1024 + j * 512 + lane * 8); const u32x4 w = *zp;
            float f[8] = {lo_f(w[0]), hi_f(w[0]), lo_f(w[1]), hi_f(w[1]), lo_f(w[2]), hi_f(w[2]), lo_f(w[3]), hi_f(w[3])};
            float ss = 0.f;
#pragma unroll
            for (int i = 0; i < 8; ++i) ss += f[i] * f[i];
            const float rs = rsqrtf(wave_sum(ss) * (1.f / 512.f) + EPS);
            u32x4 o; o[0] = pk2(f[0] * rs, f[1] * rs); o[1] = pk2(f[2] * rs, f[3] * rs); o[2] = pk2(f[4] * rs, f[5] * rs); o[3] = pk2(f[6] * rs, f[7] * rs); *zp = o; }
    }
}
__device__ __forceinline__ void phase_prep(CPar p, int l) {
    const size_t gtid = (size_t)lbid() * 512 + ltid(), gsz = (size_t)lgdim() * 512;
    unsigned char* ws = p->ws;
    prep_w<1>((bf16_t*)(ws + W_BT1), p->in[I_WIN] + (size_t)l * 1024 * IN_COLS, 1024, N1, IN_COLS, nullptr, gtid, gsz);
    prep_w<2>((bf16_t*)(ws + W_GLU), p->in[I_WGLU] + (size_t)l * 512 * 2048, 512, 2048, 2048, nullptr, gtid, gsz);
    prep_w<0>((bf16_t*)(ws + W_LA), p->in[I_WLA] + (size_t)l * 1024 * 1024, 1024, 1024, 1024, p->in[I_NSSD] + l * 1024, gtid, gsz);
    prep_w<0>((bf16_t*)(ws + W_LC), p->in[I_WLC] + (size_t)l * 512 * 1024, 512, 1024, 1024, nullptr, gtid, gsz);
    prep_w<0>((bf16_t*)(ws + W_OUT), p->in[I_WOUT] + (size_t)l * 1024 * 1024, 1024, 1024, 1024, nullptr, gtid, gsz);
    prep_w<0>((bf16_t*)(ws + W_UP), p->in[I_WUP] + (size_t)l * 1024 * 4096, 1024, 4096, 4096, p->in[I_NFFN] + l * 1024, gtid, gsz);
    prep_w<0>((bf16_t*)(ws + W_DOWN), p->in[I_WDOWN] + (size_t)l * 4096 * 1024, 4096, 1024, 1024, nullptr, gtid, gsz);
    rmsnorm_rows(p, p->in[I_NMIX] + l * 1024, l == 0);
}

__device__ __forceinline__ bf16_t f2bf_(float v) { return (bf16_t)(pk2(v, v) & 0xffffu); }
__device__ __forceinline__ void ssd_item(CPar p, int l, int item, float* sm) {
    const int tid = ltid(), lane = tid & 63, wave = __builtin_amdgcn_readfirstlane(tid >> 6), rb = wave >> 1, chh = wave & 1, fr = lane & 15, fq = lane >> 4;
    const int s = item < 512 ? (item >> 4) : 32 + ((item - 512) >> 4), h = item & 15, g = h >> 3;
    const bool prompt = s < 32; const int b = prompt ? s : s - 32, T = prompt ? TP : TS;
    constexpr int LB = 72;
    bf16_t *Cb = (bf16_t*)sm, *Bb = Cb + 64 * LB, *XT = Bb + 64 * LB, *WB = XT + 64 * LB, *Mb = WB + 64 * LB, *Sb = Mb + 64 * LB;
    float *sRaw = (float*)(Sb + 64 * LB), *sW = sRaw + 67 * 192, *sdtA = sW + 5 * 192, *sacA = sdtA + 33 * 64, *sw = sacA + 33 * 64;
    const bf16_t* XBC = (const bf16_t*)(p->ws + WS_XBC); bf16_t* Z = (bf16_t*)(p->ws + WS_Z);
    const float* DT = (const float*)(p->ws + WS_DT);
    const float* cw = p->in[I_CONVW] + (size_t)l * 4 * 1280; const float* cb = p->in[I_CONVB] + (size_t)l * 1280;
    const float* hist = p->in[I_SCONV] + (size_t)(l * 16 + b) * 3 * 1280;
    const float dtb = p->in[I_DTB][l * 16 + h], aneg = -__expf(p->in[I_ALOG][l * 16 + h]), dsk = p->in[I_DSSD][l * 16 + h];
    float* sout = prompt ? p->out + O_SSDP + ((size_t)(l * 32 + b) * 16 + h) * 4096 : p->out + O_SSDS + ((size_t)(l * 16 + b) * 16 + h) * 4096;
    for (int i = tid; i < 5 * 192; i += 512) { const int k = i / 192, ch = i - k * 192; const int col = ch < 64 ? h * 64 + ch : (ch < 128 ? 1024 + g * 64 + (ch - 64) : 1152 + g * 64 + (ch - 128));
        sW[i] = k < 4 ? cw[k * 1280 + col] : cb[col]; }
    f32x4 accS[2];
#pragma unroll
    for (int c2 = 0; c2 < 2; ++c2)
#pragma unroll
        for (int r = 0; r < 4; ++r) { const int pp = rb * 16 + fq * 4 + r, n = chh * 32 + c2 * 16 + fr;
            const float v = prompt ? 0.f : p->in[I_SSSD][((size_t)(l * 16 + b) * 16 + h) * 4096 + pp * 64 + n]; accS[c2][r] = v; Sb[pp * LB + n] = f2bf_(v); }
    const int nch = (T + 63) >> 6;
    { const int wv = tid >> 6, ln = tid & 63; float xv[5];
#pragma unroll
        for (int r = 0; r < 5; ++r) { const int c = wv + 8 * r, t = c * 64 + ln; xv[r] = (c < nch && t < T) ? DT[(size_t)row_of(s, t) * 16 + h] + dtb : -1e30f; }
#pragma unroll
        for (int r = 0; r < 5; ++r) { const int c = wv + 8 * r;
            if (c < nch) { const float x = xv[r]; const float dtv = x < -1e29f ? 0.f : (x > 20.f ? x : log1pf(__expf(x))); float cs = dtv * aneg;
#pragma unroll
                for (int o = 1; o < 64; o <<= 1) { const float nb = __shfl_up(cs, o); if (ln >= o) cs += nb; }
                sdtA[c * 64 + ln] = dtv; sacA[c * 64 + ln] = cs; } } }
    u32x4 pf[4];
#define SSD_ISSUE(cc) do { _Pragma("unroll") for (int it4 = 0; it4 < 4; ++it4) { const int pi = tid + it4 * 512; pf[it4] = (u32x4){0u, 0u, 0u, 0u}; \
        if (pi < 67 * 24) { const int rl = pi / 24, pc = pi - rl * 24, seg = pc >> 3, q8 = pc & 7, tt = (cc) * 64 - 3 + rl; \
            const int col = (seg == 0 ? h * 64 : (seg == 1 ? 1024 + g * 64 : 1152 + g * 64)) + q8 * 8; \
            if (tt >= 0 && tt < T) pf[it4] = *(const u32x4*)(XBC + (size_t)row_of(s, tt) * 1280 + col); } } } while (0)
#define SSD_FRAG(P, r0, ks) (*(const bf16x8*)((P) + ((r0) + fr) * LB + (ks) * 32 + fq * 8))
    SSD_ISSUE(0);
#pragma unroll 1
    for (int c = 0; c < nch; ++c) {
        const int t0 = c * 64; const float* sdt = sdtA + t0; const float* sac = sacA + t0;
        __syncthreads();
#pragma unroll
        for (int it4 = 0; it4 < 4; ++it4) { const int pi = tid + it4 * 512;
            if (pi < 67 * 24) { const int rl = pi / 24, pc = pi - rl * 24, seg = pc >> 3, q8 = pc & 7, tt = t0 - 3 + rl;
                const u32x4 w = pf[it4];
                f32x4 f0 = {lo_f(w[0]), hi_f(w[0]), lo_f(w[1]), hi_f(w[1])}, f1 = {lo_f(w[2]), hi_f(w[2]), lo_f(w[3]), hi_f(w[3])};
                if (tt < 0 && !prompt) { const int col = (seg == 0 ? h * 64 : (seg == 1 ? 1024 + g * 64 : 1152 + g * 64)) + q8 * 8; const float* hp = hist + (3 + tt) * 1280 + col; f0 = *(const f32x4*)hp; f1 = *(const f32x4*)(hp + 4); }
                float* dp = sRaw + rl * 192 + seg * 64 + q8 * 8; *(f32x4*)dp = f0; *(f32x4*)(dp + 4) = f1; } }
        if (tid < 64) sw[tid] = __expf(sac[63] - sac[tid]) * sdt[tid];
        if (c + 1 < nch) SSD_ISSUE(c + 1);
        bf16_t zq[2][4];
#pragma unroll
        for (int c2 = 0; c2 < 2; ++c2)
#pragma unroll
            for (int r = 0; r < 4; ++r) { const int t = t0 + rb * 16 + fq * 4 + r; zq[c2][r] = (t < T) ? Z[(size_t)row_of(s, t) * 1024 + h * 64 + chh * 32 + c2 * 16 + fr] : (bf16_t)0; }
        __syncthreads();
        if (tid < 384) { const int ch = tid % 192, tlb = (tid / 192) * 32, cc = ch & 63;
            const float w0 = sW[ch], w1 = sW[192 + ch], w2 = sW[384 + ch], w3 = sW[576 + ch], bias = sW[768 + ch];
            float r0 = sRaw[(tlb + 0) * 192 + ch], r1 = sRaw[(tlb + 1) * 192 + ch], r2 = sRaw[(tlb + 2) * 192 + ch];
            float ov[32];
#pragma unroll
            for (int i2 = 0; i2 < 32; ++i2) { const float r3 = sRaw[(tlb + i2 + 3) * 192 + ch];
                const float v = bias + w0 * r0 + w1 * r1 + w2 * r2 + w3 * r3; ov[i2] = (t0 + tlb + i2 < T) ? siluf_(v) : 0.f; r0 = r1; r1 = r2; r2 = r3; }
            if (ch < 128) { bf16_t* dst = (ch < 64 ? XT : WB) + cc * LB + tlb;
#pragma unroll
                for (int q4 = 0; q4 < 4; ++q4) { u32x4 w;
#pragma unroll
                    for (int c4 = 0; c4 < 4; ++c4) { const int i2 = q4 * 8 + c4 * 2; const float s0 = ch < 64 ? 1.f : sw[tlb + i2], s1 = ch < 64 ? 1.f : sw[tlb + i2 + 1]; w[c4] = pk2(ov[i2] * s0, ov[i2 + 1] * s1); }
                    *(u32x4*)(dst + q4 * 8) = w; } }
            if (ch >= 64) { bf16_t* dst = (ch < 128 ? Bb : Cb) + tlb * LB + cc;
#pragma unroll
                for (int i2 = 0; i2 < 32; ++i2) dst[i2 * LB] = f2bf_(ov[i2]); } }
        __syncthreads();
        f32x4 acc2[2];
        { const bf16x8 aC0 = SSD_FRAG(Cb, rb * 16, 0), aC1 = SSD_FRAG(Cb, rb * 16, 1);
#pragma unroll
            for (int c2 = 0; c2 < 2; ++c2) { const int j0 = chh * 32 + c2 * 16;
                f32x4 m = {0.f, 0.f, 0.f, 0.f};
                if (j0 <= rb * 16 + 15) { m = __builtin_amdgcn_mfma_f32_16x16x32_bf16(aC0, SSD_FRAG(Bb, j0, 0), m, 0, 0, 0); m = __builtin_amdgcn_mfma_f32_16x16x32_bf16(aC1, SSD_FRAG(Bb, j0, 1), m, 0, 0, 0); }
                const int j = j0 + fr; const float acj = sac[j], dtj = sdt[j];
#pragma unroll
                for (int r = 0; r < 4; ++r) { const int tl = rb * 16 + fq * 4 + r; Mb[tl * LB + j] = f2bf_(j <= tl ? m[r] * __expf(sac[tl] - acj) * dtj : 0.f); }
                f32x4 y = {0.f, 0.f, 0.f, 0.f};
                y = __builtin_amdgcn_mfma_f32_16x16x32_bf16(aC0, SSD_FRAG(Sb, j0, 0), y, 0, 0, 0); y = __builtin_amdgcn_mfma_f32_16x16x32_bf16(aC1, SSD_FRAG(Sb, j0, 1), y, 0, 0, 0);
#pragma unroll
                for (int r = 0; r < 4; ++r) y[r] *= __expf(sac[rb * 16 + fq * 4 + r]);
                acc2[c2] = y; }
            const bf16x8 aX0 = SSD_FRAG(XT, rb * 16, 0), aX1 = SSD_FRAG(XT, rb * 16, 1); const float eL = __expf(sac[63]);
#pragma unroll
            for (int c2 = 0; c2 < 2; ++c2) { const int n0 = chh * 32 + c2 * 16; f32x4 sv = accS[c2] * eL;
                sv = __builtin_amdgcn_mfma_f32_16x16x32_bf16(aX0, SSD_FRAG(WB, n0, 0), sv, 0, 0, 0); sv = __builtin_amdgcn_mfma_f32_16x16x32_bf16(aX1, SSD_FRAG(WB, n0, 1), sv, 0, 0, 0); accS[c2] = sv; } }
        __syncthreads();
        { const bf16x8 aM0 = SSD_FRAG(Mb, rb * 16, 0), aM1 = SSD_FRAG(Mb, rb * 16, 1);
#pragma unroll
            for (int c2 = 0; c2 < 2; ++c2) { const int p0 = chh * 32 + c2 * 16, pp = p0 + fr; f32x4 y = acc2[c2];
                y = __builtin_amdgcn_mfma_f32_16x16x32_bf16(aM0, SSD_FRAG(XT, p0, 0), y, 0, 0, 0); y = __builtin_amdgcn_mfma_f32_16x16x32_bf16(aM1, SSD_FRAG(XT, p0, 1), y, 0, 0, 0);
#pragma unroll
                for (int r = 0; r < 4; ++r) { const int tl = rb * 16 + fq * 4 + r, t = t0 + tl;
                    if (t < T) { bf16_t* zp = Z + (size_t)row_of(s, t) * 1024 + h * 64 + pp; const float yy = (y[r] + dsk * bf2f(XT[pp * LB + tl])) * siluf_(bf2f(zq[c2][r])); *zp = f2bf_(yy); } } }
#pragma unroll
            for (int c2 = 0; c2 < 2; ++c2)
#pragma unroll
                for (int r = 0; r < 4; ++r) Sb[(rb * 16 + fq * 4 + r) * LB + chh * 32 + c2 * 16 + fr] = f2bf_(accS[c2][r]); }
    }
    __syncthreads();
#pragma unroll
    for (int c2 = 0; c2 < 2; ++c2)
#pragma unroll
        for (int r = 0; r < 4; ++r) sout[(rb * 16 + fq * 4 + r) * 64 + chh * 32 + c2 * 16 + fr] = accS[c2][r];
    float* cout_ = prompt ? p->out + O_CONVP + (size_t)(l * 32 + b) * 3 * 1280 : p->out + O_CONVS + (size_t)(l * 16 + b) * 3 * 1280;
    for (int idx = tid; idx < 3 * 192; idx += 512) { const int k = idx / 192, ch = idx - k * 192;
        if (ch >= 64 && (h & 7) != 0) continue;
        const int col = ch < 64 ? h * 64 + ch : (ch < 128 ? 1024 + g * 64 + (ch - 64) : 1152 + g * 64 + (ch - 128));
        cout_[k * 1280 + col] = bf2f(XBC[(size_t)row_of(s, T - 3 + k) * 1280 + col]); }
    __syncthreads();
#undef SSD_ISSUE
#undef SSD_FRAG
}

__device__ __forceinline__ void s5_item(CPar p, int l, int s, int g, float* wl) {
    const int lane = ltid() & 63, fr = lane & 15, fq = lane >> 4;
    const bool prompt = s < 32; const int b = prompt ? s : s - 32, T = prompt ? TP : TS, nblk = T >> 4;
    constexpr int LBX = 136;
    bf16_t* Xb = (bf16_t*)wl;
    bf16_t* U = (bf16_t*)(p->ws + WS_U);
    const int gp = (l * 32 + g) * 64 + lane;
    const float lr = p->in[I_LRE][gp], li = p->in[I_LIM][gp], step = expf(p->in[I_LSTEP][l * 32 + g]);
    float sn, cs; sincos_red((double)li * (double)step, sn, cs);
    const float mag = expf(lr * step), ab_re = mag * cs, ab_im = mag * sn;
    const float den = lr * lr + li * li, nr = ab_re - 1.f, f_re = (nr * lr + ab_im * li) / den, f_im = (ab_im * lr - nr * li) / den;
    float bbr[16], bbi[16];
#pragma unroll
    for (int hh = 0; hh < 16; ++hh) { const float br = p->in[I_BRE][(size_t)gp * 16 + hh], bi = p->in[I_BIM][(size_t)gp * 16 + hh]; bbr[hh] = f_re * br - f_im * bi; bbi[hh] = f_re * bi + f_im * br; }
    bf16x8 cfrag[4];
#pragma unroll
    for (int ks = 0; ks < 4; ++ks) { const int k0 = ks * 32 + fq * 8; const bool im = k0 >= 64;
        const float* cp = (im ? p->in[I_CIM] : p->in[I_CRE]) + ((size_t)(l * 32 + g) * 16 + fr) * 64 + (k0 & 63);
        const f32x4 c0 = *(const f32x4*)cp, c1 = *(const f32x4*)(cp + 4); const float sg = im ? -1.f : 1.f;
        u32x4 w; w[0] = pk2(sg * c0[0], sg * c0[1]); w[1] = pk2(sg * c0[2], sg * c0[3]); w[2] = pk2(sg * c1[0], sg * c1[1]); w[3] = pk2(sg * c1[2], sg * c1[3]);
        cfrag[ks] = __builtin_bit_cast(bf16x8, w); }
    float xr = prompt ? 0.f : p->in[I_S5R][(size_t)(l * 16 + b) * 2048 + g * 64 + lane], xi = prompt ? 0.f : p->in[I_S5I][(size_t)(l * 16 + b) * 2048 + g * 64 + lane];
    const float dsk = p->in[I_DS5][(size_t)(l * 32 + g) * 16 + fr];
    u32x4 ua = {0, 0, 0, 0}, ub = {0, 0, 0, 0};
    { const int r0 = row_of(s, 0); if (lane < 16) { const u32x4* up = (const u32x4*)(U + (size_t)(r0 + lane) * 512 + g * 16); ua = up[0]; ub = up[1]; } }
    for (int blk = 0; blk < nblk; ++blk) {
        const int r0 = row_of(s, blk * 16);
        const u32x4 ca = ua, cbv = ub;
        if (blk + 1 < nblk && lane < 16) { const int r1 = row_of(s, blk * 16 + 16); const u32x4* up = (const u32x4*)(U + (size_t)(r1 + lane) * 512 + g * 16); ua = up[0]; ub = up[1]; }
#pragma unroll
        for (int i = 0; i < 16; ++i) {
            float br4[4] = {0.f, 0.f, 0.f, 0.f}, bi4[4] = {0.f, 0.f, 0.f, 0.f};
#pragma unroll
            for (int w = 0; w < 8; ++w) { const unsigned word = (unsigned)__builtin_amdgcn_readlane((int)(w < 4 ? ca[w] : cbv[w - 4]), i);
                const float u0 = lo_f(word), u1 = hi_f(word);
                br4[w & 3] += bbr[2 * w] * u0 + bbr[2 * w + 1] * u1; bi4[w & 3] += bbi[2 * w] * u0 + bbi[2 * w + 1] * u1; }
            const float bur = (br4[0] + br4[1]) + (br4[2] + br4[3]), bui = (bi4[0] + bi4[1]) + (bi4[2] + bi4[3]);
            const float nxr = ab_re * xr - ab_im * xi + bur, nxi = ab_re * xi + ab_im * xr + bui; xr = nxr; xi = nxi;
            Xb[i * LBX + lane] = f2bf_(xr); Xb[i * LBX + 64 + lane] = f2bf_(xi);
        }
        __builtin_amdgcn_wave_barrier(); asm volatile("s_waitcnt lgkmcnt(0)" ::: "memory");
        f32x4 y = {0.f, 0.f, 0.f, 0.f};
#pragma unroll
        for (int ks = 0; ks < 4; ++ks) y = __builtin_amdgcn_mfma_f32_16x16x32_bf16(*(const bf16x8*)(Xb + fr * LBX + ks * 32 + fq * 8), cfrag[ks], y, 0, 0, 0);
#pragma unroll
        for (int r = 0; r < 4; ++r) { bf16_t* up = U + (size_t)(r0 + fq * 4 + r) * 512 + g * 16 + fr; *up = f2bf_(geluf_(y[r] + dsk * bf2f(*up))); }
        __builtin_amdgcn_wave_barrier(); asm volatile("s_waitcnt lgkmcnt(0)" ::: "memory");
    }
    float* ore = prompt ? p->out + O_S5RP + (size_t)(l * 32 + b) * 2048 : p->out + O_S5RS + (size_t)(l * 16 + b) * 2048;
    float* oim = prompt ? p->out + O_S5IP + (size_t)(l * 32 + b) * 2048 : p->out + O_S5IS + (size_t)(l * 16 + b) * 2048;
    ore[g * 64 + lane] = xr; oim[g * 64 + lane] = xi;
}

typedef __bf16 bf2_t __attribute__((ext_vector_type(2)));
__device__ __forceinline__ float dot2bf(unsigned a, unsigned b, float c) { return __builtin_amdgcn_fdot2_f32_bf16(__builtin_bit_cast(bf2_t, a), __builtin_bit_cast(bf2_t, b), c, false); }
__device__ __forceinline__ void attn_item(CPar p, int l, int item, float* wl) {
    const int lane = ltid() & 63;
    int s, h, qt;
    if (item < 8448) { s = item / 264; const int rem = item - s * 264; h = rem / 33; qt = rem - h * 33; } else { const int it = item - 8448; s = 32 + (it >> 3); h = it & 7; qt = 0; }
    const bool prompt = s < 32; const int b = prompt ? s : s - 32, T = prompt ? TP : TS, nh = prompt ? 0 : PAST;
    const int i = qt * 64 + lane; const bool active = i < T; const int row = row_of(s, active ? i : T - 1);
    bf16_t* Q = (bf16_t*)(p->ws + WS_Q);
    unsigned* Kt = (unsigned*)wl; unsigned* Vp = Kt + 32 * 32;
    unsigned q[32]; float o[64];
    { const u32x4* qp = (const u32x4*)(Q + (size_t)row * 512 + h * 64);
#pragma unroll
        for (int e = 0; e < 8; ++e) { const u32x4 w = qp[e];
#pragma unroll
            for (int j = 0; j < 4; ++j) q[e * 4 + j] = pk2(lo_f(w[j]) * 0.125f, hi_f(w[j]) * 0.125f); } }
#pragma unroll
    for (int d = 0; d < 64; ++d) o[d] = 0.f;
    const float* kp_new = prompt ? p->out + O_KP + (size_t)(l * 32 + b) * 2064 * 512 + h * 64 : p->out + O_KS + (size_t)(l * 16 + b) * 64 * 512 + h * 64;
    const float* vp_new = prompt ? p->out + O_VP + (size_t)(l * 32 + b) * 2064 * 512 + h * 64 : p->out + O_VS + (size_t)(l * 16 + b) * 64 * 512 + h * 64;
    const float* kp_old = p->in[I_CK] + (size_t)(l * 16 + b) * 2048 * 512 + h * 64;
    const float* vp_old = p->in[I_CV] + (size_t)(l * 16 + b) * 2048 * 512 + h * 64;
    const int imax = (qt * 64 + 63 < T - 1) ? qt * 64 + 63 : T - 1;
    const int jtop = nh + imax - 1;
    float run = 0.f;
    f32x4 kreg[8], va[4], vb[4];
#define ATT_FETCH(JT) do { _Pragma("unroll") for (int e = 0; e < 8; ++e) { const int idx = e * 64 + lane, kr = idx >> 4, pc = idx & 15, j = (JT) - kr; kreg[e] = (f32x4){0.f, 0.f, 0.f, 0.f}; \
            if (j >= 0) { const float* kp = (j < nh) ? kp_old + (size_t)j * 512 : kp_new + (size_t)(j - nh) * 512; kreg[e] = *(const f32x4*)(kp + pc * 4); } } \
        _Pragma("unroll") for (int e = 0; e < 4; ++e) { const int idx = e * 64 + lane, m = idx >> 4, pc = idx & 15, j0 = (JT) - 2 * m, j1 = j0 - 1; va[e] = (f32x4){0.f, 0.f, 0.f, 0.f}; vb[e] = (f32x4){0.f, 0.f, 0.f, 0.f}; \
            if (j0 >= 0) { const float* vp = (j0 < nh) ? vp_old + (size_t)j0 * 512 : vp_new + (size_t)(j0 - nh) * 512; va[e] = *(const f32x4*)(vp + pc * 4); } \
            if (j1 >= 0) { const float* vp = (j1 < nh) ? vp_old + (size_t)j1 * 512 : vp_new + (size_t)(j1 - nh) * 512; vb[e] = *(const f32x4*)(vp + pc * 4); } } } while (0)
    if (jtop >= 0) ATT_FETCH(jtop);
    for (int jt = jtop; jt >= 0; jt -= 32) {
#pragma unroll
        for (int e = 0; e < 8; ++e) { const int idx = e * 64 + lane, kr = idx >> 4, pc = idx & 15; u32x2 w; w[0] = pk2(kreg[e][0], kreg[e][1]); w[1] = pk2(kreg[e][2], kreg[e][3]); *(u32x2*)(Kt + kr * 32 + pc * 2) = w; }
#pragma unroll
        for (int e = 0; e < 4; ++e) { const int idx = e * 64 + lane, m = idx >> 4, pc = idx & 15;
            u32x4 w; w[0] = pk2(va[e][0], vb[e][0]); w[1] = pk2(va[e][1], vb[e][1]); w[2] = pk2(va[e][2], vb[e][2]); w[3] = pk2(va[e][3], vb[e][3]); *(u32x4*)(Vp + m * 64 + pc * 4) = w; }
        __builtin_amdgcn_wave_barrier(); asm volatile("s_waitcnt lgkmcnt(0)" ::: "memory");
        if (jt - 32 >= 0) ATT_FETCH(jt - 32);
        const int nk = jt + 1 < 32 ? jt + 1 : 32, npair = (nk + 1) >> 1;
        for (int m = 0; m < npair; ++m) { const int j0 = jt - 2 * m, j1 = j0 - 1;
            float z0 = 0.f, z1 = 0.f;
#pragma unroll
            for (int d8 = 0; d8 < 8; ++d8) { const u32x4 k0 = *(const u32x4*)(Kt + (2 * m) * 32 + d8 * 4), k1 = *(const u32x4*)(Kt + (2 * m + 1) * 32 + d8 * 4);
#pragma unroll
                for (int c = 0; c < 4; ++c) { z0 = dot2bf(q[d8 * 4 + c], k0[c], z0); z1 = dot2bf(q[d8 * 4 + c], k1[c], z1); } }
            const bool v0 = active && (j0 < nh + i), v1 = active && (j1 >= 0) && (j1 < nh + i);
            const float e0 = __expf(-z0), ls0 = -__logf(1.f + e0);
            const float w0 = v0 ? __expf(ls0 + run) : 0.f; run += v0 ? (ls0 - z0) : 0.f;
            const float e1 = __expf(-z1), ls1 = -__logf(1.f + e1);
            const float w1 = v1 ? __expf(ls1 + run) : 0.f; run += v1 ? (ls1 - z1) : 0.f;
            const unsigned wp = pk2(w0, w1);
#pragma unroll
            for (int d4 = 0; d4 < 16; ++d4) { const u32x4 vv = *(const u32x4*)(Vp + m * 64 + d4 * 4);
#pragma unroll
                for (int c = 0; c < 4; ++c) o[d4 * 4 + c] = dot2bf(wp, vv[c], o[d4 * 4 + c]); } }
        __builtin_amdgcn_wave_barrier(); asm volatile("s_waitcnt lgkmcnt(0)" ::: "memory");
        const int fin = (!active) || (run < -50.f);
        if (__all(fin)) break;
    }
#undef ATT_FETCH
    if (active) { u32x4* op = (u32x4*)(Q + (size_t)row * 512 + h * 64);
#pragma unroll
        for (int e = 0; e < 8; ++e) { u32x4 w; w[0] = pk2(o[e * 8], o[e * 8 + 1]); w[1] = pk2(o[e * 8 + 2], o[e * 8 + 3]); w[2] = pk2(o[e * 8 + 4], o[e * 8 + 5]); w[3] = pk2(o[e * 8 + 6], o[e * 8 + 7]); op[e] = w; } }
}

__device__ __forceinline__ void phase_mixers(CPar p, int l, float* sm) {
#ifndef SKIP_SSD
    { CPar p1 = params_ptr();
#pragma unroll 1
      for (int it = lbid(); it < 768; it += lgdim()) ssd_item(p1, l, it, sm); }
#endif
    __syncthreads();
    const int wave = __builtin_amdgcn_readfirstlane(ltid() >> 6);
    float* wl = sm + wave * (68 * 64);
#ifndef SKIP_S5
    { CPar p2 = params_ptr();
    if (wave < 4) { for (int it = lbid() * 4 + wave; it < 1024; it += lgdim() * 4) s5_item(p2, l, it >> 5, it & 31, wl); }
    else if (wave < 6) { for (int it = lbid() * 2 + (wave - 4); it < 512; it += lgdim() * 2) s5_item(p2, l, 32 + (it >> 5), it & 31, wl); } }
#endif
#ifndef SKIP_ATT
    CPar p3 = params_ptr();
    unsigned* ctr = (unsigned*)(p3->ws + WS_CTR) + l;
    for (;;) {
        unsigned it = 0; if ((ltid() & 63) == 0) it = atomicAdd(ctr, 1u);
        it = (unsigned)__builtin_amdgcn_readfirstlane((int)it);
        if (it >= 8576u) break;
        attn_item(p3, l, (int)it, wl);
    }
#endif
}

#define XB_TMO      128
#define XB_XCNT(j)  (256  + 64 * (j))
#define XB_XSUB(j)  (1280 + 64 * (j))
#define XB_XGEN(j)  (2304 + 64 * (j))
#define XB_TOP      3328
#define XB_TOPGEN   3392
#define XCD_BAR_WORDS 3456
#define XB_SPIN_CAP (1u << 18)

__device__ __forceinline__ unsigned xb_ld(unsigned* p)              { return __hip_atomic_load(p, __ATOMIC_RELAXED, __HIP_MEMORY_SCOPE_AGENT); }
__device__ __forceinline__ unsigned xb_add(unsigned* p, unsigned v) { return __hip_atomic_fetch_add(p, v, __ATOMIC_RELAXED, __HIP_MEMORY_SCOPE_AGENT); }
__device__ __forceinline__ unsigned xb_xcc_id() { return (unsigned)__builtin_amdgcn_s_getreg((3 << 11) | 20) & 0xFu; }
#define XB_SPIN(cond, bar) do { unsigned _sp = 0; while (cond) { __builtin_amdgcn_s_sleep(1); \
    if ((++_sp & 255u) == 0u) { if (xb_ld(&(bar)[XB_TMO])) break; if (_sp > XB_SPIN_CAP) { atomicAdd(&(bar)[XB_TMO], 1u); break; } } } } while (0)

struct XcdBarrier {
    unsigned* bar; unsigned x;
    volatile LAS unsigned* st;
};

__device__ __forceinline__ XcdBarrier xcd_barrier_post(unsigned* bar, volatile LAS unsigned* st) {
    XcdBarrier b; b.bar = bar; b.x = xb_xcc_id(); b.st = st;
    if (threadIdx.x == 0) (void)xb_add(&bar[XB_XCNT(b.x)], 1u);
    return b;
}
__device__ __forceinline__ void xcd_barrier_complete(unsigned* bar, unsigned x, unsigned& nloc, unsigned& nx) {
    const unsigned G = gridDim.x * gridDim.y * gridDim.z;
    unsigned sum, cnt, mine, sp = 0u;
    for (;;) {
        sum = 0u; cnt = 0u; mine = 0u;
#pragma unroll
        for (unsigned j = 0; j < 16; ++j) { const unsigned c = xb_ld(&bar[XB_XCNT(j)]); sum += c; cnt += (c > 0u) ? 1u : 0u; mine = (j == x) ? c : mine; }
        if (sum == G) break;
        __builtin_amdgcn_s_sleep(1);
        if ((++sp & 255u) == 0u) { if (xb_ld(&bar[XB_TMO])) break; if (sp > XB_SPIN_CAP) { atomicAdd(&bar[XB_TMO], 1u); break; } }
    }
    nloc = mine > 0u ? mine : 1u; nx = cnt > 0u ? cnt : 1u;
}

__device__ __forceinline__ void xcd_barrier(const XcdBarrier& b) {
    asm volatile("s_waitcnt vmcnt(0)" ::: "memory");
    __syncthreads();
    if (threadIdx.x == 0) {
        unsigned* bar = b.bar;
        __builtin_amdgcn_s_waitcnt(0);
        unsigned nloc = b.st[0], nx = b.st[1];
        if (nloc == 0u) { xcd_barrier_complete(bar, b.x, nloc, nx); b.st[0] = nloc; b.st[1] = nx; }
        const unsigned old = xb_add(&bar[XB_XSUB(b.x)], 1u);
        const unsigned gen = old / nloc;
        if (old + 1u == (gen + 1u) * nloc) {
            __builtin_amdgcn_fence(__ATOMIC_RELEASE, "agent");
            asm volatile("s_waitcnt vmcnt(0)" ::: "memory");
            const unsigned og = xb_add(&bar[XB_TOP], 1u);
            const unsigned tg = og / nx;
            if (og + 1u == (tg + 1u) * nx) xb_add(&bar[XB_TOPGEN], 1u);
            else XB_SPIN(xb_ld(&bar[XB_TOPGEN]) == tg, bar);
            __builtin_amdgcn_fence(__ATOMIC_ACQUIRE, "agent");
            xb_add(&bar[XB_XGEN(b.x)], 1u);
            asm volatile("s_waitcnt vmcnt(0)" ::: "memory");
        } else {
            XB_SPIN(xb_ld(&bar[XB_XGEN(b.x)]) == gen, bar);
            __builtin_amdgcn_fence(__ATOMIC_ACQUIRE, "agent");
            asm volatile("s_waitcnt vmcnt(0)" ::: "memory");
        }
    }
    __syncthreads();
}
__global__ __launch_bounds__(512, 2) void mega(Params pk) {
    extern __shared__ __attribute__((aligned(16))) unsigned char smem[];
    cg::grid_group grid = cg::this_grid();
    LAS unsigned char* lds = (LAS unsigned char*)smem;
    const int ph_lo = pk.ph_lo, ph_hi = pk.ph_hi;
    volatile LAS unsigned* xst = (volatile LAS unsigned*)(lds + (LDS_BYTES - 16));
    if (threadIdx.x == 0) { xst[0] = 0u; xst[1] = 0u; }
    const XcdBarrier xb = xcd_barrier_post((unsigned*)(pk.ws + WS_SSQ), xst);
    for (int ph = ph_lo; ph < ph_hi; ++ph) {
        if (ph == ph_lo + 1) grid.sync();
        else if (ph > ph_lo + 1) xcd_barrier(xb);
        CPar p = params_ptr();
        unsigned char* ws = p->ws;
        bf16_t *HB = (bf16_t*)(ws + WS_HB), *Z = (bf16_t*)(ws + WS_Z), *XBC = (bf16_t*)(ws + WS_XBC), *U = (bf16_t*)(ws + WS_U), *Q = (bf16_t*)(ws + WS_Q), *G = (bf16_t*)(ws + WS_G);
        float *DT = (float*)(ws + WS_DT), *XM = (float*)(ws + WS_XMETA);
        const int l = ph >> 3, sub = ph & 7;
        pg8::StaticOrder S;
        if (sub == 0) {
#ifndef SKIP0
            phase_prep(p, l);
#endif
        } else if (sub == 1) {
            S.init(NROWS, N1, lgdim(), lbid());
            EpiIn E{Z, XBC, U, Q, G, DT, p->out, p->in[I_QN] + l * 64, p->in[I_KN] + l * 64, l};
#ifndef SKIP1
            pg8::gemm_phase(lds, pg8::Gemm{HB, (const bf16_t*)(ws + W_BT1), NROWS, N1, 1024, 1024, 1024}, S, E);
#endif
        } else if (sub == 2) {
#ifndef SKIP2
            phase_mixers(p, l, (float*)smem);
#endif
        } else if (sub == 3) {
            ssd_norm_rows(p);
            S.init(NROWS, 2048, lgdim(), lbid());
            EpiGlu E{XBC};
            pg8::gemm_phase(lds, pg8::Gemm{U, (const bf16_t*)(ws + W_GLU), NROWS, 2048, 512, 512, 512}, S, E);
        } else if (sub == 4) {
            S.init(NROWS, 1024, lgdim(), lbid());
            for (int call = 0; call < 2; ++call) {
                EpiMix E; pg8::Gemm g;
                if (call == 0) { E = EpiMix{HB, G, XBC, 0}; g = pg8::Gemm{Z, (const bf16_t*)(ws + W_LA), NROWS, 1024, 1024, 1024, 1024}; }
                else { E = EpiMix{HB, G + 2048, nullptr, 1}; g = pg8::Gemm{Q, (const bf16_t*)(ws + W_LC), NROWS, 1024, 512, 512, 512}; }
#ifndef SKIP3
                pg8::gemm_phase(lds, g, S, E);
#endif
            }
        } else if (sub == 5) {
            S.init(NROWS, 1024, lgdim(), lbid());
            EpiRes E{p->out, XM, (bf16_t*)(ws + WS_XB2), (float*)(ws + WS_SSQX) + (size_t)l * NROWS};
            pg8::gemm_phase(lds, pg8::Gemm{HB, (const bf16_t*)(ws + W_OUT), NROWS, 1024, 1024, 1024, 1024}, S, E);
        } else if (sub == 6) {
            S.init(NROWS, 4096, lgdim(), lbid());
            EpiUp E{(bf16_t*)(ws + WS_ACT), (const float*)(ws + WS_SSQX) + (size_t)l * NROWS};
            pg8::gemm_phase(lds, pg8::Gemm{(const bf16_t*)(ws + WS_XB2), (const bf16_t*)(ws + W_UP), NROWS, 4096, 1024, 1024, 1024}, S, E);
        } else {
            S.init(NROWS, 1024, lgdim(), lbid());
            EpiRes E{p->out, XM, nullptr, nullptr};
            pg8::gemm_phase(lds, pg8::Gemm{(const bf16_t*)(ws + WS_ACT), (const bf16_t*)(ws + W_DOWN), NROWS, 1024, 4096, 4096, 4096}, S, E);
        }
    }
}

extern "C" void kernel_launch(void* const* d_in, const int* in_sizes, int n_in, void* d_out, int out_size, void* d_ws, size_t ws_size, hipStream_t stream) {
    static int grid = 0;
    if (grid == 0) {
        if (n_in != 34 || (size_t)out_size != O_END || ws_size < WS_END) { fprintf(stderr, "kernel_launch: unexpected shapes n_in %d out %d ws %zu (need %zu)\n", n_in, out_size, ws_size, (size_t)WS_END); grid = -1; return; }
        int dev = 0, cus = 0, per_cu = 0;
        hipGetDevice(&dev); hipDeviceGetAttribute(&cus, hipDeviceAttributeMultiprocessorCount, dev);
        if (hipFuncSetAttribute((const void*)mega, hipFuncAttributeMaxDynamicSharedMemorySize, LDS_BYTES) != hipSuccess) { fprintf(stderr, "kernel_launch: hipFuncSetAttribute failed\n"); grid = -1; return; }
        if (hipOccupancyMaxActiveBlocksPerMultiprocessor(&per_cu, (const void*)mega, 512, LDS_BYTES) != hipSuccess || per_cu < 1) { fprintf(stderr, "kernel_launch: occupancy query says %d\n", per_cu); per_cu = 1; }
        (void)hipGetLastError();
        grid = cus * per_cu;
    }
    if (grid < 0) return;
    if (hipMemsetAsync((char*)d_ws + WS_CTR, 0, 4096, stream) != hipSuccess || hipMemsetAsync((char*)d_ws + WS_SSQ, 0, 16384 + 2ull * NROWS * 4, stream) != hipSuccess) { fprintf(stderr, "kernel_launch: memset failed\n"); return; }
    Params p{};
    for (int i = 0; i < 34; ++i) p.in[i] = (const float*)d_in[i];
    p.out = (float*)d_out; p.ws = (unsigned char*)d_ws;
#if MULTI_LAUNCH
    for (int ph = 0; ph < 16; ++ph) { p.ph_lo = ph; p.ph_hi = ph + 1; hipLaunchKernelGGL(mega, dim3(grid), dim3(512), LDS_BYTES, stream, p); }
#else
    p.ph_lo = 0; p.ph_hi = 16;
    void* args[] = {&p};
    hipError_t e = hipLaunchCooperativeKernel((const void*)mega, dim3(grid), dim3(512), args, LDS_BYTES, stream);
    if (e != hipSuccess) fprintf(stderr, "cooperative launch failed: %s (grid %d)\n", hipGetErrorString(e), grid);
#endif
}
```

```cpp
#include <hip/hip_runtime.h>
#include <hip/hip_cooperative_groups.h>
#include <cstdio>
#include <cstdint>
namespace cg = cooperative_groups;

#ifndef MULTI_LAUNCH
#define MULTI_LAUNCH 0
#endif

typedef unsigned short bf16_t;
typedef short bf16x8 __attribute__((ext_vector_type(8)));
typedef float f32x4 __attribute__((ext_vector_type(4)));
typedef unsigned u32x4 __attribute__((ext_vector_type(4)));
typedef unsigned u32x2 __attribute__((ext_vector_type(2)));
#define LAS __attribute__((address_space(3)))

constexpr int D = 1024, NROWS = 67072, NS0 = 65536, NM0 = 66560;
constexpr int TP = 2064, TS = 64, NB_P = 32, NB_S = 16, PAST = 2048;
constexpr int IN_COLS = 7440, N1 = 7680;
constexpr int SSQ_SLOTS = NM0 + 32 * 32;
constexpr float EPS = 1e-6f;
constexpr size_t O_YP = 0, O_YS = 67108864ull, O_KP = O_YS + 1048576ull, SZ_KP = 2ull * 32 * 2064 * 512, O_VP = O_KP + SZ_KP,
                 O_CONVP = O_VP + SZ_KP, O_SSDP = O_CONVP + 2ull * 32 * 3 * 1280, O_S5RP = O_SSDP + 2ull * 32 * 16 * 4096, O_S5IP = O_S5RP + 2ull * 32 * 2048,
                 O_KS = O_S5IP + 2ull * 32 * 2048, O_VS = O_KS + 2ull * 16 * 64 * 512, O_CONVS = O_VS + 2ull * 16 * 64 * 512, O_SSDS = O_CONVS + 2ull * 16 * 3 * 1280,
                 O_S5RS = O_SSDS + 2ull * 16 * 16 * 4096, O_S5IS = O_S5RS + 2ull * 16 * 2048, O_END = O_S5IS + 2ull * 16 * 2048;
constexpr size_t W_BT1 = 0, W_GLU = W_BT1 + (size_t)N1 * 1024 * 2, W_LA = W_GLU + 2048ull * 512 * 2, W_LC = W_LA + 1024ull * 1024 * 2, W_OUT = W_LC + 1024ull * 512 * 2,
                 W_UP = W_OUT + 1024ull * 1024 * 2, W_DOWN = W_UP + 4096ull * 1024 * 2, W_END = W_DOWN + 4096ull * 1024 * 2;
constexpr size_t WS_CTR = W_END, WS_XMETA = WS_CTR + 4096, WS_HB = WS_XMETA + 512ull * 1024 * 4, WS_Z = WS_HB + (size_t)NROWS * 1024 * 2, WS_XBC = WS_Z + (size_t)NROWS * 1024 * 2,
                 WS_U = WS_XBC + (size_t)NROWS * 1280 * 2, WS_Q = WS_U + (size_t)NROWS * 512 * 2, WS_G = WS_Q + (size_t)NROWS * 512 * 2, WS_DT = WS_G + (size_t)NROWS * 3072 * 2,
                 WS_SSQ = WS_DT + (size_t)NROWS * 16 * 4, WS_END = WS_SSQ + (size_t)SSQ_SLOTS * 16 * 4;
constexpr size_t WS_XB2 = WS_DT - (size_t)NROWS * 1024 * 2;
constexpr size_t WS_SSQX = WS_SSQ + 16384;
constexpr size_t WS_ACT = WS_Z;
static_assert(WS_ACT + (size_t)NROWS * 4096 * 2 <= WS_XB2, "ACT overlay");
static_assert(WS_SSQX + 2ull * NROWS * 4 <= WS_END, "ssqx");
constexpr int LDS_BYTES = 147456;

struct Params {
    const float* in[34];
    float* out;
    unsigned char* ws;
    int ph_lo, ph_hi;
};
typedef const __attribute__((address_space(4))) Params* CPar;
__device__ __forceinline__ CPar params_ptr() { CPar q = (CPar)__builtin_amdgcn_kernarg_segment_ptr(); asm volatile("" : "+s"(q)); return q; }
#define PIN(i) (p->in[i])
enum { I_XP = 0, I_XS, I_CK, I_CV, I_SCONV, I_SSSD, I_S5R, I_S5I, I_META, I_NMIX, I_WIN, I_CONVW, I_CONVB, I_DTB, I_ALOG, I_DSSD, I_NSSD, I_LRE, I_LIM, I_LSTEP, I_BRE, I_BIM,
       I_CRE, I_CIM, I_DS5, I_WGLU, I_QN, I_KN, I_WLA, I_WLC, I_WOUT, I_NFFN, I_WUP, I_WDOWN };

__device__ __forceinline__ int ltid() { int t = threadIdx.x; asm volatile("" : "+v"(t)); return t; }
__device__ __forceinline__ int lbid() { int t = blockIdx.x; asm volatile("" : "+s"(t)); return t; }
__device__ __forceinline__ int lgdim() { int t = gridDim.x; asm volatile("" : "+s"(t)); return t; }

__device__ __forceinline__ float bf2f(bf16_t v) { return __uint_as_float((unsigned)v << 16); }
__device__ __forceinline__ unsigned pk2(float lo, float hi) { unsigned r; asm volatile("v_cvt_pk_bf16_f32 %0, %1, %2" : "=v"(r) : "v"(lo), "v"(hi)); return r; }
__device__ __forceinline__ float lo_f(unsigned w) { return __uint_as_float(w << 16); }
__device__ __forceinline__ float hi_f(unsigned w) { return __uint_as_float(w & 0xffff0000u); }
__device__ __forceinline__ u32x2 ld_l2_u32x2(const void* ptr) { const unsigned long long v = __hip_atomic_load((const unsigned long long*)ptr, __ATOMIC_RELAXED, __HIP_MEMORY_SCOPE_AGENT); u32x2 r; r[0] = (unsigned)v; r[1] = (unsigned)(v >> 32); return r; }
__device__ __forceinline__ float sigmoidf_(float v) { return __builtin_amdgcn_rcpf(1.f + __expf(-v)); }
__device__ __forceinline__ float siluf_(float v) { return v * sigmoidf_(v); }
__device__ __forceinline__ float geluf_(float y) { const float a = 0.7978845608f * (y + 0.044715f * y * y * y); const float t = __expf(2.f * a); return 0.5f * y * (2.f - 2.f * __builtin_amdgcn_rcpf(t + 1.f)); }
__device__ __forceinline__ float wave_sum(float v) {
#pragma unroll
    for (int o = 1; o < 64; o <<= 1) v += __shfl_xor(v, o);
    return v;
}
__device__ __forceinline__ void sincos_red(double x, float& sn, float& cs) {
    const double k = __builtin_rint(x * 0.63661977236758134308);
    const float r = (float)__builtin_fma(-k, 1.57079632679489661923, x), r2 = r * r;
    const float sp = r + r * r2 * (-1.6666667163e-01f + r2 * (8.3333337680e-03f + r2 * (-1.9841270114e-04f + r2 * 2.7557314297e-06f)));
    const float cp = 1.f + r2 * (-0.5f + r2 * (4.1666667908e-02f + r2 * (-1.3888889225e-03f + r2 * (2.4801587642e-05f - r2 * 2.7557314297e-07f))));
    const int q = ((int)k) & 3;
    sn = (q == 0) ? sp : (q == 1) ? cp : (q == 2) ? -sp : -cp;
    cs = (q == 0) ? cp : (q == 1) ? -sp : (q == 2) ? -cp : sp;
}
__device__ __forceinline__ int row_of(int s, int t) { return s < 32 ? (t < 16 ? NM0 + s * 16 + t : s * 2048 + t - 16) : NS0 + (s - 32) * 64 + t; }
__device__ __forceinline__ int ssq_slot(int r) { return r < NM0 ? r : NM0 + ((r - NM0) >> 4) * 32 + ((r - NM0) & 15); }
__device__ __forceinline__ float* xloc(CPar p, int r) { return r < NM0 ? p->out + (size_t)r * 1024 : (float*)(p->ws + WS_XMETA) + (size_t)(r - NM0) * 1024; }
__device__ __forceinline__ size_t k_off(int l, int r) {
    if (r < NS0) return O_KP + ((size_t)(l * 32 + (r >> 11)) * 2064 + 16 + (r & 2047)) * 512;
    if (r < NM0) { const int rs = r - NS0; return O_KS + ((size_t)(l * 16 + (rs >> 6)) * 64 + (rs & 63)) * 512; }
    const int rm = r - NM0; return O_KP + ((size_t)(l * 32 + (rm >> 4)) * 2064 + (rm & 15)) * 512;
}

namespace pg8 {
constexpr int BM = 256, BK = 64, HALF = 128, HTB = HALF * BK * 2, STAGE_BYTES = 8 * HTB, NXCD = 8, WGM = 8;
__host__ __device__ __forceinline__ int lds_byte(int r, int c) { const int st = (r >> 4) * 2 + (c >> 5), rr = r & 15, cc = c & 31, ob = rr * 64 + cc * 2; return st * 1024 + (ob ^ (((ob >> 9) & 1) << 5)); }
__host__ __device__ __forceinline__ void stage_rc(int b, int& R, int& C) { const int st = b / 1024, sb = b % 1024, swz = sb ^ (((sb >> 9) & 1) << 5); R = (st >> 1) * 16 + swz / 64; C = (st & 1) * 32 + (swz % 64) / 2; }
struct Unit { int pm, pn; };
struct Gemm { const bf16_t* A; const bf16_t* Bt; int M, N, K, lda, ldb; };
struct StaticOrder {
    int nM, nN, nwg, G, c;
    __device__ void init(int M, int N, int G_, int c_) { nM = M / BM; nN = N / BM; nwg = nM * nN; G = G_; c = c_; }
    __device__ bool next(int i, Unit& u) const {
        const long L = (long)i * G + c; if (L >= nwg) return false;
        int wgid = (int)L; { const int q = nwg / NXCD, r = nwg % NXCD, xcd = wgid % NXCD, off = wgid / NXCD; wgid = (xcd < r ? xcd * (q + 1) : r * (q + 1) + (xcd - r) * q) + off; }
        const int nig = WGM * nN, gid = wgid / nig, fm = gid * WGM, gsz = (nM - fm) < WGM ? (nM - fm) : WGM;
        u.pm = fm + ((wgid % nig) % gsz); u.pn = (wgid % nig) / gsz; return true;
    }
};
template <class Epi>
__device__ __forceinline__ void gemm_phase(LAS unsigned char* lds, const Gemm g, const StaticOrder& S, const Epi& E) {
    const int tid = ltid(), wid = __builtin_amdgcn_readfirstlane(tid >> 6), lane = tid & 63, wr = wid >> 2, wc = wid & 3, fr = lane & 15, fq = lane >> 4;
    const int K = g.K, nt = K / BK;
    unsigned voffA[2], voffB[2];
#pragma unroll
    for (int i = 0; i < 2; ++i) { int R, C; stage_rc(tid * 16 + i * 8192, R, C); voffA[i] = (unsigned)(R * g.lda + C) * 2u; voffB[i] = (unsigned)(R * g.ldb + C) * 2u; }
    const size_t kstep = (size_t)(BK * 2);
    const size_t hstepA = (size_t)HALF * g.lda * 2, hstepB = (size_t)HALF * g.ldb * 2;
    const size_t tstepA = 2 * hstepA, tstepB = 2 * hstepB;
    const unsigned ldsw = (unsigned)wid * 1024u;
    const int aoff = lds_byte(wr * 64 + fr, fq * 8), boff = lds_byte(wc * 32 + fr, fq * 8);
#define PG8_SA(b, h) (((b) * 2 + (h)) * HTB)
#define PG8_SB(b, h) ((4 + (b) * 2 + (h)) * HTB)
#define PG8_STAGE(bufoff, gbase, voff) do { _Pragma("unroll") for (int _i = 0; _i < 2; ++_i) \
        __builtin_amdgcn_global_load_lds((const unsigned*)((const char*)(gbase) + (voff)[_i]), (LAS unsigned*)(lds + (bufoff) + ldsw + _i * 8192), 16, 0, 0); } while (0)
#define PG8_LDA(dst, b, h) do { _Pragma("unroll") for (int m = 0; m < 4; ++m) _Pragma("unroll") for (int k = 0; k < 2; ++k) dst[m][k] = *(const LAS bf16x8*)(lds + PG8_SA(b, h) + aoff + m * 2048 + k * 1024); } while (0)
#define PG8_LDB(dst, b, h) do { _Pragma("unroll") for (int n = 0; n < 2; ++n) _Pragma("unroll") for (int k = 0; k < 2; ++k) dst[n][k] = *(const LAS bf16x8*)(lds + PG8_SB(b, h) + boff + n * 2048 + k * 1024); } while (0)
#define PG8_MMA(ai, bj, At, Bt) do { __builtin_amdgcn_s_setprio(1); _Pragma("unroll") for (int m = 0; m < 4; ++m) _Pragma("unroll") for (int n = 0; n < 2; ++n) _Pragma("unroll") for (int k = 0; k < 2; ++k) \
        acc[ai][bj][m][n] = __builtin_amdgcn_mfma_f32_16x16x32_bf16(Bt[n][k], At[m][k], acc[ai][bj][m][n], 0, 0, 0); __builtin_amdgcn_s_setprio(0); } while (0)
#define PG8_WAIT_V(n) asm volatile("s_waitcnt vmcnt(" #n ")" ::: "memory")
#define PG8_WAIT_L(n) asm volatile("s_waitcnt lgkmcnt(" #n ")" ::: "memory")
#define PG8_BAR __builtin_amdgcn_s_barrier()
#define PG8_SCHED __builtin_amdgcn_sched_barrier(0)
    Unit cur, nxt; int ui = 0;
    if (!S.next(0, cur)) return;
    f32x4 acc[2][2][4][2];
#pragma unroll
    for (int a = 0; a < 2; ++a)
#pragma unroll
        for (int b = 0; b < 2; ++b)
#pragma unroll
            for (int m = 0; m < 4; ++m)
#pragma unroll
                for (int n = 0; n < 2; ++n) acc[a][b][m][n] = (f32x4){0.f, 0.f, 0.f, 0.f};
    bf16x8 At[4][2], B0[2][2], B1[2][2];
    const char* cA = (const char*)g.A + (size_t)cur.pm * tstepA; const char* cB = (const char*)g.Bt + (size_t)cur.pn * tstepB;
    PG8_STAGE(PG8_SB(0, 0), cB, voffB); PG8_STAGE(PG8_SA(0, 0), cA, voffA); PG8_STAGE(PG8_SB(0, 1), cB + hstepB, voffB); PG8_STAGE(PG8_SA(0, 1), cA + hstepA, voffA);
    if (wr == 1) PG8_BAR;
    PG8_WAIT_V(4); PG8_BAR;
    PG8_STAGE(PG8_SB(1, 0), cB + kstep, voffB); PG8_STAGE(PG8_SA(1, 0), cA + kstep, voffA); PG8_STAGE(PG8_SB(1, 1), cB + hstepB + kstep, voffB);
    PG8_WAIT_V(6); PG8_BAR;
    for (;;) {
        const bool has_next = S.next(ui + 1, nxt);
        const char* nA = has_next ? (const char*)g.A + (size_t)nxt.pm * tstepA : cA; const char* nB = has_next ? (const char*)g.Bt + (size_t)nxt.pn * tstepB : cB;
        for (int t = 0; t < nt; t += 2) {
            const bool last = (t == nt - 2);
            const char* a1 = cA + (size_t)(t + 1) * kstep;
            const char* a2 = last ? nA : cA + (size_t)(t + 2) * kstep; const char* b2 = last ? nB : cB + (size_t)(t + 2) * kstep;
            const char* a3 = a2 + kstep; const char* b3 = b2 + kstep;
            PG8_LDB(B0, 0, 0); PG8_SCHED; PG8_LDA(At, 0, 0); PG8_STAGE(PG8_SA(1, 1), a1 + hstepA, voffA);
            PG8_WAIT_L(8); PG8_BAR; PG8_WAIT_L(0); PG8_MMA(0, 0, At, B0); PG8_BAR; PG8_SCHED;
            PG8_LDB(B1, 0, 1); PG8_STAGE(PG8_SB(0, 0), b2, voffB);
            PG8_BAR; PG8_WAIT_L(0); PG8_MMA(0, 1, At, B1); PG8_BAR;
            PG8_LDA(At, 0, 1); PG8_STAGE(PG8_SA(0, 0), a2, voffA);
            PG8_BAR; PG8_WAIT_L(0); PG8_MMA(1, 0, At, B0); PG8_BAR; PG8_SCHED;
            PG8_STAGE(PG8_SB(0, 1), b2 + hstepB, voffB);
            PG8_WAIT_V(6); PG8_BAR; PG8_MMA(1, 1, At, B1); PG8_BAR;
            PG8_LDB(B0, 1, 0); PG8_SCHED; PG8_LDA(At, 1, 0); PG8_STAGE(PG8_SA(0, 1), a2 + hstepA, voffA);
            PG8_WAIT_L(8); PG8_BAR; PG8_WAIT_L(0); PG8_MMA(0, 0, At, B0); PG8_BAR; PG8_SCHED;
            PG8_LDB(B1, 1, 1); PG8_STAGE(PG8_SB(1, 0), b3, voffB);
            PG8_BAR; PG8_WAIT_L(0); PG8_MMA(0, 1, At, B1); PG8_BAR;
            PG8_LDA(At, 1, 1); PG8_STAGE(PG8_SA(1, 0), a3, voffA);
            PG8_BAR; PG8_WAIT_L(0); PG8_MMA(1, 0, At, B0); PG8_BAR; PG8_SCHED;
            PG8_STAGE(PG8_SB(1, 1), b3 + hstepB, voffB);
            PG8_WAIT_V(6); PG8_BAR; PG8_MMA(1, 1, At, B1); PG8_BAR;
        }
        E(acc, cur, wr, wc, fr, fq);
        if (!has_next) break;
#pragma unroll
        for (int a = 0; a < 2; ++a)
#pragma unroll
            for (int b = 0; b < 2; ++b)
#pragma unroll
                for (int m = 0; m < 4; ++m)
#pragma unroll
                    for (int n = 0; n < 2; ++n) acc[a][b][m][n] = (f32x4){0.f, 0.f, 0.f, 0.f};
        cur = nxt; cA = nA; cB = nB; ++ui;
    }
    PG8_WAIT_V(0);
    if (wr == 0) PG8_BAR;
    PG8_BAR;
#undef PG8_SA
#undef PG8_SB
#undef PG8_STAGE
#undef PG8_LDA
#undef PG8_LDB
#undef PG8_MMA
#undef PG8_WAIT_V
#undef PG8_WAIT_L
#undef PG8_BAR
#undef PG8_SCHED
}
}
using pg8::Unit;

struct EpiIn {
    bf16_t *Z, *XBC, *U, *Q, *G; float* DT; float* out; const float *qn, *kn; int layer;
    __device__ __forceinline__ void operator()(const f32x4 (&acc)[2][2][4][2], const Unit& u, int wr, int wc, int fr, int fq) const {
        const int pn = u.pn, rowb = u.pm * 256 + wr * 64 + fr, ctb = wc * 32 + fq * 4;
        if (pn < 11 || (pn >= 17 && pn < 29)) {
            bf16_t* base; int ld, col0; bool sig = false;
            if (pn < 4) { base = Z; ld = 1024; col0 = pn * 256; } else if (pn < 9) { base = XBC; ld = 1280; col0 = (pn - 4) * 256; }
            else if (pn < 11) { base = U; ld = 512; col0 = (pn - 9) * 256; } else { base = G; ld = 3072; col0 = (pn - 17) * 256; sig = true; }
#pragma unroll
            for (int ai = 0; ai < 2; ++ai)
#pragma unroll
                for (int m = 0; m < 4; ++m) { bf16_t* rp = base + (size_t)(rowb + ai * 128 + m * 16) * ld + col0 + wc * 32 + fq * 8;
#pragma unroll
                    for (int bj = 0; bj < 2; ++bj) { f32x4 v0 = acc[ai][bj][m][0], v1 = acc[ai][bj][m][1];
                        if (sig) {
#pragma unroll
                            for (int j = 0; j < 4; ++j) { v0[j] = sigmoidf_(v0[j]); v1[j] = sigmoidf_(v1[j]); } }
                        u32x4 o; o[0] = pk2(v0[0], v0[1]); o[1] = pk2(v0[2], v0[3]); o[2] = pk2(v1[0], v1[1]); o[3] = pk2(v1[2], v1[3]); *(u32x4*)(rp + bj * 128) = o; } }
        } else if (pn < 17) {
            const int seg = (pn - 11) >> 1, head = ((pn - 11) & 1) * 4 + wc;
            const float* nw = seg == 0 ? qn : kn;
            f32x4 wv[2][2];
#pragma unroll
            for (int bj = 0; bj < 2; ++bj)
#pragma unroll
                for (int n = 0; n < 2; ++n) wv[bj][n] = (seg < 2) ? *(const f32x4*)(nw + 32 * bj + 16 * n + 4 * fq) : (f32x4){1.f, 1.f, 1.f, 1.f};
#pragma unroll
            for (int ai = 0; ai < 2; ++ai)
#pragma unroll
                for (int m = 0; m < 4; ++m) { const int row = rowb + ai * 128 + m * 16;
                    float rs = 1.f;
                    if (seg < 2) { float ss = 0.f;
#pragma unroll
                        for (int bj = 0; bj < 2; ++bj)
#pragma unroll
                            for (int n = 0; n < 2; ++n) { const f32x4 v = acc[ai][bj][m][n]; ss += v[0] * v[0] + v[1] * v[1] + v[2] * v[2] + v[3] * v[3]; }
                        ss += __shfl_xor(ss, 16); ss += __shfl_xor(ss, 32);
                        rs = rsqrtf(ss * (1.f / 64.f) + EPS); }
                    if (seg == 0) { bf16_t* rp = Q + (size_t)row * 512 + head * 64 + 4 * fq;
#pragma unroll
                        for (int bj = 0; bj < 2; ++bj)
#pragma unroll
                            for (int n = 0; n < 2; ++n) { const f32x4 v = acc[ai][bj][m][n] * rs * wv[bj][n]; u32x2 o; o[0] = pk2(v[0], v[1]); o[1] = pk2(v[2], v[3]); *(u32x2*)(rp + 32 * bj + 16 * n) = o; }
                    } else { float* rp = out + k_off(layer, row) + (seg == 2 ? (row >= NS0 && row < NM0 ? (O_VS - O_KS) : (O_VP - O_KP)) : 0) + head * 64 + 4 * fq;
#pragma unroll
                        for (int bj = 0; bj < 2; ++bj)
#pragma unroll
                            for (int n = 0; n < 2; ++n) { const f32x4 v = acc[ai][bj][m][n] * rs * wv[bj][n]; *(f32x4*)(rp + 32 * bj + 16 * n) = v; } } }
        } else {
            if (wc == 0) {
#pragma unroll
                for (int ai = 0; ai < 2; ++ai)
#pragma unroll
                    for (int m = 0; m < 4; ++m) *(f32x4*)(DT + (size_t)(rowb + ai * 128 + m * 16) * 16 + 4 * fq) = acc[ai][0][m][0];
            }
        }
    }
};
struct EpiGlu {
    bf16_t* OB;
    __device__ __forceinline__ void operator()(const f32x4 (&acc)[2][2][4][2], const Unit& u, int wr, int wc, int fr, int fq) const {
        const int rowb = u.pm * 256 + wr * 64 + fr, colb = u.pn * 128 + wc * 32 + fq * 8;
#pragma unroll
        for (int ai = 0; ai < 2; ++ai)
#pragma unroll
            for (int m = 0; m < 4; ++m) { bf16_t* rp = OB + (size_t)(rowb + ai * 128 + m * 16) * 1024 + colb;
                const f32x4 a0 = acc[ai][0][m][0], g0 = acc[ai][1][m][0], a1 = acc[ai][0][m][1], g1 = acc[ai][1][m][1];
                u32x4 o; o[0] = pk2(a0[0] * sigmoidf_(g0[0]), a0[1] * sigmoidf_(g0[1])); o[1] = pk2(a0[2] * sigmoidf_(g0[2]), a0[3] * sigmoidf_(g0[3]));
                o[2] = pk2(a1[0] * sigmoidf_(g1[0]), a1[1] * sigmoidf_(g1[1])); o[3] = pk2(a1[2] * sigmoidf_(g1[2]), a1[3] * sigmoidf_(g1[3])); *(u32x4*)rp = o; }
    }
};
struct EpiMix {
    bf16_t* R; const bf16_t* G; const bf16_t* OB; int accum;
    __device__ __forceinline__ void operator()(const f32x4 (&acc)[2][2][4][2], const Unit& u, int wr, int wc, int fr, int fq) const {
        const int rowb = u.pm * 256 + wr * 64 + fr, colb = u.pn * 256 + wc * 32 + fq * 4;
#pragma unroll
        for (int ai = 0; ai < 2; ++ai)
#pragma unroll
            for (int m = 0; m < 4; ++m) { const int row = rowb + ai * 128 + m * 16;
                u32x2 gw[2][2], g1[2][2], ob[2][2], rw[2][2];
#pragma unroll
                for (int bj = 0; bj < 2; ++bj)
#pragma unroll
                    for (int n = 0; n < 2; ++n) { const int col = colb + bj * 128 + n * 16;
                        gw[bj][n] = *(const u32x2*)(G + (size_t)row * 3072 + col);
                        g1[bj][n] = (u32x2){0u, 0u}; ob[bj][n] = (u32x2){0u, 0u}; rw[bj][n] = (u32x2){0u, 0u};
                        if (OB) { g1[bj][n] = *(const u32x2*)(G + (size_t)row * 3072 + 1024 + col); ob[bj][n] = *(const u32x2*)(OB + (size_t)row * 1024 + col); }
                        if (accum) rw[bj][n] = ld_l2_u32x2(R + (size_t)row * 1024 + col); }
#pragma unroll
                for (int bj = 0; bj < 2; ++bj)
#pragma unroll
                    for (int n = 0; n < 2; ++n) { const int col = colb + bj * 128 + n * 16; f32x4 v = acc[ai][bj][m][n];
                        v = v * (f32x4){lo_f(gw[bj][n][0]), hi_f(gw[bj][n][0]), lo_f(gw[bj][n][1]), hi_f(gw[bj][n][1])};
                        v = v + (f32x4){lo_f(g1[bj][n][0]), hi_f(g1[bj][n][0]), lo_f(g1[bj][n][1]), hi_f(g1[bj][n][1])} * (f32x4){lo_f(ob[bj][n][0]), hi_f(ob[bj][n][0]), lo_f(ob[bj][n][1]), hi_f(ob[bj][n][1])};
                        v = v + (f32x4){lo_f(rw[bj][n][0]), hi_f(rw[bj][n][0]), lo_f(rw[bj][n][1]), hi_f(rw[bj][n][1])};
                        u32x2 o; o[0] = pk2(v[0], v[1]); o[1] = pk2(v[2], v[3]); *(u32x2*)(R + (size_t)row * 1024 + col) = o; } }
    }
};
struct EpiRes {
    float* out; float* xmeta; bf16_t* XB; float* ssq;
    __device__ __forceinline__ void operator()(const f32x4 (&acc)[2][2][4][2], const Unit& u, int wr, int wc, int fr, int fq) const {
        const int rowb = u.pm * 256 + wr * 64 + fr, colb = u.pn * 256 + wc * 32 + fq * 4;
        float* base = (u.pm * 256 < NM0) ? out : xmeta - (size_t)NM0 * 1024;
#pragma unroll
        for (int ai = 0; ai < 2; ++ai)
#pragma unroll
            for (int mh = 0; mh < 2; ++mh) {
                f32x4 xv[2][2][2];
#pragma unroll
                for (int m2 = 0; m2 < 2; ++m2)
#pragma unroll
                    for (int bj = 0; bj < 2; ++bj)
#pragma unroll
                        for (int n = 0; n < 2; ++n) xv[m2][bj][n] = __builtin_nontemporal_load((const f32x4*)(base + (size_t)(rowb + ai * 128 + (mh * 2 + m2) * 16) * 1024 + colb + bj * 128 + n * 16));
#pragma unroll
                for (int m2 = 0; m2 < 2; ++m2) { const int m = mh * 2 + m2, row = rowb + ai * 128 + m * 16; float* rp = base + (size_t)row * 1024 + colb; float ss = 0.f;
#pragma unroll
                    for (int bj = 0; bj < 2; ++bj)
#pragma unroll
                        for (int n = 0; n < 2; ++n) { const f32x4 v = xv[m2][bj][n] + acc[ai][bj][m][n]; *(f32x4*)(rp + bj * 128 + n * 16) = v;
                            if (XB) { u32x2 o; o[0] = pk2(v[0], v[1]); o[1] = pk2(v[2], v[3]); *(u32x2*)(XB + (size_t)row * 1024 + colb + bj * 128 + n * 16) = o; ss += (v[0] * v[0] + v[1] * v[1]) + (v[2] * v[2] + v[3] * v[3]); } }
                    if (XB) { ss += __shfl_xor(ss, 16); ss += __shfl_xor(ss, 32); if (fq == 0) __hip_atomic_fetch_add(ssq + row, ss, __ATOMIC_RELAXED, __HIP_MEMORY_SCOPE_AGENT); } } }
    }
};
struct EpiUp {
    bf16_t* ACT; const float* ssq;
    __device__ __forceinline__ void operator()(const f32x4 (&acc)[2][2][4][2], const Unit& u, int wr, int wc, int fr, int fq) const {
        const int rowb = u.pm * 256 + wr * 64 + fr, colb = u.pn * 256 + wc * 32 + fq * 4;
        float rs[2][4];
#pragma unroll
        for (int ai = 0; ai < 2; ++ai)
#pragma unroll
            for (int m = 0; m < 4; ++m) rs[ai][m] = ssq[rowb + ai * 128 + m * 16];
#pragma unroll
        for (int ai = 0; ai < 2; ++ai)
#pragma unroll
            for (int m = 0; m < 4; ++m) { bf16_t* rp = ACT + (size_t)(rowb + ai * 128 + m * 16) * 4096 + u.pn * 256 + wc * 32 + fq * 8; const float r_ = rsqrtf(rs[ai][m] * (1.f / 1024.f) + EPS);
#pragma unroll
                for (int bj = 0; bj < 2; ++bj) { f32x4 v0 = acc[ai][bj][m][0], v1 = acc[ai][bj][m][1];
#pragma unroll
                    for (int j = 0; j < 4; ++j) { const float r0 = fmaxf(v0[j] * r_, 0.f), r1 = fmaxf(v1[j] * r_, 0.f); v0[j] = r0 * r0; v1[j] = r1 * r1; }
                    u32x4 o; o[0] = pk2(v0[0], v0[1]); o[1] = pk2(v0[2], v0[3]); o[2] = pk2(v1[0], v1[1]); o[3] = pk2(v1[2], v1[3]); *(u32x4*)(rp + bj * 128) = o; } }
    }
};

__device__ __forceinline__ int perm32(int rho) { const int n = rho >> 4, i = rho & 15; return 8 * (i >> 2) + 4 * n + (i & 3); }
__device__ __forceinline__ int col_in(int n) {
    if (n < 2304) return n;
    if (n < 2816) return n + 16;
    if (n < 4352) { const int w0 = n - 2816, seg = w0 >> 9, w = w0 & 511, tile = w >> 8, ct = w & 255, bj = ct >> 7, wc = (ct >> 5) & 3, ww = ct & 31;
        return 2832 + seg * 512 + (tile * 4 + wc) * 64 + 32 * bj + ww; }
    if (n < 7424) return n + 16;
    if (n < 7440) return 2304 + (n - 7424);
    return -1;
}
template <int MAP, bool PERMALL = false>
__device__ __forceinline__ void prep_w(bf16_t* dst, const float* src, int K, int N, int ld, const float* scale, size_t gtid, size_t gsz) {
    const size_t items = (size_t)(K / 8) * N;
    for (size_t it = gtid; it < items; it += gsz) {
        const int n = (int)(it % N), k8 = (int)(it / N);
        const bool pm_ = PERMALL || MAP == 2 || (MAP == 1 && (n < 2816 || (n >= 4352 && n < 7424)));
        const int np = pm_ ? (n & ~31) + perm32(n & 31) : n;
        const int c = MAP == 1 ? col_in(np) : (MAP == 2 ? (((np >> 7) & 1) * 1024 + (np >> 8) * 128 + (np & 127)) : np);
        float v[8];
#pragma unroll
        for (int kk = 0; kk < 8; ++kk) { const int k = k8 * 8 + kk; float x = (c >= 0) ? src[(size_t)k * ld + c] : 0.f; if (scale) x *= scale[k]; v[kk] = x; }
        u32x4 o; o[0] = pk2(v[0], v[1]); o[1] = pk2(v[2], v[3]); o[2] = pk2(v[4], v[5]); o[3] = pk2(v[6], v[7]);
        *(u32x4*)(dst + (size_t)n * K + k8 * 8) = o;
    }
}
__device__ __forceinline__ void rmsnorm_rows(CPar p, const float* g, int from_inputs) {
    const int lane = ltid() & 63, gw = lbid() * 8 + (ltid() >> 6), ngw = lgdim() * 8;
    bf16_t* HB = (bf16_t*)(p->ws + WS_HB);
    f32x4 gv[4];
#pragma unroll
    for (int j = 0; j < 4; ++j) gv[j] = *(const f32x4*)(g + lane * 4 + 256 * j);
    for (int r = gw; r < NROWS; r += ngw) {
        float* xl = xloc(p, r);
        const float* src = xl;
        if (from_inputs) src = r < NS0 ? p->in[I_XP] + (size_t)r * 1024 : (r < NM0 ? p->in[I_XS] + (size_t)(r - NS0) * 1024 : p->in[I_META] + (size_t)((r - NM0) & 15) * 1024);
        f32x4 v[4]; float s = 0.f;
#pragma unroll
        for (int j = 0; j < 4; ++j) { v[j] = *(const f32x4*)(src + lane * 4 + 256 * j); s += (v[j][0] * v[j][0] + v[j][1] * v[j][1]) + (v[j][2] * v[j][2] + v[j][3] * v[j][3]); }
        const float rstd = rsqrtf(wave_sum(s) * (1.f / 1024.f) + EPS);
#pragma unroll
        for (int j = 0; j < 4; ++j) { if (from_inputs) *(f32x4*)(xl + lane * 4 + 256 * j) = v[j];
            const f32x4 h = v[j] * rstd * gv[j]; u32x2 o; o[0] = pk2(h[0], h[1]); o[1] = pk2(h[2], h[3]); *(u32x2*)(HB + (size_t)r * 1024 + lane * 4 + 256 * j) = o; }
    }
}
__device__ __forceinline__ void ssd_norm_rows(CPar p) {
    const int lane = ltid() & 63, gw = lbid() * 8 + (ltid() >> 6), ngw = lgdim() * 8;
    bf16_t* Z = (bf16_t*)(p->ws + WS_Z);
    for (int r = gw; r < NROWS; r += ngw) {
#pragma unroll
        for (int j = 0; j < 2; ++j) { u32x4* zp = (u32x4*)(Z + (size_t)r * 1024 + j * 512 + lane * 8); const u32x4 w = *zp;
            float f[8] = {lo_f(w[0]), hi_f(w[0]), lo_f(w[1]), hi_f(w[1]), lo_f(w[2]), hi_f(w[2]), lo_f(w[3]), hi_f(w[3])};
            float ss = 0.f;
#pragma unroll
            for (int i = 0; i < 8; ++i) ss += f[i] * f[i];
            const float rs = rsqrtf(wave_sum(ss) * (1.f / 512.f) + EPS);
            u32x4 o; o[0] = pk2(f[0] * rs, f[1] * rs); o[1] = pk2(f[2] * rs, f[3] * rs); o[2] = pk2(f[4] * rs, f[5] * rs); o[3] = pk2(f[6] * rs, f[7] * rs); *zp = o; }
    }
}
__device__ __forceinline__ void phase_prep(CPar p, int l) {
    const size_t gtid = (size_t)lbid() * 512 + ltid(), gsz = (size_t)lgdim() * 512;
    unsigned char* ws = p->ws;
    prep_w<1>((bf16_t*)(ws + W_BT1), p->in[I_WIN] + (size_t)l * 1024 * IN_COLS, 1024, N1, IN_COLS, nullptr, gtid, gsz);
    prep_w<2>((bf16_t*)(ws + W_GLU), p->in[I_WGLU] + (size_t)l * 512 * 2048, 512, 2048, 2048, nullptr, gtid, gsz);
    prep_w<0>((bf16_t*)(ws + W_LA), p->in[I_WLA] + (size_t)l * 1024 * 1024, 1024, 1024, 1024, p->in[I_NSSD] + l * 1024, gtid, gsz);
    prep_w<0>((bf16_t*)(ws + W_LC), p->in[I_WLC] + (size_t)l * 512 * 1024, 512, 1024, 1024, nullptr, gtid, gsz);
    prep_w<0>((bf16_t*)(ws + W_OUT), p->in[I_WOUT] + (size_t)l * 1024 * 1024, 1024, 1024, 1024, nullptr, gtid, gsz);
    prep_w<0, true>((bf16_t*)(ws + W_UP), p->in[I_WUP] + (size_t)l * 1024 * 4096, 1024, 4096, 4096, p->in[I_NFFN] + l * 1024, gtid, gsz);
    prep_w<0>((bf16_t*)(ws + W_DOWN), p->in[I_WDOWN] + (size_t)l * 4096 * 1024, 4096, 1024, 1024, nullptr, gtid, gsz);
    rmsnorm_rows(p, p->in[I_NMIX] + l * 1024, l == 0);
}

__device__ __forceinline__ bf16_t f2bf_(float v) { return (bf16_t)(pk2(v, v) & 0xffffu); }
__device__ __forceinline__ void ssd_item(CPar p, int l, int item, float* sm) {
    const int tid = ltid(), lane = tid & 63, wave = __builtin_amdgcn_readfirstlane(tid >> 6), rb = wave >> 1, chh = wave & 1, fr = lane & 15, fq = lane >> 4;
    const int s = item < 512 ? (item >> 4) : 32 + ((item - 512) >> 4), h = item & 15, g = h >> 3;
    const bool prompt = s < 32; const int b = prompt ? s : s - 32, T = prompt ? TP : TS;
    constexpr int LB = 72;
    bf16_t *Cb = (bf16_t*)sm, *Bb = Cb + 64 * LB, *XT = Bb + 64 * LB, *WB = XT + 64 * LB, *Mb = WB + 64 * LB, *Sb = Mb + 64 * LB;
    float *sRaw = (float*)(Sb + 64 * LB), *sW = sRaw + 67 * 192, *sdtA = sW + 5 * 192, *sacA = sdtA + 33 * 64, *sw = sacA + 33 * 64;
    const bf16_t* XBC = (const bf16_t*)(p->ws + WS_XBC); bf16_t* Z = (bf16_t*)(p->ws + WS_Z);
    const float* DT = (const float*)(p->ws + WS_DT);
    const float* cw = p->in[I_CONVW] + (size_t)l * 4 * 1280; const float* cb = p->in[I_CONVB] + (size_t)l * 1280;
    const float* hist = p->in[I_SCONV] + (size_t)(l * 16 + b) * 3 * 1280;
    const float dtb = p->in[I_DTB][l * 16 + h], aneg = -__expf(p->in[I_ALOG][l * 16 + h]), dsk = p->in[I_DSSD][l * 16 + h];
    float* sout = prompt ? p->out + O_SSDP + ((size_t)(l * 32 + b) * 16 + h) * 4096 : p->out + O_SSDS + ((size_t)(l * 16 + b) * 16 + h) * 4096;
    for (int i = tid; i < 5 * 192; i += 512) { const int k = i / 192, ch = i - k * 192; const int col = ch < 64 ? h * 64 + ch : (ch < 128 ? 1024 + g * 64 + (ch - 64) : 1152 + g * 64 + (ch - 128));
        sW[i] = k < 4 ? cw[k * 1280 + col] : cb[col]; }
    f32x4 accS[2];
#pragma unroll
    for (int c2 = 0; c2 < 2; ++c2)
#pragma unroll
        for (int r = 0; r < 4; ++r) { const int pp = rb * 16 + fq * 4 + r, n = chh * 32 + c2 * 16 + fr;
            const float v = prompt ? 0.f : p->in[I_SSSD][((size_t)(l * 16 + b) * 16 + h) * 4096 + pp * 64 + n]; accS[c2][r] = v; Sb[pp * LB + n] = f2bf_(v); }
    const int nch = (T + 63) >> 6;
    { const int wv = tid >> 6, ln = tid & 63; float xv[5];
#pragma unroll
        for (int r = 0; r < 5; ++r) { const int c = wv + 8 * r, t = c * 64 + ln; xv[r] = (c < nch && t < T) ? DT[(size_t)row_of(s, t) * 16 + h] + dtb : -1e30f; }
#pragma unroll
        for (int r = 0; r < 5; ++r) { const int c = wv + 8 * r;
            if (c < nch) { const float x = xv[r]; const float dtv = x < -1e29f ? 0.f : (x > 20.f ? x : log1pf(__expf(x))); float cs = dtv * aneg;
#pragma unroll
                for (int o = 1; o < 64; o <<= 1) { const float nb = __shfl_up(cs, o); if (ln >= o) cs += nb; }
                sdtA[c * 64 + ln] = dtv; sacA[c * 64 + ln] = cs; } } }
    u32x4 pf[4];
#define SSD_ISSUE(cc) do { _Pragma("unroll") for (int it4 = 0; it4 < 4; ++it4) { const int pi = tid + it4 * 512; pf[it4] = (u32x4){0u, 0u, 0u, 0u}; \
        if (pi < 67 * 24) { const int rl = pi / 24, pc = pi - rl * 24, seg = pc >> 3, q8 = pc & 7, tt = (cc) * 64 - 3 + rl; \
            const int col = (seg == 0 ? h * 64 : (seg == 1 ? 1024 + g * 64 : 1152 + g * 64)) + q8 * 8; \
            if (tt >= 0 && tt < T) pf[it4] = *(const u32x4*)(XBC + (size_t)row_of(s, tt) * 1280 + col); } } } while (0)
#define SSD_FRAG(P, r0, ks) (*(const bf16x8*)((P) + ((r0) + fr) * LB + (ks) * 32 + fq * 8))
    SSD_ISSUE(0);
#pragma unroll 1
    for (int c = 0; c < nch; ++c) {
        const int t0 = c * 64; const float* sdt = sdtA + t0; const float* sac = sacA + t0;
        __syncthreads();
#pragma unroll
        for (int it4 = 0; it4 < 4; ++it4) { const int pi = tid + it4 * 512;
            if (pi < 67 * 24) { const int rl = pi / 24, pc = pi - rl * 24, seg = pc >> 3, q8 = pc & 7, tt = t0 - 3 + rl;
                const u32x4 w = pf[it4];
                f32x4 f0 = {lo_f(w[0]), hi_f(w[0]), lo_f(w[1]), hi_f(w[1])}, f1 = {lo_f(w[2]), hi_f(w[2]), lo_f(w[3]), hi_f(w[3])};
                if (tt < 0 && !prompt) { const int col = (seg == 0 ? h * 64 : (seg == 1 ? 1024 + g * 64 : 1152 + g * 64)) + q8 * 8; const float* hp = hist + (3 + tt) * 1280 + col; f0 = *(const f32x4*)hp; f1 = *(const f32x4*)(hp + 4); }
                float* dp = sRaw + rl * 192 + seg * 64 + q8 * 8; *(f32x4*)dp = f0; *(f32x4*)(dp + 4) = f1; } }
        if (tid < 64) sw[tid] = __expf(sac[63] - sac[tid]) * sdt[tid];
        if (c + 1 < nch) SSD_ISSUE(c + 1);
        bf16_t zq[2][4];
#pragma unroll
        for (int c2 = 0; c2 < 2; ++c2)
#pragma unroll
            for (int r = 0; r < 4; ++r) { const int t = t0 + rb * 16 + fq * 4 + r; zq[c2][r] = (t < T) ? Z[(size_t)row_of(s, t) * 1024 + h * 64 + chh * 32 + c2 * 16 + fr] : (bf16_t)0; }
        __syncthreads();
        if (tid < 384) { const int ch = tid % 192, tlb = (tid / 192) * 32, cc = ch & 63;
            const float w0 = sW[ch], w1 = sW[192 + ch], w2 = sW[384 + ch], w3 = sW[576 + ch], bias = sW[768 + ch];
            float r0 = sRaw[(tlb + 0) * 192 + ch], r1 = sRaw[(tlb + 1) * 192 + ch], r2 = sRaw[(tlb + 2) * 192 + ch];
            float ov[32];
#pragma unroll
            for (int i2 = 0; i2 < 32; ++i2) { const float r3 = sRaw[(tlb + i2 + 3) * 192 + ch];
                const float v = bias + w0 * r0 + w1 * r1 + w2 * r2 + w3 * r3; ov[i2] = (t0 + tlb + i2 < T) ? siluf_(v) : 0.f; r0 = r1; r1 = r2; r2 = r3; }
            if (ch < 128) { bf16_t* dst = (ch < 64 ? XT : WB) + cc * LB + tlb;
#pragma unroll
                for (int q4 = 0; q4 < 4; ++q4) { u32x4 w;
#pragma unroll
                    for (int c4 = 0; c4 < 4; ++c4) { const int i2 = q4 * 8 + c4 * 2; const float s0 = ch < 64 ? 1.f : sw[tlb + i2], s1 = ch < 64 ? 1.f : sw[tlb + i2 + 1]; w[c4] = pk2(ov[i2] * s0, ov[i2 + 1] * s1); }
                    *(u32x4*)(dst + q4 * 8) = w; } }
            if (ch >= 64) { bf16_t* dst = (ch < 128 ? Bb : Cb) + tlb * LB + cc;
#pragma unroll
                for (int i2 = 0; i2 < 32; ++i2) dst[i2 * LB] = f2bf_(ov[i2]); } }
        __syncthreads();
        f32x4 acc2[2];
        { const bf16x8 aC0 = SSD_FRAG(Cb, rb * 16, 0), aC1 = SSD_FRAG(Cb, rb * 16, 1);
#pragma unroll
            for (int c2 = 0; c2 < 2; ++c2) { const int j0 = chh * 32 + c2 * 16;
                f32x4 m = {0.f, 0.f, 0.f, 0.f};
                if (j0 <= rb * 16 + 15) { m = __builtin_amdgcn_mfma_f32_16x16x32_bf16(aC0, SSD_FRAG(Bb, j0, 0), m, 0, 0, 0); m = __builtin_amdgcn_mfma_f32_16x16x32_bf16(aC1, SSD_FRAG(Bb, j0, 1), m, 0, 0, 0); }
                const int j = j0 + fr; const float acj = sac[j], dtj = sdt[j];
#pragma unroll
                for (int r = 0; r < 4; ++r) { const int tl = rb * 16 + fq * 4 + r; Mb[tl * LB + j] = f2bf_(j <= tl ? m[r] * __expf(sac[tl] - acj) * dtj : 0.f); }
                f32x4 y = {0.f, 0.f, 0.f, 0.f};
                y = __builtin_amdgcn_mfma_f32_16x16x32_bf16(aC0, SSD_FRAG(Sb, j0, 0), y, 0, 0, 0); y = __builtin_amdgcn_mfma_f32_16x16x32_bf16(aC1, SSD_FRAG(Sb, j0, 1), y, 0, 0, 0);
#pragma unroll
                for (int r = 0; r < 4; ++r) y[r] *= __expf(sac[rb * 16 + fq * 4 + r]);
                acc2[c2] = y; }
            const bf16x8 aX0 = SSD_FRAG(XT, rb * 16, 0), aX1 = SSD_FRAG(XT, rb * 16, 1); const float eL = __expf(sac[63]);
#pragma unroll
            for (int c2 = 0; c2 < 2; ++c2) { const int n0 = chh * 32 + c2 * 16; f32x4 sv = accS[c2] * eL;
                sv = __builtin_amdgcn_mfma_f32_16x16x32_bf16(aX0, SSD_FRAG(WB, n0, 0), sv, 0, 0, 0); sv = __builtin_amdgcn_mfma_f32_16x16x32_bf16(aX1, SSD_FRAG(WB, n0, 1), sv, 0, 0, 0); accS[c2] = sv; } }
        __syncthreads();
        { const bf16x8 aM0 = SSD_FRAG(Mb, rb * 16, 0), aM1 = SSD_FRAG(Mb, rb * 16, 1);
#pragma unroll
            for (int c2 = 0; c2 < 2; ++c2) { const int p0 = chh * 32 + c2 * 16, pp = p0 + fr; f32x4 y = acc2[c2];
                y = __builtin_amdgcn_mfma_f32_16x16x32_bf16(aM0, SSD_FRAG(XT, p0, 0), y, 0, 0, 0); y = __builtin_amdgcn_mfma_f32_16x16x32_bf16(aM1, SSD_FRAG(XT, p0, 1), y, 0, 0, 0);
#pragma unroll
                for (int r = 0; r < 4; ++r) { const int tl = rb * 16 + fq * 4 + r, t = t0 + tl;
                    if (t < T) { bf16_t* zp = Z + (size_t)row_of(s, t) * 1024 + h * 64 + pp; const float yy = (y[r] + dsk * bf2f(XT[pp * LB + tl])) * siluf_(bf2f(zq[c2][r])); *zp = f2bf_(yy); } } }
#pragma unroll
            for (int c2 = 0; c2 < 2; ++c2)
#pragma unroll
                for (int r = 0; r < 4; ++r) Sb[(rb * 16 + fq * 4 + r) * LB + chh * 32 + c2 * 16 + fr] = f2bf_(accS[c2][r]); }
    }
    __syncthreads();
#pragma unroll
    for (int c2 = 0; c2 < 2; ++c2)
#pragma unroll
        for (int r = 0; r < 4; ++r) sout[(rb * 16 + fq * 4 + r) * 64 + chh * 32 + c2 * 16 + fr] = accS[c2][r];
    float* cout_ = prompt ? p->out + O_CONVP + (size_t)(l * 32 + b) * 3 * 1280 : p->out + O_CONVS + (size_t)(l * 16 + b) * 3 * 1280;
    for (int idx = tid; idx < 3 * 192; idx += 512) { const int k = idx / 192, ch = idx - k * 192;
        if (ch >= 64 && (h & 7) != 0) continue;
        const int col = ch < 64 ? h * 64 + ch : (ch < 128 ? 1024 + g * 64 + (ch - 64) : 1152 + g * 64 + (ch - 128));
        cout_[k * 1280 + col] = bf2f(XBC[(size_t)row_of(s, T - 3 + k) * 1280 + col]); }
    __syncthreads();
#undef SSD_ISSUE
#undef SSD_FRAG
}

__device__ __forceinline__ void s5_item(CPar p, int l, int s, int g, float* wl) {
    const int lane = ltid() & 63, fr = lane & 15, fq = lane >> 4;
    const bool prompt = s < 32; const int b = prompt ? s : s - 32, T = prompt ? TP : TS, nblk = T >> 4;
    constexpr int LBX = 136;
    bf16_t* Xb = (bf16_t*)wl;
    bf16_t* U = (bf16_t*)(p->ws + WS_U);
    const int gp = (l * 32 + g) * 64 + lane;
    const float lr = p->in[I_LRE][gp], li = p->in[I_LIM][gp], step = expf(p->in[I_LSTEP][l * 32 + g]);
    float sn, cs; sincos_red((double)li * (double)step, sn, cs);
    const float mag = expf(lr * step), ab_re = mag * cs, ab_im = mag * sn;
    const float den = lr * lr + li * li, nr = ab_re - 1.f, f_re = (nr * lr + ab_im * li) / den, f_im = (ab_im * lr - nr * li) / den;
    float bbr[16], bbi[16];
#pragma unroll
    for (int hh = 0; hh < 16; ++hh) { const float br = p->in[I_BRE][(size_t)gp * 16 + hh], bi = p->in[I_BIM][(size_t)gp * 16 + hh]; bbr[hh] = f_re * br - f_im * bi; bbi[hh] = f_re * bi + f_im * br; }
    bf16x8 cfrag[4];
#pragma unroll
    for (int ks = 0; ks < 4; ++ks) { const int k0 = ks * 32 + fq * 8; const bool im = k0 >= 64;
        const float* cp = (im ? p->in[I_CIM] : p->in[I_CRE]) + ((size_t)(l * 32 + g) * 16 + fr) * 64 + (k0 & 63);
        const f32x4 c0 = *(const f32x4*)cp, c1 = *(const f32x4*)(cp + 4); const float sg = im ? -1.f : 1.f;
        u32x4 w; w[0] = pk2(sg * c0[0], sg * c0[1]); w[1] = pk2(sg * c0[2], sg * c0[3]); w[2] = pk2(sg * c1[0], sg * c1[1]); w[3] = pk2(sg * c1[2], sg * c1[3]);
        cfrag[ks] = __builtin_bit_cast(bf16x8, w); }
    float xr = prompt ? 0.f : p->in[I_S5R][(size_t)(l * 16 + b) * 2048 + g * 64 + lane], xi = prompt ? 0.f : p->in[I_S5I][(size_t)(l * 16 + b) * 2048 + g * 64 + lane];
    const float dsk = p->in[I_DS5][(size_t)(l * 32 + g) * 16 + fr];
    u32x4 ua = {0, 0, 0, 0}, ub = {0, 0, 0, 0};
    { const int r0 = row_of(s, 0); if (lane < 16) { const u32x4* up = (const u32x4*)(U + (size_t)(r0 + lane) * 512 + g * 16); ua = up[0]; ub = up[1]; } }
    for (int blk = 0; blk < nblk; ++blk) {
        const int r0 = row_of(s, blk * 16);
        const u32x4 ca = ua, cbv = ub;
        if (blk + 1 < nblk && lane < 16) { const int r1 = row_of(s, blk * 16 + 16); const u32x4* up = (const u32x4*)(U + (size_t)(r1 + lane) * 512 + g * 16); ua = up[0]; ub = up[1]; }
#pragma unroll
        for (int i = 0; i < 16; ++i) {
            float br4[4] = {0.f, 0.f, 0.f, 0.f}, bi4[4] = {0.f, 0.f, 0.f, 0.f};
#pragma unroll
            for (int w = 0; w < 8; ++w) { const unsigned word = (unsigned)__builtin_amdgcn_readlane((int)(w < 4 ? ca[w] : cbv[w - 4]), i);
                const float u0 = lo_f(word), u1 = hi_f(word);
                br4[w & 3] += bbr[2 * w] * u0 + bbr[2 * w + 1] * u1; bi4[w & 3] += bbi[2 * w] * u0 + bbi[2 * w + 1] * u1; }
            const float bur = (br4[0] + br4[1]) + (br4[2] + br4[3]), bui = (bi4[0] + bi4[1]) + (bi4[2] + bi4[3]);
            const float nxr = ab_re * xr - ab_im * xi + bur, nxi = ab_re * xi + ab_im * xr + bui; xr = nxr; xi = nxi;
            Xb[i * LBX + lane] = f2bf_(xr); Xb[i * LBX + 64 + lane] = f2bf_(xi);
        }
        __builtin_amdgcn_wave_barrier(); asm volatile("s_waitcnt lgkmcnt(0)" ::: "memory");
        f32x4 y = {0.f, 0.f, 0.f, 0.f};
#pragma unroll
        for (int ks = 0; ks < 4; ++ks) y = __builtin_amdgcn_mfma_f32_16x16x32_bf16(*(const bf16x8*)(Xb + fr * LBX + ks * 32 + fq * 8), cfrag[ks], y, 0, 0, 0);
#pragma unroll
        for (int r = 0; r < 4; ++r) { bf16_t* up = U + (size_t)(r0 + fq * 4 + r) * 512 + g * 16 + fr; *up = f2bf_(geluf_(y[r] + dsk * bf2f(*up))); }
        __builtin_amdgcn_wave_barrier(); asm volatile("s_waitcnt lgkmcnt(0)" ::: "memory");
    }
    float* ore = prompt ? p->out + O_S5RP + (size_t)(l * 32 + b) * 2048 : p->out + O_S5RS + (size_t)(l * 16 + b) * 2048;
    float* oim = prompt ? p->out + O_S5IP + (size_t)(l * 32 + b) * 2048 : p->out + O_S5IS + (size_t)(l * 16 + b) * 2048;
    ore[g * 64 + lane] = xr; oim[g * 64 + lane] = xi;
}

typedef __bf16 bf2_t __attribute__((ext_vector_type(2)));
__device__ __forceinline__ float dot2bf(unsigned a, unsigned b, float c) { return __builtin_amdgcn_fdot2_f32_bf16(__builtin_bit_cast(bf2_t, a), __builtin_bit_cast(bf2_t, b), c, false); }
__device__ __forceinline__ void attn_item(CPar p, int l, int item, float* wl) {
    const int lane = ltid() & 63;
    int s, h, qt;
    if (item < 8448) { s = item / 264; const int rem = item - s * 264; h = rem / 33; qt = rem - h * 33; } else { const int it = item - 8448; s = 32 + (it >> 3); h = it & 7; qt = 0; }
    const bool prompt = s < 32; const int b = prompt ? s : s - 32, T = prompt ? TP : TS, nh = prompt ? 0 : PAST;
    const int i = qt * 64 + lane; const bool active = i < T; const int row = row_of(s, active ? i : T - 1);
    bf16_t* Q = (bf16_t*)(p->ws + WS_Q);
    unsigned* Kt = (unsigned*)wl; unsigned* Vp = Kt + 32 * 32;
    unsigned q[32]; float o[64];
    { const u32x4* qp = (const u32x4*)(Q + (size_t)row * 512 + h * 64);
#pragma unroll
        for (int e = 0; e < 8; ++e) { const u32x4 w = qp[e];
#pragma unroll
            for (int j = 0; j < 4; ++j) q[e * 4 + j] = pk2(lo_f(w[j]) * 0.125f, hi_f(w[j]) * 0.125f); } }
#pragma unroll
    for (int d = 0; d < 64; ++d) o[d] = 0.f;
    const float* kp_new = prompt ? p->out + O_KP + (size_t)(l * 32 + b) * 2064 * 512 + h * 64 : p->out + O_KS + (size_t)(l * 16 + b) * 64 * 512 + h * 64;
    const float* vp_new = prompt ? p->out + O_VP + (size_t)(l * 32 + b) * 2064 * 512 + h * 64 : p->out + O_VS + (size_t)(l * 16 + b) * 64 * 512 + h * 64;
    const float* kp_old = p->in[I_CK] + (size_t)(l * 16 + b) * 2048 * 512 + h * 64;
    const float* vp_old = p->in[I_CV] + (size_t)(l * 16 + b) * 2048 * 512 + h * 64;
    const int imax = (qt * 64 + 63 < T - 1) ? qt * 64 + 63 : T - 1;
    const int jtop = nh + imax - 1;
    float run = 0.f;
    f32x4 kreg[8], va[4], vb[4];
#define ATT_FETCH(JT) do { _Pragma("unroll") for (int e = 0; e < 8; ++e) { const int idx = e * 64 + lane, kr = idx >> 4, pc = idx & 15, j = (JT) - kr; kreg[e] = (f32x4){0.f, 0.f, 0.f, 0.f}; \
            if (j >= 0) { const float* kp = (j < nh) ? kp_old + (size_t)j * 512 : kp_new + (size_t)(j - nh) * 512; kreg[e] = *(const f32x4*)(kp + pc * 4); } } \
        _Pragma("unroll") for (int e = 0; e < 4; ++e) { const int idx = e * 64 + lane, m = idx >> 4, pc = idx & 15, j0 = (JT) - 2 * m, j1 = j0 - 1; va[e] = (f32x4){0.f, 0.f, 0.f, 0.f}; vb[e] = (f32x4){0.f, 0.f, 0.f, 0.f}; \
            if (j0 >= 0) { const float* vp = (j0 < nh) ? vp_old + (size_t)j0 * 512 : vp_new + (size_t)(j0 - nh) * 512; va[e] = *(const f32x4*)(vp + pc * 4); } \
            if (j1 >= 0) { const float* vp = (j1 < nh) ? vp_old + (size_t)j1 * 512 : vp_new + (size_t)(j1 - nh) * 512; vb[e] = *(const f32x4*)(vp + pc * 4); } } } while (0)
    if (jtop >= 0) ATT_FETCH(jtop);
    for (int jt = jtop; jt >= 0; jt -= 32) {
#pragma unroll
        for (int e = 0; e < 8; ++e) { const int idx = e * 64 + lane, kr = idx >> 4, pc = idx & 15; u32x2 w; w[0] = pk2(kreg[e][0], kreg[e][1]); w[1] = pk2(kreg[e][2], kreg[e][3]); *(u32x2*)(Kt + kr * 32 + pc * 2) = w; }
#pragma unroll
        for (int e = 0; e < 4; ++e) { const int idx = e * 64 + lane, m = idx >> 4, pc = idx & 15;
            u32x4 w; w[0] = pk2(va[e][0], vb[e][0]); w[1] = pk2(va[e][1], vb[e][1]); w[2] = pk2(va[e][2], vb[e][2]); w[3] = pk2(va[e][3], vb[e][3]); *(u32x4*)(Vp + m * 64 + pc * 4) = w; }
        __builtin_amdgcn_wave_barrier(); asm volatile("s_waitcnt lgkmcnt(0)" ::: "memory");
        if (jt - 32 >= 0) ATT_FETCH(jt - 32);
        const int nk = jt + 1 < 32 ? jt + 1 : 32, npair = (nk + 1) >> 1;
        for (int m = 0; m < npair; ++m) { const int j0 = jt - 2 * m, j1 = j0 - 1;
            float z0 = 0.f, z1 = 0.f;
#pragma unroll
            for (int d8 = 0; d8 < 8; ++d8) { const u32x4 k0 = *(const u32x4*)(Kt + (2 * m) * 32 + d8 * 4), k1 = *(const u32x4*)(Kt + (2 * m + 1) * 32 + d8 * 4);
#pragma unroll
                for (int c = 0; c < 4; ++c) { z0 = dot2bf(q[d8 * 4 + c], k0[c], z0); z1 = dot2bf(q[d8 * 4 + c], k1[c], z1); } }
            const bool v0 = active && (j0 < nh + i), v1 = active && (j1 >= 0) && (j1 < nh + i);
            const float e0 = __expf(-z0), ls0 = -__logf(1.f + e0);
            const float w0 = v0 ? __expf(ls0 + run) : 0.f; run += v0 ? (ls0 - z0) : 0.f;
            const float e1 = __expf(-z1), ls1 = -__logf(1.f + e1);
            const float w1 = v1 ? __expf(ls1 + run) : 0.f; run += v1 ? (ls1 - z1) : 0.f;
            const unsigned wp = pk2(w0, w1);
#pragma unroll
            for (int d4 = 0; d4 < 16; ++d4) { const u32x4 vv = *(const u32x4*)(Vp + m * 64 + d4 * 4);
#pragma unroll
                for (int c = 0; c < 4; ++c) o[d4 * 4 + c] = dot2bf(wp, vv[c], o[d4 * 4 + c]); } }
        __builtin_amdgcn_wave_barrier(); asm volatile("s_waitcnt lgkmcnt(0)" ::: "memory");
        const int fin = (!active) || (run < -50.f);
        if (__all(fin)) break;
    }
#undef ATT_FETCH
    if (active) { u32x4* op = (u32x4*)(Q + (size_t)row * 512 + h * 64);
#pragma unroll
        for (int e = 0; e < 8; ++e) { u32x4 w; w[0] = pk2(o[e * 8], o[e * 8 + 1]); w[1] = pk2(o[e * 8 + 2], o[e * 8 + 3]); w[2] = pk2(o[e * 8 + 4], o[e * 8 + 5]); w[3] = pk2(o[e * 8 + 6], o[e * 8 + 7]); op[e] = w; } }
}

__device__ __forceinline__ void phase_mixers(CPar p, int l, float* sm) {
#ifndef SKIP_SSD
    { CPar p1 = params_ptr();
#pragma unroll 1
      for (int it = lbid(); it < 768; it += lgdim()) ssd_item(p1, l, it, sm); }
#endif
    __syncthreads();
    const int wave = __builtin_amdgcn_readfirstlane(ltid() >> 6);
    float* wl = sm + wave * (68 * 64);
#ifndef SKIP_S5
    { CPar p2 = params_ptr();
    if (wave < 4) { for (int it = lbid() * 4 + wave; it < 1024; it += lgdim() * 4) s5_item(p2, l, it >> 5, it & 31, wl); }
    else if (wave < 6) { for (int it = lbid() * 2 + (wave - 4); it < 512; it += lgdim() * 2) s5_item(p2, l, 32 + (it >> 5), it & 31, wl); } }
#endif
#ifndef SKIP_ATT
    CPar p3 = params_ptr();
    unsigned* ctr = (unsigned*)(p3->ws + WS_CTR) + l;
    for (;;) {
        unsigned it = 0; if ((ltid() & 63) == 0) it = atomicAdd(ctr, 1u);
        it = (unsigned)__builtin_amdgcn_readfirstlane((int)it);
        if (it >= 8576u) break;
        attn_item(p3, l, (int)it, wl);
    }
#endif
}

#define XB_TMO      128
#define XB_XCNT(j)  (256  + 64 * (j))
#define XB_XSUB(j)  (1280 + 64 * (j))
#define XB_XGEN(j)  (2304 + 64 * (j))
#define XB_TOP      3328
#define XB_TOPGEN   3392
#define XCD_BAR_WORDS 3456
#define XB_SPIN_CAP (1u << 18)

__device__ __forceinline__ unsigned xb_ld(unsigned* p)              { return __hip_atomic_load(p, __ATOMIC_RELAXED, __HIP_MEMORY_SCOPE_AGENT); }
__device__ __forceinline__ unsigned xb_add(unsigned* p, unsigned v) { return __hip_atomic_fetch_add(p, v, __ATOMIC_RELAXED, __HIP_MEMORY_SCOPE_AGENT); }
__device__ __forceinline__ unsigned xb_xcc_id() { return (unsigned)__builtin_amdgcn_s_getreg((3 << 11) | 20) & 0xFu; }
#define XB_SPIN(cond, bar) do { unsigned _sp = 0; while (cond) { __builtin_amdgcn_s_sleep(1); \
    if ((++_sp & 255u) == 0u) { if (xb_ld(&(bar)[XB_TMO])) break; if (_sp > XB_SPIN_CAP) { atomicAdd(&(bar)[XB_TMO], 1u); break; } } } } while (0)

struct XcdBarrier {
    unsigned* bar; unsigned x;
    volatile LAS unsigned* st;
};

__device__ __forceinline__ XcdBarrier xcd_barrier_post(unsigned* bar, volatile LAS unsigned* st) {
    XcdBarrier b; b.bar = bar; b.x = xb_xcc_id(); b.st = st;
    if (threadIdx.x == 0) (void)xb_add(&bar[XB_XCNT(b.x)], 1u);
    return b;
}
__device__ __forceinline__ void xcd_barrier_complete(unsigned* bar, unsigned x, unsigned& nloc, unsigned& nx) {
    const unsigned G = gridDim.x * gridDim.y * gridDim.z;
    unsigned sum, cnt, mine, sp = 0u;
    for (;;) {
        sum = 0u; cnt = 0u; mine = 0u;
#pragma unroll
        for (unsigned j = 0; j < 16; ++j) { const unsigned c = xb_ld(&bar[XB_XCNT(j)]); sum += c; cnt += (c > 0u) ? 1u : 0u; mine = (j == x) ? c : mine; }
        if (sum == G) break;
        __builtin_amdgcn_s_sleep(1);
        if ((++sp & 255u) == 0u) { if (xb_ld(&bar[XB_TMO])) break; if (sp > XB_SPIN_CAP) { atomicAdd(&bar[XB_TMO], 1u); break; } }
    }
    nloc = mine > 0u ? mine : 1u; nx = cnt > 0u ? cnt : 1u;
}

__device__ __forceinline__ void xcd_barrier(const XcdBarrier& b) {
    asm volatile("s_waitcnt vmcnt(0)" ::: "memory");
    __syncthreads();
    if (threadIdx.x == 0) {
        unsigned* bar = b.bar;
        __builtin_amdgcn_s_waitcnt(0);
        unsigned nloc = b.st[0], nx = b.st[1];
        if (nloc == 0u) { xcd_barrier_complete(bar, b.x, nloc, nx); b.st[0] = nloc; b.st[1] = nx; }
        const unsigned old = xb_add(&bar[XB_XSUB(b.x)], 1u);
        const unsigned gen = old / nloc;
        if (old + 1u == (gen + 1u) * nloc) {
            __builtin_amdgcn_fence(__ATOMIC_RELEASE, "agent");
            asm volatile("s_waitcnt vmcnt(0)" ::: "memory");
            const unsigned og = xb_add(&bar[XB_TOP], 1u);
            const unsigned tg = og / nx;
            if (og + 1u == (tg + 1u) * nx) xb_add(&bar[XB_TOPGEN], 1u);
            else XB_SPIN(xb_ld(&bar[XB_TOPGEN]) == tg, bar);
            __builtin_amdgcn_fence(__ATOMIC_ACQUIRE, "agent");
            xb_add(&bar[XB_XGEN(b.x)], 1u);
            asm volatile("s_waitcnt vmcnt(0)" ::: "memory");
        } else {
            XB_SPIN(xb_ld(&bar[XB_XGEN(b.x)]) == gen, bar);
            __builtin_amdgcn_fence(__ATOMIC_ACQUIRE, "agent");
            asm volatile("s_waitcnt vmcnt(0)" ::: "memory");
        }
    }
    __syncthreads();
}
__global__ __launch_bounds__(512, 2) void mega(Params pk) {
    extern __shared__ __attribute__((aligned(16))) unsigned char smem[];
    cg::grid_group grid = cg::this_grid();
    LAS unsigned char* lds = (LAS unsigned char*)smem;
    const int ph_lo = pk.ph_lo, ph_hi = pk.ph_hi;
    volatile LAS unsigned* xst = (volatile LAS unsigned*)(lds + (LDS_BYTES - 16));
    if (threadIdx.x == 0) { xst[0] = 0u; xst[1] = 0u; }
    const XcdBarrier xb = xcd_barrier_post((unsigned*)(pk.ws + WS_SSQ), xst);
    for (int ph = ph_lo; ph < ph_hi; ++ph) {
        if (ph == ph_lo + 1) grid.sync();
        else if (ph > ph_lo + 1) xcd_barrier(xb);
        CPar p = params_ptr();
        unsigned char* ws = p->ws;
        bf16_t *HB = (bf16_t*)(ws + WS_HB), *Z = (bf16_t*)(ws + WS_Z), *XBC = (bf16_t*)(ws + WS_XBC), *U = (bf16_t*)(ws + WS_U), *Q = (bf16_t*)(ws + WS_Q), *G = (bf16_t*)(ws + WS_G);
        float *DT = (float*)(ws + WS_DT), *XM = (float*)(ws + WS_XMETA);
        const int l = ph >> 3, sub = ph & 7;
        pg8::StaticOrder S;
        if (sub == 0) {
#ifndef SKIP0
            phase_prep(p, l);
#endif
        } else if (sub == 1) {
            S.init(NROWS, N1, lgdim(), lbid());
            EpiIn E{Z, XBC, U, Q, G, DT, p->out, p->in[I_QN] + l * 64, p->in[I_KN] + l * 64, l};
#ifndef SKIP1
            pg8::gemm_phase(lds, pg8::Gemm{HB, (const bf16_t*)(ws + W_BT1), NROWS, N1, 1024, 1024, 1024}, S, E);
#endif
        } else if (sub == 2) {
#ifndef SKIP2
            phase_mixers(p, l, (float*)smem);
#endif
        } else if (sub == 3) {
            ssd_norm_rows(p);
            S.init(NROWS, 2048, lgdim(), lbid());
            EpiGlu E{XBC};
            pg8::gemm_phase(lds, pg8::Gemm{U, (const bf16_t*)(ws + W_GLU), NROWS, 2048, 512, 512, 512}, S, E);
        } else if (sub == 4) {
            S.init(NROWS, 1024, lgdim(), lbid());
            for (int call = 0; call < 2; ++call) {
                EpiMix E; pg8::Gemm g;
                if (call == 0) { E = EpiMix{HB, G, XBC, 0}; g = pg8::Gemm{Z, (const bf16_t*)(ws + W_LA), NROWS, 1024, 1024, 1024, 1024}; }
                else { E = EpiMix{HB, G + 2048, nullptr, 1}; g = pg8::Gemm{Q, (const bf16_t*)(ws + W_LC), NROWS, 1024, 512, 512, 512}; }
#ifndef SKIP3
                pg8::gemm_phase(lds, g, S, E);
#endif
            }
        } else if (sub == 5) {
            S.init(NROWS, 1024, lgdim(), lbid());
            EpiRes E{p->out, XM, (bf16_t*)(ws + WS_XB2), (float*)(ws + WS_SSQX) + (size_t)l * NROWS};
            pg8::gemm_phase(lds, pg8::Gemm{HB, (const bf16_t*)(ws + W_OUT), NROWS, 1024, 1024, 1024, 1024}, S, E);
        } else if (sub == 6) {
            S.init(NROWS, 4096, lgdim(), lbid());
            EpiUp E{(bf16_t*)(ws + WS_ACT), (const float*)(ws + WS_SSQX) + (size_t)l * NROWS};
            pg8::gemm_phase(lds, pg8::Gemm{(const bf16_t*)(ws + WS_XB2), (const bf16_t*)(ws + W_UP), NROWS, 4096, 1024, 1024, 1024}, S, E);
        } else {
            S.init(NROWS, 1024, lgdim(), lbid());
            EpiRes E{p->out, XM, nullptr, nullptr};
            pg8::gemm_phase(lds, pg8::Gemm{(const bf16_t*)(ws + WS_ACT), (const bf16_t*)(ws + W_DOWN), NROWS, 1024, 4096, 4096, 4096}, S, E);
        }
    }
}

extern "C" void kernel_launch(void* const* d_in, const int* in_sizes, int n_in, void* d_out, int out_size, void* d_ws, size_t ws_size, hipStream_t stream) {
    static int grid = 0;
    if (grid == 0) {
        if (n_in != 34 || (size_t)out_size != O_END || ws_size < WS_END) { fprintf(stderr, "kernel_launch: unexpected shapes n_in %d out %d ws %zu (need %zu)\n", n_in, out_size, ws_size, (size_t)WS_END); grid = -1; return; }
        int dev = 0, cus = 0, per_cu = 0;
        hipGetDevice(&dev); hipDeviceGetAttribute(&cus, hipDeviceAttributeMultiprocessorCount, dev);
        if (hipFuncSetAttribute((const void*)mega, hipFuncAttributeMaxDynamicSharedMemorySize, LDS_BYTES) != hipSuccess) { fprintf(stderr, "kernel_launch: hipFuncSetAttribute failed\n"); grid = -1; return; }
        if (hipOccupancyMaxActiveBlocksPerMultiprocessor(&per_cu, (const void*)mega, 512, LDS_BYTES) != hipSuccess || per_cu < 1) { fprintf(stderr, "kernel_launch: occupancy query says %d\n", per_cu); per_cu = 1; }
        (void)hipGetLastError();
        grid = cus * per_cu;
    }
    if (grid < 0) return;
    if (hipMemsetAsync((char*)d_ws + WS_CTR, 0, 4096, stream) != hipSuccess || hipMemsetAsync((char*)d_ws + WS_SSQ, 0, 16384 + 2ull * NROWS * 4, stream) != hipSuccess) { fprintf(stderr, "kernel_launch: memset failed\n"); return; }
    Params p{};
    for (int i = 0; i < 34; ++i) p.in[i] = (const float*)d_in[i];
    p.out = (float*)d_out; p.ws = (unsigned char*)d_ws;
#if MULTI_LAUNCH
    for (int ph = 0; ph < 16; ++ph) { p.ph_lo = ph; p.ph_hi = ph + 1; hipLaunchKernelGGL(mega, dim3(grid), dim3(512), LDS_BYTES, stream, p); }
#else
    p.ph_lo = 0; p.ph_hi = 16;
    void* args[] = {&p};
    hipError_t e = hipLaunchCooperativeKernel((const void*)mega, dim3(grid), dim3(512), args, LDS_BYTES, stream);
    if (e != hipSuccess) fprintf(stderr, "cooperative launch failed: %s (grid %d)\n", hipGetErrorString(e), grid);
#endif
}
```

```cpp
#include <hip/hip_runtime.h>
#include <hip/hip_cooperative_groups.h>
#include <cstdio>
#include <cstdint>
namespace cg = cooperative_groups;

#ifndef MULTI_LAUNCH
#define MULTI_LAUNCH 0
#endif

typedef unsigned short bf16_t;
typedef short bf16x8 __attribute__((ext_vector_type(8)));
typedef float f32x4 __attribute__((ext_vector_type(4)));
typedef unsigned u32x4 __attribute__((ext_vector_type(4)));
typedef unsigned u32x2 __attribute__((ext_vector_type(2)));
#define LAS __attribute__((address_space(3)))

constexpr int D = 1024, NROWS = 67072, NS0 = 65536, NM0 = 66560;
constexpr int TP = 2064, TS = 64, NB_P = 32, NB_S = 16, PAST = 2048;
constexpr int IN_COLS = 7440, N1 = 7680;
constexpr int SSQ_SLOTS = NM0 + 32 * 32;
constexpr float EPS = 1e-6f;
constexpr size_t O_YP = 0, O_YS = 67108864ull, O_KP = O_YS + 1048576ull, SZ_KP = 2ull * 32 * 2064 * 512, O_VP = O_KP + SZ_KP,
                 O_CONVP = O_VP + SZ_KP, O_SSDP = O_CONVP + 2ull * 32 * 3 * 1280, O_S5RP = O_SSDP + 2ull * 32 * 16 * 4096, O_S5IP = O_S5RP + 2ull * 32 * 2048,
                 O_KS = O_S5IP + 2ull * 32 * 2048, O_VS = O_KS + 2ull * 16 * 64 * 512, O_CONVS = O_VS + 2ull * 16 * 64 * 512, O_SSDS = O_CONVS + 2ull * 16 * 3 * 1280,
                 O_S5RS = O_SSDS + 2ull * 16 * 16 * 4096, O_S5IS = O_S5RS + 2ull * 16 * 2048, O_END = O_S5IS + 2ull * 16 * 2048;
constexpr size_t W_BT1 = 0, W_GLU = W_BT1 + (size_t)N1 * 1024 * 2, W_LA = W_GLU + 2048ull * 512 * 2, W_LC = W_LA + 1024ull * 1024 * 2, W_OUT = W_LC + 1024ull * 512 * 2,
                 W_UP = W_OUT + 1024ull * 1024 * 2, W_DOWN = W_UP + 4096ull * 1024 * 2, W_END = W_DOWN + 4096ull * 1024 * 2;
constexpr size_t WS_CTR = W_END, WS_XMETA = WS_CTR + 4096, WS_HB = WS_XMETA + 512ull * 1024 * 4, WS_Z = WS_HB + (size_t)NROWS * 1024 * 2, WS_XBC = WS_Z + (size_t)NROWS * 1024 * 2,
                 WS_U = WS_XBC + (size_t)NROWS * 1280 * 2, WS_Q = WS_U + (size_t)NROWS * 512 * 2, WS_G = WS_Q + (size_t)NROWS * 512 * 2, WS_DT = WS_G + (size_t)NROWS * 3072 * 2,
                 WS_SSQ = WS_DT + (size_t)NROWS * 16 * 4, WS_END = WS_SSQ + (size_t)SSQ_SLOTS * 16 * 4;
constexpr size_t WS_XB2 = WS_DT - (size_t)NROWS * 1024 * 2;
constexpr size_t WS_SSQX = WS_SSQ + 16384;
constexpr size_t WS_ACT = WS_Z;
static_assert(WS_ACT + (size_t)NROWS * 4096 * 2 <= WS_XB2, "ACT overlay");
static_assert(WS_SSQX + 2ull * NROWS * 4 <= WS_END, "ssqx");
constexpr int LDS_BYTES = 147456;

struct Params {
    const float* in[34];
    float* out;
    unsigned char* ws;
    int ph_lo, ph_hi;
};
typedef const __attribute__((address_space(4))) Params* CPar;
__device__ __forceinline__ CPar params_ptr() { CPar q = (CPar)__builtin_amdgcn_kernarg_segment_ptr(); asm volatile("" : "+s"(q)); return q; }
#define PIN(i) (p->in[i])
enum { I_XP = 0, I_XS, I_CK, I_CV, I_SCONV, I_SSSD, I_S5R, I_S5I, I_META, I_NMIX, I_WIN, I_CONVW, I_CONVB, I_DTB, I_ALOG, I_DSSD, I_NSSD, I_LRE, I_LIM, I_LSTEP, I_BRE, I_BIM,
       I_CRE, I_CIM, I_DS5, I_WGLU, I_QN, I_KN, I_WLA, I_WLC, I_WOUT, I_NFFN, I_WUP, I_WDOWN };

__device__ __forceinline__ int ltid() { int t = threadIdx.x; asm volatile("" : "+v"(t)); return t; }
__device__ __forceinline__ int lbid() { int t = blockIdx.x; asm volatile("" : "+s"(t)); return t; }
__device__ __forceinline__ int lgdim() { int t = gridDim.x; asm volatile("" : "+s"(t)); return t; }

__device__ __forceinline__ float bf2f(bf16_t v) { return __uint_as_float((unsigned)v << 16); }
__device__ __forceinline__ unsigned pk2(float lo, float hi) { unsigned r; asm volatile("v_cvt_pk_bf16_f32 %0, %1, %2" : "=v"(r) : "v"(lo), "v"(hi)); return r; }
__device__ __forceinline__ float lo_f(unsigned w) { return __uint_as_float(w << 16); }
__device__ __forceinline__ float hi_f(unsigned w) { return __uint_as_float(w & 0xffff0000u); }
__device__ __forceinline__ u32x2 ld_l2_u32x2(const void* ptr) { const unsigned long long v = __hip_atomic_load((const unsigned long long*)ptr, __ATOMIC_RELAXED, __HIP_MEMORY_SCOPE_AGENT); u32x2 r; r[0] = (unsigned)v; r[1] = (unsigned)(v >> 32); return r; }
__device__ __forceinline__ float sigmoidf_(float v) { return __builtin_amdgcn_rcpf(1.f + __expf(-v)); }
__device__ __forceinline__ float siluf_(float v) { return v * sigmoidf_(v); }
__device__ __forceinline__ float geluf_(float y) { const float a = 0.7978845608f * (y + 0.044715f * y * y * y); const float t = __expf(2.f * a); return 0.5f * y * (2.f - 2.f * __builtin_amdgcn_rcpf(t + 1.f)); }
__device__ __forceinline__ float wave_sum(float v) {
#pragma unroll
    for (int o = 1; o < 64; o <<= 1) v += __shfl_xor(v, o);
    return v;
}
__device__ __forceinline__ void sincos_red(double x, float& sn, float& cs) {
    const double k = __builtin_rint(x * 0.63661977236758134308);
    const float r = (float)__builtin_fma(-k, 1.57079632679489661923, x), r2 = r * r;
    const float sp = r + r * r2 * (-1.6666667163e-01f + r2 * (8.3333337680e-03f + r2 * (-1.9841270114e-04f + r2 * 2.7557314297e-06f)));
    const float cp = 1.f + r2 * (-0.5f + r2 * (4.1666667908e-02f + r2 * (-1.3888889225e-03f + r2 * (2.4801587642e-05f - r2 * 2.7557314297e-07f))));
    const int q = ((int)k) & 3;
    sn = (q == 0) ? sp : (q == 1) ? cp : (q == 2) ? -sp : -cp;
    cs = (q == 0) ? cp : (q == 1) ? -sp : (q == 2) ? -cp : sp;
}
__device__ __forceinline__ int row_of(int s, int t) { return s < 32 ? (t < 16 ? NM0 + s * 16 + t : s * 2048 + t - 16) : NS0 + (s - 32) * 64 + t; }
__device__ __forceinline__ int ssq_slot(int r) { return r < NM0 ? r : NM0 + ((r - NM0) >> 4) * 32 + ((r - NM0) & 15); }
__device__ __forceinline__ float* xloc(CPar p, int r) { return r < NM0 ? p->out + (size_t)r * 1024 : (float*)(p->ws + WS_XMETA) + (size_t)(r - NM0) * 1024; }
__device__ __forceinline__ size_t k_off(int l, int r) {
    if (r < NS0) return O_KP + ((size_t)(l * 32 + (r >> 11)) * 2064 + 16 + (r & 2047)) * 512;
    if (r < NM0) { const int rs = r - NS0; return O_KS + ((size_t)(l * 16 + (rs >> 6)) * 64 + (rs & 63)) * 512; }
    const int rm = r - NM0; return O_KP + ((size_t)(l * 32 + (rm >> 4)) * 2064 + (rm & 15)) * 512;
}

namespace pg8 {
constexpr int BM = 256, BK = 64, HALF = 128, HTB = HALF * BK * 2, STAGE_BYTES = 8 * HTB, NXCD = 8, WGM = 8;
__host__ __device__ __forceinline__ int lds_byte(int r, int c) { const int st = (r >> 4) * 2 + (c >> 5), rr = r & 15, cc = c & 31, ob = rr * 64 + cc * 2; return st * 1024 + (ob ^ (((ob >> 9) & 1) << 5)); }
__host__ __device__ __forceinline__ void stage_rc(int b, int& R, int& C) { const int st = b / 1024, sb = b % 1024, swz = sb ^ (((sb >> 9) & 1) << 5); R = (st >> 1) * 16 + swz / 64; C = (st & 1) * 32 + (swz % 64) / 2; }
struct Unit { int pm, pn; };
struct Gemm { const bf16_t* A; const bf16_t* Bt; int M, N, K, lda, ldb; };
struct StaticOrder {
    int nM, nN, nwg, G, c;
    __device__ void init(int M, int N, int G_, int c_) { nM = M / BM; nN = N / BM; nwg = nM * nN; G = G_; c = c_; }
    __device__ bool next(int i, Unit& u) const {
        const long L = (long)i * G + c; if (L >= nwg) return false;
        int wgid = (int)L; { const int q = nwg / NXCD, r = nwg % NXCD, xcd = wgid % NXCD, off = wgid / NXCD; wgid = (xcd < r ? xcd * (q + 1) : r * (q + 1) + (xcd - r) * q) + off; }
        const int nig = WGM * nN, gid = wgid / nig, fm = gid * WGM, gsz = (nM - fm) < WGM ? (nM - fm) : WGM;
        u.pm = fm + ((wgid % nig) % gsz); u.pn = (wgid % nig) / gsz; return true;
    }
};
template <class Epi>
__device__ __forceinline__ void gemm_phase(LAS unsigned char* lds, const Gemm g, const StaticOrder& S, const Epi& E) {
    const int tid = ltid(), wid = __builtin_amdgcn_readfirstlane(tid >> 6), lane = tid & 63, wr = wid >> 2, wc = wid & 3, fr = lane & 15, fq = lane >> 4;
    const int K = g.K, nt = K / BK;
    unsigned voffA[2], voffB[2];
#pragma unroll
    for (int i = 0; i < 2; ++i) { int R, C; stage_rc(tid * 16 + i * 8192, R, C); voffA[i] = (unsigned)(R * g.lda + C) * 2u; voffB[i] = (unsigned)(R * g.ldb + C) * 2u; }
    const size_t kstep = (size_t)(BK * 2);
    const size_t hstepA = (size_t)HALF * g.lda * 2, hstepB = (size_t)HALF * g.ldb * 2;
    const size_t tstepA = 2 * hstepA, tstepB = 2 * hstepB;
    const unsigned ldsw = (unsigned)wid * 1024u;
    const int aoff = lds_byte(wr * 64 + fr, fq * 8), boff = lds_byte(wc * 32 + fr, fq * 8);
#define PG8_SA(b, h) (((b) * 2 + (h)) * HTB)
#define PG8_SB(b, h) ((4 + (b) * 2 + (h)) * HTB)
#define PG8_STAGE(bufoff, gbase, voff) do { _Pragma("unroll") for (int _i = 0; _i < 2; ++_i) \
        __builtin_amdgcn_global_load_lds((const unsigned*)((const char*)(gbase) + (voff)[_i]), (LAS unsigned*)(lds + (bufoff) + ldsw + _i * 8192), 16, 0, 0); } while (0)
#define PG8_LDA(dst, b, h) do { _Pragma("unroll") for (int m = 0; m < 4; ++m) _Pragma("unroll") for (int k = 0; k < 2; ++k) dst[m][k] = *(const LAS bf16x8*)(lds + PG8_SA(b, h) + aoff + m * 2048 + k * 1024); } while (0)
#define PG8_LDB(dst, b, h) do { _Pragma("unroll") for (int n = 0; n < 2; ++n) _Pragma("unroll") for (int k = 0; k < 2; ++k) dst[n][k] = *(const LAS bf16x8*)(lds + PG8_SB(b, h) + boff + n * 2048 + k * 1024); } while (0)
#define PG8_MMA(ai, bj, At, Bt) do { __builtin_amdgcn_s_setprio(1); _Pragma("unroll") for (int m = 0; m < 4; ++m) _Pragma("unroll") for (int n = 0; n < 2; ++n) _Pragma("unroll") for (int k = 0; k < 2; ++k) \
        acc[ai][bj][m][n] = __builtin_amdgcn_mfma_f32_16x16x32_bf16(Bt[n][k], At[m][k], acc[ai][bj][m][n], 0, 0, 0); __builtin_amdgcn_s_setprio(0); } while (0)
#define PG8_WAIT_V(n) asm volatile("s_waitcnt vmcnt(" #n ")" ::: "memory")
#define PG8_WAIT_L(n) asm volatile("s_waitcnt lgkmcnt(" #n ")" ::: "memory")
#define PG8_BAR __builtin_amdgcn_s_barrier()
#define PG8_SCHED __builtin_amdgcn_sched_barrier(0)
    Unit cur, nxt; int ui = 0;
    if (!S.next(0, cur)) return;
    f32x4 acc[2][2][4][2];
#pragma unroll
    for (int a = 0; a < 2; ++a)
#pragma unroll
        for (int b = 0; b < 2; ++b)
#pragma unroll
            for (int m = 0; m < 4; ++m)
#pragma unroll
                for (int n = 0; n < 2; ++n) acc[a][b][m][n] = (f32x4){0.f, 0.f, 0.f, 0.f};
    bf16x8 At[4][2], B0[2][2], B1[2][2];
    const char* cA = (const char*)g.A + (size_t)cur.pm * tstepA; const char* cB = (const char*)g.Bt + (size_t)cur.pn * tstepB;
    PG8_STAGE(PG8_SB(0, 0), cB, voffB); PG8_STAGE(PG8_SA(0, 0), cA, voffA); PG8_STAGE(PG8_SB(0, 1), cB + hstepB, voffB); PG8_STAGE(PG8_SA(0, 1), cA + hstepA, voffA);
    if (wr == 1) PG8_BAR;
    PG8_WAIT_V(4); PG8_BAR;
    PG8_STAGE(PG8_SB(1, 0), cB + kstep, voffB); PG8_STAGE(PG8_SA(1, 0), cA + kstep, voffA); PG8_STAGE(PG8_SB(1, 1), cB + hstepB + kstep, voffB);
    PG8_WAIT_V(6); PG8_BAR;
    for (;;) {
        const bool has_next = S.next(ui + 1, nxt);
        const char* nA = has_next ? (const char*)g.A + (size_t)nxt.pm * tstepA : cA; const char* nB = has_next ? (const char*)g.Bt + (size_t)nxt.pn * tstepB : cB;
        for (int t = 0; t < nt; t += 2) {
            const bool last = (t == nt - 2);
            const char* a1 = cA + (size_t)(t + 1) * kstep;
            const char* a2 = last ? nA : cA + (size_t)(t + 2) * kstep; const char* b2 = last ? nB : cB + (size_t)(t + 2) * kstep;
            const char* a3 = a2 + kstep; const char* b3 = b2 + kstep;
            PG8_LDB(B0, 0, 0); PG8_SCHED; PG8_LDA(At, 0, 0); PG8_STAGE(PG8_SA(1, 1), a1 + hstepA, voffA);
            PG8_WAIT_L(8); PG8_BAR; PG8_WAIT_L(0); PG8_MMA(0, 0, At, B0); PG8_BAR; PG8_SCHED;
            PG8_LDB(B1, 0, 1); PG8_STAGE(PG8_SB(0, 0), b2, voffB);
            PG8_BAR; PG8_WAIT_L(0); PG8_MMA(0, 1, At, B1); PG8_BAR;
            PG8_LDA(At, 0, 1); PG8_STAGE(PG8_SA(0, 0), a2, voffA);
            PG8_BAR; PG8_WAIT_L(0); PG8_MMA(1, 0, At, B0); PG8_BAR; PG8_SCHED;
            PG8_STAGE(PG8_SB(0, 1), b2 + hstepB, voffB);
            PG8_WAIT_V(6); PG8_BAR; PG8_MMA(1, 1, At, B1); PG8_BAR;
            PG8_LDB(B0, 1, 0); PG8_SCHED; PG8_LDA(At, 1, 0); PG8_STAGE(PG8_SA(0, 1), a2 + hstepA, voffA);
            PG8_WAIT_L(8); PG8_BAR; PG8_WAIT_L(0); PG8_MMA(0, 0, At, B0); PG8_BAR; PG8_SCHED;
            PG8_LDB(B1, 1, 1); PG8_STAGE(PG8_SB(1, 0), b3, voffB);
            PG8_BAR; PG8_WAIT_L(0); PG8_MMA(0, 1, At, B1); PG8_BAR;
            PG8_LDA(At, 1, 1); PG8_STAGE(PG8_SA(1, 0), a3, voffA);
            PG8_BAR; PG8_WAIT_L(0); PG8_MMA(1, 0, At, B0); PG8_BAR; PG8_SCHED;
            PG8_STAGE(PG8_SB(1, 1), b3 + hstepB, voffB);
            PG8_WAIT_V(6); PG8_BAR; PG8_MMA(1, 1, At, B1); PG8_BAR;
        }
        E(acc, cur, wr, wc, fr, fq);
        if (!has_next) break;
#pragma unroll
        for (int a = 0; a < 2; ++a)
#pragma unroll
            for (int b = 0; b < 2; ++b)
#pragma unroll
                for (int m = 0; m < 4; ++m)
#pragma unroll
                    for (int n = 0; n < 2; ++n) acc[a][b][m][n] = (f32x4){0.f, 0.f, 0.f, 0.f};
        cur = nxt; cA = nA; cB = nB; ++ui;
    }
    PG8_WAIT_V(0);
    if (wr == 0) PG8_BAR;
    PG8_BAR;
#undef PG8_SA
#undef PG8_SB
#undef PG8_STAGE
#undef PG8_LDA
#undef PG8_LDB
#undef PG8_MMA
#undef PG8_WAIT_V
#undef PG8_WAIT_L
#undef PG8_BAR
#undef PG8_SCHED
}
}
using pg8::Unit;

struct EpiIn {
    bf16_t *Z, *XBC, *U, *Q, *G; float* DT; float* out; const float *qn, *kn; int layer;
    __device__ __forceinline__ void operator()(const f32x4 (&acc)[2][2][4][2], const Unit& u, int wr, int wc, int fr, int fq) const {
        const int pn = u.pn, rowb = u.pm * 256 + wr * 64 + fr, ctb = wc * 32 + fq * 4;
        if (pn < 11 || (pn >= 17 && pn < 29)) {
            bf16_t* base; int ld, col0; bool sig = false;
            if (pn < 4) { base = Z; ld = 1024; col0 = pn * 256; } else if (pn < 9) { base = XBC; ld = 1280; col0 = (pn - 4) * 256; }
            else if (pn < 11) { base = U; ld = 512; col0 = (pn - 9) * 256; } else { base = G; ld = 3072; col0 = (pn - 17) * 256; sig = true; }
#pragma unroll
            for (int ai = 0; ai < 2; ++ai)
#pragma unroll
                for (int m = 0; m < 4; ++m) { bf16_t* rp = base + (size_t)(rowb + ai * 128 + m * 16) * ld + col0 + wc * 32 + fq * 8;
#pragma unroll
                    for (int bj = 0; bj < 2; ++bj) { f32x4 v0 = acc[ai][bj][m][0], v1 = acc[ai][bj][m][1];
                        if (sig) {
#pragma unroll
                            for (int j = 0; j < 4; ++j) { v0[j] = sigmoidf_(v0[j]); v1[j] = sigmoidf_(v1[j]); } }
                        u32x4 o; o[0] = pk2(v0[0], v0[1]); o[1] = pk2(v0[2], v0[3]); o[2] = pk2(v1[0], v1[1]); o[3] = pk2(v1[2], v1[3]); *(u32x4*)(rp + bj * 128) = o; } }
        } else if (pn < 17) {
            const int seg = (pn - 11) >> 1, head = ((pn - 11) & 1) * 4 + wc;
            const float* nw = seg == 0 ? qn : kn;
            f32x4 wv[2][2];
#pragma unroll
            for (int bj = 0; bj < 2; ++bj)
#pragma unroll
                for (int n = 0; n < 2; ++n) wv[bj][n] = (seg < 2) ? *(const f32x4*)(nw + 32 * bj + 16 * n + 4 * fq) : (f32x4){1.f, 1.f, 1.f, 1.f};
#pragma unroll
            for (int ai = 0; ai < 2; ++ai)
#pragma unroll
                for (int m = 0; m < 4; ++m) { const int row = rowb + ai * 128 + m * 16;
                    float rs = 1.f;
                    if (seg < 2) { float ss = 0.f;
#pragma unroll
                        for (int bj = 0; bj < 2; ++bj)
#pragma unroll
                            for (int n = 0; n < 2; ++n) { const f32x4 v = acc[ai][bj][m][n]; ss += v[0] * v[0] + v[1] * v[1] + v[2] * v[2] + v[3] * v[3]; }
                        ss += __shfl_xor(ss, 16); ss += __shfl_xor(ss, 32);
                        rs = rsqrtf(ss * (1.f / 64.f) + EPS); }
                    if (seg == 0) { bf16_t* rp = Q + (size_t)row * 512 + head * 64 + 4 * fq;
#pragma unroll
                        for (int bj = 0; bj < 2; ++bj)
#pragma unroll
                            for (int n = 0; n < 2; ++n) { const f32x4 v = acc[ai][bj][m][n] * rs * wv[bj][n]; u32x2 o; o[0] = pk2(v[0], v[1]); o[1] = pk2(v[2], v[3]); *(u32x2*)(rp + 32 * bj + 16 * n) = o; }
                    } else { float* rp = out + k_off(layer, row) + (seg == 2 ? (row >= NS0 && row < NM0 ? (O_VS - O_KS) : (O_VP - O_KP)) : 0) + head * 64 + 4 * fq;
#pragma unroll
                        for (int bj = 0; bj < 2; ++bj)
#pragma unroll
                            for (int n = 0; n < 2; ++n) { const f32x4 v = acc[ai][bj][m][n] * rs * wv[bj][n]; *(f32x4*)(rp + 32 * bj + 16 * n) = v; } } }
        } else {
            if (wc == 0) {
#pragma unroll
                for (int ai = 0; ai < 2; ++ai)
#pragma unroll
                    for (int m = 0; m < 4; ++m) *(f32x4*)(DT + (size_t)(rowb + ai * 128 + m * 16) * 16 + 4 * fq) = acc[ai][0][m][0];
            }
        }
    }
};
struct EpiGlu {
    bf16_t* OB;
    __device__ __forceinline__ void operator()(const f32x4 (&acc)[2][2][4][2], const Unit& u, int wr, int wc, int fr, int fq) const {
        const int rowb = u.pm * 256 + wr * 64 + fr, colb = u.pn * 128 + wc * 32 + fq * 8;
#pragma unroll
        for (int ai = 0; ai < 2; ++ai)
#pragma unroll
            for (int m = 0; m < 4; ++m) { bf16_t* rp = OB + (size_t)(rowb + ai * 128 + m * 16) * 1024 + colb;
                const f32x4 a0 = acc[ai][0][m][0], g0 = acc[ai][1][m][0], a1 = acc[ai][0][m][1], g1 = acc[ai][1][m][1];
                u32x4 o; o[0] = pk2(a0[0] * sigmoidf_(g0[0]), a0[1] * sigmoidf_(g0[1])); o[1] = pk2(a0[2] * sigmoidf_(g0[2]), a0[3] * sigmoidf_(g0[3]));
                o[2] = pk2(a1[0] * sigmoidf_(g1[0]), a1[1] * sigmoidf_(g1[1])); o[3] = pk2(a1[2] * sigmoidf_(g1[2]), a1[3] * sigmoidf_(g1[3])); *(u32x4*)rp = o; }
    }
};
struct EpiMix {
    bf16_t* R; const bf16_t* G; const bf16_t* OB; int accum;
    __device__ __forceinline__ void operator()(const f32x4 (&acc)[2][2][4][2], const Unit& u, int wr, int wc, int fr, int fq) const {
        const int rowb = u.pm * 256 + wr * 64 + fr, colb = u.pn * 256 + wc * 32 + fq * 8;
#pragma unroll
        for (int ai = 0; ai < 2; ++ai)
#pragma unroll
            for (int m = 0; m < 4; ++m) { const int row = rowb + ai * 128 + m * 16;
                u32x4 gw[2], g1[2], ob[2]; u32x2 rw[2][2];
#pragma unroll
                for (int bj = 0; bj < 2; ++bj) { const int col = colb + bj * 128;
                    gw[bj] = *(const u32x4*)(G + (size_t)row * 3072 + col);
                    g1[bj] = (u32x4){0u, 0u, 0u, 0u}; ob[bj] = (u32x4){0u, 0u, 0u, 0u}; rw[bj][0] = (u32x2){0u, 0u}; rw[bj][1] = (u32x2){0u, 0u};
                    if (OB) { g1[bj] = *(const u32x4*)(G + (size_t)row * 3072 + 1024 + col); ob[bj] = *(const u32x4*)(OB + (size_t)row * 1024 + col); }
                    if (accum) { rw[bj][0] = ld_l2_u32x2(R + (size_t)row * 1024 + col); rw[bj][1] = ld_l2_u32x2(R + (size_t)row * 1024 + col + 4); } }
#pragma unroll
                for (int bj = 0; bj < 2; ++bj) { u32x4 o;
#pragma unroll
                    for (int n = 0; n < 2; ++n) { f32x4 v = acc[ai][bj][m][n];
                        const unsigned a0 = gw[bj][2 * n], a1 = gw[bj][2 * n + 1], b0 = g1[bj][2 * n], b1 = g1[bj][2 * n + 1], c0 = ob[bj][2 * n], c1 = ob[bj][2 * n + 1];
                        v = v * (f32x4){lo_f(a0), hi_f(a0), lo_f(a1), hi_f(a1)};
                        v = v + (f32x4){lo_f(b0), hi_f(b0), lo_f(b1), hi_f(b1)} * (f32x4){lo_f(c0), hi_f(c0), lo_f(c1), hi_f(c1)};
                        v = v + (f32x4){lo_f(rw[bj][n][0]), hi_f(rw[bj][n][0]), lo_f(rw[bj][n][1]), hi_f(rw[bj][n][1])};
                        o[2 * n] = pk2(v[0], v[1]); o[2 * n + 1] = pk2(v[2], v[3]); }
                    *(u32x4*)(R + (size_t)row * 1024 + colb + bj * 128) = o; } }
    }
};
struct EpiRes {
    float* out; float* xmeta; bf16_t* XB; float* ssq;
    __device__ __forceinline__ void operator()(const f32x4 (&acc)[2][2][4][2], const Unit& u, int wr, int wc, int fr, int fq) const {
        const int rowb = u.pm * 256 + wr * 64 + fr, colb = u.pn * 256 + wc * 32 + fq * 4;
        float* base = (u.pm * 256 < NM0) ? out : xmeta - (size_t)NM0 * 1024;
#pragma unroll
        for (int ai = 0; ai < 2; ++ai)
#pragma unroll
            for (int mh = 0; mh < 2; ++mh) {
                f32x4 xv[2][2][2];
#pragma unroll
                for (int m2 = 0; m2 < 2; ++m2)
#pragma unroll
                    for (int bj = 0; bj < 2; ++bj)
#pragma unroll
                        for (int n = 0; n < 2; ++n) xv[m2][bj][n] = __builtin_nontemporal_load((const f32x4*)(base + (size_t)(rowb + ai * 128 + (mh * 2 + m2) * 16) * 1024 + colb + bj * 128 + n * 16));
#pragma unroll
                for (int m2 = 0; m2 < 2; ++m2) { const int m = mh * 2 + m2, row = rowb + ai * 128 + m * 16; float* rp = base + (size_t)row * 1024 + colb; float ss = 0.f;
#pragma unroll
                    for (int bj = 0; bj < 2; ++bj)
#pragma unroll
                        for (int n = 0; n < 2; ++n) { const f32x4 v = xv[m2][bj][n] + acc[ai][bj][m][n]; *(f32x4*)(rp + bj * 128 + n * 16) = v;
                            if (XB) { u32x2 o; o[0] = pk2(v[0], v[1]); o[1] = pk2(v[2], v[3]); *(u32x2*)(XB + (size_t)row * 1024 + colb + bj * 128 + n * 16) = o; ss += (v[0] * v[0] + v[1] * v[1]) + (v[2] * v[2] + v[3] * v[3]); } }
                    if (XB) { ss += __shfl_xor(ss, 16); ss += __shfl_xor(ss, 32); if (fq == 0) __hip_atomic_fetch_add(ssq + row, ss, __ATOMIC_RELAXED, __HIP_MEMORY_SCOPE_AGENT); } } }
    }
};
struct EpiUp {
    bf16_t* ACT; const float* ssq;
    __device__ __forceinline__ void operator()(const f32x4 (&acc)[2][2][4][2], const Unit& u, int wr, int wc, int fr, int fq) const {
        const int rowb = u.pm * 256 + wr * 64 + fr, colb = u.pn * 256 + wc * 32 + fq * 4;
        float rs[2][4];
#pragma unroll
        for (int ai = 0; ai < 2; ++ai)
#pragma unroll
            for (int m = 0; m < 4; ++m) rs[ai][m] = ssq[rowb + ai * 128 + m * 16];
#pragma unroll
        for (int ai = 0; ai < 2; ++ai)
#pragma unroll
            for (int m = 0; m < 4; ++m) { bf16_t* rp = ACT + (size_t)(rowb + ai * 128 + m * 16) * 4096 + u.pn * 256 + wc * 32 + fq * 8; const float r_ = rsqrtf(rs[ai][m] * (1.f / 1024.f) + EPS);
#pragma unroll
                for (int bj = 0; bj < 2; ++bj) { f32x4 v0 = acc[ai][bj][m][0], v1 = acc[ai][bj][m][1];
#pragma unroll
                    for (int j = 0; j < 4; ++j) { const float r0 = fmaxf(v0[j] * r_, 0.f), r1 = fmaxf(v1[j] * r_, 0.f); v0[j] = r0 * r0; v1[j] = r1 * r1; }
                    u32x4 o; o[0] = pk2(v0[0], v0[1]); o[1] = pk2(v0[2], v0[3]); o[2] = pk2(v1[0], v1[1]); o[3] = pk2(v1[2], v1[3]); *(u32x4*)(rp + bj * 128) = o; } }
    }
};

__device__ __forceinline__ int perm32(int rho) { const int n = rho >> 4, i = rho & 15; return 8 * (i >> 2) + 4 * n + (i & 3); }
__device__ __forceinline__ int col_in(int n) {
    if (n < 2304) return n;
    if (n < 2816) return n + 16;
    if (n < 4352) { const int w0 = n - 2816, seg = w0 >> 9, w = w0 & 511, tile = w >> 8, ct = w & 255, bj = ct >> 7, wc = (ct >> 5) & 3, ww = ct & 31;
        return 2832 + seg * 512 + (tile * 4 + wc) * 64 + 32 * bj + ww; }
    if (n < 7424) return n + 16;
    if (n < 7440) return 2304 + (n - 7424);
    return -1;
}
template <int MAP, bool PERMALL = false>
__device__ __forceinline__ void prep_w(bf16_t* dst, const float* src, int K, int N, int ld, const float* scale, size_t gtid, size_t gsz) {
    const size_t items = (size_t)(K / 8) * N;
    for (size_t it = gtid; it < items; it += gsz) {
        const int n = (int)(it % N), k8 = (int)(it / N);
        const bool pm_ = PERMALL || MAP == 2 || (MAP == 1 && (n < 2816 || (n >= 4352 && n < 7424)));
        const int np = pm_ ? (n & ~31) + perm32(n & 31) : n;
        const int c = MAP == 1 ? col_in(np) : (MAP == 2 ? (((np >> 7) & 1) * 1024 + (np >> 8) * 128 + (np & 127)) : np);
        float v[8];
#pragma unroll
        for (int kk = 0; kk < 8; ++kk) { const int k = k8 * 8 + kk; float x = (c >= 0) ? src[(size_t)k * ld + c] : 0.f; if (scale) x *= scale[k]; v[kk] = x; }
        u32x4 o; o[0] = pk2(v[0], v[1]); o[1] = pk2(v[2], v[3]); o[2] = pk2(v[4], v[5]); o[3] = pk2(v[6], v[7]);
        *(u32x4*)(dst + (size_t)n * K + k8 * 8) = o;
    }
}
__device__ __forceinline__ void rmsnorm_rows(CPar p, const float* g, int from_inputs) {
    const int lane = ltid() & 63, gw = lbid() * 8 + (ltid() >> 6), ngw = lgdim() * 8;
    bf16_t* HB = (bf16_t*)(p->ws + WS_HB);
    f32x4 gv[4];
#pragma unroll
    for (int j = 0; j < 4; ++j) gv[j] = *(const f32x4*)(g + lane * 4 + 256 * j);
    for (int r = gw; r < NROWS; r += ngw) {
        float* xl = xloc(p, r);
        const float* src = xl;
        if (from_inputs) src = r < NS0 ? p->in[I_XP] + (size_t)r * 1024 : (r < NM0 ? p->in[I_XS] + (size_t)(r - NS0) * 1024 : p->in[I_META] + (size_t)((r - NM0) & 15) * 1024);
        f32x4 v[4]; float s = 0.f;
#pragma unroll
        for (int j = 0; j < 4; ++j) { v[j] = *(const f32x4*)(src + lane * 4 + 256 * j); s += (v[j][0] * v[j][0] + v[j][1] * v[j][1]) + (v[j][2] * v[j][2] + v[j][3] * v[j][3]); }
        const float rstd = rsqrtf(wave_sum(s) * (1.f / 1024.f) + EPS);
#pragma unroll
        for (int j = 0; j < 4; ++j) { if (from_inputs) *(f32x4*)(xl + lane * 4 + 256 * j) = v[j];
            const f32x4 h = v[j] * rstd * gv[j]; u32x2 o; o[0] = pk2(h[0], h[1]); o[1] = pk2(h[2], h[3]); *(u32x2*)(HB + (size_t)r * 1024 + lane * 4 + 256 * j) = o; }
    }
}
__device__ __forceinline__ void ssd_norm_rows(CPar p) {
    const int lane = ltid() & 63, gw = lbid() * 8 + (ltid() >> 6), ngw = lgdim() * 8;
    bf16_t* Z = (bf16_t*)(p->ws + WS_Z);
    for (int r = gw; r < NROWS; r += ngw) {
#pragma unroll
        for (int j = 0; j < 2; ++j) { u32x4* zp = (u32x4*)(Z + (size_t)r * 1024 + j * 512 + lane * 8); const u32x4 w = *zp;
            float f[8] = {lo_f(w[0]), hi_f(w[0]), lo_f(w[1]), hi_f(w[1]), lo_f(w[2]), hi_f(w[2]), lo_f(w[3]), hi_f(w[3])};
            float ss = 0.f;
#pragma unroll
            for (int i = 0; i < 8; ++i) ss += f[i] * f[i];
            const float rs = rsqrtf(wave_sum(ss) * (1.f / 512.f) + EPS);
            u32x4 o; o[0] = pk2(f[0] * rs, f[1] * rs); o[1] = pk2(f[2] * rs, f[3] * rs); o[2] = pk2(f[4] * rs, f[5] * rs); o[3] = pk2(f[6] * rs, f[7] * rs); *zp = o; }
    }
}
__device__ __forceinline__ void phase_prep(CPar p, int l) {
    const size_t gtid = (size_t)lbid() * 512 + ltid(), gsz = (size_t)lgdim() * 512;
    unsigned char* ws = p->ws;
    prep_w<1>((bf16_t*)(ws + W_BT1), p->in[I_WIN] + (size_t)l * 1024 * IN_COLS, 1024, N1, IN_COLS, nullptr, gtid, gsz);
    prep_w<2>((bf16_t*)(ws + W_GLU), p->in[I_WGLU] + (size_t)l * 512 * 2048, 512, 2048, 2048, nullptr, gtid, gsz);
    prep_w<0, true>((bf16_t*)(ws + W_LA), p->in[I_WLA] + (size_t)l * 1024 * 1024, 1024, 1024, 1024, p->in[I_NSSD] + l * 1024, gtid, gsz);
    prep_w<0, true>((bf16_t*)(ws + W_LC), p->in[I_WLC] + (size_t)l * 512 * 1024, 512, 1024, 1024, nullptr, gtid, gsz);
    prep_w<0>((bf16_t*)(ws + W_OUT), p->in[I_WOUT] + (size_t)l * 1024 * 1024, 1024, 1024, 1024, nullptr, gtid, gsz);
    prep_w<0, true>((bf16_t*)(ws + W_UP), p->in[I_WUP] + (size_t)l * 1024 * 4096, 1024, 4096, 4096, p->in[I_NFFN] + l * 1024, gtid, gsz);
    prep_w<0>((bf16_t*)(ws + W_DOWN), p->in[I_WDOWN] + (size_t)l * 4096 * 1024, 4096, 1024, 1024, nullptr, gtid, gsz);
    rmsnorm_rows(p, p->in[I_NMIX] + l * 1024, l == 0);
}

__device__ __forceinline__ bf16_t f2bf_(float v) { return (bf16_t)(pk2(v, v) & 0xffffu); }
__device__ __forceinline__ void ssd_item(CPar p, int l, int item, float* sm) {
    const int tid = ltid(), lane = tid & 63, wave = __builtin_amdgcn_readfirstlane(tid >> 6), rb = wave >> 1, chh = wave & 1, fr = lane & 15, fq = lane >> 4;
    const int s = item < 512 ? (item >> 4) : 32 + ((item - 512) >> 4), h = item & 15, g = h >> 3;
    const bool prompt = s < 32; const int b = prompt ? s : s - 32, T = prompt ? TP : TS;
    constexpr int LB = 72;
    bf16_t *Cb = (bf16_t*)sm, *Bb = Cb + 64 * LB, *XT = Bb + 64 * LB, *WB = XT + 64 * LB, *Mb = WB + 64 * LB, *Sb = Mb + 64 * LB;
    float *sRaw = (float*)(Sb + 64 * LB), *sW = sRaw + 67 * 192, *sdtA = sW + 5 * 192, *sacA = sdtA + 33 * 64, *sw = sacA + 33 * 64;
    const bf16_t* XBC = (const bf16_t*)(p->ws + WS_XBC); bf16_t* Z = (bf16_t*)(p->ws + WS_Z);
    const float* DT = (const float*)(p->ws + WS_DT);
    const float* cw = p->in[I_CONVW] + (size_t)l * 4 * 1280; const float* cb = p->in[I_CONVB] + (size_t)l * 1280;
    const float* hist = p->in[I_SCONV] + (size_t)(l * 16 + b) * 3 * 1280;
    const float dtb = p->in[I_DTB][l * 16 + h], aneg = -__expf(p->in[I_ALOG][l * 16 + h]), dsk = p->in[I_DSSD][l * 16 + h];
    float* sout = prompt ? p->out + O_SSDP + ((size_t)(l * 32 + b) * 16 + h) * 4096 : p->out + O_SSDS + ((size_t)(l * 16 + b) * 16 + h) * 4096;
    for (int i = tid; i < 5 * 192; i += 512) { const int k = i / 192, ch = i - k * 192; const int col = ch < 64 ? h * 64 + ch : (ch < 128 ? 1024 + g * 64 + (ch - 64) : 1152 + g * 64 + (ch - 128));
        sW[i] = k < 4 ? cw[k * 1280 + col] : cb[col]; }
    f32x4 accS[2];
#pragma unroll
    for (int c2 = 0; c2 < 2; ++c2)
#pragma unroll
        for (int r = 0; r < 4; ++r) { const int pp = rb * 16 + fq * 4 + r, n = chh * 32 + c2 * 16 + fr;
            const float v = prompt ? 0.f : p->in[I_SSSD][((size_t)(l * 16 + b) * 16 + h) * 4096 + pp * 64 + n]; accS[c2][r] = v; Sb[pp * LB + n] = f2bf_(v); }
    const int nch = (T + 63) >> 6;
    { const int wv = tid >> 6, ln = tid & 63; float xv[5];
#pragma unroll
        for (int r = 0; r < 5; ++r) { const int c = wv + 8 * r, t = c * 64 + ln; xv[r] = (c < nch && t < T) ? DT[(size_t)row_of(s, t) * 16 + h] + dtb : -1e30f; }
#pragma unroll
        for (int r = 0; r < 5; ++r) { const int c = wv + 8 * r;
            if (c < nch) { const float x = xv[r]; const float dtv = x < -1e29f ? 0.f : (x > 20.f ? x : log1pf(__expf(x))); float cs = dtv * aneg;
#pragma unroll
                for (int o = 1; o < 64; o <<= 1) { const float nb = __shfl_up(cs, o); if (ln >= o) cs += nb; }
                sdtA[c * 64 + ln] = dtv; sacA[c * 64 + ln] = cs; } } }
    u32x4 pf[4];
#define SSD_ISSUE(cc) do { _Pragma("unroll") for (int it4 = 0; it4 < 4; ++it4) { const int pi = tid + it4 * 512; pf[it4] = (u32x4){0u, 0u, 0u, 0u}; \
        if (pi < 67 * 24) { const int rl = pi / 24, pc = pi - rl * 24, seg = pc >> 3, q8 = pc & 7, tt = (cc) * 64 - 3 + rl; \
            const int col = (seg == 0 ? h * 64 : (seg == 1 ? 1024 + g * 64 : 1152 + g * 64)) + q8 * 8; \
            if (tt >= 0 && tt < T) pf[it4] = *(const u32x4*)(XBC + (size_t)row_of(s, tt) * 1280 + col); } } } while (0)
#define SSD_FRAG(P, r0, ks) (*(const bf16x8*)((P) + ((r0) + fr) * LB + (ks) * 32 + fq * 8))
    SSD_ISSUE(0);
#pragma unroll 1
    for (int c = 0; c < nch; ++c) {
        const int t0 = c * 64; const float* sdt = sdtA + t0; const float* sac = sacA + t0;
        __syncthreads();
#pragma unroll
        for (int it4 = 0; it4 < 4; ++it4) { const int pi = tid + it4 * 512;
            if (pi < 67 * 24) { const int rl = pi / 24, pc = pi - rl * 24, seg = pc >> 3, q8 = pc & 7, tt = t0 - 3 + rl;
                const u32x4 w = pf[it4];
                f32x4 f0 = {lo_f(w[0]), hi_f(w[0]), lo_f(w[1]), hi_f(w[1])}, f1 = {lo_f(w[2]), hi_f(w[2]), lo_f(w[3]), hi_f(w[3])};
                if (tt < 0 && !prompt) { const int col = (seg == 0 ? h * 64 : (seg == 1 ? 1024 + g * 64 : 1152 + g * 64)) + q8 * 8; const float* hp = hist + (3 + tt) * 1280 + col; f0 = *(const f32x4*)hp; f1 = *(const f32x4*)(hp + 4); }
                float* dp = sRaw + rl * 192 + seg * 64 + q8 * 8; *(f32x4*)dp = f0; *(f32x4*)(dp + 4) = f1; } }
        if (tid < 64) sw[tid] = __expf(sac[63] - sac[tid]) * sdt[tid];
        if (c + 1 < nch) SSD_ISSUE(c + 1);
        bf16_t zq[2][4];
#pragma unroll
        for (int c2 = 0; c2 < 2; ++c2)
#pragma unroll
            for (int r = 0; r < 4; ++r) { const int t = t0 + rb * 16 + fq * 4 + r; zq[c2][r] = (t < T) ? Z[(size_t)row_of(s, t) * 1024 + h * 64 + chh * 32 + c2 * 16 + fr] : (bf16_t)0; }
        __syncthreads();
        if (tid < 384) { const int ch = tid % 192, tlb = (tid / 192) * 32, cc = ch & 63;
            const float w0 = sW[ch], w1 = sW[192 + ch], w2 = sW[384 + ch], w3 = sW[576 + ch], bias = sW[768 + ch];
            float r0 = sRaw[(tlb + 0) * 192 + ch], r1 = sRaw[(tlb + 1) * 192 + ch], r2 = sRaw[(tlb + 2) * 192 + ch];
            float ov[32];
#pragma unroll
            for (int i2 = 0; i2 < 32; ++i2) { const float r3 = sRaw[(tlb + i2 + 3) * 192 + ch];
                const float v = bias + w0 * r0 + w1 * r1 + w2 * r2 + w3 * r3; ov[i2] = (t0 + tlb + i2 < T) ? siluf_(v) : 0.f; r0 = r1; r1 = r2; r2 = r3; }
            if (ch < 128) { bf16_t* dst = (ch < 64 ? XT : WB) + cc * LB + tlb;
#pragma unroll
                for (int q4 = 0; q4 < 4; ++q4) { u32x4 w;
#pragma unroll
                    for (int c4 = 0; c4 < 4; ++c4) { const int i2 = q4 * 8 + c4 * 2; const float s0 = ch < 64 ? 1.f : sw[tlb + i2], s1 = ch < 64 ? 1.f : sw[tlb + i2 + 1]; w[c4] = pk2(ov[i2] * s0, ov[i2 + 1] * s1); }
                    *(u32x4*)(dst + q4 * 8) = w; } }
            if (ch >= 64) { bf16_t* dst = (ch < 128 ? Bb : Cb) + tlb * LB + cc;
#pragma unroll
                for (int i2 = 0; i2 < 32; ++i2) dst[i2 * LB] = f2bf_(ov[i2]); } }
        __syncthreads();
        f32x4 acc2[2];
        { const bf16x8 aC0 = SSD_FRAG(Cb, rb * 16, 0), aC1 = SSD_FRAG(Cb, rb * 16, 1);
#pragma unroll
            for (int c2 = 0; c2 < 2; ++c2) { const int j0 = chh * 32 + c2 * 16;
                f32x4 m = {0.f, 0.f, 0.f, 0.f};
                if (j0 <= rb * 16 + 15) { m = __builtin_amdgcn_mfma_f32_16x16x32_bf16(aC0, SSD_FRAG(Bb, j0, 0), m, 0, 0, 0); m = __builtin_amdgcn_mfma_f32_16x16x32_bf16(aC1, SSD_FRAG(Bb, j0, 1), m, 0, 0, 0); }
                const int j = j0 + fr; const float acj = sac[j], dtj = sdt[j];
#pragma unroll
                for (int r = 0; r < 4; ++r) { const int tl = rb * 16 + fq * 4 + r; Mb[tl * LB + j] = f2bf_(j <= tl ? m[r] * __expf(sac[tl] - acj) * dtj : 0.f); }
                f32x4 y = {0.f, 0.f, 0.f, 0.f};
                y = __builtin_amdgcn_mfma_f32_16x16x32_bf16(aC0, SSD_FRAG(Sb, j0, 0), y, 0, 0, 0); y = __builtin_amdgcn_mfma_f32_16x16x32_bf16(aC1, SSD_FRAG(Sb, j0, 1), y, 0, 0, 0);
#pragma unroll
                for (int r = 0; r < 4; ++r) y[r] *= __expf(sac[rb * 16 + fq * 4 + r]);
                acc2[c2] = y; }
            const bf16x8 aX0 = SSD_FRAG(XT, rb * 16, 0), aX1 = SSD_FRAG(XT, rb * 16, 1); const float eL = __expf(sac[63]);
#pragma unroll
            for (int c2 = 0; c2 < 2; ++c2) { const int n0 = chh * 32 + c2 * 16; f32x4 sv = accS[c2] * eL;
                sv = __builtin_amdgcn_mfma_f32_16x16x32_bf16(aX0, SSD_FRAG(WB, n0, 0), sv, 0, 0, 0); sv = __builtin_amdgcn_mfma_f32_16x16x32_bf16(aX1, SSD_FRAG(WB, n0, 1), sv, 0, 0, 0); accS[c2] = sv; } }
        __syncthreads();
        { const bf16x8 aM0 = SSD_FRAG(Mb, rb * 16, 0), aM1 = SSD_FRAG(Mb, rb * 16, 1);
#pragma unroll
            for (int c2 = 0; c2 < 2; ++c2) { const int p0 = chh * 32 + c2 * 16, pp = p0 + fr; f32x4 y = acc2[c2];
                y = __builtin_amdgcn_mfma_f32_16x16x32_bf16(aM0, SSD_FRAG(XT, p0, 0), y, 0, 0, 0); y = __builtin_amdgcn_mfma_f32_16x16x32_bf16(aM1, SSD_FRAG(XT, p0, 1), y, 0, 0, 0);
#pragma unroll
                for (int r = 0; r < 4; ++r) { const int tl = rb * 16 + fq * 4 + r, t = t0 + tl;
                    if (t < T) { bf16_t* zp = Z + (size_t)row_of(s, t) * 1024 + h * 64 + pp; const float yy = (y[r] + dsk * bf2f(XT[pp * LB + tl])) * siluf_(bf2f(zq[c2][r])); *zp = f2bf_(yy); } } }
#pragma unroll
            for (int c2 = 0; c2 < 2; ++c2)
#pragma unroll
                for (int r = 0; r < 4; ++r) Sb[(rb * 16 + fq * 4 + r) * LB + chh * 32 + c2 * 16 + fr] = f2bf_(accS[c2][r]); }
    }
    __syncthreads();
#pragma unroll
    for (int c2 = 0; c2 < 2; ++c2)
#pragma unroll
        for (int r = 0; r < 4; ++r) sout[(rb * 16 + fq * 4 + r) * 64 + chh * 32 + c2 * 16 + fr] = accS[c2][r];
    float* cout_ = prompt ? p->out + O_CONVP + (size_t)(l * 32 + b) * 3 * 1280 : p->out + O_CONVS + (size_t)(l * 16 + b) * 3 * 1280;
    for (int idx = tid; idx < 3 * 192; idx += 512) { const int k = idx / 192, ch = idx - k * 192;
        if (ch >= 64 && (h & 7) != 0) continue;
        const int col = ch < 64 ? h * 64 + ch : (ch < 128 ? 1024 + g * 64 + (ch - 64) : 1152 + g * 64 + (ch - 128));
        cout_[k * 1280 + col] = bf2f(XBC[(size_t)row_of(s, T - 3 + k) * 1280 + col]); }
    __syncthreads();
#undef SSD_ISSUE
#undef SSD_FRAG
}

__device__ __forceinline__ void s5_item(CPar p, int l, int s, int g, float* wl) {
    const int lane = ltid() & 63, fr = lane & 15, fq = lane >> 4;
    const bool prompt = s < 32; const int b = prompt ? s : s - 32, T = prompt ? TP : TS, nblk = T >> 4;
    constexpr int LBX = 136;
    bf16_t* Xb = (bf16_t*)wl;
    bf16_t* U = (bf16_t*)(p->ws + WS_U);
    const int gp = (l * 32 + g) * 64 + lane;
    const float lr = p->in[I_LRE][gp], li = p->in[I_LIM][gp], step = expf(p->in[I_LSTEP][l * 32 + g]);
    float sn, cs; sincos_red((double)li * (double)step, sn, cs);
    const float mag = expf(lr * step), ab_re = mag * cs, ab_im = mag * sn;
    const float den = lr * lr + li * li, nr = ab_re - 1.f, f_re = (nr * lr + ab_im * li) / den, f_im = (ab_im * lr - nr * li) / den;
    float bbr[16], bbi[16];
#pragma unroll
    for (int hh = 0; hh < 16; ++hh) { const float br = p->in[I_BRE][(size_t)gp * 16 + hh], bi = p->in[I_BIM][(size_t)gp * 16 + hh]; bbr[hh] = f_re * br - f_im * bi; bbi[hh] = f_re * bi + f_im * br; }
    bf16x8 cfrag[4];
#pragma unroll
    for (int ks = 0; ks < 4; ++ks) { const int k0 = ks * 32 + fq * 8; const bool im = k0 >= 64;
        const float* cp = (im ? p->in[I_CIM] : p->in[I_CRE]) + ((size_t)(l * 32 + g) * 16 + fr) * 64 + (k0 & 63);
        const f32x4 c0 = *(const f32x4*)cp, c1 = *(const f32x4*)(cp + 4); const float sg = im ? -1.f : 1.f;
        u32x4 w; w[0] = pk2(sg * c0[0], sg * c0[1]); w[1] = pk2(sg * c0[2], sg * c0[3]); w[2] = pk2(sg * c1[0], sg * c1[1]); w[3] = pk2(sg * c1[2], sg * c1[3]);
        cfrag[ks] = __builtin_bit_cast(bf16x8, w); }
    float xr = prompt ? 0.f : p->in[I_S5R][(size_t)(l * 16 + b) * 2048 + g * 64 + lane], xi = prompt ? 0.f : p->in[I_S5I][(size_t)(l * 16 + b) * 2048 + g * 64 + lane];
    const float dsk = p->in[I_DS5][(size_t)(l * 32 + g) * 16 + fr];
    u32x4 ua = {0, 0, 0, 0}, ub = {0, 0, 0, 0};
    { const int r0 = row_of(s, 0); if (lane < 16) { const u32x4* up = (const u32x4*)(U + (size_t)(r0 + lane) * 512 + g * 16); ua = up[0]; ub = up[1]; } }
    for (int blk = 0; blk < nblk; ++blk) {
        const int r0 = row_of(s, blk * 16);
        const u32x4 ca = ua, cbv = ub;
        if (blk + 1 < nblk && lane < 16) { const int r1 = row_of(s, blk * 16 + 16); const u32x4* up = (const u32x4*)(U + (size_t)(r1 + lane) * 512 + g * 16); ua = up[0]; ub = up[1]; }
#pragma unroll
        for (int i = 0; i < 16; ++i) {
            float br4[4] = {0.f, 0.f, 0.f, 0.f}, bi4[4] = {0.f, 0.f, 0.f, 0.f};
#pragma unroll
            for (int w = 0; w < 8; ++w) { const unsigned word = (unsigned)__builtin_amdgcn_readlane((int)(w < 4 ? ca[w] : cbv[w - 4]), i);
                const float u0 = lo_f(word), u1 = hi_f(word);
                br4[w & 3] += bbr[2 * w] * u0 + bbr[2 * w + 1] * u1; bi4[w & 3] += bbi[2 * w] * u0 + bbi[2 * w + 1] * u1; }
            const float bur = (br4[0] + br4[1]) + (br4[2] + br4[3]), bui = (bi4[0] + bi4[1]) + (bi4[2] + bi4[3]);
            const float nxr = ab_re * xr - ab_im * xi + bur, nxi = ab_re * xi + ab_im * xr + bui; xr = nxr; xi = nxi;
            Xb[i * LBX + lane] = f2bf_(xr); Xb[i * LBX + 64 + lane] = f2bf_(xi);
        }
        __builtin_amdgcn_wave_barrier(); asm volatile("s_waitcnt lgkmcnt(0)" ::: "memory");
        f32x4 y = {0.f, 0.f, 0.f, 0.f};
#pragma unroll
        for (int ks = 0; ks < 4; ++ks) y = __builtin_amdgcn_mfma_f32_16x16x32_bf16(*(const bf16x8*)(Xb + fr * LBX + ks * 32 + fq * 8), cfrag[ks], y, 0, 0, 0);
#pragma unroll
        for (int r = 0; r < 4; ++r) { bf16_t* up = U + (size_t)(r0 + fq * 4 + r) * 512 + g * 16 + fr; *up = f2bf_(geluf_(y[r] + dsk * bf2f(*up))); }
        __builtin_amdgcn_wave_barrier(); asm volatile("s_waitcnt lgkmcnt(0)" ::: "memory");
    }
    float* ore = prompt ? p->out + O_S5RP + (size_t)(l * 32 + b) * 2048 : p->out + O_S5RS + (size_t)(l * 16 + b) * 2048;
    float* oim = prompt ? p->out + O_S5IP + (size_t)(l * 32 + b) * 2048 : p->out + O_S5IS + (size_t)(l * 16 + b) * 2048;
    ore[g * 64 + lane] = xr; oim[g * 64 + lane] = xi;
}

typedef __bf16 bf2_t __attribute__((ext_vector_type(2)));
__device__ __forceinline__ float dot2bf(unsigned a, unsigned b, float c) { return __builtin_amdgcn_fdot2_f32_bf16(__builtin_bit_cast(bf2_t, a), __builtin_bit_cast(bf2_t, b), c, false); }
__device__ __forceinline__ void attn_item(CPar p, int l, int item, float* wl) {
    const int lane = ltid() & 63;
    int s, h, qt;
    if (item < 8448) { s = item / 264; const int rem = item - s * 264; h = rem / 33; qt = rem - h * 33; } else { const int it = item - 8448; s = 32 + (it >> 3); h = it & 7; qt = 0; }
    const bool prompt = s < 32; const int b = prompt ? s : s - 32, T = prompt ? TP : TS, nh = prompt ? 0 : PAST;
    const int i = qt * 64 + lane; const bool active = i < T; const int row = row_of(s, active ? i : T - 1);
    bf16_t* Q = (bf16_t*)(p->ws + WS_Q);
    unsigned* Kt = (unsigned*)wl; unsigned* Vp = Kt + 32 * 32;
    unsigned q[32]; float o[64];
    { const u32x4* qp = (const u32x4*)(Q + (size_t)row * 512 + h * 64);
#pragma unroll
        for (int e = 0; e < 8; ++e) { const u32x4 w = qp[e];
#pragma unroll
            for (int j = 0; j < 4; ++j) q[e * 4 + j] = pk2(lo_f(w[j]) * 0.125f, hi_f(w[j]) * 0.125f); } }
#pragma unroll
    for (int d = 0; d < 64; ++d) o[d] = 0.f;
    const float* kp_new = prompt ? p->out + O_KP + (size_t)(l * 32 + b) * 2064 * 512 + h * 64 : p->out + O_KS + (size_t)(l * 16 + b) * 64 * 512 + h * 64;
    const float* vp_new = prompt ? p->out + O_VP + (size_t)(l * 32 + b) * 2064 * 512 + h * 64 : p->out + O_VS + (size_t)(l * 16 + b) * 64 * 512 + h * 64;
    const float* kp_old = p->in[I_CK] + (size_t)(l * 16 + b) * 2048 * 512 + h * 64;
    const float* vp_old = p->in[I_CV] + (size_t)(l * 16 + b) * 2048 * 512 + h * 64;
    const int imax = (qt * 64 + 63 < T - 1) ? qt * 64 + 63 : T - 1;
    const int jtop = nh + imax - 1;
    float run = 0.f;
    f32x4 kreg[8], va[4], vb[4];
#define ATT_FETCH(JT) do { _Pragma("unroll") for (int e = 0; e < 8; ++e) { const int idx = e * 64 + lane, kr = idx >> 4, pc = idx & 15, j = (JT) - kr; kreg[e] = (f32x4){0.f, 0.f, 0.f, 0.f}; \
            if (j >= 0) { const float* kp = (j < nh) ? kp_old + (size_t)j * 512 : kp_new + (size_t)(j - nh) * 512; kreg[e] = *(const f32x4*)(kp + pc * 4); } } \
        _Pragma("unroll") for (int e = 0; e < 4; ++e) { const int idx = e * 64 + lane, m = idx >> 4, pc = idx & 15, j0 = (JT) - 2 * m, j1 = j0 - 1; va[e] = (f32x4){0.f, 0.f, 0.f, 0.f}; vb[e] = (f32x4){0.f, 0.f, 0.f, 0.f}; \
            if (j0 >= 0) { const float* vp = (j0 < nh) ? vp_old + (size_t)j0 * 512 : vp_new + (size_t)(j0 - nh) * 512; va[e] = *(const f32x4*)(vp + pc * 4); } \
            if (j1 >= 0) { const float* vp = (j1 < nh) ? vp_old + (size_t)j1 * 512 : vp_new + (size_t)(j1 - nh) * 512; vb[e] = *(const f32x4*)(vp + pc * 4); } } } while (0)
    if (jtop >= 0) ATT_FETCH(jtop);
    for (int jt = jtop; jt >= 0; jt -= 32) {
#pragma unroll
        for (int e = 0; e < 8; ++e) { const int idx = e * 64 + lane, kr = idx >> 4, pc = idx & 15; u32x2 w; w[0] = pk2(kreg[e][0], kreg[e][1]); w[1] = pk2(kreg[e][2], kreg[e][3]); *(u32x2*)(Kt + kr * 32 + pc * 2) = w; }
#pragma unroll
        for (int e = 0; e < 4; ++e) { const int idx = e * 64 + lane, m = idx >> 4, pc = idx & 15;
            u32x4 w; w[0] = pk2(va[e][0], vb[e][0]); w[1] = pk2(va[e][1], vb[e][1]); w[2] = pk2(va[e][2], vb[e][2]); w[3] = pk2(va[e][3], vb[e][3]); *(u32x4*)(Vp + m * 64 + pc * 4) = w; }
        __builtin_amdgcn_wave_barrier(); asm volatile("s_waitcnt lgkmcnt(0)" ::: "memory");
        if (jt - 32 >= 0) ATT_FETCH(jt - 32);
        const int nk = jt + 1 < 32 ? jt + 1 : 32, npair = (nk + 1) >> 1;
        for (int m = 0; m < npair; ++m) { const int j0 = jt - 2 * m, j1 = j0 - 1;
            float z0 = 0.f, z1 = 0.f;
#pragma unroll
            for (int d8 = 0; d8 < 8; ++d8) { const u32x4 k0 = *(const u32x4*)(Kt + (2 * m) * 32 + d8 * 4), k1 = *(const u32x4*)(Kt + (2 * m + 1) * 32 + d8 * 4);
#pragma unroll
                for (int c = 0; c < 4; ++c) { z0 = dot2bf(q[d8 * 4 + c], k0[c], z0); z1 = dot2bf(q[d8 * 4 + c], k1[c], z1); } }
            const bool v0 = active && (j0 < nh + i), v1 = active && (j1 >= 0) && (j1 < nh + i);
            const float e0 = __expf(-z0), ls0 = -__logf(1.f + e0);
            const float w0 = v0 ? __expf(ls0 + run) : 0.f; run += v0 ? (ls0 - z0) : 0.f;
            const float e1 = __expf(-z1), ls1 = -__logf(1.f + e1);
            const float w1 = v1 ? __expf(ls1 + run) : 0.f; run += v1 ? (ls1 - z1) : 0.f;
            const unsigned wp = pk2(w0, w1);
#pragma unroll
            for (int d4 = 0; d4 < 16; ++d4) { const u32x4 vv = *(const u32x4*)(Vp + m * 64 + d4 * 4);
#pragma unroll
                for (int c = 0; c < 4; ++c) o[d4 * 4 + c] = dot2bf(wp, vv[c], o[d4 * 4 + c]); } }
        __builtin_amdgcn_wave_barrier(); asm volatile("s_waitcnt lgkmcnt(0)" ::: "memory");
        const int fin = (!active) || (run < -50.f);
        if (__all(fin)) break;
    }
#undef ATT_FETCH
    if (active) { u32x4* op = (u32x4*)(Q + (size_t)row * 512 + h * 64);
#pragma unroll
        for (int e = 0; e < 8; ++e) { u32x4 w; w[0] = pk2(o[e * 8], o[e * 8 + 1]); w[1] = pk2(o[e * 8 + 2], o[e * 8 + 3]); w[2] = pk2(o[e * 8 + 4], o[e * 8 + 5]); w[3] = pk2(o[e * 8 + 6], o[e * 8 + 7]); op[e] = w; } }
}

__device__ __forceinline__ void phase_mixers(CPar p, int l, float* sm) {
#ifndef SKIP_SSD
    { CPar p1 = params_ptr();
#pragma unroll 1
      for (int it = lbid(); it < 768; it += lgdim()) ssd_item(p1, l, it, sm); }
#endif
    __syncthreads();
    const int wave = __builtin_amdgcn_readfirstlane(ltid() >> 6);
    float* wl = sm + wave * (68 * 64);
#ifndef SKIP_S5
    { CPar p2 = params_ptr();
    if (wave < 4) { for (int it = lbid() * 4 + wave; it < 1024; it += lgdim() * 4) s5_item(p2, l, it >> 5, it & 31, wl); }
    else if (wave < 6) { for (int it = lbid() * 2 + (wave - 4); it < 512; it += lgdim() * 2) s5_item(p2, l, 32 + (it >> 5), it & 31, wl); } }
#endif
#ifndef SKIP_ATT
    CPar p3 = params_ptr();
    unsigned* ctr = (unsigned*)(p3->ws + WS_CTR) + l;
    for (;;) {
        unsigned it = 0; if ((ltid() & 63) == 0) it = atomicAdd(ctr, 1u);
        it = (unsigned)__builtin_amdgcn_readfirstlane((int)it);
        if (it >= 8576u) break;
        attn_item(p3, l, (int)it, wl);
    }
#endif
}

#define XB_TMO      128
#define XB_XCNT(j)  (256  + 64 * (j))
#define XB_XSUB(j)  (1280 + 64 * (j))
#define XB_XGEN(j)  (2304 + 64 * (j))
#define XB_TOP      3328
#define XB_TOPGEN   3392
#define XCD_BAR_WORDS 3456
#define XB_SPIN_CAP (1u << 18)

__device__ __forceinline__ unsigned xb_ld(unsigned* p)              { return __hip_atomic_load(p, __ATOMIC_RELAXED, __HIP_MEMORY_SCOPE_AGENT); }
__device__ __forceinline__ unsigned xb_add(unsigned* p, unsigned v) { return __hip_atomic_fetch_add(p, v, __ATOMIC_RELAXED, __HIP_MEMORY_SCOPE_AGENT); }
__device__ __forceinline__ unsigned xb_xcc_id() { return (unsigned)__builtin_amdgcn_s_getreg((3 << 11) | 20) & 0xFu; }
#define XB_SPIN(cond, bar) do { unsigned _sp = 0; while (cond) { __builtin_amdgcn_s_sleep(1); \
    if ((++_sp & 255u) == 0u) { if (xb_ld(&(bar)[XB_TMO])) break; if (_sp > XB_SPIN_CAP) { atomicAdd(&(bar)[XB_TMO], 1u); break; } } } } while (0)

struct XcdBarrier {
    unsigned* bar; unsigned x;
    volatile LAS unsigned* st;
};

__device__ __forceinline__ XcdBarrier xcd_barrier_post(unsigned* bar, volatile LAS unsigned* st) {
    XcdBarrier b; b.bar = bar; b.x = xb_xcc_id(); b.st = st;
    if (threadIdx.x == 0) (void)xb_add(&bar[XB_XCNT(b.x)], 1u);
    return b;
}
__device__ __forceinline__ void xcd_barrier_complete(unsigned* bar, unsigned x, unsigned& nloc, unsigned& nx) {
    const unsigned G = gridDim.x * gridDim.y * gridDim.z;
    unsigned sum, cnt, mine, sp = 0u;
    for (;;) {
        sum = 0u; cnt = 0u; mine = 0u;
#pragma unroll
        for (unsigned j = 0; j < 16; ++j) { const unsigned c = xb_ld(&bar[XB_XCNT(j)]); sum += c; cnt += (c > 0u) ? 1u : 0u; mine = (j == x) ? c : mine; }
        if (sum == G) break;
        __builtin_amdgcn_s_sleep(1);
        if ((++sp & 255u) == 0u) { if (xb_ld(&bar[XB_TMO])) break; if (sp > XB_SPIN_CAP) { atomicAdd(&bar[XB_TMO], 1u); break; } }
    }
    nloc = mine > 0u ? mine : 1u; nx = cnt > 0u ? cnt : 1u;
}

__device__ __forceinline__ void xcd_barrier(const XcdBarrier& b) {
    asm volatile("s_waitcnt vmcnt(0)" ::: "memory");
    __syncthreads();
    if (threadIdx.x == 0) {
        unsigned* bar = b.bar;
        __builtin_amdgcn_s_waitcnt(0);
        unsigned nloc = b.st[0], nx = b.st[1];
        if (nloc == 0u) { xcd_barrier_complete(bar, b.x, nloc, nx); b.st[0] = nloc; b.st[1] = nx; }
        const unsigned old = xb_add(&bar[XB_XSUB(b.x)], 1u);
        const unsigned gen = old / nloc;
        if (old + 1u == (gen + 1u) * nloc) {
            __builtin_amdgcn_fence(__ATOMIC_RELEASE, "agent");
            asm volatile("s_waitcnt vmcnt(0)" ::: "memory");
            const unsigned og = xb_add(&bar[XB_TOP], 1u);
            const unsigned tg = og / nx;
            if (og + 1u == (tg + 1u) * nx) xb_add(&bar[XB_TOPGEN], 1u);
            else XB_SPIN(xb_ld(&bar[XB_TOPGEN]) == tg, bar);
            __builtin_amdgcn_fence(__ATOMIC_ACQUIRE, "agent");
            xb_add(&bar[XB_XGEN(b.x)], 1u);
            asm volatile("s_waitcnt vmcnt(0)" ::: "memory");
        } else {
            XB_SPIN(xb_ld(&bar[XB_XGEN(b.x)]) == gen, bar);
            __builtin_amdgcn_fence(__ATOMIC_ACQUIRE, "agent");
            asm volatile("s_waitcnt vmcnt(0)" ::: "memory");
        }
    }
    __syncthreads();
}
__global__ __launch_bounds__(512, 2) void mega(Params pk) {
    extern __shared__ __attribute__((aligned(16))) unsigned char smem[];
    cg::grid_group grid = cg::this_grid();
    LAS unsigned char* lds = (LAS unsigned char*)smem;
    const int ph_lo = pk.ph_lo, ph_hi = pk.ph_hi;
    volatile LAS unsigned* xst = (volatile LAS unsigned*)(lds + (LDS_BYTES - 16));
    if (threadIdx.x == 0) { xst[0] = 0u; xst[1] = 0u; }
    const XcdBarrier xb = xcd_barrier_post((unsigned*)(pk.ws + WS_SSQ), xst);
    for (int ph = ph_lo; ph < ph_hi; ++ph) {
        if (ph == ph_lo + 1) grid.sync();
        else if (ph > ph_lo + 1) xcd_barrier(xb);
        CPar p = params_ptr();
        unsigned char* ws = p->ws;
        bf16_t *HB = (bf16_t*)(ws + WS_HB), *Z = (bf16_t*)(ws + WS_Z), *XBC = (bf16_t*)(ws + WS_XBC), *U = (bf16_t*)(ws + WS_U), *Q = (bf16_t*)(ws + WS_Q), *G = (bf16_t*)(ws + WS_G);
        float *DT = (float*)(ws + WS_DT), *XM = (float*)(ws + WS_XMETA);
        const int l = ph >> 3, sub = ph & 7;
        pg8::StaticOrder S;
        if (sub == 0) {
#ifndef SKIP0
            phase_prep(p, l);
#endif
        } else if (sub == 1) {
            S.init(NROWS, N1, lgdim(), lbid());
            EpiIn E{Z, XBC, U, Q, G, DT, p->out, p->in[I_QN] + l * 64, p->in[I_KN] + l * 64, l};
#ifndef SKIP1
            pg8::gemm_phase(lds, pg8::Gemm{HB, (const bf16_t*)(ws + W_BT1), NROWS, N1, 1024, 1024, 1024}, S, E);
#endif
        } else if (sub == 2) {
#ifndef SKIP2
            phase_mixers(p, l, (float*)smem);
#endif
        } else if (sub == 3) {
            ssd_norm_rows(p);
            S.init(NROWS, 2048, lgdim(), lbid());
            EpiGlu E{XBC};
            pg8::gemm_phase(lds, pg8::Gemm{U, (const bf16_t*)(ws + W_GLU), NROWS, 2048, 512, 512, 512}, S, E);
        } else if (sub == 4) {
            S.init(NROWS, 1024, lgdim(), lbid());
            for (int call = 0; call < 2; ++call) {
                EpiMix E; pg8::Gemm g;
                if (call == 0) { E = EpiMix{HB, G, XBC, 0}; g = pg8::Gemm{Z, (const bf16_t*)(ws + W_LA), NROWS, 1024, 1024, 1024, 1024}; }
                else { E = EpiMix{HB, G + 2048, nullptr, 1}; g = pg8::Gemm{Q, (const bf16_t*)(ws + W_LC), NROWS, 1024, 512, 512, 512}; }
#ifndef SKIP3
                pg8::gemm_phase(lds, g, S, E);
#endif
            }
        } else if (sub == 5) {
            S.init(NROWS, 1024, lgdim(), lbid());
            EpiRes E{p->out, XM, (bf16_t*)(ws + WS_XB2), (float*)(ws + WS_SSQX) + (size_t)l * NROWS};
            pg8::gemm_phase(lds, pg8::Gemm{HB, (const bf16_t*)(ws + W_OUT), NROWS, 1024, 1024, 1024, 1024}, S, E);
        } else if (sub == 6) {
            S.init(NROWS, 4096, lgdim(), lbid());
            EpiUp E{(bf16_t*)(ws + WS_ACT), (const float*)(ws + WS_SSQX) + (size_t)l * NROWS};
            pg8::gemm_phase(lds, pg8::Gemm{(const bf16_t*)(ws + WS_XB2), (const bf16_t*)(ws + W_UP), NROWS, 4096, 1024, 1024, 1024}, S, E);
        } else {
            S.init(NROWS, 1024, lgdim(), lbid());
            EpiRes E{p->out, XM, nullptr, nullptr};
            pg8::gemm_phase(lds, pg8::Gemm{(const bf16_t*)(ws + WS_ACT), (const bf16_t*)(ws + W_DOWN), NROWS, 1024, 4096, 4096, 4096}, S, E);
        }
    }
}

extern "C" void kernel_launch(void* const* d_in, const int* in_sizes, int n_in, void* d_out, int out_size, void* d_ws, size_t ws_size, hipStream_t stream) {
    static int grid = 0;
    if (grid == 0) {
        if (n_in != 34 || (size_t)out_size != O_END || ws_size < WS_END) { fprintf(stderr, "kernel_launch: unexpected shapes n_in %d out %d ws %zu (need %zu)\n", n_in, out_size, ws_size, (size_t)WS_END); grid = -1; return; }
        int dev = 0, cus = 0, per_cu = 0;
        hipGetDevice(&dev); hipDeviceGetAttribute(&cus, hipDeviceAttributeMultiprocessorCount, dev);
        if (hipFuncSetAttribute((const void*)mega, hipFuncAttributeMaxDynamicSharedMemorySize, LDS_BYTES) != hipSuccess) { fprintf(stderr, "kernel_launch: hipFuncSetAttribute failed\n"); grid = -1; return; }
        if (hipOccupancyMaxActiveBlocksPerMultiprocessor(&per_cu, (const void*)mega, 512, LDS_BYTES) != hipSuccess || per_cu < 1) { fprintf(stderr, "kernel_launch: occupancy query says %d\n", per_cu); per_cu = 1; }
        (void)hipGetLastError();
        grid = cus * per_cu;
    }
    if (grid < 0) return;
    if (hipMemsetAsync((char*)d_ws + WS_CTR, 0, 4096, stream) != hipSuccess || hipMemsetAsync((char*)d_ws + WS_SSQ, 0, 16384 + 2ull * NROWS * 4, stream) != hipSuccess) { fprintf(stderr, "kernel_launch: memset failed\n"); return; }
    Params p{};
    for (int i = 0; i < 34; ++i) p.in[i] = (const float*)d_in[i];
    p.out = (float*)d_out; p.ws = (unsigned char*)d_ws;
#if MULTI_LAUNCH
    for (int ph = 0; ph < 16; ++ph) { p.ph_lo = ph; p.ph_hi = ph + 1; hipLaunchKernelGGL(mega, dim3(grid), dim3(512), LDS_BYTES, stream, p); }
#else
    p.ph_lo = 0; p.ph_hi = 16;
    void* args[] = {&p};
    hipError_t e = hipLaunchCooperativeKernel((const void*)mega, dim3(grid), dim3(512), args, LDS_BYTES, stream);
    if (e != hipSuccess) fprintf(stderr, "cooperative launch failed: %s (grid %d)\n", hipGetErrorString(e), grid);
#endif
}
```

```cpp
#include <hip/hip_runtime.h>
#include <hip/hip_cooperative_groups.h>
#include <cstdio>
#include <cstdint>
namespace cg = cooperative_groups;

#ifndef MULTI_LAUNCH
#define MULTI_LAUNCH 0
#endif

typedef unsigned short bf16_t;
typedef short bf16x8 __attribute__((ext_vector_type(8)));
typedef float f32x4 __attribute__((ext_vector_type(4)));
typedef unsigned u32x4 __attribute__((ext_vector_type(4)));
typedef unsigned u32x2 __attribute__((ext_vector_type(2)));
#define LAS __attribute__((address_space(3)))

constexpr int D = 1024, NROWS = 67072, NS0 = 65536, NM0 = 66560;
constexpr int TP = 2064, TS = 64, NB_P = 32, NB_S = 16, PAST = 2048;
constexpr int IN_COLS = 7440, N1 = 7680;
constexpr int SSQ_SLOTS = NM0 + 32 * 32;
constexpr float EPS = 1e-6f;
constexpr size_t O_YP = 0, O_YS = 67108864ull, O_KP = O_YS + 1048576ull, SZ_KP = 2ull * 32 * 2064 * 512, O_VP = O_KP + SZ_KP,
                 O_CONVP = O_VP + SZ_KP, O_SSDP = O_CONVP + 2ull * 32 * 3 * 1280, O_S5RP = O_SSDP + 2ull * 32 * 16 * 4096, O_S5IP = O_S5RP + 2ull * 32 * 2048,
                 O_KS = O_S5IP + 2ull * 32 * 2048, O_VS = O_KS + 2ull * 16 * 64 * 512, O_CONVS = O_VS + 2ull * 16 * 64 * 512, O_SSDS = O_CONVS + 2ull * 16 * 3 * 1280,
                 O_S5RS = O_SSDS + 2ull * 16 * 16 * 4096, O_S5IS = O_S5RS + 2ull * 16 * 2048, O_END = O_S5IS + 2ull * 16 * 2048;
constexpr size_t W_BT1 = 0, W_GLU = W_BT1 + (size_t)N1 * 1024 * 2, W_LA = W_GLU + 2048ull * 512 * 2, W_LC = W_LA + 1024ull * 1024 * 2, W_OUT = W_LC + 1024ull * 512 * 2,
                 W_UP = W_OUT + 1024ull * 1024 * 2, W_DOWN = W_UP + 4096ull * 1024 * 2, W_END = W_DOWN + 4096ull * 1024 * 2;
constexpr size_t WS_CTR = W_END, WS_XMETA = WS_CTR + 4096, WS_HB = WS_XMETA + 512ull * 1024 * 4, WS_Z = WS_HB + (size_t)NROWS * 1024 * 2, WS_XBC = WS_Z + (size_t)NROWS * 1024 * 2,
                 WS_U = WS_XBC + (size_t)NROWS * 1280 * 2, WS_Q = WS_U + (size_t)NROWS * 512 * 2, WS_G = WS_Q + (size_t)NROWS * 512 * 2, WS_DT = WS_G + (size_t)NROWS * 3072 * 2,
                 WS_SSQ = WS_DT + (size_t)NROWS * 16 * 4, WS_END = WS_SSQ + (size_t)SSQ_SLOTS * 16 * 4;
constexpr size_t WS_XB2 = WS_DT - (size_t)NROWS * 1024 * 2;
constexpr size_t WS_SSQX = WS_SSQ + 16384;
constexpr size_t WS_ACT = WS_Z;
static_assert(WS_ACT + (size_t)NROWS * 4096 * 2 <= WS_XB2, "ACT overlay");
static_assert(WS_SSQX + 2ull * NROWS * 4 <= WS_END, "ssqx");
constexpr int LDS_BYTES = 147456;

struct Params {
    const float* in[34];
    float* out;
    unsigned char* ws;
    int ph_lo, ph_hi;
};
typedef const __attribute__((address_space(4))) Params* CPar;
__device__ __forceinline__ CPar params_ptr() { CPar q = (CPar)__builtin_amdgcn_kernarg_segment_ptr(); asm volatile("" : "+s"(q)); return q; }
#define PIN(i) (p->in[i])
enum { I_XP = 0, I_XS, I_CK, I_CV, I_SCONV, I_SSSD, I_S5R, I_S5I, I_META, I_NMIX, I_WIN, I_CONVW, I_CONVB, I_DTB, I_ALOG, I_DSSD, I_NSSD, I_LRE, I_LIM, I_LSTEP, I_BRE, I_BIM,
       I_CRE, I_CIM, I_DS5, I_WGLU, I_QN, I_KN, I_WLA, I_WLC, I_WOUT, I_NFFN, I_WUP, I_WDOWN };

__device__ __forceinline__ int ltid() { int t = threadIdx.x; asm volatile("" : "+v"(t)); return t; }
__device__ __forceinline__ int lbid() { int t = blockIdx.x; asm volatile("" : "+s"(t)); return t; }
__device__ __forceinline__ int lgdim() { int t = gridDim.x; asm volatile("" : "+s"(t)); return t; }

__device__ __forceinline__ float bf2f(bf16_t v) { return __uint_as_float((unsigned)v << 16); }
__device__ __forceinline__ unsigned pk2(float lo, float hi) { unsigned r; asm volatile("v_cvt_pk_bf16_f32 %0, %1, %2" : "=v"(r) : "v"(lo), "v"(hi)); return r; }
__device__ __forceinline__ float lo_f(unsigned w) { return __uint_as_float(w << 16); }
__device__ __forceinline__ float hi_f(unsigned w) { return __uint_as_float(w & 0xffff0000u); }
__device__ __forceinline__ u32x2 ld_l2_u32x2(const void* ptr) { const unsigned long long v = __hip_atomic_load((const unsigned long long*)ptr, __ATOMIC_RELAXED, __HIP_MEMORY_SCOPE_AGENT); u32x2 r; r[0] = (unsigned)v; r[1] = (unsigned)(v >> 32); return r; }
__device__ __forceinline__ float sigmoidf_(float v) { return __builtin_amdgcn_rcpf(1.f + __expf(-v)); }
__device__ __forceinline__ float siluf_(float v) { return v * sigmoidf_(v); }
__device__ __forceinline__ float geluf_(float y) { const float a = 0.7978845608f * (y + 0.044715f * y * y * y); const float t = __expf(2.f * a); return 0.5f * y * (2.f - 2.f * __builtin_amdgcn_rcpf(t + 1.f)); }
__device__ __forceinline__ float wave_sum(float v) {
#pragma unroll
    for (int o = 1; o < 64; o <<= 1) v += __shfl_xor(v, o);
    return v;
}
__device__ __forceinline__ void sincos_red(double x, float& sn, float& cs) {
    const double k = __builtin_rint(x * 0.63661977236758134308);
    const float r = (float)__builtin_fma(-k, 1.57079632679489661923, x), r2 = r * r;
    const float sp = r + r * r2 * (-1.6666667163e-01f + r2 * (8.3333337680e-03f + r2 * (-1.9841270114e-04f + r2 * 2.7557314297e-06f)));
    const float cp = 1.f + r2 * (-0.5f + r2 * (4.1666667908e-02f + r2 * (-1.3888889225e-03f + r2 * (2.4801587642e-05f - r2 * 2.7557314297e-07f))));
    const int q = ((int)k) & 3;
    sn = (q == 0) ? sp : (q == 1) ? cp : (q == 2) ? -sp : -cp;
    cs = (q == 0) ? cp : (q == 1) ? -sp : (q == 2) ? -cp : sp;
}
__device__ __forceinline__ int row_of(int s, int t) { return s < 32 ? (t < 16 ? NM0 + s * 16 + t : s * 2048 + t - 16) : NS0 + (s - 32) * 64 + t; }
__device__ __forceinline__ int ssq_slot(int r) { return r < NM0 ? r : NM0 + ((r - NM0) >> 4) * 32 + ((r - NM0) & 15); }
__device__ __forceinline__ float* xloc(CPar p, int r) { return r < NM0 ? p->out + (size_t)r * 1024 : (float*)(p->ws + WS_XMETA) + (size_t)(r - NM0) * 1024; }
__device__ __forceinline__ size_t k_off(int l, int r) {
    if (r < NS0) return O_KP + ((size_t)(l * 32 + (r >> 11)) * 2064 + 16 + (r & 2047)) * 512;
    if (r < NM0) { const int rs = r - NS0; return O_KS + ((size_t)(l * 16 + (rs >> 6)) * 64 + (rs & 63)) * 512; }
    const int rm = r - NM0; return O_KP + ((size_t)(l * 32 + (rm >> 4)) * 2064 + (rm & 15)) * 512;
}

namespace pg8 {
constexpr int BM = 256, BK = 64, HALF = 128, HTB = HALF * BK * 2, STAGE_BYTES = 8 * HTB, NXCD = 8, WGM = 8;
__host__ __device__ __forceinline__ int lds_byte(int r, int c) { const int st = (r >> 4) * 2 + (c >> 5), rr = r & 15, cc = c & 31, ob = rr * 64 + cc * 2; return st * 1024 + (ob ^ (((ob >> 9) & 1) << 5)); }
__host__ __device__ __forceinline__ void stage_rc(int b, int& R, int& C) { const int st = b / 1024, sb = b % 1024, swz = sb ^ (((sb >> 9) & 1) << 5); R = (st >> 1) * 16 + swz / 64; C = (st & 1) * 32 + (swz % 64) / 2; }
struct Unit { int pm, pn; };
struct Gemm { const bf16_t* A; const bf16_t* Bt; int M, N, K, lda, ldb; };
struct StaticOrder {
    int nM, nN, nwg, G, c;
    __device__ void init(int M, int N, int G_, int c_) { nM = M / BM; nN = N / BM; nwg = nM * nN; G = G_; c = c_; }
    __device__ bool next(int i, Unit& u) const {
        const long L = (long)i * G + c; if (L >= nwg) return false;
        int wgid = (int)L; { const int q = nwg / NXCD, r = nwg % NXCD, xcd = wgid % NXCD, off = wgid / NXCD; wgid = (xcd < r ? xcd * (q + 1) : r * (q + 1) + (xcd - r) * q) + off; }
        const int nig = WGM * nN, gid = wgid / nig, fm = gid * WGM, gsz = (nM - fm) < WGM ? (nM - fm) : WGM;
        u.pm = fm + ((wgid % nig) % gsz); u.pn = (wgid % nig) / gsz; return true;
    }
};
template <class Epi>
__device__ __forceinline__ void gemm_phase(LAS unsigned char* lds, const Gemm g, const StaticOrder& S, const Epi& E) {
    const int tid = ltid(), wid = __builtin_amdgcn_readfirstlane(tid >> 6), lane = tid & 63, wr = wid >> 2, wc = wid & 3, fr = lane & 15, fq = lane >> 4;
    const int K = g.K, nt = K / BK;
    unsigned voffA[2], voffB[2];
#pragma unroll
    for (int i = 0; i < 2; ++i) { int R, C; stage_rc(tid * 16 + i * 8192, R, C); voffA[i] = (unsigned)(R * g.lda + C) * 2u; voffB[i] = (unsigned)(R * g.ldb + C) * 2u; }
    const size_t kstep = (size_t)(BK * 2);
    const size_t hstepA = (size_t)HALF * g.lda * 2, hstepB = (size_t)HALF * g.ldb * 2;
    const size_t tstepA = 2 * hstepA, tstepB = 2 * hstepB;
    const unsigned ldsw = (unsigned)wid * 1024u;
    const int aoff = lds_byte(wr * 64 + fr, fq * 8), boff = lds_byte(wc * 32 + fr, fq * 8);
#define PG8_SA(b, h) (((b) * 2 + (h)) * HTB)
#define PG8_SB(b, h) ((4 + (b) * 2 + (h)) * HTB)
#define PG8_STAGE(bufoff, gbase, voff) do { _Pragma("unroll") for (int _i = 0; _i < 2; ++_i) \
        __builtin_amdgcn_global_load_lds((const unsigned*)((const char*)(gbase) + (voff)[_i]), (LAS unsigned*)(lds + (bufoff) + ldsw + _i * 8192), 16, 0, 0); } while (0)
#define PG8_LDA(dst, b, h) do { _Pragma("unroll") for (int m = 0; m < 4; ++m) _Pragma("unroll") for (int k = 0; k < 2; ++k) dst[m][k] = *(const LAS bf16x8*)(lds + PG8_SA(b, h) + aoff + m * 2048 + k * 1024); } while (0)
#define PG8_LDB(dst, b, h) do { _Pragma("unroll") for (int n = 0; n < 2; ++n) _Pragma("unroll") for (int k = 0; k < 2; ++k) dst[n][k] = *(const LAS bf16x8*)(lds + PG8_SB(b, h) + boff + n * 2048 + k * 1024); } while (0)
#define PG8_MMA(ai, bj, At, Bt) do { __builtin_amdgcn_s_setprio(1); _Pragma("unroll") for (int m = 0; m < 4; ++m) _Pragma("unroll") for (int n = 0; n < 2; ++n) _Pragma("unroll") for (int k = 0; k < 2; ++k) \
        acc[ai][bj][m][n] = __builtin_amdgcn_mfma_f32_16x16x32_bf16(Bt[n][k], At[m][k], acc[ai][bj][m][n], 0, 0, 0); __builtin_amdgcn_s_setprio(0); } while (0)
#define PG8_WAIT_V(n) asm volatile("s_waitcnt vmcnt(" #n ")" ::: "memory")
#define PG8_WAIT_L(n) asm volatile("s_waitcnt lgkmcnt(" #n ")" ::: "memory")
#define PG8_BAR __builtin_amdgcn_s_barrier()
#define PG8_SCHED __builtin_amdgcn_sched_barrier(0)
    Unit cur, nxt; int ui = 0;
    if (!S.next(0, cur)) return;
    f32x4 acc[2][2][4][2];
#pragma unroll
    for (int a = 0; a < 2; ++a)
#pragma unroll
        for (int b = 0; b < 2; ++b)
#pragma unroll
            for (int m = 0; m < 4; ++m)
#pragma unroll
                for (int n = 0; n < 2; ++n) acc[a][b][m][n] = (f32x4){0.f, 0.f, 0.f, 0.f};
    bf16x8 At[4][2], B0[2][2], B1[2][2];
    const char* cA = (const char*)g.A + (size_t)cur.pm * tstepA; const char* cB = (const char*)g.Bt + (size_t)cur.pn * tstepB;
    PG8_STAGE(PG8_SB(0, 0), cB, voffB); PG8_STAGE(PG8_SA(0, 0), cA, voffA); PG8_STAGE(PG8_SB(0, 1), cB + hstepB, voffB); PG8_STAGE(PG8_SA(0, 1), cA + hstepA, voffA);
    if (wr == 1) PG8_BAR;
    PG8_WAIT_V(4); PG8_BAR;
    PG8_STAGE(PG8_SB(1, 0), cB + kstep, voffB); PG8_STAGE(PG8_SA(1, 0), cA + kstep, voffA); PG8_STAGE(PG8_SB(1, 1), cB + hstepB + kstep, voffB);
    PG8_WAIT_V(6); PG8_BAR;
    for (;;) {
        const bool has_next = S.next(ui + 1, nxt);
        const char* nA = has_next ? (const char*)g.A + (size_t)nxt.pm * tstepA : cA; const char* nB = has_next ? (const char*)g.Bt + (size_t)nxt.pn * tstepB : cB;
        for (int t = 0; t < nt; t += 2) {
            const bool last = (t == nt - 2);
            const char* a1 = cA + (size_t)(t + 1) * kstep;
            const char* a2 = last ? nA : cA + (size_t)(t + 2) * kstep; const char* b2 = last ? nB : cB + (size_t)(t + 2) * kstep;
            const char* a3 = a2 + kstep; const char* b3 = b2 + kstep;
            PG8_LDB(B0, 0, 0); PG8_SCHED; PG8_LDA(At, 0, 0); PG8_STAGE(PG8_SA(1, 1), a1 + hstepA, voffA);
            PG8_WAIT_L(8); PG8_BAR; PG8_WAIT_L(0); PG8_MMA(0, 0, At, B0); PG8_BAR; PG8_SCHED;
            PG8_LDB(B1, 0, 1); PG8_STAGE(PG8_SB(0, 0), b2, voffB);
            PG8_BAR; PG8_WAIT_L(0); PG8_MMA(0, 1, At, B1); PG8_BAR;
            PG8_LDA(At, 0, 1); PG8_STAGE(PG8_SA(0, 0), a2, voffA);
            PG8_BAR; PG8_WAIT_L(0); PG8_MMA(1, 0, At, B0); PG8_BAR; PG8_SCHED;
            PG8_STAGE(PG8_SB(0, 1), b2 + hstepB, voffB);
            PG8_WAIT_V(6); PG8_BAR; PG8_MMA(1, 1, At, B1); PG8_BAR;
            PG8_LDB(B0, 1, 0); PG8_SCHED; PG8_LDA(At, 1, 0); PG8_STAGE(PG8_SA(0, 1), a2 + hstepA, voffA);
            PG8_WAIT_L(8); PG8_BAR; PG8_WAIT_L(0); PG8_MMA(0, 0, At, B0); PG8_BAR; PG8_SCHED;
            PG8_LDB(B1, 1, 1); PG8_STAGE(PG8_SB(1, 0), b3, voffB);
            PG8_BAR; PG8_WAIT_L(0); PG8_MMA(0, 1, At, B1); PG8_BAR;
            PG8_LDA(At, 1, 1); PG8_STAGE(PG8_SA(1, 0), a3, voffA);
            PG8_BAR; PG8_WAIT_L(0); PG8_MMA(1, 0, At, B0); PG8_BAR; PG8_SCHED;
            PG8_STAGE(PG8_SB(1, 1), b3 + hstepB, voffB);
            PG8_WAIT_V(6); PG8_BAR; PG8_MMA(1, 1, At, B1); PG8_BAR;
        }
        E(acc, cur, wr, wc, fr, fq);
        if (!has_next) break;
#pragma unroll
        for (int a = 0; a < 2; ++a)
#pragma unroll
            for (int b = 0; b < 2; ++b)
#pragma unroll
                for (int m = 0; m < 4; ++m)
#pragma unroll
                    for (int n = 0; n < 2; ++n) acc[a][b][m][n] = (f32x4){0.f, 0.f, 0.f, 0.f};
        cur = nxt; cA = nA; cB = nB; ++ui;
    }
    PG8_WAIT_V(0);
    if (wr == 0) PG8_BAR;
    PG8_BAR;
#undef PG8_SA
#undef PG8_SB
#undef PG8_STAGE
#undef PG8_LDA
#undef PG8_LDB
#undef PG8_MMA
#undef PG8_WAIT_V
#undef PG8_WAIT_L
#undef PG8_BAR
#undef PG8_SCHED
}
}
using pg8::Unit;

struct EpiIn {
    bf16_t *Z, *XBC, *U, *Q, *G; float* DT; float* out; const float *qn, *kn; int layer;
    __device__ __forceinline__ void operator()(const f32x4 (&acc)[2][2][4][2], const Unit& u, int wr, int wc, int fr, int fq) const {
        const int pn = u.pn, rowb = u.pm * 256 + wr * 64 + fr, ctb = wc * 32 + fq * 4;
        if (pn < 11 || (pn >= 17 && pn < 29)) {
            bf16_t* base; int ld, col0; bool sig = false;
            if (pn < 4) { base = Z; ld = 1024; col0 = pn * 256; } else if (pn < 9) { base = XBC; ld = 1280; col0 = (pn - 4) * 256; }
            else if (pn < 11) { base = U; ld = 512; col0 = (pn - 9) * 256; } else { base = G; ld = 3072; col0 = (pn - 17) * 256; sig = true; }
#pragma unroll
            for (int ai = 0; ai < 2; ++ai)
#pragma unroll
                for (int m = 0; m < 4; ++m) { bf16_t* rp = base + (size_t)(rowb + ai * 128 + m * 16) * ld + col0 + wc * 32 + fq * 8;
#pragma unroll
                    for (int bj = 0; bj < 2; ++bj) { f32x4 v0 = acc[ai][bj][m][0], v1 = acc[ai][bj][m][1];
                        if (sig) {
#pragma unroll
                            for (int j = 0; j < 4; ++j) { v0[j] = sigmoidf_(v0[j]); v1[j] = sigmoidf_(v1[j]); } }
                        u32x4 o; o[0] = pk2(v0[0], v0[1]); o[1] = pk2(v0[2], v0[3]); o[2] = pk2(v1[0], v1[1]); o[3] = pk2(v1[2], v1[3]); *(u32x4*)(rp + bj * 128) = o; } }
        } else if (pn < 17) {
            const int seg = (pn - 11) >> 1, head = ((pn - 11) & 1) * 4 + wc;
            const float* nw = seg == 0 ? qn : kn;
            f32x4 wv[2][2];
#pragma unroll
            for (int bj = 0; bj < 2; ++bj)
#pragma unroll
                for (int n = 0; n < 2; ++n) wv[bj][n] = (seg < 2) ? *(const f32x4*)(nw + 32 * bj + 16 * n + 4 * fq) : (f32x4){1.f, 1.f, 1.f, 1.f};
#pragma unroll
            for (int ai = 0; ai < 2; ++ai)
#pragma unroll
                for (int m = 0; m < 4; ++m) { const int row = rowb + ai * 128 + m * 16;
                    float rs = 1.f;
                    if (seg < 2) { float ss = 0.f;
#pragma unroll
                        for (int bj = 0; bj < 2; ++bj)
#pragma unroll
                            for (int n = 0; n < 2; ++n) { const f32x4 v = acc[ai][bj][m][n]; ss += v[0] * v[0] + v[1] * v[1] + v[2] * v[2] + v[3] * v[3]; }
                        ss += __shfl_xor(ss, 16); ss += __shfl_xor(ss, 32);
                        rs = rsqrtf(ss * (1.f / 64.f) + EPS); }
                    if (seg == 0) { bf16_t* rp = Q + (size_t)row * 512 + head * 64 + 4 * fq;
#pragma unroll
                        for (int bj = 0; bj < 2; ++bj)
#pragma unroll
                            for (int n = 0; n < 2; ++n) { const f32x4 v = acc[ai][bj][m][n] * rs * wv[bj][n]; u32x2 o; o[0] = pk2(v[0], v[1]); o[1] = pk2(v[2], v[3]); *(u32x2*)(rp + 32 * bj + 16 * n) = o; }
                    } else { float* rp = out + k_off(layer, row) + (seg == 2 ? (row >= NS0 && row < NM0 ? (O_VS - O_KS) : (O_VP - O_KP)) : 0) + head * 64 + 4 * fq;
#pragma unroll
                        for (int bj = 0; bj < 2; ++bj)
#pragma unroll
                            for (int n = 0; n < 2; ++n) { const f32x4 v = acc[ai][bj][m][n] * rs * wv[bj][n]; *(f32x4*)(rp + 32 * bj + 16 * n) = v; } } }
        } else {
            if (wc == 0) {
#pragma unroll
                for (int ai = 0; ai < 2; ++ai)
#pragma unroll
                    for (int m = 0; m < 4; ++m) *(f32x4*)(DT + (size_t)(rowb + ai * 128 + m * 16) * 16 + 4 * fq) = acc[ai][0][m][0];
            }
        }
    }
};
struct EpiGlu {
    bf16_t* OB;
    __device__ __forceinline__ void operator()(const f32x4 (&acc)[2][2][4][2], const Unit& u, int wr, int wc, int fr, int fq) const {
        const int rowb = u.pm * 256 + wr * 64 + fr, colb = u.pn * 128 + wc * 32 + fq * 8;
#pragma unroll
        for (int ai = 0; ai < 2; ++ai)
#pragma unroll
            for (int m = 0; m < 4; ++m) { bf16_t* rp = OB + (size_t)(rowb + ai * 128 + m * 16) * 1024 + colb;
                const f32x4 a0 = acc[ai][0][m][0], g0 = acc[ai][1][m][0], a1 = acc[ai][0][m][1], g1 = acc[ai][1][m][1];
                u32x4 o; o[0] = pk2(a0[0] * sigmoidf_(g0[0]), a0[1] * sigmoidf_(g0[1])); o[1] = pk2(a0[2] * sigmoidf_(g0[2]), a0[3] * sigmoidf_(g0[3]));
                o[2] = pk2(a1[0] * sigmoidf_(g1[0]), a1[1] * sigmoidf_(g1[1])); o[3] = pk2(a1[2] * sigmoidf_(g1[2]), a1[3] * sigmoidf_(g1[3])); *(u32x4*)rp = o; }
    }
};
struct EpiMix {
    bf16_t* R; const bf16_t* G; const bf16_t* OB; int accum;
    __device__ __forceinline__ void operator()(const f32x4 (&acc)[2][2][4][2], const Unit& u, int wr, int wc, int fr, int fq) const {
        const int rowb = u.pm * 256 + wr * 64 + fr, colb = u.pn * 256 + wc * 32 + fq * 8;
#pragma unroll
        for (int ai = 0; ai < 2; ++ai)
#pragma unroll
            for (int m = 0; m < 4; ++m) { const int row = rowb + ai * 128 + m * 16;
                u32x4 gw[2], g1[2], ob[2]; u32x2 rw[2][2];
#pragma unroll
                for (int bj = 0; bj < 2; ++bj) { const int col = colb + bj * 128;
                    gw[bj] = *(const u32x4*)(G + (size_t)row * 3072 + col);
                    g1[bj] = (u32x4){0u, 0u, 0u, 0u}; ob[bj] = (u32x4){0u, 0u, 0u, 0u}; rw[bj][0] = (u32x2){0u, 0u}; rw[bj][1] = (u32x2){0u, 0u};
                    if (OB) { g1[bj] = *(const u32x4*)(G + (size_t)row * 3072 + 1024 + col); ob[bj] = *(const u32x4*)(OB + (size_t)row * 1024 + col); }
                    if (accum) { rw[bj][0] = ld_l2_u32x2(R + (size_t)row * 1024 + col); rw[bj][1] = ld_l2_u32x2(R + (size_t)row * 1024 + col + 4); } }
#pragma unroll
                for (int bj = 0; bj < 2; ++bj) { u32x4 o;
#pragma unroll
                    for (int n = 0; n < 2; ++n) { f32x4 v = acc[ai][bj][m][n];
                        const unsigned a0 = gw[bj][2 * n], a1 = gw[bj][2 * n + 1], b0 = g1[bj][2 * n], b1 = g1[bj][2 * n + 1], c0 = ob[bj][2 * n], c1 = ob[bj][2 * n + 1];
                        v = v * (f32x4){lo_f(a0), hi_f(a0), lo_f(a1), hi_f(a1)};
                        v = v + (f32x4){lo_f(b0), hi_f(b0), lo_f(b1), hi_f(b1)} * (f32x4){lo_f(c0), hi_f(c0), lo_f(c1), hi_f(c1)};
                        v = v + (f32x4){lo_f(rw[bj][n][0]), hi_f(rw[bj][n][0]), lo_f(rw[bj][n][1]), hi_f(rw[bj][n][1])};
                        o[2 * n] = pk2(v[0], v[1]); o[2 * n + 1] = pk2(v[2], v[3]); }
                    *(u32x4*)(R + (size_t)row * 1024 + colb + bj * 128) = o; } }
    }
};
struct EpiRes {
    float* out; float* xmeta; bf16_t* XB; float* ssq; const float *xin_p, *xin_s, *xin_m;
    __device__ __forceinline__ void operator()(const f32x4 (&acc)[2][2][4][2], const Unit& u, int wr, int wc, int fr, int fq) const {
        const int rowb = u.pm * 256 + wr * 64 + fr, colb = u.pn * 256 + wc * 32 + fq * 4;
        float* base = (u.pm * 256 < NM0) ? out : xmeta - (size_t)NM0 * 1024;
#pragma unroll
        for (int ai = 0; ai < 2; ++ai)
#pragma unroll
            for (int mh = 0; mh < 2; ++mh) {
                f32x4 xv[2][2][2];
#pragma unroll
                for (int m2 = 0; m2 < 2; ++m2)
#pragma unroll
                    for (int bj = 0; bj < 2; ++bj)
#pragma unroll
                        for (int n = 0; n < 2; ++n) { const int rr = rowb + ai * 128 + (mh * 2 + m2) * 16; const float* lp = !xin_p ? base + (size_t)rr * 1024 : (u.pm < 256 ? xin_p + (size_t)rr * 1024 : (u.pm < 260 ? xin_s + (size_t)(rr - NS0) * 1024 : xin_m + (size_t)fr * 1024));
                            xv[m2][bj][n] = __builtin_nontemporal_load((const f32x4*)(lp + colb + bj * 128 + n * 16)); }
#pragma unroll
                for (int m2 = 0; m2 < 2; ++m2) { const int m = mh * 2 + m2, row = rowb + ai * 128 + m * 16; float* rp = base + (size_t)row * 1024 + colb; float ss = 0.f;
#pragma unroll
                    for (int bj = 0; bj < 2; ++bj)
#pragma unroll
                        for (int n = 0; n < 2; ++n) { const f32x4 v = xv[m2][bj][n] + acc[ai][bj][m][n]; *(f32x4*)(rp + bj * 128 + n * 16) = v;
                            if (XB) { u32x2 o; o[0] = pk2(v[0], v[1]); o[1] = pk2(v[2], v[3]); *(u32x2*)(XB + (size_t)row * 1024 + colb + bj * 128 + n * 16) = o; ss += (v[0] * v[0] + v[1] * v[1]) + (v[2] * v[2] + v[3] * v[3]); } }
                    if (XB) { ss += __shfl_xor(ss, 16); ss += __shfl_xor(ss, 32); if (fq == 0) __hip_atomic_fetch_add(ssq + row, ss, __ATOMIC_RELAXED, __HIP_MEMORY_SCOPE_AGENT); } } }
    }
};
struct EpiUp {
    bf16_t* ACT; const float* ssq;
    __device__ __forceinline__ void operator()(const f32x4 (&acc)[2][2][4][2], const Unit& u, int wr, int wc, int fr, int fq) const {
        const int rowb = u.pm * 256 + wr * 64 + fr, colb = u.pn * 256 + wc * 32 + fq * 4;
        float rs[2][4];
#pragma unroll
        for (int ai = 0; ai < 2; ++ai)
#pragma unroll
            for (int m = 0; m < 4; ++m) rs[ai][m] = ssq[rowb + ai * 128 + m * 16];
#pragma unroll
        for (int ai = 0; ai < 2; ++ai)
#pragma unroll
            for (int m = 0; m < 4; ++m) { bf16_t* rp = ACT + (size_t)(rowb + ai * 128 + m * 16) * 4096 + u.pn * 256 + wc * 32 + fq * 8; const float r_ = rsqrtf(rs[ai][m] * (1.f / 1024.f) + EPS);
#pragma unroll
                for (int bj = 0; bj < 2; ++bj) { f32x4 v0 = acc[ai][bj][m][0], v1 = acc[ai][bj][m][1];
#pragma unroll
                    for (int j = 0; j < 4; ++j) { const float r0 = fmaxf(v0[j] * r_, 0.f), r1 = fmaxf(v1[j] * r_, 0.f); v0[j] = r0 * r0; v1[j] = r1 * r1; }
                    u32x4 o; o[0] = pk2(v0[0], v0[1]); o[1] = pk2(v0[2], v0[3]); o[2] = pk2(v1[0], v1[1]); o[3] = pk2(v1[2], v1[3]); *(u32x4*)(rp + bj * 128) = o; } }
    }
};

__device__ __forceinline__ int perm32(int rho) { const int n = rho >> 4, i = rho & 15; return 8 * (i >> 2) + 4 * n + (i & 3); }
__device__ __forceinline__ int col_in(int n) {
    if (n < 2304) return n;
    if (n < 2816) return n + 16;
    if (n < 4352) { const int w0 = n - 2816, seg = w0 >> 9, w = w0 & 511, tile = w >> 8, ct = w & 255, bj = ct >> 7, wc = (ct >> 5) & 3, ww = ct & 31;
        return 2832 + seg * 512 + (tile * 4 + wc) * 64 + 32 * bj + ww; }
    if (n < 7424) return n + 16;
    if (n < 7440) return 2304 + (n - 7424);
    return -1;
}
template <int MAP, bool PERMALL = false>
__device__ __forceinline__ void prep_w(bf16_t* dst, const float* src, int K, int N, int ld, const float* scale, size_t gtid, size_t gsz) {
    const size_t items = (size_t)(K / 8) * N;
    for (size_t it = gtid; it < items; it += gsz) {
        const int n = (int)(it % N), k8 = (int)(it / N);
        const bool pm_ = PERMALL || MAP == 2 || (MAP == 1 && (n < 2816 || (n >= 4352 && n < 7424)));
        const int np = pm_ ? (n & ~31) + perm32(n & 31) : n;
        const int c = MAP == 1 ? col_in(np) : (MAP == 2 ? (((np >> 7) & 1) * 1024 + (np >> 8) * 128 + (np & 127)) : np);
        float v[8];
#pragma unroll
        for (int kk = 0; kk < 8; ++kk) { const int k = k8 * 8 + kk; float x = (c >= 0) ? src[(size_t)k * ld + c] : 0.f; if (scale) x *= scale[k]; v[kk] = x; }
        u32x4 o; o[0] = pk2(v[0], v[1]); o[1] = pk2(v[2], v[3]); o[2] = pk2(v[4], v[5]); o[3] = pk2(v[6], v[7]);
        *(u32x4*)(dst + (size_t)n * K + k8 * 8) = o;
    }
}
__device__ __forceinline__ void rmsnorm_rows(CPar p, const float* g, int from_inputs) {
    const int lane = ltid() & 63, gw = lbid() * 8 + (ltid() >> 6), ngw = lgdim() * 8;
    bf16_t* HB = (bf16_t*)(p->ws + WS_HB);
    f32x4 gv[4];
#pragma unroll
    for (int j = 0; j < 4; ++j) gv[j] = *(const f32x4*)(g + lane * 4 + 256 * j);
    for (int r = gw; r < NROWS; r += ngw) {
        float* xl = xloc(p, r);
        const float* src = xl;
        if (from_inputs) src = r < NS0 ? p->in[I_XP] + (size_t)r * 1024 : (r < NM0 ? p->in[I_XS] + (size_t)(r - NS0) * 1024 : p->in[I_META] + (size_t)((r - NM0) & 15) * 1024);
        f32x4 v[4]; float s = 0.f;
#pragma unroll
        for (int j = 0; j < 4; ++j) { v[j] = *(const f32x4*)(src + lane * 4 + 256 * j); s += (v[j][0] * v[j][0] + v[j][1] * v[j][1]) + (v[j][2] * v[j][2] + v[j][3] * v[j][3]); }
        const float rstd = rsqrtf(wave_sum(s) * (1.f / 1024.f) + EPS);
#pragma unroll
        for (int j = 0; j < 4; ++j) {
            const f32x4 h = v[j] * rstd * gv[j]; u32x2 o; o[0] = pk2(h[0], h[1]); o[1] = pk2(h[2], h[3]); *(u32x2*)(HB + (size_t)r * 1024 + lane * 4 + 256 * j) = o; }
    }
}
__device__ __forceinline__ void ssd_norm_rows(CPar p) {
    const int lane = ltid() & 63, gw = lbid() * 8 + (ltid() >> 6), ngw = lgdim() * 8;
    bf16_t* Z = (bf16_t*)(p->ws + WS_Z);
    for (int r = gw; r < NROWS; r += ngw) {
#pragma unroll
        for (int j = 0; j < 2; ++j) { u32x4* zp = (u32x4*)(Z + (size_t)r * 1024 + j * 512 + lane * 8); const u32x4 w = *zp;
            float f[8] = {lo_f(w[0]), hi_f(w[0]), lo_f(w[1]), hi_f(w[1]), lo_f(w[2]), hi_f(w[2]), lo_f(w[3]), hi_f(w[3])};
            float ss = 0.f;
#pragma unroll
            for (int i = 0; i < 8; ++i) ss += f[i] * f[i];
            const float rs = rsqrtf(wave_sum(ss) * (1.f / 512.f) + EPS);
            u32x4 o; o[0] = pk2(f[0] * rs, f[1] * rs); o[1] = pk2(f[2] * rs, f[3] * rs); o[2] = pk2(f[4] * rs, f[5] * rs); o[3] = pk2(f[6] * rs, f[7] * rs); *zp = o; }
    }
}
__device__ __forceinline__ void phase_prep(CPar p, int l) {
    const size_t gtid = (size_t)lbid() * 512 + ltid(), gsz = (size_t)lgdim() * 512;
    unsigned char* ws = p->ws;
    prep_w<1>((bf16_t*)(ws + W_BT1), p->in[I_WIN] + (size_t)l * 1024 * IN_COLS, 1024, N1, IN_COLS, nullptr, gtid, gsz);
    prep_w<2>((bf16_t*)(ws + W_GLU), p->in[I_WGLU] + (size_t)l * 512 * 2048, 512, 2048, 2048, nullptr, gtid, gsz);
    prep_w<0, true>((bf16_t*)(ws + W_LA), p->in[I_WLA] + (size_t)l * 1024 * 1024, 1024, 1024, 1024, p->in[I_NSSD] + l * 1024, gtid, gsz);
    prep_w<0, true>((bf16_t*)(ws + W_LC), p->in[I_WLC] + (size_t)l * 512 * 1024, 512, 1024, 1024, nullptr, gtid, gsz);
    prep_w<0>((bf16_t*)(ws + W_OUT), p->in[I_WOUT] + (size_t)l * 1024 * 1024, 1024, 1024, 1024, nullptr, gtid, gsz);
    prep_w<0, true>((bf16_t*)(ws + W_UP), p->in[I_WUP] + (size_t)l * 1024 * 4096, 1024, 4096, 4096, p->in[I_NFFN] + l * 1024, gtid, gsz);
    prep_w<0>((bf16_t*)(ws + W_DOWN), p->in[I_WDOWN] + (size_t)l * 4096 * 1024, 4096, 1024, 1024, nullptr, gtid, gsz);
    rmsnorm_rows(p, p->in[I_NMIX] + l * 1024, l == 0);
}

__device__ __forceinline__ bf16_t f2bf_(float v) { return (bf16_t)(pk2(v, v) & 0xffffu); }
__device__ __forceinline__ void ssd_item(CPar p, int l, int item, float* sm) {
    const int tid = ltid(), lane = tid & 63, wave = __builtin_amdgcn_readfirstlane(tid >> 6), rb = wave >> 1, chh = wave & 1, fr = lane & 15, fq = lane >> 4;
    const int s = item < 512 ? (item >> 4) : 32 + ((item - 512) >> 4), h = item & 15, g = h >> 3;
    const bool prompt = s < 32; const int b = prompt ? s : s - 32, T = prompt ? TP : TS;
    constexpr int LB = 72;
    bf16_t *Cb = (bf16_t*)sm, *Bb = Cb + 64 * LB, *XT = Bb + 64 * LB, *WB = XT + 64 * LB, *Mb = WB + 64 * LB, *Sb = Mb + 64 * LB;
    float *sRaw = (float*)(Sb + 64 * LB), *sW = sRaw + 67 * 192, *sdtA = sW + 5 * 192, *sacA = sdtA + 33 * 64, *sw = sacA + 33 * 64;
    const bf16_t* XBC = (const bf16_t*)(p->ws + WS_XBC); bf16_t* Z = (bf16_t*)(p->ws + WS_Z);
    const float* DT = (const float*)(p->ws + WS_DT);
    const float* cw = p->in[I_CONVW] + (size_t)l * 4 * 1280; const float* cb = p->in[I_CONVB] + (size_t)l * 1280;
    const float* hist = p->in[I_SCONV] + (size_t)(l * 16 + b) * 3 * 1280;
    const float dtb = p->in[I_DTB][l * 16 + h], aneg = -__expf(p->in[I_ALOG][l * 16 + h]), dsk = p->in[I_DSSD][l * 16 + h];
    float* sout = prompt ? p->out + O_SSDP + ((size_t)(l * 32 + b) * 16 + h) * 4096 : p->out + O_SSDS + ((size_t)(l * 16 + b) * 16 + h) * 4096;
    for (int i = tid; i < 5 * 192; i += 512) { const int k = i / 192, ch = i - k * 192; const int col = ch < 64 ? h * 64 + ch : (ch < 128 ? 1024 + g * 64 + (ch - 64) : 1152 + g * 64 + (ch - 128));
        sW[i] = k < 4 ? cw[k * 1280 + col] : cb[col]; }
    f32x4 accS[2];
#pragma unroll
    for (int c2 = 0; c2 < 2; ++c2)
#pragma unroll
        for (int r = 0; r < 4; ++r) { const int pp = rb * 16 + fq * 4 + r, n = chh * 32 + c2 * 16 + fr;
            const float v = prompt ? 0.f : p->in[I_SSSD][((size_t)(l * 16 + b) * 16 + h) * 4096 + pp * 64 + n]; accS[c2][r] = v; Sb[pp * LB + n] = f2bf_(v); }
    const int nch = (T + 63) >> 6;
    { const int wv = tid >> 6, ln = tid & 63; float xv[5];
#pragma unroll
        for (int r = 0; r < 5; ++r) { const int c = wv + 8 * r, t = c * 64 + ln; xv[r] = (c < nch && t < T) ? DT[(size_t)row_of(s, t) * 16 + h] + dtb : -1e30f; }
#pragma unroll
        for (int r = 0; r < 5; ++r) { const int c = wv + 8 * r;
            if (c < nch) { const float x = xv[r]; const float dtv = x < -1e29f ? 0.f : (x > 20.f ? x : log1pf(__expf(x))); float cs = dtv * aneg;
#pragma unroll
                for (int o = 1; o < 64; o <<= 1) { const float nb = __shfl_up(cs, o); if (ln >= o) cs += nb; }
                sdtA[c * 64 + ln] = dtv; sacA[c * 64 + ln] = cs; } } }
    u32x4 pf[4];
#define SSD_ISSUE(cc) do { _Pragma("unroll") for (int it4 = 0; it4 < 4; ++it4) { const int pi = tid + it4 * 512; pf[it4] = (u32x4){0u, 0u, 0u, 0u}; \
        if (pi < 67 * 24) { const int rl = pi / 24, pc = pi - rl * 24, seg = pc >> 3, q8 = pc & 7, tt = (cc) * 64 - 3 + rl; \
            const int col = (seg == 0 ? h * 64 : (seg == 1 ? 1024 + g * 64 : 1152 + g * 64)) + q8 * 8; \
            if (tt >= 0 && tt < T) pf[it4] = *(const u32x4*)(XBC + (size_t)row_of(s, tt) * 1280 + col); } } } while (0)
#define SSD_FRAG(P, r0, ks) (*(const bf16x8*)((P) + ((r0) + fr) * LB + (ks) * 32 + fq * 8))
    SSD_ISSUE(0);
#pragma unroll 1
    for (int c = 0; c < nch; ++c) {
        const int t0 = c * 64; const float* sdt = sdtA + t0; const float* sac = sacA + t0;
        __syncthreads();
#pragma unroll
        for (int it4 = 0; it4 < 4; ++it4) { const int pi = tid + it4 * 512;
            if (pi < 67 * 24) { const int rl = pi / 24, pc = pi - rl * 24, seg = pc >> 3, q8 = pc & 7, tt = t0 - 3 + rl;
                const u32x4 w = pf[it4];
                f32x4 f0 = {lo_f(w[0]), hi_f(w[0]), lo_f(w[1]), hi_f(w[1])}, f1 = {lo_f(w[2]), hi_f(w[2]), lo_f(w[3]), hi_f(w[3])};
                if (tt < 0 && !prompt) { const int col = (seg == 0 ? h * 64 : (seg == 1 ? 1024 + g * 64 : 1152 + g * 64)) + q8 * 8; const float* hp = hist + (3 + tt) * 1280 + col; f0 = *(const f32x4*)hp; f1 = *(const f32x4*)(hp + 4); }
                float* dp = sRaw + rl * 192 + seg * 64 + q8 * 8; *(f32x4*)dp = f0; *(f32x4*)(dp + 4) = f1; } }
        if (tid < 64) sw[tid] = __expf(sac[63] - sac[tid]) * sdt[tid];
        if (c + 1 < nch) SSD_ISSUE(c + 1);
        bf16_t zq[2][4];
#pragma unroll
        for (int c2 = 0; c2 < 2; ++c2)
#pragma unroll
            for (int r = 0; r < 4; ++r) { const int t = t0 + rb * 16 + fq * 4 + r; zq[c2][r] = (t < T) ? Z[(size_t)row_of(s, t) * 1024 + h * 64 + chh * 32 + c2 * 16 + fr] : (bf16_t)0; }
        __syncthreads();
        if (tid < 384) { const int ch = tid % 192, tlb = (tid / 192) * 32, cc = ch & 63;
            const float w0 = sW[ch], w1 = sW[192 + ch], w2 = sW[384 + ch], w3 = sW[576 + ch], bias = sW[768 + ch];
            float r0 = sRaw[(tlb + 0) * 192 + ch], r1 = sRaw[(tlb + 1) * 192 + ch], r2 = sRaw[(tlb + 2) * 192 + ch];
            float ov[32];
#pragma unroll
            for (int i2 = 0; i2 < 32; ++i2) { const float r3 = sRaw[(tlb + i2 + 3) * 192 + ch];
                const float v = bias + w0 * r0 + w1 * r1 + w2 * r2 + w3 * r3; ov[i2] = (t0 + tlb + i2 < T) ? siluf_(v) : 0.f; r0 = r1; r1 = r2; r2 = r3; }
            if (ch < 128) { bf16_t* dst = (ch < 64 ? XT : WB) + cc * LB + tlb;
#pragma unroll
                for (int q4 = 0; q4 < 4; ++q4) { u32x4 w;
#pragma unroll
                    for (int c4 = 0; c4 < 4; ++c4) { const int i2 = q4 * 8 + c4 * 2; const float s0 = ch < 64 ? 1.f : sw[tlb + i2], s1 = ch < 64 ? 1.f : sw[tlb + i2 + 1]; w[c4] = pk2(ov[i2] * s0, ov[i2 + 1] * s1); }
                    *(u32x4*)(dst + q4 * 8) = w; } }
            if (ch >= 64) { bf16_t* dst = (ch < 128 ? Bb : Cb) + tlb * LB + cc;
#pragma unroll
                for (int i2 = 0; i2 < 32; ++i2) dst[i2 * LB] = f2bf_(ov[i2]); } }
        __syncthreads();
        f32x4 acc2[2];
        { const bf16x8 aC0 = SSD_FRAG(Cb, rb * 16, 0), aC1 = SSD_FRAG(Cb, rb * 16, 1);
#pragma unroll
            for (int c2 = 0; c2 < 2; ++c2) { const int j0 = chh * 32 + c2 * 16;
                f32x4 m = {0.f, 0.f, 0.f, 0.f};
                if (j0 <= rb * 16 + 15) { m = __builtin_amdgcn_mfma_f32_16x16x32_bf16(aC0, SSD_FRAG(Bb, j0, 0), m, 0, 0, 0); m = __builtin_amdgcn_mfma_f32_16x16x32_bf16(aC1, SSD_FRAG(Bb, j0, 1), m, 0, 0, 0); }
                const int j = j0 + fr; const float acj = sac[j], dtj = sdt[j];
#pragma unroll
                for (int r = 0; r < 4; ++r) { const int tl = rb * 16 + fq * 4 + r; Mb[tl * LB + j] = f2bf_(j <= tl ? m[r] * __expf(sac[tl] - acj) * dtj : 0.f); }
                f32x4 y = {0.f, 0.f, 0.f, 0.f};
                y = __builtin_amdgcn_mfma_f32_16x16x32_bf16(aC0, SSD_FRAG(Sb, j0, 0), y, 0, 0, 0); y = __builtin_amdgcn_mfma_f32_16x16x32_bf16(aC1, SSD_FRAG(Sb, j0, 1), y, 0, 0, 0);
#pragma unroll
                for (int r = 0; r < 4; ++r) y[r] *= __expf(sac[rb * 16 + fq * 4 + r]);
                acc2[c2] = y; }
            const bf16x8 aX0 = SSD_FRAG(XT, rb * 16, 0), aX1 = SSD_FRAG(XT, rb * 16, 1); const float eL = __expf(sac[63]);
#pragma unroll
            for (int c2 = 0; c2 < 2; ++c2) { const int n0 = chh * 32 + c2 * 16; f32x4 sv = accS[c2] * eL;
                sv = __builtin_amdgcn_mfma_f32_16x16x32_bf16(aX0, SSD_FRAG(WB, n0, 0), sv, 0, 0, 0); sv = __builtin_amdgcn_mfma_f32_16x16x32_bf16(aX1, SSD_FRAG(WB, n0, 1), sv, 0, 0, 0); accS[c2] = sv; } }
        __syncthreads();
        { const bf16x8 aM0 = SSD_FRAG(Mb, rb * 16, 0), aM1 = SSD_FRAG(Mb, rb * 16, 1);
#pragma unroll
            for (int c2 = 0; c2 < 2; ++c2) { const int p0 = chh * 32 + c2 * 16, pp = p0 + fr; f32x4 y = acc2[c2];
                y = __builtin_amdgcn_mfma_f32_16x16x32_bf16(aM0, SSD_FRAG(XT, p0, 0), y, 0, 0, 0); y = __builtin_amdgcn_mfma_f32_16x16x32_bf16(aM1, SSD_FRAG(XT, p0, 1), y, 0, 0, 0);
#pragma unroll
                for (int r = 0; r < 4; ++r) { const int tl = rb * 16 + fq * 4 + r, t = t0 + tl;
                    if (t < T) { bf16_t* zp = Z + (size_t)row_of(s, t) * 1024 + h * 64 + pp; const float yy = (y[r] + dsk * bf2f(XT[pp * LB + tl])) * siluf_(bf2f(zq[c2][r])); *zp = f2bf_(yy); } } }
#pragma unroll
            for (int c2 = 0; c2 < 2; ++c2)
#pragma unroll
                for (int r = 0; r < 4; ++r) Sb[(rb * 16 + fq * 4 + r) * LB + chh * 32 + c2 * 16 + fr] = f2bf_(accS[c2][r]); }
    }
    __syncthreads();
#pragma unroll
    for (int c2 = 0; c2 < 2; ++c2)
#pragma unroll
        for (int r = 0; r < 4; ++r) sout[(rb * 16 + fq * 4 + r) * 64 + chh * 32 + c2 * 16 + fr] = accS[c2][r];
    float* cout_ = prompt ? p->out + O_CONVP + (size_t)(l * 32 + b) * 3 * 1280 : p->out + O_CONVS + (size_t)(l * 16 + b) * 3 * 1280;
    for (int idx = tid; idx < 3 * 192; idx += 512) { const int k = idx / 192, ch = idx - k * 192;
        if (ch >= 64 && (h & 7) != 0) continue;
        const int col = ch < 64 ? h * 64 + ch : (ch < 128 ? 1024 + g * 64 + (ch - 64) : 1152 + g * 64 + (ch - 128));
        cout_[k * 1280 + col] = bf2f(XBC[(size_t)row_of(s, T - 3 + k) * 1280 + col]); }
    __syncthreads();
#undef SSD_ISSUE
#undef SSD_FRAG
}

__device__ __forceinline__ void s5_item(CPar p, int l, int s, int g, float* wl) {
    const int lane = ltid() & 63, fr = lane & 15, fq = lane >> 4;
    const bool prompt = s < 32; const int b = prompt ? s : s - 32, T = prompt ? TP : TS, nblk = T >> 4;
    constexpr int LBX = 136;
    bf16_t* Xb = (bf16_t*)wl;
    bf16_t* U = (bf16_t*)(p->ws + WS_U);
    const int gp = (l * 32 + g) * 64 + lane;
    const float lr = p->in[I_LRE][gp], li = p->in[I_LIM][gp], step = expf(p->in[I_LSTEP][l * 32 + g]);
    float sn, cs; sincos_red((double)li * (double)step, sn, cs);
    const float mag = expf(lr * step), ab_re = mag * cs, ab_im = mag * sn;
    const float den = lr * lr + li * li, nr = ab_re - 1.f, f_re = (nr * lr + ab_im * li) / den, f_im = (ab_im * lr - nr * li) / den;
    float bbr[16], bbi[16];
#pragma unroll
    for (int hh = 0; hh < 16; ++hh) { const float br = p->in[I_BRE][(size_t)gp * 16 + hh], bi = p->in[I_BIM][(size_t)gp * 16 + hh]; bbr[hh] = f_re * br - f_im * bi; bbi[hh] = f_re * bi + f_im * br; }
    bf16x8 cfrag[4];
#pragma unroll
    for (int ks = 0; ks < 4; ++ks) { const int k0 = ks * 32 + fq * 8; const bool im = k0 >= 64;
        const float* cp = (im ? p->in[I_CIM] : p->in[I_CRE]) + ((size_t)(l * 32 + g) * 16 + fr) * 64 + (k0 & 63);
        const f32x4 c0 = *(const f32x4*)cp, c1 = *(const f32x4*)(cp + 4); const float sg = im ? -1.f : 1.f;
        u32x4 w; w[0] = pk2(sg * c0[0], sg * c0[1]); w[1] = pk2(sg * c0[2], sg * c0[3]); w[2] = pk2(sg * c1[0], sg * c1[1]); w[3] = pk2(sg * c1[2], sg * c1[3]);
        cfrag[ks] = __builtin_bit_cast(bf16x8, w); }
    float xr = prompt ? 0.f : p->in[I_S5R][(size_t)(l * 16 + b) * 2048 + g * 64 + lane], xi = prompt ? 0.f : p->in[I_S5I][(size_t)(l * 16 + b) * 2048 + g * 64 + lane];
    const float dsk = p->in[I_DS5][(size_t)(l * 32 + g) * 16 + fr];
    u32x4 ua = {0, 0, 0, 0}, ub = {0, 0, 0, 0};
    { const int r0 = row_of(s, 0); if (lane < 16) { const u32x4* up = (const u32x4*)(U + (size_t)(r0 + lane) * 512 + g * 16); ua = up[0]; ub = up[1]; } }
    for (int blk = 0; blk < nblk; ++blk) {
        const int r0 = row_of(s, blk * 16);
        const u32x4 ca = ua, cbv = ub;
        if (blk + 1 < nblk && lane < 16) { const int r1 = row_of(s, blk * 16 + 16); const u32x4* up = (const u32x4*)(U + (size_t)(r1 + lane) * 512 + g * 16); ua = up[0]; ub = up[1]; }
#pragma unroll
        for (int i = 0; i < 16; ++i) {
            float br4[4] = {0.f, 0.f, 0.f, 0.f}, bi4[4] = {0.f, 0.f, 0.f, 0.f};
#pragma unroll
            for (int w = 0; w < 8; ++w) { const unsigned word = (unsigned)__builtin_amdgcn_readlane((int)(w < 4 ? ca[w] : cbv[w - 4]), i);
                const float u0 = lo_f(word), u1 = hi_f(word);
                br4[w & 3] += bbr[2 * w] * u0 + bbr[2 * w + 1] * u1; bi4[w & 3] += bbi[2 * w] * u0 + bbi[2 * w + 1] * u1; }
            const float bur = (br4[0] + br4[1]) + (br4[2] + br4[3]), bui = (bi4[0] + bi4[1]) + (bi4[2] + bi4[3]);
            const float nxr = ab_re * xr - ab_im * xi + bur, nxi = ab_re * xi + ab_im * xr + bui; xr = nxr; xi = nxi;
            Xb[i * LBX + lane] = f2bf_(xr); Xb[i * LBX + 64 + lane] = f2bf_(xi);
        }
        __builtin_amdgcn_wave_barrier(); asm volatile("s_waitcnt lgkmcnt(0)" ::: "memory");
        f32x4 y = {0.f, 0.f, 0.f, 0.f};
#pragma unroll
        for (int ks = 0; ks < 4; ++ks) y = __builtin_amdgcn_mfma_f32_16x16x32_bf16(*(const bf16x8*)(Xb + fr * LBX + ks * 32 + fq * 8), cfrag[ks], y, 0, 0, 0);
#pragma unroll
        for (int r = 0; r < 4; ++r) { bf16_t* up = U + (size_t)(r0 + fq * 4 + r) * 512 + g * 16 + fr; *up = f2bf_(geluf_(y[r] + dsk * bf2f(*up))); }
        __builtin_amdgcn_wave_barrier(); asm volatile("s_waitcnt lgkmcnt(0)" ::: "memory");
    }
    float* ore = prompt ? p->out + O_S5RP + (size_t)(l * 32 + b) * 2048 : p->out + O_S5RS + (size_t)(l * 16 + b) * 2048;
    float* oim = prompt ? p->out + O_S5IP + (size_t)(l * 32 + b) * 2048 : p->out + O_S5IS + (size_t)(l * 16 + b) * 2048;
    ore[g * 64 + lane] = xr; oim[g * 64 + lane] = xi;
}

typedef __bf16 bf2_t __attribute__((ext_vector_type(2)));
__device__ __forceinline__ float dot2bf(unsigned a, unsigned b, float c) { return __builtin_amdgcn_fdot2_f32_bf16(__builtin_bit_cast(bf2_t, a), __builtin_bit_cast(bf2_t, b), c, false); }
__device__ __forceinline__ void attn_item(CPar p, int l, int item, float* wl) {
    const int lane = ltid() & 63;
    int s, h, qt;
    if (item < 8448) { s = item / 264; const int rem = item - s * 264; h = rem / 33; qt = rem - h * 33; } else { const int it = item - 8448; s = 32 + (it >> 3); h = it & 7; qt = 0; }
    const bool prompt = s < 32; const int b = prompt ? s : s - 32, T = prompt ? TP : TS, nh = prompt ? 0 : PAST;
    const int i = qt * 64 + lane; const bool active = i < T; const int row = row_of(s, active ? i : T - 1);
    bf16_t* Q = (bf16_t*)(p->ws + WS_Q);
    unsigned* Kt = (unsigned*)wl; unsigned* Vp = Kt + 32 * 32;
    unsigned q[32]; float o[64];
    { const u32x4* qp = (const u32x4*)(Q + (size_t)row * 512 + h * 64);
#pragma unroll
        for (int e = 0; e < 8; ++e) { const u32x4 w = qp[e];
#pragma unroll
            for (int j = 0; j < 4; ++j) q[e * 4 + j] = pk2(lo_f(w[j]) * 0.125f, hi_f(w[j]) * 0.125f); } }
#pragma unroll
    for (int d = 0; d < 64; ++d) o[d] = 0.f;
    const float* kp_new = prompt ? p->out + O_KP + (size_t)(l * 32 + b) * 2064 * 512 + h * 64 : p->out + O_KS + (size_t)(l * 16 + b) * 64 * 512 + h * 64;
    const float* vp_new = prompt ? p->out + O_VP + (size_t)(l * 32 + b) * 2064 * 512 + h * 64 : p->out + O_VS + (size_t)(l * 16 + b) * 64 * 512 + h * 64;
    const float* kp_old = p->in[I_CK] + (size_t)(l * 16 + b) * 2048 * 512 + h * 64;
    const float* vp_old = p->in[I_CV] + (size_t)(l * 16 + b) * 2048 * 512 + h * 64;
    const int imax = (qt * 64 + 63 < T - 1) ? qt * 64 + 63 : T - 1;
    const int jtop = nh + imax - 1;
    float run = 0.f;
    f32x4 kreg[8], va[4], vb[4];
#define ATT_FETCH(JT) do { _Pragma("unroll") for (int e = 0; e < 8; ++e) { const int idx = e * 64 + lane, kr = idx >> 4, pc = idx & 15, j = (JT) - kr; kreg[e] = (f32x4){0.f, 0.f, 0.f, 0.f}; \
            if (j >= 0) { const float* kp = (j < nh) ? kp_old + (size_t)j * 512 : kp_new + (size_t)(j - nh) * 512; kreg[e] = *(const f32x4*)(kp + pc * 4); } } \
        _Pragma("unroll") for (int e = 0; e < 4; ++e) { const int idx = e * 64 + lane, m = idx >> 4, pc = idx & 15, j0 = (JT) - 2 * m, j1 = j0 - 1; va[e] = (f32x4){0.f, 0.f, 0.f, 0.f}; vb[e] = (f32x4){0.f, 0.f, 0.f, 0.f}; \
            if (j0 >= 0) { const float* vp = (j0 < nh) ? vp_old + (size_t)j0 * 512 : vp_new + (size_t)(j0 - nh) * 512; va[e] = *(const f32x4*)(vp + pc * 4); } \
            if (j1 >= 0) { const float* vp = (j1 < nh) ? vp_old + (size_t)j1 * 512 : vp_new + (size_t)(j1 - nh) * 512; vb[e] = *(const f32x4*)(vp + pc * 4); } } } while (0)
    if (jtop >= 0) ATT_FETCH(jtop);
    for (int jt = jtop; jt >= 0; jt -= 32) {
#pragma unroll
        for (int e = 0; e < 8; ++e) { const int idx = e * 64 + lane, kr = idx >> 4, pc = idx & 15; u32x2 w; w[0] = pk2(kreg[e][0], kreg[e][1]); w[1] = pk2(kreg[e][2], kreg[e][3]); *(u32x2*)(Kt + kr * 32 + pc * 2) = w; }
#pragma unroll
        for (int e = 0; e < 4; ++e) { const int idx = e * 64 + lane, m = idx >> 4, pc = idx & 15;
            u32x4 w; w[0] = pk2(va[e][0], vb[e][0]); w[1] = pk2(va[e][1], vb[e][1]); w[2] = pk2(va[e][2], vb[e][2]); w[3] = pk2(va[e][3], vb[e][3]); *(u32x4*)(Vp + m * 64 + pc * 4) = w; }
        __builtin_amdgcn_wave_barrier(); asm volatile("s_waitcnt lgkmcnt(0)" ::: "memory");
        if (jt - 32 >= 0) ATT_FETCH(jt - 32);
        const int nk = jt + 1 < 32 ? jt + 1 : 32, npair = (nk + 1) >> 1;
        for (int m = 0; m < npair; ++m) { const int j0 = jt - 2 * m, j1 = j0 - 1;
            float z0 = 0.f, z1 = 0.f;
#pragma unroll
            for (int d8 = 0; d8 < 8; ++d8) { const u32x4 k0 = *(const u32x4*)(Kt + (2 * m) * 32 + d8 * 4), k1 = *(const u32x4*)(Kt + (2 * m + 1) * 32 + d8 * 4);
#pragma unroll
                for (int c = 0; c < 4; ++c) { z0 = dot2bf(q[d8 * 4 + c], k0[c], z0); z1 = dot2bf(q[d8 * 4 + c], k1[c], z1); } }
            const bool v0 = active && (j0 < nh + i), v1 = active && (j1 >= 0) && (j1 < nh + i);
            const float e0 = __expf(-z0), ls0 = -__logf(1.f + e0);
            const float w0 = v0 ? __expf(ls0 + run) : 0.f; run += v0 ? (ls0 - z0) : 0.f;
            const float e1 = __expf(-z1), ls1 = -__logf(1.f + e1);
            const float w1 = v1 ? __expf(ls1 + run) : 0.f; run += v1 ? (ls1 - z1) : 0.f;
            const unsigned wp = pk2(w0, w1);
#pragma unroll
            for (int d4 = 0; d4 < 16; ++d4) { const u32x4 vv = *(const u32x4*)(Vp + m * 64 + d4 * 4);
#pragma unroll
                for (int c = 0; c < 4; ++c) o[d4 * 4 + c] = dot2bf(wp, vv[c], o[d4 * 4 + c]); } }
        __builtin_amdgcn_wave_barrier(); asm volatile("s_waitcnt lgkmcnt(0)" ::: "memory");
        const int fin = (!active) || (run < -50.f);
        if (__all(fin)) break;
    }
#undef ATT_FETCH
    if (active) { u32x4* op = (u32x4*)(Q + (size_t)row * 512 + h * 64);
#pragma unroll
        for (int e = 0; e < 8; ++e) { u32x4 w; w[0] = pk2(o[e * 8], o[e * 8 + 1]); w[1] = pk2(o[e * 8 + 2], o[e * 8 + 3]); w[2] = pk2(o[e * 8 + 4], o[e * 8 + 5]); w[3] = pk2(o[e * 8 + 6], o[e * 8 + 7]); op[e] = w; } }
}

__device__ __forceinline__ void phase_mixers(CPar p, int l, float* sm) {
#ifndef SKIP_SSD
    { CPar p1 = params_ptr();
#pragma unroll 1
      for (int it = lbid(); it < 768; it += lgdim()) ssd_item(p1, l, it, sm); }
#endif
    __syncthreads();
    const int wave = __builtin_amdgcn_readfirstlane(ltid() >> 6);
    float* wl = sm + wave * (68 * 64);
#ifndef SKIP_S5
    { CPar p2 = params_ptr();
    if (wave < 4) { for (int it = lbid() * 4 + wave; it < 1024; it += lgdim() * 4) s5_item(p2, l, it >> 5, it & 31, wl); }
    else if (wave < 6) { for (int it = lbid() * 2 + (wave - 4); it < 512; it += lgdim() * 2) s5_item(p2, l, 32 + (it >> 5), it & 31, wl); } }
#endif
#ifndef SKIP_ATT
    CPar p3 = params_ptr();
    unsigned* ctr = (unsigned*)(p3->ws + WS_CTR) + l;
    for (;;) {
        unsigned it = 0; if ((ltid() & 63) == 0) it = atomicAdd(ctr, 1u);
        it = (unsigned)__builtin_amdgcn_readfirstlane((int)it);
        if (it >= 8576u) break;
        attn_item(p3, l, (int)it, wl);
    }
#endif
}

#define XB_TMO      128
#define XB_XCNT(j)  (256  + 64 * (j))
#define XB_XSUB(j)  (1280 + 64 * (j))
#define XB_XGEN(j)  (2304 + 64 * (j))
#define XB_TOP      3328
#define XB_TOPGEN   3392
#define XCD_BAR_WORDS 3456
#define XB_SPIN_CAP (1u << 18)

__device__ __forceinline__ unsigned xb_ld(unsigned* p)              { return __hip_atomic_load(p, __ATOMIC_RELAXED, __HIP_MEMORY_SCOPE_AGENT); }
__device__ __forceinline__ unsigned xb_add(unsigned* p, unsigned v) { return __hip_atomic_fetch_add(p, v, __ATOMIC_RELAXED, __HIP_MEMORY_SCOPE_AGENT); }
__device__ __forceinline__ unsigned xb_xcc_id() { return (unsigned)__builtin_amdgcn_s_getreg((3 << 11) | 20) & 0xFu; }
#define XB_SPIN(cond, bar) do { unsigned _sp = 0; while (cond) { __builtin_amdgcn_s_sleep(1); \
    if ((++_sp & 255u) == 0u) { if (xb_ld(&(bar)[XB_TMO])) break; if (_sp > XB_SPIN_CAP) { atomicAdd(&(bar)[XB_TMO], 1u); break; } } } } while (0)

struct XcdBarrier {
    unsigned* bar; unsigned x;
    volatile LAS unsigned* st;
};

__device__ __forceinline__ XcdBarrier xcd_barrier_post(unsigned* bar, volatile LAS unsigned* st) {
    XcdBarrier b; b.bar = bar; b.x = xb_xcc_id(); b.st = st;
    if (threadIdx.x == 0) (void)xb_add(&bar[XB_XCNT(b.x)], 1u);
    return b;
}
__device__ __forceinline__ void xcd_barrier_complete(unsigned* bar, unsigned x, unsigned& nloc, unsigned& nx) {
    const unsigned G = gridDim.x * gridDim.y * gridDim.z;
    unsigned sum, cnt, mine, sp = 0u;
    for (;;) {
        sum = 0u; cnt = 0u; mine = 0u;
#pragma unroll
        for (unsigned j = 0; j < 16; ++j) { const unsigned c = xb_ld(&bar[XB_XCNT(j)]); sum += c; cnt += (c > 0u) ? 1u : 0u; mine = (j == x) ? c : mine; }
        if (sum == G) break;
        __builtin_amdgcn_s_sleep(1);
        if ((++sp & 255u) == 0u) { if (xb_ld(&bar[XB_TMO])) break; if (sp > XB_SPIN_CAP) { atomicAdd(&bar[XB_TMO], 1u); break; } }
    }
    nloc = mine > 0u ? mine : 1u; nx = cnt > 0u ? cnt : 1u;
}

__device__ __forceinline__ void xcd_barrier(const XcdBarrier& b) {
    asm volatile("s_waitcnt vmcnt(0)" ::: "memory");
    __syncthreads();
    if (threadIdx.x == 0) {
        unsigned* bar = b.bar;
        __builtin_amdgcn_s_waitcnt(0);
        unsigned nloc = b.st[0], nx = b.st[1];
        if (nloc == 0u) { xcd_barrier_complete(bar, b.x, nloc, nx); b.st[0] = nloc; b.st[1] = nx; }
        const unsigned old = xb_add(&bar[XB_XSUB(b.x)], 1u);
        const unsigned gen = old / nloc;
        if (old + 1u == (gen + 1u) * nloc) {
            __builtin_amdgcn_fence(__ATOMIC_RELEASE, "agent");
            asm volatile("s_waitcnt vmcnt(0)" ::: "memory");
            const unsigned og = xb_add(&bar[XB_TOP], 1u);
            const unsigned tg = og / nx;
            if (og + 1u == (tg + 1u) * nx) xb_add(&bar[XB_TOPGEN], 1u);
            else XB_SPIN(xb_ld(&bar[XB_TOPGEN]) == tg, bar);
            __builtin_amdgcn_fence(__ATOMIC_ACQUIRE, "agent");
            xb_add(&bar[XB_XGEN(b.x)], 1u);
            asm volatile("s_waitcnt vmcnt(0)" ::: "memory");
        } else {
            XB_SPIN(xb_ld(&bar[XB_XGEN(b.x)]) == gen, bar);
            __builtin_amdgcn_fence(__ATOMIC_ACQUIRE, "agent");
            asm volatile("s_waitcnt vmcnt(0)" ::: "memory");
        }
    }
    __syncthreads();
}
__global__ __launch_bounds__(512, 2) void mega(Params pk) {
    extern __shared__ __attribute__((aligned(16))) unsigned char smem[];
    cg::grid_group grid = cg::this_grid();
    LAS unsigned char* lds = (LAS unsigned char*)smem;
    const int ph_lo = pk.ph_lo, ph_hi = pk.ph_hi;
    volatile LAS unsigned* xst = (volatile LAS unsigned*)(lds + (LDS_BYTES - 16));
    if (threadIdx.x == 0) { xst[0] = 0u; xst[1] = 0u; }
    const XcdBarrier xb = xcd_barrier_post((unsigned*)(pk.ws + WS_SSQ), xst);
    for (int ph = ph_lo; ph < ph_hi; ++ph) {
        if (ph == ph_lo + 1) grid.sync();
        else if (ph > ph_lo + 1) xcd_barrier(xb);
        CPar p = params_ptr();
        unsigned char* ws = p->ws;
        bf16_t *HB = (bf16_t*)(ws + WS_HB), *Z = (bf16_t*)(ws + WS_Z), *XBC = (bf16_t*)(ws + WS_XBC), *U = (bf16_t*)(ws + WS_U), *Q = (bf16_t*)(ws + WS_Q), *G = (bf16_t*)(ws + WS_G);
        float *DT = (float*)(ws + WS_DT), *XM = (float*)(ws + WS_XMETA);
        const int l = ph >> 3, sub = ph & 7;
        pg8::StaticOrder S;
        if (sub == 0) {
#ifndef SKIP0
            phase_prep(p, l);
#endif
        } else if (sub == 1) {
            S.init(NROWS, N1, lgdim(), lbid());
            EpiIn E{Z, XBC, U, Q, G, DT, p->out, p->in[I_QN] + l * 64, p->in[I_KN] + l * 64, l};
#ifndef SKIP1
            pg8::gemm_phase(lds, pg8::Gemm{HB, (const bf16_t*)(ws + W_BT1), NROWS, N1, 1024, 1024, 1024}, S, E);
#endif
        } else if (sub == 2) {
#ifndef SKIP2
            phase_mixers(p, l, (float*)smem);
#endif
        } else if (sub == 3) {
            ssd_norm_rows(p);
            S.init(NROWS, 2048, lgdim(), lbid());
            EpiGlu E{XBC};
            pg8::gemm_phase(lds, pg8::Gemm{U, (const bf16_t*)(ws + W_GLU), NROWS, 2048, 512, 512, 512}, S, E);
        } else if (sub == 4) {
            S.init(NROWS, 1024, lgdim(), lbid());
            for (int call = 0; call < 2; ++call) {
                EpiMix E; pg8::Gemm g;
                if (call == 0) { E = EpiMix{HB, G, XBC, 0}; g = pg8::Gemm{Z, (const bf16_t*)(ws + W_LA), NROWS, 1024, 1024, 1024, 1024}; }
                else { E = EpiMix{HB, G + 2048, nullptr, 1}; g = pg8::Gemm{Q, (const bf16_t*)(ws + W_LC), NROWS, 1024, 512, 512, 512}; }
#ifndef SKIP3
                pg8::gemm_phase(lds, g, S, E);
#endif
            }
        } else if (sub == 5) {
            S.init(NROWS, 1024, lgdim(), lbid());
            EpiRes E{p->out, XM, (bf16_t*)(ws + WS_XB2), (float*)(ws + WS_SSQX) + (size_t)l * NROWS, l == 0 ? p->in[I_XP] : nullptr, p->in[I_XS], p->in[I_META]};
            pg8::gemm_phase(lds, pg8::Gemm{HB, (const bf16_t*)(ws + W_OUT), NROWS, 1024, 1024, 1024, 1024}, S, E);
        } else if (sub == 6) {
            S.init(NROWS, 4096, lgdim(), lbid());
            EpiUp E{(bf16_t*)(ws + WS_ACT), (const float*)(ws + WS_SSQX) + (size_t)l * NROWS};
            pg8::gemm_phase(lds, pg8::Gemm{(const bf16_t*)(ws + WS_XB2), (const bf16_t*)(ws + W_UP), NROWS, 4096, 1024, 1024, 1024}, S, E);
        } else {
            S.init(NROWS, 1024, lgdim(), lbid());
            EpiRes E{p->out, XM, nullptr, nullptr, nullptr, nullptr, nullptr};
            pg8::gemm_phase(lds, pg8::Gemm{(const bf16_t*)(ws + WS_ACT), (const bf16_t*)(ws + W_DOWN), NROWS, 1024, 4096, 4096, 4096}, S, E);
        }
    }
}

extern "C" void kernel_launch(void* const* d_in, const int* in_sizes, int n_in, void* d_out, int out_size, void* d_ws, size_t ws_size, hipStream_t stream) {
    static int grid = 0;
    if (grid == 0) {
        if (n_in != 34 || (size_t)out_size != O_END || ws_size < WS_END) { fprintf(stderr, "kernel_launch: unexpected shapes n_in %d out %d ws %zu (need %zu)\n", n_in, out_size, ws_size, (size_t)WS_END); grid = -1; return; }
        int dev = 0, cus = 0, per_cu = 0;
        hipGetDevice(&dev); hipDeviceGetAttribute(&cus, hipDeviceAttributeMultiprocessorCount, dev);
        if (hipFuncSetAttribute((const void*)mega, hipFuncAttributeMaxDynamicSharedMemorySize, LDS_BYTES) != hipSuccess) { fprintf(stderr, "kernel_launch: hipFuncSetAttribute failed\n"); grid = -1; return; }
        if (hipOccupancyMaxActiveBlocksPerMultiprocessor(&per_cu, (const void*)mega, 512, LDS_BYTES) != hipSuccess || per_cu < 1) { fprintf(stderr, "kernel_launch: occupancy query says %d\n", per_cu); per_cu = 1; }
        (void)hipGetLastError();
        grid = cus * per_cu;
    }
    if (grid < 0) return;
    if (hipMemsetAsync((char*)d_ws + WS_CTR, 0, 4096, stream) != hipSuccess || hipMemsetAsync((char*)d_ws + WS_SSQ, 0, 16384 + 2ull * NROWS * 4, stream) != hipSuccess) { fprintf(stderr, "kernel_launch: memset failed\n"); return; }
    Params p{};
    for (int i = 0; i < 34; ++i) p.in[i] = (const float*)d_in[i];
    p.out = (float*)d_out; p.ws = (unsigned char*)d_ws;
#if MULTI_LAUNCH
    for (int ph = 0; ph < 16; ++ph) { p.ph_lo = ph; p.ph_hi = ph + 1; hipLaunchKernelGGL(mega, dim3(grid), dim3(512), LDS_BYTES, stream, p); }
#else
    p.ph_lo = 0; p.ph_hi = 16;
    void* args[] = {&p};
    hipError_t e = hipLaunchCooperativeKernel((const void*)mega, dim3(grid), dim3(512), args, LDS_BYTES, stream);
    if (e != hipSuccess) fprintf(stderr, "cooperative launch failed: %s (grid %d)\n", hipGetErrorString(e), grid);
#endif
}
```

```cpp
#include <hip/hip_runtime.h>
#include <hip/hip_cooperative_groups.h>
#include <cstdio>
#include <cstdint>
namespace cg = cooperative_groups;

#ifndef MULTI_LAUNCH
#define MULTI_LAUNCH 0
#endif

typedef unsigned short bf16_t;
typedef short bf16x8 __attribute__((ext_vector_type(8)));
typedef float f32x4 __attribute__((ext_vector_type(4)));
typedef unsigned u32x4 __attribute__((ext_vector_type(4)));
typedef unsigned u32x2 __attribute__((ext_vector_type(2)));
#define LAS __attribute__((address_space(3)))

constexpr int D = 1024, NROWS = 67072, NS0 = 65536, NM0 = 66560;
constexpr int TP = 2064, TS = 64, NB_P = 32, NB_S = 16, PAST = 2048;
constexpr int IN_COLS = 7440, N1 = 7680;
constexpr int SSQ_SLOTS = NM0 + 32 * 32;
constexpr float EPS = 1e-6f;
constexpr size_t O_YP = 0, O_YS = 67108864ull, O_KP = O_YS + 1048576ull, SZ_KP = 2ull * 32 * 2064 * 512, O_VP = O_KP + SZ_KP,
                 O_CONVP = O_VP + SZ_KP, O_SSDP = O_CONVP + 2ull * 32 * 3 * 1280, O_S5RP = O_SSDP + 2ull * 32 * 16 * 4096, O_S5IP = O_S5RP + 2ull * 32 * 2048,
                 O_KS = O_S5IP + 2ull * 32 * 2048, O_VS = O_KS + 2ull * 16 * 64 * 512, O_CONVS = O_VS + 2ull * 16 * 64 * 512, O_SSDS = O_CONVS + 2ull * 16 * 3 * 1280,
                 O_S5RS = O_SSDS + 2ull * 16 * 16 * 4096, O_S5IS = O_S5RS + 2ull * 16 * 2048, O_END = O_S5IS + 2ull * 16 * 2048;
constexpr size_t W_BT1 = 0, W_GLU = W_BT1 + (size_t)N1 * 1024 * 2, W_LA = W_GLU + 2048ull * 512 * 2, W_LC = W_LA + 1024ull * 1024 * 2, W_OUT = W_LC + 1024ull * 512 * 2,
                 W_UP = W_OUT + 1024ull * 1024 * 2, W_DOWN = W_UP + 4096ull * 1024 * 2, W_END = W_DOWN + 4096ull * 1024 * 2;
constexpr size_t WS_CTR = W_END, WS_XMETA = WS_CTR + 4096, WS_HB = WS_XMETA + 512ull * 1024 * 4, WS_Z = WS_HB + (size_t)NROWS * 1024 * 2, WS_XBC = WS_Z + (size_t)NROWS * 1024 * 2,
                 WS_U = WS_XBC + (size_t)NROWS * 1280 * 2, WS_Q = WS_U + (size_t)NROWS * 512 * 2, WS_G = WS_Q + (size_t)NROWS * 512 * 2, WS_DT = WS_G + (size_t)NROWS * 3072 * 2,
                 WS_SSQ = WS_DT + (size_t)NROWS * 16 * 4, WS_END = WS_SSQ + (size_t)SSQ_SLOTS * 16 * 4;
constexpr size_t WS_XB2 = WS_DT - (size_t)NROWS * 1024 * 2;
constexpr size_t WS_SSQX = WS_SSQ + 16384;
constexpr size_t WS_ACT = WS_Z;
static_assert(WS_ACT + (size_t)NROWS * 4096 * 2 <= WS_XB2, "ACT overlay");
static_assert(WS_SSQX + 2ull * NROWS * 4 <= WS_END, "ssqx");
constexpr int LDS_BYTES = 147456;

struct Params {
    const float* in[34];
    float* out;
    unsigned char* ws;
    int ph_lo, ph_hi;
};
typedef const __attribute__((address_space(4))) Params* CPar;
__device__ __forceinline__ CPar params_ptr() { CPar q = (CPar)__builtin_amdgcn_kernarg_segment_ptr(); asm volatile("" : "+s"(q)); return q; }
#define PIN(i) (p->in[i])
enum { I_XP = 0, I_XS, I_CK, I_CV, I_SCONV, I_SSSD, I_S5R, I_S5I, I_META, I_NMIX, I_WIN, I_CONVW, I_CONVB, I_DTB, I_ALOG, I_DSSD, I_NSSD, I_LRE, I_LIM, I_LSTEP, I_BRE, I_BIM,
       I_CRE, I_CIM, I_DS5, I_WGLU, I_QN, I_KN, I_WLA, I_WLC, I_WOUT, I_NFFN, I_WUP, I_WDOWN };

__device__ __forceinline__ int ltid() { int t = threadIdx.x; asm volatile("" : "+v"(t)); return t; }
__device__ __forceinline__ int lbid() { int t = blockIdx.x; asm volatile("" : "+s"(t)); return t; }
__device__ __forceinline__ int lgdim() { int t = gridDim.x; asm volatile("" : "+s"(t)); return t; }

__device__ __forceinline__ float bf2f(bf16_t v) { return __uint_as_float((unsigned)v << 16); }
__device__ __forceinline__ unsigned pk2(float lo, float hi) { unsigned r; asm volatile("v_cvt_pk_bf16_f32 %0, %1, %2" : "=v"(r) : "v"(lo), "v"(hi)); return r; }
__device__ __forceinline__ float lo_f(unsigned w) { return __uint_as_float(w << 16); }
__device__ __forceinline__ float hi_f(unsigned w) { return __uint_as_float(w & 0xffff0000u); }
__device__ __forceinline__ u32x2 ld_l2_u32x2(const void* ptr) { const unsigned long long v = __hip_atomic_load((const unsigned long long*)ptr, __ATOMIC_RELAXED, __HIP_MEMORY_SCOPE_AGENT); u32x2 r; r[0] = (unsigned)v; r[1] = (unsigned)(v >> 32); return r; }
__device__ __forceinline__ float sigmoidf_(float v) { return __builtin_amdgcn_rcpf(1.f + __expf(-v)); }
__device__ __forceinline__ float siluf_(float v) { return v * sigmoidf_(v); }
__device__ __forceinline__ float geluf_(float y) { const float a = 0.7978845608f * (y + 0.044715f * y * y * y); const float t = __expf(2.f * a); return 0.5f * y * (2.f - 2.f * __builtin_amdgcn_rcpf(t + 1.f)); }
__device__ __forceinline__ float wave_sum(float v) {
#pragma unroll
    for (int o = 1; o < 64; o <<= 1) v += __shfl_xor(v, o);
    return v;
}
__device__ __forceinline__ void sincos_red(double x, float& sn, float& cs) {
    const double k = __builtin_rint(x * 0.63661977236758134308);
    const float r = (float)__builtin_fma(-k, 1.57079632679489661923, x), r2 = r * r;
    const float sp = r + r * r2 * (-1.6666667163e-01f + r2 * (8.3333337680e-03f + r2 * (-1.9841270114e-04f + r2 * 2.7557314297e-06f)));
    const float cp = 1.f + r2 * (-0.5f + r2 * (4.1666667908e-02f + r2 * (-1.3888889225e-03f + r2 * (2.4801587642e-05f - r2 * 2.7557314297e-07f))));
    const int q = ((int)k) & 3;
    sn = (q == 0) ? sp : (q == 1) ? cp : (q == 2) ? -sp : -cp;
    cs = (q == 0) ? cp : (q == 1) ? -sp : (q == 2) ? -cp : sp;
}
__device__ __forceinline__ int row_of(int s, int t) { return s < 32 ? (t < 16 ? NM0 + s * 16 + t : s * 2048 + t - 16) : NS0 + (s - 32) * 64 + t; }
__device__ __forceinline__ int ssq_slot(int r) { return r < NM0 ? r : NM0 + ((r - NM0) >> 4) * 32 + ((r - NM0) & 15); }
__device__ __forceinline__ float* xloc(CPar p, int r) { return r < NM0 ? p->out + (size_t)r * 1024 : (float*)(p->ws + WS_XMETA) + (size_t)(r - NM0) * 1024; }
__device__ __forceinline__ size_t k_off(int l, int r) {
    if (r < NS0) return O_KP + ((size_t)(l * 32 + (r >> 11)) * 2064 + 16 + (r & 2047)) * 512;
    if (r < NM0) { const int rs = r - NS0; return O_KS + ((size_t)(l * 16 + (rs >> 6)) * 64 + (rs & 63)) * 512; }
    const int rm = r - NM0; return O_KP + ((size_t)(l * 32 + (rm >> 4)) * 2064 + (rm & 15)) * 512;
}

namespace pg8 {
constexpr int BM = 256, BK = 64, HALF = 128, HTB = HALF * BK * 2, STAGE_BYTES = 8 * HTB, NXCD = 8, WGM = 8;
__host__ __device__ __forceinline__ int lds_byte(int r, int c) { const int st = (r >> 4) * 2 + (c >> 5), rr = r & 15, cc = c & 31, ob = rr * 64 + cc * 2; return st * 1024 + (ob ^ (((ob >> 9) & 1) << 5)); }
__host__ __device__ __forceinline__ void stage_rc(int b, int& R, int& C) { const int st = b / 1024, sb = b % 1024, swz = sb ^ (((sb >> 9) & 1) << 5); R = (st >> 1) * 16 + swz / 64; C = (st & 1) * 32 + (swz % 64) / 2; }
struct Unit { int pm, pn; };
struct Gemm { const bf16_t* A; const bf16_t* Bt; int M, N, K, lda, ldb; };
struct StaticOrder {
    int nM, nN, nwg, G, c;
    __device__ void init(int M, int N, int G_, int c_) { nM = M / BM; nN = N / BM; nwg = nM * nN; G = G_; c = c_; }
    __device__ bool next(int i, Unit& u) const {
        const long L = (long)i * G + c; if (L >= nwg) return false;
        int wgid = (int)L; { const int q = nwg / NXCD, r = nwg % NXCD, xcd = wgid % NXCD, off = wgid / NXCD; wgid = (xcd < r ? xcd * (q + 1) : r * (q + 1) + (xcd - r) * q) + off; }
        const int nig = WGM * nN, gid = wgid / nig, fm = gid * WGM, gsz = (nM - fm) < WGM ? (nM - fm) : WGM;
        u.pm = fm + ((wgid % nig) % gsz); u.pn = (wgid % nig) / gsz; return true;
    }
};
template <class Epi>
__device__ __forceinline__ void gemm_phase(LAS unsigned char* lds, const Gemm g, const StaticOrder& S, const Epi& E) {
    const int tid = ltid(), wid = __builtin_amdgcn_readfirstlane(tid >> 6), lane = tid & 63, wr = wid >> 2, wc = wid & 3, fr = lane & 15, fq = lane >> 4;
    const int K = g.K, nt = K / BK;
    unsigned voffA[2], voffB[2];
#pragma unroll
    for (int i = 0; i < 2; ++i) { int R, C; stage_rc(tid * 16 + i * 8192, R, C); voffA[i] = (unsigned)(R * g.lda + C) * 2u; voffB[i] = (unsigned)(R * g.ldb + C) * 2u; }
    const size_t kstep = (size_t)(BK * 2);
    const size_t hstepA = (size_t)HALF * g.lda * 2, hstepB = (size_t)HALF * g.ldb * 2;
    const size_t tstepA = 2 * hstepA, tstepB = 2 * hstepB;
    const unsigned ldsw = (unsigned)wid * 1024u;
    const int aoff = lds_byte(wr * 64 + fr, fq * 8), boff = lds_byte(wc * 32 + fr, fq * 8);
#define PG8_SA(b, h) (((b) * 2 + (h)) * HTB)
#define PG8_SB(b, h) ((4 + (b) * 2 + (h)) * HTB)
#define PG8_STAGE(bufoff, gbase, voff) do { _Pragma("unroll") for (int _i = 0; _i < 2; ++_i) \
        __builtin_amdgcn_global_load_lds((const unsigned*)((const char*)(gbase) + (voff)[_i]), (LAS unsigned*)(lds + (bufoff) + ldsw + _i * 8192), 16, 0, 0); } while (0)
#define PG8_LDA(dst, b, h) do { _Pragma("unroll") for (int m = 0; m < 4; ++m) _Pragma("unroll") for (int k = 0; k < 2; ++k) dst[m][k] = *(const LAS bf16x8*)(lds + PG8_SA(b, h) + aoff + m * 2048 + k * 1024); } while (0)
#define PG8_LDB(dst, b, h) do { _Pragma("unroll") for (int n = 0; n < 2; ++n) _Pragma("unroll") for (int k = 0; k < 2; ++k) dst[n][k] = *(const LAS bf16x8*)(lds + PG8_SB(b, h) + boff + n * 2048 + k * 1024); } while (0)
#define PG8_MMA(ai, bj, At, Bt) do { __builtin_amdgcn_s_setprio(1); _Pragma("unroll") for (int m = 0; m < 4; ++m) _Pragma("unroll") for (int n = 0; n < 2; ++n) _Pragma("unroll") for (int k = 0; k < 2; ++k) \
        acc[ai][bj][m][n] = __builtin_amdgcn_mfma_f32_16x16x32_bf16(Bt[n][k], At[m][k], acc[ai][bj][m][n], 0, 0, 0); __builtin_amdgcn_s_setprio(0); } while (0)
#define PG8_WAIT_V(n) asm volatile("s_waitcnt vmcnt(" #n ")" ::: "memory")
#define PG8_WAIT_L(n) asm volatile("s_waitcnt lgkmcnt(" #n ")" ::: "memory")
#define PG8_BAR __builtin_amdgcn_s_barrier()
#define PG8_SCHED __builtin_amdgcn_sched_barrier(0)
    Unit cur, nxt; int ui = 0;
    if (!S.next(0, cur)) return;
    f32x4 acc[2][2][4][2];
#pragma unroll
    for (int a = 0; a < 2; ++a)
#pragma unroll
        for (int b = 0; b < 2; ++b)
#pragma unroll
            for (int m = 0; m < 4; ++m)
#pragma unroll
                for (int n = 0; n < 2; ++n) acc[a][b][m][n] = (f32x4){0.f, 0.f, 0.f, 0.f};
    bf16x8 At[4][2], B0[2][2], B1[2][2];
    const char* cA = (const char*)g.A + (size_t)cur.pm * tstepA; const char* cB = (const char*)g.Bt + (size_t)cur.pn * tstepB;
    PG8_STAGE(PG8_SB(0, 0), cB, voffB); PG8_STAGE(PG8_SA(0, 0), cA, voffA); PG8_STAGE(PG8_SB(0, 1), cB + hstepB, voffB); PG8_STAGE(PG8_SA(0, 1), cA + hstepA, voffA);
    if (wr == 1) PG8_BAR;
    PG8_WAIT_V(4); PG8_BAR;
    PG8_STAGE(PG8_SB(1, 0), cB + kstep, voffB); PG8_STAGE(PG8_SA(1, 0), cA + kstep, voffA); PG8_STAGE(PG8_SB(1, 1), cB + hstepB + kstep, voffB);
    PG8_WAIT_V(6); PG8_BAR;
    for (;;) {
        const bool has_next = S.next(ui + 1, nxt);
        const char* nA = has_next ? (const char*)g.A + (size_t)nxt.pm * tstepA : cA; const char* nB = has_next ? (const char*)g.Bt + (size_t)nxt.pn * tstepB : cB;
        for (int t = 0; t < nt; t += 2) {
            const bool last = (t == nt - 2);
            const char* a1 = cA + (size_t)(t + 1) * kstep;
            const char* a2 = last ? nA : cA + (size_t)(t + 2) * kstep; const char* b2 = last ? nB : cB + (size_t)(t + 2) * kstep;
            const char* a3 = a2 + kstep; const char* b3 = b2 + kstep;
            PG8_LDB(B0, 0, 0); PG8_SCHED; PG8_LDA(At, 0, 0); PG8_STAGE(PG8_SA(1, 1), a1 + hstepA, voffA);
            PG8_WAIT_L(8); PG8_BAR; PG8_WAIT_L(0); PG8_MMA(0, 0, At, B0); PG8_BAR; PG8_SCHED;
            PG8_LDB(B1, 0, 1); PG8_STAGE(PG8_SB(0, 0), b2, voffB);
            PG8_BAR; PG8_WAIT_L(0); PG8_MMA(0, 1, At, B1); PG8_BAR;
            PG8_LDA(At, 0, 1); PG8_STAGE(PG8_SA(0, 0), a2, voffA);
            PG8_BAR; PG8_WAIT_L(0); PG8_MMA(1, 0, At, B0); PG8_BAR; PG8_SCHED;
            PG8_STAGE(PG8_SB(0, 1), b2 + hstepB, voffB);
            PG8_WAIT_V(6); PG8_BAR; PG8_MMA(1, 1, At, B1); PG8_BAR;
            PG8_LDB(B0, 1, 0); PG8_SCHED; PG8_LDA(At, 1, 0); PG8_STAGE(PG8_SA(0, 1), a2 + hstepA, voffA);
            PG8_WAIT_L(8); PG8_BAR; PG8_WAIT_L(0); PG8_MMA(0, 0, At, B0); PG8_BAR; PG8_SCHED;
            PG8_LDB(B1, 1, 1); PG8_STAGE(PG8_SB(1, 0), b3, voffB);
            PG8_BAR; PG8_WAIT_L(0); PG8_MMA(0, 1, At, B1); PG8_BAR;
            PG8_LDA(At, 1, 1); PG8_STAGE(PG8_SA(1, 0), a3, voffA);
            PG8_BAR; PG8_WAIT_L(0); PG8_MMA(1, 0, At, B0); PG8_BAR; PG8_SCHED;
            PG8_STAGE(PG8_SB(1, 1), b3 + hstepB, voffB);
            PG8_WAIT_V(6); PG8_BAR; PG8_MMA(1, 1, At, B1); PG8_BAR;
        }
        E(acc, cur, wr, wc, fr, fq);
        if (!has_next) break;
#pragma unroll
        for (int a = 0; a < 2; ++a)
#pragma unroll
            for (int b = 0; b < 2; ++b)
#pragma unroll
                for (int m = 0; m < 4; ++m)
#pragma unroll
                    for (int n = 0; n < 2; ++n) acc[a][b][m][n] = (f32x4){0.f, 0.f, 0.f, 0.f};
        cur = nxt; cA = nA; cB = nB; ++ui;
    }
    PG8_WAIT_V(0);
    if (wr == 0) PG8_BAR;
    PG8_BAR;
#undef PG8_SA
#undef PG8_SB
#undef PG8_STAGE
#undef PG8_LDA
#undef PG8_LDB
#undef PG8_MMA
#undef PG8_WAIT_V
#undef PG8_WAIT_L
#undef PG8_BAR
#undef PG8_SCHED
}
}
using pg8::Unit;

struct EpiIn {
    bf16_t *Z, *XBC, *U, *Q, *G; float* DT; float* out; const float *qn, *kn; int layer;
    __device__ __forceinline__ void operator()(const f32x4 (&acc)[2][2][4][2], const Unit& u, int wr, int wc, int fr, int fq) const {
        const int pn = u.pn, rowb = u.pm * 256 + wr * 64 + fr, ctb = wc * 32 + fq * 4;
        if (pn < 11 || (pn >= 17 && pn < 29)) {
            bf16_t* base; int ld, col0; bool sig = false;
            if (pn < 4) { base = Z; ld = 1024; col0 = pn * 256; } else if (pn < 9) { base = XBC; ld = 1280; col0 = (pn - 4) * 256; }
            else if (pn < 11) { base = U; ld = 512; col0 = (pn - 9) * 256; } else { base = G; ld = 3072; col0 = (pn - 17) * 256; sig = true; }
#pragma unroll
            for (int ai = 0; ai < 2; ++ai)
#pragma unroll
                for (int m = 0; m < 4; ++m) { bf16_t* rp = base + (size_t)(rowb + ai * 128 + m * 16) * ld + col0 + wc * 32 + fq * 8;
#pragma unroll
                    for (int bj = 0; bj < 2; ++bj) { f32x4 v0 = acc[ai][bj][m][0], v1 = acc[ai][bj][m][1];
                        if (sig) {
#pragma unroll
                            for (int j = 0; j < 4; ++j) { v0[j] = sigmoidf_(v0[j]); v1[j] = sigmoidf_(v1[j]); } }
                        u32x4 o; o[0] = pk2(v0[0], v0[1]); o[1] = pk2(v0[2], v0[3]); o[2] = pk2(v1[0], v1[1]); o[3] = pk2(v1[2], v1[3]); *(u32x4*)(rp + bj * 128) = o; } }
        } else if (pn < 17) {
            const int seg = (pn - 11) >> 1, head = ((pn - 11) & 1) * 4 + wc;
            const float* nw = seg == 0 ? qn : kn;
            f32x4 wv[2][2];
#pragma unroll
            for (int bj = 0; bj < 2; ++bj)
#pragma unroll
                for (int n = 0; n < 2; ++n) wv[bj][n] = (seg < 2) ? *(const f32x4*)(nw + 32 * bj + 16 * n + 4 * fq) : (f32x4){1.f, 1.f, 1.f, 1.f};
#pragma unroll
            for (int ai = 0; ai < 2; ++ai)
#pragma unroll
                for (int m = 0; m < 4; ++m) { const int row = rowb + ai * 128 + m * 16;
                    float rs = 1.f;
                    if (seg < 2) { float ss = 0.f;
#pragma unroll
                        for (int bj = 0; bj < 2; ++bj)
#pragma unroll
                            for (int n = 0; n < 2; ++n) { const f32x4 v = acc[ai][bj][m][n]; ss += v[0] * v[0] + v[1] * v[1] + v[2] * v[2] + v[3] * v[3]; }
                        ss += __shfl_xor(ss, 16); ss += __shfl_xor(ss, 32);
                        rs = rsqrtf(ss * (1.f / 64.f) + EPS); }
                    if (seg == 0) { bf16_t* rp = Q + (size_t)row * 512 + head * 64 + 4 * fq;
#pragma unroll
                        for (int bj = 0; bj < 2; ++bj)
#pragma unroll
                            for (int n = 0; n < 2; ++n) { const f32x4 v = acc[ai][bj][m][n] * rs * wv[bj][n]; u32x2 o; o[0] = pk2(v[0], v[1]); o[1] = pk2(v[2], v[3]); *(u32x2*)(rp + 32 * bj + 16 * n) = o; }
                    } else { float* rp = out + k_off(layer, row) + (seg == 2 ? (row >= NS0 && row < NM0 ? (O_VS - O_KS) : (O_VP - O_KP)) : 0) + head * 64 + 4 * fq;
#pragma unroll
                        for (int bj = 0; bj < 2; ++bj)
#pragma unroll
                            for (int n = 0; n < 2; ++n) { const f32x4 v = acc[ai][bj][m][n] * rs * wv[bj][n]; *(f32x4*)(rp + 32 * bj + 16 * n) = v; } } }
        } else {
            if (wc == 0) {
#pragma unroll
                for (int ai = 0; ai < 2; ++ai)
#pragma unroll
                    for (int m = 0; m < 4; ++m) *(f32x4*)(DT + (size_t)(rowb + ai * 128 + m * 16) * 16 + 4 * fq) = acc[ai][0][m][0];
            }
        }
    }
};
struct EpiGlu {
    bf16_t* OB;
    __device__ __forceinline__ void operator()(const f32x4 (&acc)[2][2][4][2], const Unit& u, int wr, int wc, int fr, int fq) const {
        const int rowb = u.pm * 256 + wr * 64 + fr, colb = u.pn * 128 + wc * 32 + fq * 8;
#pragma unroll
        for (int ai = 0; ai < 2; ++ai)
#pragma unroll
            for (int m = 0; m < 4; ++m) { bf16_t* rp = OB + (size_t)(rowb + ai * 128 + m * 16) * 1024 + colb;
                const f32x4 a0 = acc[ai][0][m][0], g0 = acc[ai][1][m][0], a1 = acc[ai][0][m][1], g1 = acc[ai][1][m][1];
                u32x4 o; o[0] = pk2(a0[0] * sigmoidf_(g0[0]), a0[1] * sigmoidf_(g0[1])); o[1] = pk2(a0[2] * sigmoidf_(g0[2]), a0[3] * sigmoidf_(g0[3]));
                o[2] = pk2(a1[0] * sigmoidf_(g1[0]), a1[1] * sigmoidf_(g1[1])); o[3] = pk2(a1[2] * sigmoidf_(g1[2]), a1[3] * sigmoidf_(g1[3])); *(u32x4*)rp = o; }
    }
};
struct EpiMix {
    bf16_t* R; const bf16_t* G; const bf16_t* OB; int accum;
    __device__ __forceinline__ void operator()(const f32x4 (&acc)[2][2][4][2], const Unit& u, int wr, int wc, int fr, int fq) const {
        const int rowb = u.pm * 256 + wr * 64 + fr, colb = u.pn * 256 + wc * 32 + fq * 8;
#pragma unroll
        for (int ai = 0; ai < 2; ++ai)
#pragma unroll
            for (int m = 0; m < 4; ++m) { const int row = rowb + ai * 128 + m * 16;
                u32x4 gw[2], g1[2], ob[2]; u32x2 rw[2][2];
#pragma unroll
                for (int bj = 0; bj < 2; ++bj) { const int col = colb + bj * 128;
                    gw[bj] = *(const u32x4*)(G + (size_t)row * 3072 + col);
                    g1[bj] = (u32x4){0u, 0u, 0u, 0u}; ob[bj] = (u32x4){0u, 0u, 0u, 0u}; rw[bj][0] = (u32x2){0u, 0u}; rw[bj][1] = (u32x2){0u, 0u};
                    if (OB) { g1[bj] = *(const u32x4*)(G + (size_t)row * 3072 + 1024 + col); ob[bj] = *(const u32x4*)(OB + (size_t)row * 1024 + col); }
                    if (accum) { rw[bj][0] = ld_l2_u32x2(R + (size_t)row * 1024 + col); rw[bj][1] = ld_l2_u32x2(R + (size_t)row * 1024 + col + 4); } }
#pragma unroll
                for (int bj = 0; bj < 2; ++bj) { u32x4 o;
#pragma unroll
                    for (int n = 0; n < 2; ++n) { f32x4 v = acc[ai][bj][m][n];
                        const unsigned a0 = gw[bj][2 * n], a1 = gw[bj][2 * n + 1], b0 = g1[bj][2 * n], b1 = g1[bj][2 * n + 1], c0 = ob[bj][2 * n], c1 = ob[bj][2 * n + 1];
                        v = v * (f32x4){lo_f(a0), hi_f(a0), lo_f(a1), hi_f(a1)};
                        v = v + (f32x4){lo_f(b0), hi_f(b0), lo_f(b1), hi_f(b1)} * (f32x4){lo_f(c0), hi_f(c0), lo_f(c1), hi_f(c1)};
                        v = v + (f32x4){lo_f(rw[bj][n][0]), hi_f(rw[bj][n][0]), lo_f(rw[bj][n][1]), hi_f(rw[bj][n][1])};
                        o[2 * n] = pk2(v[0], v[1]); o[2 * n + 1] = pk2(v[2], v[3]); }
                    *(u32x4*)(R + (size_t)row * 1024 + colb + bj * 128) = o; } }
    }
};
struct EpiRes {
    float* out; float* xmeta; bf16_t* XB; float* ssq; const float *xin_p, *xin_s, *xin_m;
    __device__ __forceinline__ void operator()(const f32x4 (&acc)[2][2][4][2], const Unit& u, int wr, int wc, int fr, int fq) const {
        const int rowb = u.pm * 256 + wr * 64 + fr, colb = u.pn * 256 + wc * 32 + fq * 4;
        float* base = (u.pm * 256 < NM0) ? out : xmeta - (size_t)NM0 * 1024;
#pragma unroll
        for (int ai = 0; ai < 2; ++ai)
#pragma unroll
            for (int mh = 0; mh < 2; ++mh) {
                f32x4 xv[2][2][2];
#pragma unroll
                for (int m2 = 0; m2 < 2; ++m2)
#pragma unroll
                    for (int bj = 0; bj < 2; ++bj)
#pragma unroll
                        for (int n = 0; n < 2; ++n) { const int rr = rowb + ai * 128 + (mh * 2 + m2) * 16; const float* lp = !xin_p ? base + (size_t)rr * 1024 : (u.pm < 256 ? xin_p + (size_t)rr * 1024 : (u.pm < 260 ? xin_s + (size_t)(rr - NS0) * 1024 : xin_m + (size_t)fr * 1024));
                            xv[m2][bj][n] = *(const f32x4*)(lp + colb + bj * 128 + n * 16); }
#pragma unroll
                for (int m2 = 0; m2 < 2; ++m2) { const int m = mh * 2 + m2, row = rowb + ai * 128 + m * 16; float* rp = base + (size_t)row * 1024 + colb; float ss = 0.f;
#pragma unroll
                    for (int bj = 0; bj < 2; ++bj)
#pragma unroll
                        for (int n = 0; n < 2; ++n) { const f32x4 v = xv[m2][bj][n] + acc[ai][bj][m][n]; *(f32x4*)(rp + bj * 128 + n * 16) = v;
                            if (XB) { u32x2 o; o[0] = pk2(v[0], v[1]); o[1] = pk2(v[2], v[3]); *(u32x2*)(XB + (size_t)row * 1024 + colb + bj * 128 + n * 16) = o; ss += (v[0] * v[0] + v[1] * v[1]) + (v[2] * v[2] + v[3] * v[3]); } }
                    if (XB) { ss += __shfl_xor(ss, 16); ss += __shfl_xor(ss, 32); if (fq == 0) __hip_atomic_fetch_add(ssq + row, ss, __ATOMIC_RELAXED, __HIP_MEMORY_SCOPE_AGENT); } } }
    }
};
struct EpiUp {
    bf16_t* ACT; const float* ssq;
    __device__ __forceinline__ void operator()(const f32x4 (&acc)[2][2][4][2], const Unit& u, int wr, int wc, int fr, int fq) const {
        const int rowb = u.pm * 256 + wr * 64 + fr, colb = u.pn * 256 + wc * 32 + fq * 4;
        float rs[2][4];
#pragma unroll
        for (int ai = 0; ai < 2; ++ai)
#pragma unroll
            for (int m = 0; m < 4; ++m) rs[ai][m] = ssq[rowb + ai * 128 + m * 16];
#pragma unroll
        for (int ai = 0; ai < 2; ++ai)
#pragma unroll
            for (int m = 0; m < 4; ++m) { bf16_t* rp = ACT + (size_t)(rowb + ai * 128 + m * 16) * 4096 + u.pn * 256 + wc * 32 + fq * 8; const float r_ = rsqrtf(rs[ai][m] * (1.f / 1024.f) + EPS);
#pragma unroll
                for (int bj = 0; bj < 2; ++bj) { f32x4 v0 = acc[ai][bj][m][0], v1 = acc[ai][bj][m][1];
#pragma unroll
                    for (int j = 0; j < 4; ++j) { const float r0 = fmaxf(v0[j] * r_, 0.f), r1 = fmaxf(v1[j] * r_, 0.f); v0[j] = r0 * r0; v1[j] = r1 * r1; }
                    u32x4 o; o[0] = pk2(v0[0], v0[1]); o[1] = pk2(v0[2], v0[3]); o[2] = pk2(v1[0], v1[1]); o[3] = pk2(v1[2], v1[3]); *(u32x4*)(rp + bj * 128) = o; } }
    }
};

__device__ __forceinline__ int perm32(int rho) { const int n = rho >> 4, i = rho & 15; return 8 * (i >> 2) + 4 * n + (i & 3); }
__device__ __forceinline__ int col_in(int n) {
    if (n < 2304) return n;
    if (n < 2816) return n + 16;
    if (n < 4352) { const int w0 = n - 2816, seg = w0 >> 9, w = w0 & 511, tile = w >> 8, ct = w & 255, bj = ct >> 7, wc = (ct >> 5) & 3, ww = ct & 31;
        return 2832 + seg * 512 + (tile * 4 + wc) * 64 + 32 * bj + ww; }
    if (n < 7424) return n + 16;
    if (n < 7440) return 2304 + (n - 7424);
    return -1;
}
template <int MAP, bool PERMALL = false>
__device__ __forceinline__ void prep_w(bf16_t* dst, const float* src, int K, int N, int ld, const float* scale, size_t gtid, size_t gsz) {
    const size_t items = (size_t)(K / 8) * N;
    for (size_t it = gtid; it < items; it += gsz) {
        const int n = (int)(it % N), k8 = (int)(it / N);
        const bool pm_ = PERMALL || MAP == 2 || (MAP == 1 && (n < 2816 || (n >= 4352 && n < 7424)));
        const int np = pm_ ? (n & ~31) + perm32(n & 31) : n;
        const int c = MAP == 1 ? col_in(np) : (MAP == 2 ? (((np >> 7) & 1) * 1024 + (np >> 8) * 128 + (np & 127)) : np);
        float v[8];
#pragma unroll
        for (int kk = 0; kk < 8; ++kk) { const int k = k8 * 8 + kk; float x = (c >= 0) ? src[(size_t)k * ld + c] : 0.f; if (scale) x *= scale[k]; v[kk] = x; }
        u32x4 o; o[0] = pk2(v[0], v[1]); o[1] = pk2(v[2], v[3]); o[2] = pk2(v[4], v[5]); o[3] = pk2(v[6], v[7]);
        *(u32x4*)(dst + (size_t)n * K + k8 * 8) = o;
    }
}
__device__ __forceinline__ void rmsnorm_rows(CPar p, const float* g, int from_inputs) {
    const int lane = ltid() & 63, gw = lbid() * 8 + (ltid() >> 6), ngw = lgdim() * 8;
    bf16_t* HB = (bf16_t*)(p->ws + WS_HB);
    f32x4 gv[4];
#pragma unroll
    for (int j = 0; j < 4; ++j) gv[j] = *(const f32x4*)(g + lane * 4 + 256 * j);
    for (int r = gw; r < NROWS; r += ngw) {
        float* xl = xloc(p, r);
        const float* src = xl;
        if (from_inputs) src = r < NS0 ? p->in[I_XP] + (size_t)r * 1024 : (r < NM0 ? p->in[I_XS] + (size_t)(r - NS0) * 1024 : p->in[I_META] + (size_t)((r - NM0) & 15) * 1024);
        f32x4 v[4]; float s = 0.f;
#pragma unroll
        for (int j = 0; j < 4; ++j) { v[j] = *(const f32x4*)(src + lane * 4 + 256 * j); s += (v[j][0] * v[j][0] + v[j][1] * v[j][1]) + (v[j][2] * v[j][2] + v[j][3] * v[j][3]); }
        const float rstd = rsqrtf(wave_sum(s) * (1.f / 1024.f) + EPS);
#pragma unroll
        for (int j = 0; j < 4; ++j) {
            const f32x4 h = v[j] * rstd * gv[j]; u32x2 o; o[0] = pk2(h[0], h[1]); o[1] = pk2(h[2], h[3]); *(u32x2*)(HB + (size_t)r * 1024 + lane * 4 + 256 * j) = o; }
    }
}
__device__ __forceinline__ void ssd_norm_rows(CPar p) {
    const int lane = ltid() & 63, gw = lbid() * 8 + (ltid() >> 6), ngw = lgdim() * 8;
    bf16_t* Z = (bf16_t*)(p->ws + WS_Z);
    for (int r = gw; r < NROWS; r += ngw) {
#pragma unroll
        for (int j = 0; j < 2; ++j) { u32x4* zp = (u32x4*)(Z + (size_t)r * 1024 + j * 512 + lane * 8); const u32x4 w = *zp;
            float f[8] = {lo_f(w[0]), hi_f(w[0]), lo_f(w[1]), hi_f(w[1]), lo_f(w[2]), hi_f(w[2]), lo_f(w[3]), hi_f(w[3])};
            float ss = 0.f;
#pragma unroll
            for (int i = 0; i < 8; ++i) ss += f[i] * f[i];
            const float rs = rsqrtf(wave_sum(ss) * (1.f / 512.f) + EPS);
            u32x4 o; o[0] = pk2(f[0] * rs, f[1] * rs); o[1] = pk2(f[2] * rs, f[3] * rs); o[2] = pk2(f[4] * rs, f[5] * rs); o[3] = pk2(f[6] * rs, f[7] * rs); *zp = o; }
    }
}
__device__ __forceinline__ void phase_prep(CPar p, int l) {
    const size_t gtid = (size_t)lbid() * 512 + ltid(), gsz = (size_t)lgdim() * 512;
    unsigned char* ws = p->ws;
    prep_w<1>((bf16_t*)(ws + W_BT1), p->in[I_WIN] + (size_t)l * 1024 * IN_COLS, 1024, N1, IN_COLS, nullptr, gtid, gsz);
    prep_w<2>((bf16_t*)(ws + W_GLU), p->in[I_WGLU] + (size_t)l * 512 * 2048, 512, 2048, 2048, nullptr, gtid, gsz);
    prep_w<0, true>((bf16_t*)(ws + W_LA), p->in[I_WLA] + (size_t)l * 1024 * 1024, 1024, 1024, 1024, p->in[I_NSSD] + l * 1024, gtid, gsz);
    prep_w<0, true>((bf16_t*)(ws + W_LC), p->in[I_WLC] + (size_t)l * 512 * 1024, 512, 1024, 1024, nullptr, gtid, gsz);
    prep_w<0>((bf16_t*)(ws + W_OUT), p->in[I_WOUT] + (size_t)l * 1024 * 1024, 1024, 1024, 1024, nullptr, gtid, gsz);
    prep_w<0, true>((bf16_t*)(ws + W_UP), p->in[I_WUP] + (size_t)l * 1024 * 4096, 1024, 4096, 4096, p->in[I_NFFN] + l * 1024, gtid, gsz);
    prep_w<0>((bf16_t*)(ws + W_DOWN), p->in[I_WDOWN] + (size_t)l * 4096 * 1024, 4096, 1024, 1024, nullptr, gtid, gsz);
    rmsnorm_rows(p, p->in[I_NMIX] + l * 1024, l == 0);
}

__device__ __forceinline__ bf16_t f2bf_(float v) { return (bf16_t)(pk2(v, v) & 0xffffu); }
__device__ __forceinline__ void ssd_item(CPar p, int l, int item, float* sm) {
    const int tid = ltid(), lane = tid & 63, wave = __builtin_amdgcn_readfirstlane(tid >> 6), rb = wave >> 1, chh = wave & 1, fr = lane & 15, fq = lane >> 4;
    const int s = item < 512 ? (item >> 4) : 32 + ((item - 512) >> 4), h = item & 15, g = h >> 3;
    const bool prompt = s < 32; const int b = prompt ? s : s - 32, T = prompt ? TP : TS;
    constexpr int LB = 72;
    bf16_t *Cb = (bf16_t*)sm, *Bb = Cb + 64 * LB, *XT = Bb + 64 * LB, *WB = XT + 64 * LB, *Mb = WB + 64 * LB, *Sb = Mb + 64 * LB;
    float *sRaw = (float*)(Sb + 64 * LB), *sW = sRaw + 67 * 192, *sdtA = sW + 5 * 192, *sacA = sdtA + 33 * 64, *sw = sacA + 33 * 64;
    const bf16_t* XBC = (const bf16_t*)(p->ws + WS_XBC); bf16_t* Z = (bf16_t*)(p->ws + WS_Z);
    const float* DT = (const float*)(p->ws + WS_DT);
    const float* cw = p->in[I_CONVW] + (size_t)l * 4 * 1280; const float* cb = p->in[I_CONVB] + (size_t)l * 1280;
    const float* hist = p->in[I_SCONV] + (size_t)(l * 16 + b) * 3 * 1280;
    const float dtb = p->in[I_DTB][l * 16 + h], aneg = -__expf(p->in[I_ALOG][l * 16 + h]), dsk = p->in[I_DSSD][l * 16 + h];
    float* sout = prompt ? p->out + O_SSDP + ((size_t)(l * 32 + b) * 16 + h) * 4096 : p->out + O_SSDS + ((size_t)(l * 16 + b) * 16 + h) * 4096;
    for (int i = tid; i < 5 * 192; i += 512) { const int k = i / 192, ch = i - k * 192; const int col = ch < 64 ? h * 64 + ch : (ch < 128 ? 1024 + g * 64 + (ch - 64) : 1152 + g * 64 + (ch - 128));
        sW[i] = k < 4 ? cw[k * 1280 + col] : cb[col]; }
    f32x4 accS[2];
#pragma unroll
    for (int c2 = 0; c2 < 2; ++c2)
#pragma unroll
        for (int r = 0; r < 4; ++r) { const int pp = rb * 16 + fq * 4 + r, n = chh * 32 + c2 * 16 + fr;
            const float v = prompt ? 0.f : p->in[I_SSSD][((size_t)(l * 16 + b) * 16 + h) * 4096 + pp * 64 + n]; accS[c2][r] = v; Sb[pp * LB + n] = f2bf_(v); }
    const int nch = (T + 63) >> 6;
    { const int wv = tid >> 6, ln = tid & 63; float xv[5];
#pragma unroll
        for (int r = 0; r < 5; ++r) { const int c = wv + 8 * r, t = c * 64 + ln; xv[r] = (c < nch && t < T) ? DT[(size_t)row_of(s, t) * 16 + h] + dtb : -1e30f; }
#pragma unroll
        for (int r = 0; r < 5; ++r) { const int c = wv + 8 * r;
            if (c < nch) { const float x = xv[r]; const float dtv = x < -1e29f ? 0.f : (x > 20.f ? x : log1pf(__expf(x))); float cs = dtv * aneg;
#pragma unroll
                for (int o = 1; o < 64; o <<= 1) { const float nb = __shfl_up(cs, o); if (ln >= o) cs += nb; }
                sdtA[c * 64 + ln] = dtv; sacA[c * 64 + ln] = cs; } } }
    u32x4 pf[4];
#define SSD_ISSUE(cc) do { _Pragma("unroll") for (int it4 = 0; it4 < 4; ++it4) { const int pi = tid + it4 * 512; pf[it4] = (u32x4){0u, 0u, 0u, 0u}; \
        if (pi < 67 * 24) { const int rl = pi / 24, pc = pi - rl * 24, seg = pc >> 3, q8 = pc & 7, tt = (cc) * 64 - 3 + rl; \
            const int col = (seg == 0 ? h * 64 : (seg == 1 ? 1024 + g * 64 : 1152 + g * 64)) + q8 * 8; \
            if (tt >= 0 && tt < T) pf[it4] = *(const u32x4*)(XBC + (size_t)row_of(s, tt) * 1280 + col); } } } while (0)
#define SSD_FRAG(P, r0, ks) (*(const bf16x8*)((P) + ((r0) + fr) * LB + (ks) * 32 + fq * 8))
    SSD_ISSUE(0);
#pragma unroll 1
    for (int c = 0; c < nch; ++c) {
        const int t0 = c * 64; const float* sdt = sdtA + t0; const float* sac = sacA + t0;
        __syncthreads();
#pragma unroll
        for (int it4 = 0; it4 < 4; ++it4) { const int pi = tid + it4 * 512;
            if (pi < 67 * 24) { const int rl = pi / 24, pc = pi - rl * 24, seg = pc >> 3, q8 = pc & 7, tt = t0 - 3 + rl;
                const u32x4 w = pf[it4];
                f32x4 f0 = {lo_f(w[0]), hi_f(w[0]), lo_f(w[1]), hi_f(w[1])}, f1 = {lo_f(w[2]), hi_f(w[2]), lo_f(w[3]), hi_f(w[3])};
                if (tt < 0 && !prompt) { const int col = (seg == 0 ? h * 64 : (seg == 1 ? 1024 + g * 64 : 1152 + g * 64)) + q8 * 8; const float* hp = hist + (3 + tt) * 1280 + col; f0 = *(const f32x4*)hp; f1 = *(const f32x4*)(hp + 4); }
                float* dp = sRaw + rl * 192 + seg * 64 + q8 * 8; *(f32x4*)dp = f0; *(f32x4*)(dp + 4) = f1; } }
        if (tid < 64) sw[tid] = __expf(sac[63] - sac[tid]) * sdt[tid];
        if (c + 1 < nch) SSD_ISSUE(c + 1);
        bf16_t zq[2][4];
#pragma unroll
        for (int c2 = 0; c2 < 2; ++c2)
#pragma unroll
            for (int r = 0; r < 4; ++r) { const int t = t0 + rb * 16 + fq * 4 + r; zq[c2][r] = (t < T) ? Z[(size_t)row_of(s, t) * 1024 + h * 64 + chh * 32 + c2 * 16 + fr] : (bf16_t)0; }
        __syncthreads();
        if (tid < 384) { const int ch = tid % 192, tlb = (tid / 192) * 32, cc = ch & 63;
            const float w0 = sW[ch], w1 = sW[192 + ch], w2 = sW[384 + ch], w3 = sW[576 + ch], bias = sW[768 + ch];
            float r0 = sRaw[(tlb + 0) * 192 + ch], r1 = sRaw[(tlb + 1) * 192 + ch], r2 = sRaw[(tlb + 2) * 192 + ch];
            float ov[32];
#pragma unroll
            for (int i2 = 0; i2 < 32; ++i2) { const float r3 = sRaw[(tlb + i2 + 3) * 192 + ch];
                const float v = bias + w0 * r0 + w1 * r1 + w2 * r2 + w3 * r3; ov[i2] = (t0 + tlb + i2 < T) ? siluf_(v) : 0.f; r0 = r1; r1 = r2; r2 = r3; }
            if (ch < 128) { bf16_t* dst = (ch < 64 ? XT : WB) + cc * LB + tlb;
#pragma unroll
                for (int q4 = 0; q4 < 4; ++q4) { u32x4 w;
#pragma unroll
                    for (int c4 = 0; c4 < 4; ++c4) { const int i2 = q4 * 8 + c4 * 2; const float s0 = ch < 64 ? 1.f : sw[tlb + i2], s1 = ch < 64 ? 1.f : sw[tlb + i2 + 1]; w[c4] = pk2(ov[i2] * s0, ov[i2 + 1] * s1); }
                    *(u32x4*)(dst + q4 * 8) = w; } }
            if (ch >= 64) { bf16_t* dst = (ch < 128 ? Bb : Cb) + tlb * LB + cc;
#pragma unroll
                for (int i2 = 0; i2 < 32; ++i2) dst[i2 * LB] = f2bf_(ov[i2]); } }
        __syncthreads();
        f32x4 acc2[2];
        { const bf16x8 aC0 = SSD_FRAG(Cb, rb * 16, 0), aC1 = SSD_FRAG(Cb, rb * 16, 1);
#pragma unroll
            for (int c2 = 0; c2 < 2; ++c2) { const int j0 = chh * 32 + c2 * 16;
                f32x4 m = {0.f, 0.f, 0.f, 0.f};
                if (j0 <= rb * 16 + 15) { m = __builtin_amdgcn_mfma_f32_16x16x32_bf16(aC0, SSD_FRAG(Bb, j0, 0), m, 0, 0, 0); m = __builtin_amdgcn_mfma_f32_16x16x32_bf16(aC1, SSD_FRAG(Bb, j0, 1), m, 0, 0, 0); }
                const int j = j0 + fr; const float acj = sac[j], dtj = sdt[j];
#pragma unroll
                for (int r = 0; r < 4; ++r) { const int tl = rb * 16 + fq * 4 + r; Mb[tl * LB + j] = f2bf_(j <= tl ? m[r] * __expf(sac[tl] - acj) * dtj : 0.f); }
                f32x4 y = {0.f, 0.f, 0.f, 0.f};
                y = __builtin_amdgcn_mfma_f32_16x16x32_bf16(aC0, SSD_FRAG(Sb, j0, 0), y, 0, 0, 0); y = __builtin_amdgcn_mfma_f32_16x16x32_bf16(aC1, SSD_FRAG(Sb, j0, 1), y, 0, 0, 0);
#pragma unroll
                for (int r = 0; r < 4; ++r) y[r] *= __expf(sac[rb * 16 + fq * 4 + r]);
                acc2[c2] = y; }
            const bf16x8 aX0 = SSD_FRAG(XT, rb * 16, 0), aX1 = SSD_FRAG(XT, rb * 16, 1); const float eL = __expf(sac[63]);
#pragma unroll
            for (int c2 = 0; c2 < 2; ++c2) { const int n0 = chh * 32 + c2 * 16; f32x4 sv = accS[c2] * eL;
                sv = __builtin_amdgcn_mfma_f32_16x16x32_bf16(aX0, SSD_FRAG(WB, n0, 0), sv, 0, 0, 0); sv = __builtin_amdgcn_mfma_f32_16x16x32_bf16(aX1, SSD_FRAG(WB, n0, 1), sv, 0, 0, 0); accS[c2] = sv; } }
        __syncthreads();
        { const bf16x8 aM0 = SSD_FRAG(Mb, rb * 16, 0), aM1 = SSD_FRAG(Mb, rb * 16, 1);
#pragma unroll
            for (int c2 = 0; c2 < 2; ++c2) { const int p0 = chh * 32 + c2 * 16, pp = p0 + fr; f32x4 y = acc2[c2];
                y = __builtin_amdgcn_mfma_f32_16x16x32_bf16(aM0, SSD_FRAG(XT, p0, 0), y, 0, 0, 0); y = __builtin_amdgcn_mfma_f32_16x16x32_bf16(aM1, SSD_FRAG(XT, p0, 1), y, 0, 0, 0);
#pragma unroll
                for (int r = 0; r < 4; ++r) { const int tl = rb * 16 + fq * 4 + r, t = t0 + tl;
                    if (t < T) { bf16_t* zp = Z + (size_t)row_of(s, t) * 1024 + h * 64 + pp; const float yy = (y[r] + dsk * bf2f(XT[pp * LB + tl])) * siluf_(bf2f(zq[c2][r])); *zp = f2bf_(yy); } } }
#pragma unroll
            for (int c2 = 0; c2 < 2; ++c2)
#pragma unroll
                for (int r = 0; r < 4; ++r) Sb[(rb * 16 + fq * 4 + r) * LB + chh * 32 + c2 * 16 + fr] = f2bf_(accS[c2][r]); }
    }
    __syncthreads();
#pragma unroll
    for (int c2 = 0; c2 < 2; ++c2)
#pragma unroll
        for (int r = 0; r < 4; ++r) sout[(rb * 16 + fq * 4 + r) * 64 + chh * 32 + c2 * 16 + fr] = accS[c2][r];
    float* cout_ = prompt ? p->out + O_CONVP + (size_t)(l * 32 + b) * 3 * 1280 : p->out + O_CONVS + (size_t)(l * 16 + b) * 3 * 1280;
    for (int idx = tid; idx < 3 * 192; idx += 512) { const int k = idx / 192, ch = idx - k * 192;
        if (ch >= 64 && (h & 7) != 0) continue;
        const int col = ch < 64 ? h * 64 + ch : (ch < 128 ? 1024 + g * 64 + (ch - 64) : 1152 + g * 64 + (ch - 128));
        cout_[k * 1280 + col] = bf2f(XBC[(size_t)row_of(s, T - 3 + k) * 1280 + col]); }
    __syncthreads();
#undef SSD_ISSUE
#undef SSD_FRAG
}

__device__ __forceinline__ void s5_item(CPar p, int l, int s, int g, float* wl) {
    const int lane = ltid() & 63, fr = lane & 15, fq = lane >> 4;
    const bool prompt = s < 32; const int b = prompt ? s : s - 32, T = prompt ? TP : TS, nblk = T >> 4;
    constexpr int LBX = 136;
    bf16_t* Xb = (bf16_t*)wl;
    bf16_t* U = (bf16_t*)(p->ws + WS_U);
    const int gp = (l * 32 + g) * 64 + lane;
    const float lr = p->in[I_LRE][gp], li = p->in[I_LIM][gp], step = expf(p->in[I_LSTEP][l * 32 + g]);
    float sn, cs; sincos_red((double)li * (double)step, sn, cs);
    const float mag = expf(lr * step), ab_re = mag * cs, ab_im = mag * sn;
    const float den = lr * lr + li * li, nr = ab_re - 1.f, f_re = (nr * lr + ab_im * li) / den, f_im = (ab_im * lr - nr * li) / den;
    float bbr[16], bbi[16];
#pragma unroll
    for (int hh = 0; hh < 16; ++hh) { const float br = p->in[I_BRE][(size_t)gp * 16 + hh], bi = p->in[I_BIM][(size_t)gp * 16 + hh]; bbr[hh] = f_re * br - f_im * bi; bbi[hh] = f_re * bi + f_im * br; }
    bf16x8 cfrag[4];
#pragma unroll
    for (int ks = 0; ks < 4; ++ks) { const int k0 = ks * 32 + fq * 8; const bool im = k0 >= 64;
        const float* cp = (im ? p->in[I_CIM] : p->in[I_CRE]) + ((size_t)(l * 32 + g) * 16 + fr) * 64 + (k0 & 63);
        const f32x4 c0 = *(const f32x4*)cp, c1 = *(const f32x4*)(cp + 4); const float sg = im ? -1.f : 1.f;
        u32x4 w; w[0] = pk2(sg * c0[0], sg * c0[1]); w[1] = pk2(sg * c0[2], sg * c0[3]); w[2] = pk2(sg * c1[0], sg * c1[1]); w[3] = pk2(sg * c1[2], sg * c1[3]);
        cfrag[ks] = __builtin_bit_cast(bf16x8, w); }
    float xr = prompt ? 0.f : p->in[I_S5R][(size_t)(l * 16 + b) * 2048 + g * 64 + lane], xi = prompt ? 0.f : p->in[I_S5I][(size_t)(l * 16 + b) * 2048 + g * 64 + lane];
    const float dsk = p->in[I_DS5][(size_t)(l * 32 + g) * 16 + fr];
    u32x4 ua = {0, 0, 0, 0}, ub = {0, 0, 0, 0};
    { const int r0 = row_of(s, 0); if (lane < 16) { const u32x4* up = (const u32x4*)(U + (size_t)(r0 + lane) * 512 + g * 16); ua = up[0]; ub = up[1]; } }
    for (int blk = 0; blk < nblk; ++blk) {
        const int r0 = row_of(s, blk * 16);
        const u32x4 ca = ua, cbv = ub;
        if (blk + 1 < nblk && lane < 16) { const int r1 = row_of(s, blk * 16 + 16); const u32x4* up = (const u32x4*)(U + (size_t)(r1 + lane) * 512 + g * 16); ua = up[0]; ub = up[1]; }
#pragma unroll
        for (int i = 0; i < 16; ++i) {
            float br4[4] = {0.f, 0.f, 0.f, 0.f}, bi4[4] = {0.f, 0.f, 0.f, 0.f};
#pragma unroll
            for (int w = 0; w < 8; ++w) { const unsigned word = (unsigned)__builtin_amdgcn_readlane((int)(w < 4 ? ca[w] : cbv[w - 4]), i);
                const float u0 = lo_f(word), u1 = hi_f(word);
                br4[w & 3] += bbr[2 * w] * u0 + bbr[2 * w + 1] * u1; bi4[w & 3] += bbi[2 * w] * u0 + bbi[2 * w + 1] * u1; }
            const float bur = (br4[0] + br4[1]) + (br4[2] + br4[3]), bui = (bi4[0] + bi4[1]) + (bi4[2] + bi4[3]);
            const float nxr = ab_re * xr - ab_im * xi + bur, nxi = ab_re * xi + ab_im * xr + bui; xr = nxr; xi = nxi;
            Xb[i * LBX + lane] = f2bf_(xr); Xb[i * LBX + 64 + lane] = f2bf_(xi);
        }
        __builtin_amdgcn_wave_barrier(); asm volatile("s_waitcnt lgkmcnt(0)" ::: "memory");
        f32x4 y = {0.f, 0.f, 0.f, 0.f};
#pragma unroll
        for (int ks = 0; ks < 4; ++ks) y = __builtin_amdgcn_mfma_f32_16x16x32_bf16(*(const bf16x8*)(Xb + fr * LBX + ks * 32 + fq * 8), cfrag[ks], y, 0, 0, 0);
#pragma unroll
        for (int r = 0; r < 4; ++r) { bf16_t* up = U + (size_t)(r0 + fq * 4 + r) * 512 + g * 16 + fr; *up = f2bf_(geluf_(y[r] + dsk * bf2f(*up))); }
        __builtin_amdgcn_wave_barrier(); asm volatile("s_waitcnt lgkmcnt(0)" ::: "memory");
    }
    float* ore = prompt ? p->out + O_S5RP + (size_t)(l * 32 + b) * 2048 : p->out + O_S5RS + (size_t)(l * 16 + b) * 2048;
    float* oim = prompt ? p->out + O_S5IP + (size_t)(l * 32 + b) * 2048 : p->out + O_S5IS + (size_t)(l * 16 + b) * 2048;
    ore[g * 64 + lane] = xr; oim[g * 64 + lane] = xi;
}

typedef __bf16 bf2_t __attribute__((ext_vector_type(2)));
__device__ __forceinline__ float dot2bf(unsigned a, unsigned b, float c) { return __builtin_amdgcn_fdot2_f32_bf16(__builtin_bit_cast(bf2_t, a), __builtin_bit_cast(bf2_t, b), c, false); }
__device__ __forceinline__ void attn_item(CPar p, int l, int item, float* wl) {
    const int lane = ltid() & 63;
    int s, h, qt;
    if (item < 8448) { s = item / 264; const int rem = item - s * 264; h = rem / 33; qt = rem - h * 33; } else { const int it = item - 8448; s = 32 + (it >> 3); h = it & 7; qt = 0; }
    const bool prompt = s < 32; const int b = prompt ? s : s - 32, T = prompt ? TP : TS, nh = prompt ? 0 : PAST;
    const int i = qt * 64 + lane; const bool active = i < T; const int row = row_of(s, active ? i : T - 1);
    bf16_t* Q = (bf16_t*)(p->ws + WS_Q);
    unsigned* Kt = (unsigned*)wl; unsigned* Vp = Kt + 32 * 32;
    unsigned q[32]; float o[64];
    { const u32x4* qp = (const u32x4*)(Q + (size_t)row * 512 + h * 64);
#pragma unroll
        for (int e = 0; e < 8; ++e) { const u32x4 w = qp[e];
#pragma unroll
            for (int j = 0; j < 4; ++j) q[e * 4 + j] = pk2(lo_f(w[j]) * 0.125f, hi_f(w[j]) * 0.125f); } }
#pragma unroll
    for (int d = 0; d < 64; ++d) o[d] = 0.f;
    const float* kp_new = prompt ? p->out + O_KP + (size_t)(l * 32 + b) * 2064 * 512 + h * 64 : p->out + O_KS + (size_t)(l * 16 + b) * 64 * 512 + h * 64;
    const float* vp_new = prompt ? p->out + O_VP + (size_t)(l * 32 + b) * 2064 * 512 + h * 64 : p->out + O_VS + (size_t)(l * 16 + b) * 64 * 512 + h * 64;
    const float* kp_old = p->in[I_CK] + (size_t)(l * 16 + b) * 2048 * 512 + h * 64;
    const float* vp_old = p->in[I_CV] + (size_t)(l * 16 + b) * 2048 * 512 + h * 64;
    const int imax = (qt * 64 + 63 < T - 1) ? qt * 64 + 63 : T - 1;
    const int jtop = nh + imax - 1;
    float run = 0.f;
    f32x4 kreg[8], va[4], vb[4];
#define ATT_FETCH(JT) do { _Pragma("unroll") for (int e = 0; e < 8; ++e) { const int idx = e * 64 + lane, kr = idx >> 4, pc = idx & 15, j = (JT) - kr; kreg[e] = (f32x4){0.f, 0.f, 0.f, 0.f}; \
            if (j >= 0) { const float* kp = (j < nh) ? kp_old + (size_t)j * 512 : kp_new + (size_t)(j - nh) * 512; kreg[e] = *(const f32x4*)(kp + pc * 4); } } \
        _Pragma("unroll") for (int e = 0; e < 4; ++e) { const int idx = e * 64 + lane, m = idx >> 4, pc = idx & 15, j0 = (JT) - 2 * m, j1 = j0 - 1; va[e] = (f32x4){0.f, 0.f, 0.f, 0.f}; vb[e] = (f32x4){0.f, 0.f, 0.f, 0.f}; \
            if (j0 >= 0) { const float* vp = (j0 < nh) ? vp_old + (size_t)j0 * 512 : vp_new + (size_t)(j0 - nh) * 512; va[e] = *(const f32x4*)(vp + pc * 4); } \
            if (j1 >= 0) { const float* vp = (j1 < nh) ? vp_old + (size_t)j1 * 512 : vp_new + (size_t)(j1 - nh) * 512; vb[e] = *(const f32x4*)(vp + pc * 4); } } } while (0)
    if (jtop >= 0) ATT_FETCH(jtop);
    for (int jt = jtop; jt >= 0; jt -= 32) {
#pragma unroll
        for (int e = 0; e < 8; ++e) { const int idx = e * 64 + lane, kr = idx >> 4, pc = idx & 15; u32x2 w; w[0] = pk2(kreg[e][0], kreg[e][1]); w[1] = pk2(kreg[e][2], kreg[e][3]); *(u32x2*)(Kt + kr * 32 + pc * 2) = w; }
#pragma unroll
        for (int e = 0; e < 4; ++e) { const int idx = e * 64 + lane, m = idx >> 4, pc = idx & 15;
            u32x4 w; w[0] = pk2(va[e][0], vb[e][0]); w[1] = pk2(va[e][1], vb[e][1]); w[2] = pk2(va[e][2], vb[e][2]); w[3] = pk2(va[e][3], vb[e][3]); *(u32x4*)(Vp + m * 64 + pc * 4) = w; }
        __builtin_amdgcn_wave_barrier(); asm volatile("s_waitcnt lgkmcnt(0)" ::: "memory");
        if (jt - 32 >= 0) ATT_FETCH(jt - 32);
        const int nk = jt + 1 < 32 ? jt + 1 : 32, npair = (nk + 1) >> 1;
        for (int m = 0; m < npair; ++m) { const int j0 = jt - 2 * m, j1 = j0 - 1;
            float z0 = 0.f, z1 = 0.f;
#pragma unroll
            for (int d8 = 0; d8 < 8; ++d8) { const u32x4 k0 = *(const u32x4*)(Kt + (2 * m) * 32 + d8 * 4), k1 = *(const u32x4*)(Kt + (2 * m + 1) * 32 + d8 * 4);
#pragma unroll
                for (int c = 0; c < 4; ++c) { z0 = dot2bf(q[d8 * 4 + c], k0[c], z0); z1 = dot2bf(q[d8 * 4 + c], k1[c], z1); } }
            const bool v0 = active && (j0 < nh + i), v1 = active && (j1 >= 0) && (j1 < nh + i);
            const float e0 = __expf(-z0), ls0 = -__logf(1.f + e0);
            const float w0 = v0 ? __expf(ls0 + run) : 0.f; run += v0 ? (ls0 - z0) : 0.f;
            const float e1 = __expf(-z1), ls1 = -__logf(1.f + e1);
            const float w1 = v1 ? __expf(ls1 + run) : 0.f; run += v1 ? (ls1 - z1) : 0.f;
            const unsigned wp = pk2(w0, w1);
#pragma unroll
            for (int d4 = 0; d4 < 16; ++d4) { const u32x4 vv = *(const u32x4*)(Vp + m * 64 + d4 * 4);
#pragma unroll
                for (int c = 0; c < 4; ++c) o[d4 * 4 + c] = dot2bf(wp, vv[c], o[d4 * 4 + c]); } }
        __builtin_amdgcn_wave_barrier(); asm volatile("s_waitcnt lgkmcnt(0)" ::: "memory");
        const int fin = (!active) || (run < -50.f);
        if (__all(fin)) break;
    }
#undef ATT_FETCH
    if (active) { u32x4* op = (u32x4*)(Q + (size_t)row * 512 + h * 64);
#pragma unroll
        for (int e = 0; e < 8; ++e) { u32x4 w; w[0] = pk2(o[e * 8], o[e * 8 + 1]); w[1] = pk2(o[e * 8 + 2], o[e * 8 + 3]); w[2] = pk2(o[e * 8 + 4], o[e * 8 + 5]); w[3] = pk2(o[e * 8 + 6], o[e * 8 + 7]); op[e] = w; } }
}

__device__ __forceinline__ void phase_mixers(CPar p, int l, float* sm) {
#ifndef SKIP_SSD
    { CPar p1 = params_ptr();
#pragma unroll 1
      for (int it = lbid(); it < 768; it += lgdim()) ssd_item(p1, l, it, sm); }
#endif
    __syncthreads();
    const int wave = __builtin_amdgcn_readfirstlane(ltid() >> 6);
    float* wl = sm + wave * (68 * 64);
#ifndef SKIP_S5
    { CPar p2 = params_ptr();
    if (wave < 4) { for (int it = lbid() * 4 + wave; it < 1024; it += lgdim() * 4) s5_item(p2, l, it >> 5, it & 31, wl); }
    else if (wave < 6) { for (int it = lbid() * 2 + (wave - 4); it < 512; it += lgdim() * 2) s5_item(p2, l, 32 + (it >> 5), it & 31, wl); } }
#endif
#ifndef SKIP_ATT
    CPar p3 = params_ptr();
    unsigned* ctr = (unsigned*)(p3->ws + WS_CTR) + l;
    for (;;) {
        unsigned it = 0; if ((ltid() & 63) == 0) it = atomicAdd(ctr, 1u);
        it = (unsigned)__builtin_amdgcn_readfirstlane((int)it);
        if (it >= 8576u) break;
        attn_item(p3, l, (int)it, wl);
    }
#endif
}

#define XB_TMO      128
#define XB_XCNT(j)  (256  + 64 * (j))
#define XB_XSUB(j)  (1280 + 64 * (j))
#define XB_XGEN(j)  (2304 + 64 * (j))
#define XB_TOP      3328
#define XB_TOPGEN   3392
#define XCD_BAR_WORDS 3456
#define XB_SPIN_CAP (1u << 18)

__device__ __forceinline__ unsigned xb_ld(unsigned* p)              { return __hip_atomic_load(p, __ATOMIC_RELAXED, __HIP_MEMORY_SCOPE_AGENT); }
__device__ __forceinline__ unsigned xb_add(unsigned* p, unsigned v) { return __hip_atomic_fetch_add(p, v, __ATOMIC_RELAXED, __HIP_MEMORY_SCOPE_AGENT); }
__device__ __forceinline__ unsigned xb_xcc_id() { return (unsigned)__builtin_amdgcn_s_getreg((3 << 11) | 20) & 0xFu; }
#define XB_SPIN(cond, bar) do { unsigned _sp = 0; while (cond) { __builtin_amdgcn_s_sleep(1); \
    if ((++_sp & 255u) == 0u) { if (xb_ld(&(bar)[XB_TMO])) break; if (_sp > XB_SPIN_CAP) { atomicAdd(&(bar)[XB_TMO], 1u); break; } } } } while (0)

struct XcdBarrier {
    unsigned* bar; unsigned x;
    volatile LAS unsigned* st;
};

__device__ __forceinline__ XcdBarrier xcd_barrier_post(unsigned* bar, volatile LAS unsigned* st) {
    XcdBarrier b; b.bar = bar; b.x = xb_xcc_id(); b.st = st;
    if (threadIdx.x == 0) (void)xb_add(&bar[XB_XCNT(b.x)], 1u);
    return b;
}
__device__ __forceinline__ void xcd_barrier_complete(unsigned* bar, unsigned x, unsigned& nloc, unsigned& nx) {
    const unsigned G = gridDim.x * gridDim.y * gridDim.z;
    unsigned sum, cnt, mine, sp = 0u;
    for (;;) {
        sum = 0u; cnt = 0u; mine = 0u;
#pragma unroll
        for (unsigned j = 0; j < 16; ++j) { const unsigned c = xb_ld(&bar[XB_XCNT(j)]); sum += c; cnt += (c > 0u) ? 1u : 0u; mine = (j == x) ? c : mine; }
        if (sum == G) break;
        __builtin_amdgcn_s_sleep(1);
        if ((++sp & 255u) == 0u) { if (xb_ld(&bar[XB_TMO])) break; if (sp > XB_SPIN_CAP) { atomicAdd(&bar[XB_TMO], 1u); break; } }
    }
    nloc = mine > 0u ? mine : 1u; nx = cnt > 0u ? cnt : 1u;
}

__device__ __forceinline__ void xcd_barrier(const XcdBarrier& b) {
    asm volatile("s_waitcnt vmcnt(0)" ::: "memory");
    __syncthreads();
    if (threadIdx.x == 0) {
        unsigned* bar = b.bar;
        __builtin_amdgcn_s_waitcnt(0);
        unsigned nloc = b.st[0], nx = b.st[1];
        if (nloc == 0u) { xcd_barrier_complete(bar, b.x, nloc, nx); b.st[0] = nloc; b.st[1] = nx; }
        const unsigned old = xb_add(&bar[XB_XSUB(b.x)], 1u);
        const unsigned gen = old / nloc;
        if (old + 1u == (gen + 1u) * nloc) {
            __builtin_amdgcn_fence(__ATOMIC_RELEASE, "agent");
            asm volatile("s_waitcnt vmcnt(0)" ::: "memory");
            const unsigned og = xb_add(&bar[XB_TOP], 1u);
            const unsigned tg = og / nx;
            if (og + 1u == (tg + 1u) * nx) xb_add(&bar[XB_TOPGEN], 1u);
            else XB_SPIN(xb_ld(&bar[XB_TOPGEN]) == tg, bar);
            __builtin_amdgcn_fence(__ATOMIC_ACQUIRE, "agent");
            xb_add(&bar[XB_XGEN(b.x)], 1u);
            asm volatile("s_waitcnt vmcnt(0)" ::: "memory");
        } else {
            XB_SPIN(xb_ld(&bar[XB_XGEN(b.x)]) == gen, bar);
            __builtin_amdgcn_fence(__ATOMIC_ACQUIRE, "agent");
            asm volatile("s_waitcnt vmcnt(0)" ::: "memory");
        }
    }
    __syncthreads();
}
__global__ __launch_bounds__(512, 2) void mega(Params pk) {
    extern __shared__ __attribute__((aligned(16))) unsigned char smem[];
    cg::grid_group grid = cg::this_grid();
    LAS unsigned char* lds = (LAS unsigned char*)smem;
    const int ph_lo = pk.ph_lo, ph_hi = pk.ph_hi;
    volatile LAS unsigned* xst = (volatile LAS unsigned*)(lds + (LDS_BYTES - 16));
    if (threadIdx.x == 0) { xst[0] = 0u; xst[1] = 0u; }
    const XcdBarrier xb = xcd_barrier_post((unsigned*)(pk.ws + WS_SSQ), xst);
    for (int ph = ph_lo; ph < ph_hi; ++ph) {
        if (ph == ph_lo + 1) grid.sync();
        else if (ph > ph_lo + 1) xcd_barrier(xb);
        CPar p = params_ptr();
        unsigned char* ws = p->ws;
        bf16_t *HB = (bf16_t*)(ws + WS_HB), *Z = (bf16_t*)(ws + WS_Z), *XBC = (bf16_t*)(ws + WS_XBC), *U = (bf16_t*)(ws + WS_U), *Q = (bf16_t*)(ws + WS_Q), *G = (bf16_t*)(ws + WS_G);
        float *DT = (float*)(ws + WS_DT), *XM = (float*)(ws + WS_XMETA);
        const int l = ph >> 3, sub = ph & 7;
        pg8::StaticOrder S;
        if (sub == 0) {
#ifndef SKIP0
            phase_prep(p, l);
#endif
        } else if (sub == 1) {
            S.init(NROWS, N1, lgdim(), lbid());
            EpiIn E{Z, XBC, U, Q, G, DT, p->out, p->in[I_QN] + l * 64, p->in[I_KN] + l * 64, l};
#ifndef SKIP1
            pg8::gemm_phase(lds, pg8::Gemm{HB, (const bf16_t*)(ws + W_BT1), NROWS, N1, 1024, 1024, 1024}, S, E);
#endif
        } else if (sub == 2) {
#ifndef SKIP2
            phase_mixers(p, l, (float*)smem);
#endif
        } else if (sub == 3) {
            ssd_norm_rows(p);
            S.init(NROWS, 2048, lgdim(), lbid());
            EpiGlu E{XBC};
            pg8::gemm_phase(lds, pg8::Gemm{U, (const bf16_t*)(ws + W_GLU), NROWS, 2048, 512, 512, 512}, S, E);
        } else if (sub == 4) {
            S.init(NROWS, 1024, lgdim(), lbid());
            for (int call = 0; call < 2; ++call) {
                EpiMix E; pg8::Gemm g;
                if (call == 0) { E = EpiMix{HB, G, XBC, 0}; g = pg8::Gemm{Z, (const bf16_t*)(ws + W_LA), NROWS, 1024, 1024, 1024, 1024}; }
                else { E = EpiMix{HB, G + 2048, nullptr, 1}; g = pg8::Gemm{Q, (const bf16_t*)(ws + W_LC), NROWS, 1024, 512, 512, 512}; }
#ifndef SKIP3
                pg8::gemm_phase(lds, g, S, E);
#endif
            }
        } else if (sub == 5) {
            S.init(NROWS, 1024, lgdim(), lbid());
            EpiRes E{p->out, XM, (bf16_t*)(ws + WS_XB2), (float*)(ws + WS_SSQX) + (size_t)l * NROWS, l == 0 ? p->in[I_XP] : nullptr, p->in[I_XS], p->in[I_META]};
            pg8::gemm_phase(lds, pg8::Gemm{HB, (const bf16_t*)(ws + W_OUT), NROWS, 1024, 1024, 1024, 1024}, S, E);
        } else if (sub == 6) {
            S.init(NROWS, 4096, lgdim(), lbid());
            EpiUp E{(bf16_t*)(ws + WS_ACT), (const float*)(ws + WS_SSQX) + (size_t)l * NROWS};
            pg8::gemm_phase(lds, pg8::Gemm{(const bf16_t*)(ws + WS_XB2), (const bf16_t*)(ws + W_UP), NROWS, 4096, 1024, 1024, 1024}, S, E);
        } else {
            S.init(NROWS, 1024, lgdim(), lbid());
            EpiRes E{p->out, XM, nullptr, nullptr, nullptr, nullptr, nullptr};
            pg8::gemm_phase(lds, pg8::Gemm{(const bf16_t*)(ws + WS_ACT), (const bf16_t*)(ws + W_DOWN), NROWS, 1024, 4096, 4096, 4096}, S, E);
        }
    }
}

extern "C" void kernel_launch(void* const* d_in, const int* in_sizes, int n_in, void* d_out, int out_size, void* d_ws, size_t ws_size, hipStream_t stream) {
    static int grid = 0;
    if (grid == 0) {
        if (n_in != 34 || (size_t)out_size != O_END || ws_size < WS_END) { fprintf(stderr, "kernel_launch: unexpected shapes n_in %d out %d ws %zu (need %zu)\n", n_in, out_size, ws_size, (size_t)WS_END); grid = -1; return; }
        int dev = 0, cus = 0, per_cu = 0;
        hipGetDevice(&dev); hipDeviceGetAttribute(&cus, hipDeviceAttributeMultiprocessorCount, dev);
        if (hipFuncSetAttribute((const void*)mega, hipFuncAttributeMaxDynamicSharedMemorySize, LDS_BYTES) != hipSuccess) { fprintf(stderr, "kernel_launch: hipFuncSetAttribute failed\n"); grid = -1; return; }
        if (hipOccupancyMaxActiveBlocksPerMultiprocessor(&per_cu, (const void*)mega, 512, LDS_BYTES) != hipSuccess || per_cu < 1) { fprintf(stderr, "kernel_launch: occupancy query says %d\n", per_cu); per_cu = 1; }
        (void)hipGetLastError();
        grid = cus * per_cu;
    }
    if (grid < 0) return;
    if (hipMemsetAsync((char*)d_ws + WS_CTR, 0, 4096, stream) != hipSuccess || hipMemsetAsync((char*)d_ws + WS_SSQ, 0, 16384 + 2ull * NROWS * 4, stream) != hipSuccess) { fprintf(stderr, "kernel_launch: memset failed\n"); return; }
    Params p{};
    for (int i = 0; i < 34; ++i) p.in[i] = (const float*)d_in[i];
    p.out = (float*)d_out; p.ws = (unsigned char*)d_ws;
#if MULTI_LAUNCH
    for (int ph = 0; ph < 16; ++ph) { p.ph_lo = ph; p.ph_hi = ph + 1; hipLaunchKernelGGL(mega, dim3(grid), dim3(512), LDS_BYTES, stream, p); }
#else
    p.ph_lo = 0; p.ph_hi = 16;
    void* args[] = {&p};
    hipError_t e = hipLaunchCooperativeKernel((const void*)mega, dim3(grid), dim3(512), args, LDS_BYTES, stream);
    if (e != hipSuccess) fprintf(stderr, "cooperative launch failed: %s (grid %d)\n", hipGetErrorString(e), grid);
#endif
}
```
